# Optimizing an MI355X kernel written in HIP

```python
import jax, jax.numpy as jnp
from jax import lax
import numpy as np


D_MODEL = 1024
BATCH = 8
SEQ = 2048
DEPTH = 1

HG_HEADS = 4
HG_DK = 128
HG_DV = 128
HG_WIDTH = HG_HEADS * HG_DV
HG_CHUNK = 64

MLA_HEADS = 4
MLA_Q_LORA = 384
MLA_KV_LORA = 256
MLA_NOPE = 128
MLA_ROPE = 64
MLA_QK = MLA_NOPE + MLA_ROPE
MLA_V = 128
MLA_WIDTH = MLA_HEADS * MLA_V
ATTN_BLOCK = 128
ROPE_THETA = 10000.0

MIX_WIDTH = HG_WIDTH + MLA_WIDTH
IN_SPLITS = (HG_HEADS * HG_DK, HG_HEADS * HG_DK, HG_HEADS * HG_DK, HG_WIDTH, HG_WIDTH,
             MLA_Q_LORA, MLA_KV_LORA, MLA_ROPE)
IN_WIDTH = 3 * HG_HEADS * HG_DK + 2 * HG_WIDTH + MLA_Q_LORA + MLA_KV_LORA + MLA_ROPE

PEER_HEADS = 8
PEER_NKEYS = 128
PEER_EXPERTS = PEER_NKEYS * PEER_NKEYS
PEER_TOPK = 16
PEER_DHALF = 128
PEER_DKEY = 2 * PEER_DHALF
PEER_BLOCK = 128

EPS = 1e-6

kernel_name = 'hybrid_hgrn2_mla_peer_encoder'


def rms_norm(x, gain):
    x32 = x.astype(jnp.float32)
    y = x32 * lax.rsqrt(jnp.mean(x32 * x32, axis=-1, keepdims=True) + EPS)
    return (y * gain.astype(jnp.float32)).astype(x.dtype)


def rope_tables(positions):
    inv_freq = 1.0 / (ROPE_THETA ** (jnp.arange(0, MLA_ROPE, 2, dtype=jnp.float32) / MLA_ROPE))
    ang = positions.astype(jnp.float32)[..., None] * inv_freq
    return jnp.cos(ang)[:, :, None, :], jnp.sin(ang)[:, :, None, :]


def apply_rope(t, cos, sin):
    half = MLA_ROPE // 2
    c = cos.astype(t.dtype)
    s = sin.astype(t.dtype)
    t1, t2 = t[..., :half], t[..., half:]
    return jnp.concatenate([t1 * c - t2 * s, t2 * c + t1 * s], axis=-1)


def hgrn2_chunk_scan(q, k, v, log_f):
    B, S, H, DK = q.shape
    DV = v.shape[-1]
    n = S // HG_CHUNK

    def to_chunks(t):
        return t.reshape(B, n, HG_CHUNK, H, t.shape[-1]).transpose(1, 0, 3, 2, 4)

    mask = jnp.tril(jnp.ones((HG_CHUNK, HG_CHUNK), dtype=bool))[:, :, None]

    def step(state, inp):
        qb, kb, vb, gb = inp
        b = jnp.cumsum(gb, axis=2)
        diff = b[:, :, :, None, :] - b[:, :, None, :, :]
        decay = jnp.exp(jnp.where(mask, diff, -jnp.inf))
        scores = jnp.einsum('bhtk,bhsk,bhtsk->bhts', qb, kb, decay)
        o = jnp.einsum('bhts,bhsv->bhtv', scores, vb) \
            + jnp.einsum('bhtk,bhkv->bhtv', qb * jnp.exp(b), state)
        b_last = b[:, :, -1:, :]
        new_state = jnp.exp(b_last[:, :, 0, :])[..., None] * state \
            + jnp.einsum('bhsk,bhsv->bhkv', kb * jnp.exp(b_last - b), vb)
        return new_state, o

    state0 = jnp.zeros((B, H, DK, DV), jnp.float32)
    _, o = lax.scan(step, state0, (to_chunks(q), to_chunks(k), to_chunks(v), to_chunks(log_f)))
    return o.transpose(1, 0, 3, 2, 4).reshape(B, S, H, DV)


def hgrn2_mixer(q_raw, f_fwd_raw, f_bwd_raw, i_raw, g_raw, lb, o_gain):
    B, S, _ = q_raw.shape
    q = jax.nn.silu(q_raw.reshape(B, S, HG_HEADS, HG_DK).astype(jnp.float32))
    v = i_raw.reshape(B, S, HG_HEADS, HG_DV).astype(jnp.float32)

    def direction(f_raw, lb_dir, reverse):
        lbh = lb_dir.reshape(HG_HEADS, HG_DK)
        f = lbh + (1.0 - lbh) * jax.nn.sigmoid(f_raw.reshape(B, S, HG_HEADS, HG_DK).astype(jnp.float32))
        k = 1.0 - f
        log_f = jnp.log(f)
        if reverse:
            o = hgrn2_chunk_scan(q[:, ::-1], k[:, ::-1], v[:, ::-1], log_f[:, ::-1])
            return o[:, ::-1]
        return hgrn2_chunk_scan(q, k, v, log_f)

    o = direction(f_fwd_raw, lb[0], False) + direction(f_bwd_raw, lb[1], True)
    gate = jax.nn.silu(g_raw.reshape(B, S, HG_HEADS, HG_DV).astype(jnp.float32))
    o = rms_norm(o, o_gain).astype(jnp.float32) * gate
    return o.reshape(B, S, HG_WIDTH).astype(q_raw.dtype)


def bidirectional_attention(q, k, v):
    B, S, H, DQ = q.shape
    nb = S // ATTN_BLOCK
    scale = DQ ** -0.5
    qb = q.reshape(B, nb, ATTN_BLOCK, H, DQ).transpose(1, 0, 2, 3, 4)

    def one_block(q_blk):
        s = jnp.einsum('bqhd,bkhd->bhqk', q_blk, k).astype(jnp.float32) * scale
        p = jax.nn.softmax(s, axis=-1).astype(v.dtype)
        return jnp.einsum('bhqk,bkhd->bqhd', p, v)

    o = lax.map(one_block, qb)
    return o.transpose(1, 0, 2, 3, 4).reshape(B, S, H, v.shape[-1])


def mla_mixer(cq_raw, ckv_raw, kr_raw, cos, sin, q_a_gain, w_q_up, kv_a_gain, w_kv_up,
              q_gain, k_gain, o_gain):
    B, S, _ = cq_raw.shape
    q = (rms_norm(cq_raw, q_a_gain) @ w_q_up).reshape(B, S, MLA_HEADS, MLA_QK)
    kv = (rms_norm(ckv_raw, kv_a_gain) @ w_kv_up).reshape(B, S, MLA_HEADS, MLA_NOPE + MLA_V)
    k_nope, v = kv[..., :MLA_NOPE], kv[..., MLA_NOPE:]
    q_nope = rms_norm(q[..., :MLA_NOPE], q_gain[:MLA_NOPE])
    q_rope = apply_rope(rms_norm(q[..., MLA_NOPE:], q_gain[MLA_NOPE:]), cos, sin)
    k_nope = rms_norm(k_nope, k_gain[:MLA_NOPE])
    k_rope = apply_rope(rms_norm(kr_raw.reshape(B, S, 1, MLA_ROPE), k_gain[MLA_NOPE:]), cos, sin)
    k_rope = jnp.broadcast_to(k_rope, (B, S, MLA_HEADS, MLA_ROPE))
    qf = jnp.concatenate([q_nope, q_rope], axis=-1)
    kf = jnp.concatenate([k_nope, k_rope], axis=-1)
    o = bidirectional_attention(qf, kf, v)
    o = rms_norm(o, o_gain)
    return o.reshape(B, S, MLA_WIDTH)


def peer_ffn(h, w_q, sub_keys, u_tab, v_tab):
    B, S, D = h.shape
    q = (h @ w_q).reshape(B, S, PEER_HEADS, 2, PEER_DHALF)
    scores = jnp.einsum('bspcd,pcnd->bspcn', q, sub_keys).astype(jnp.float32)
    s_top, i_top = lax.top_k(scores, PEER_TOPK)
    cand_s = (s_top[..., 0, :, None] + s_top[..., 1, None, :]).reshape(B, S, PEER_HEADS, PEER_TOPK * PEER_TOPK)
    cand_i = (i_top[..., 0, :, None] * PEER_NKEYS + i_top[..., 1, None, :]).reshape(B, S, PEER_HEADS, PEER_TOPK * PEER_TOPK)
    best_s, best_pos = lax.top_k(cand_s, PEER_TOPK)
    idx = jnp.take_along_axis(cand_i, best_pos, axis=-1)
    gates = jax.nn.softmax(best_s, axis=-1).astype(h.dtype)

    nb = (B * S) // PEER_BLOCK
    hb = h.reshape(nb, PEER_BLOCK, D)
    ib = idx.reshape(nb, PEER_BLOCK, PEER_HEADS, PEER_TOPK)
    gb = gates.reshape(nb, PEER_BLOCK, PEER_HEADS, PEER_TOPK)

    def one_block(args):
        hx, ix, gx = args
        act = jax.nn.gelu(jnp.einsum('td,tpkd->tpk', hx, u_tab[ix]), approximate=False)
        return jnp.einsum('tpk,tpkd->td', gx * act, v_tab[ix])

    y = lax.map(one_block, (hb, ib, gb))
    return y.reshape(B, S, D)


def setup_inputs(seed: int = 0) -> dict:
    key = jax.random.key(seed)
    ks = jax.random.split(key, 24)
    f32 = jnp.float32
    L = DEPTH

    def nrm(k, shape, scale):
        return jax.random.normal(k, shape, f32) * scale

    def gain(k, shape):
        return 1.0 + 0.02 * jax.random.normal(k, shape, f32)

    x = nrm(ks[0], (BATCH, SEQ, D_MODEL), 1.0)
    positions = (jnp.arange(SEQ, dtype=jnp.int32)[None, :]
                 + jax.random.randint(ks[1], (BATCH, 1), 0, 1024, dtype=jnp.int32))
    return {
        'x': x,
        'positions': positions,
        'attn_norm': gain(ks[2], (L, D_MODEL)),
        'w_in': nrm(ks[3], (L, D_MODEL, IN_WIDTH), D_MODEL ** -0.5),
        'hg_lb_logits': nrm(ks[4], (DEPTH + 1, 2, HG_HEADS * HG_DK), 0.5),
        'hg_o_norm': gain(ks[5], (L, HG_HEADS, HG_DV)),
        'q_a_norm': gain(ks[6], (L, MLA_Q_LORA)),
        'w_q_up': nrm(ks[7], (L, MLA_Q_LORA, MLA_HEADS * MLA_QK), MLA_Q_LORA ** -0.5),
        'kv_a_norm': gain(ks[8], (L, MLA_KV_LORA)),
        'w_kv_up': nrm(ks[9], (L, MLA_KV_LORA, MLA_HEADS * (MLA_NOPE + MLA_V)), MLA_KV_LORA ** -0.5),
        'q_norm': gain(ks[10], (L, MLA_QK)),
        'k_norm': gain(ks[11], (L, MLA_QK)),
        'mla_o_norm': gain(ks[12], (L, MLA_HEADS, MLA_V)),
        'w_out': nrm(ks[13], (L, MIX_WIDTH, D_MODEL), MIX_WIDTH ** -0.5),
        'ffn_norm': gain(ks[14], (L, D_MODEL)),
        'peer_w_q': nrm(ks[15], (L, D_MODEL, PEER_HEADS * PEER_DKEY), D_MODEL ** -0.5),
        'peer_sub_keys': nrm(ks[16], (L, PEER_HEADS, 2, PEER_NKEYS, PEER_DHALF), PEER_DHALF ** -0.5),
        'peer_u': nrm(ks[17], (L, PEER_EXPERTS, D_MODEL), D_MODEL ** -0.5),
        'peer_v': nrm(ks[18], (L, PEER_EXPERTS, D_MODEL), 0.3),
    }


def reference(x, positions, attn_norm, w_in, hg_lb_logits, hg_o_norm, q_a_norm, w_q_up,
              kv_a_norm, w_kv_up, q_norm, k_norm, mla_o_norm, w_out, ffn_norm,
              peer_w_q, peer_sub_keys, peer_u, peer_v):
    lower_bounds = jnp.cumsum(jax.nn.softmax(hg_lb_logits.astype(jnp.float32), axis=0), axis=0)
    cos, sin = rope_tables(positions)
    offsets = []
    acc = 0
    for w in IN_SPLITS[:-1]:
        acc += w
        offsets.append(acc)
    for l in range(DEPTH):
        h = rms_norm(x, attn_norm[l])
        proj = h @ w_in[l]
        hq, hf_fwd, hf_bwd, hi, hg, cq, ckv, kr = jnp.split(proj, offsets, axis=-1)
        y_hg = hgrn2_mixer(hq, hf_fwd, hf_bwd, hi, hg, lower_bounds[l], hg_o_norm[l])
        y_mla = mla_mixer(cq, ckv, kr, cos, sin, q_a_norm[l], w_q_up[l], kv_a_norm[l],
                          w_kv_up[l], q_norm[l], k_norm[l], mla_o_norm[l])
        x = x + jnp.concatenate([y_hg, y_mla], axis=-1) @ w_out[l]
        x = x + peer_ffn(rms_norm(x, ffn_norm[l]), peer_w_q[l], peer_sub_keys[l],
                         peer_u[l], peer_v[l])
    return x
```

```cpp
#include <hip/hip_runtime.h>
#include <hip/hip_cooperative_groups.h>
#include <cstdio>
#include <cstdint>
namespace cg = cooperative_groups;

#ifndef N_LAUNCH_MODE
#define N_LAUNCH_MODE 0
#endif
#ifndef STOP_AFTER
#define STOP_AFTER 99
#endif

typedef unsigned short bf16_t;
typedef short bf16x8 __attribute__((ext_vector_type(8)));
typedef float f32x4 __attribute__((ext_vector_type(4)));

constexpr int NT = 512;
constexpr int T = 16384, SEQ = 2048, NB = 8, DM = 1024, INW = 3264;
constexpr int OFF_Q = 0, OFF_FF = 512, OFF_FB = 1024, OFF_I = 1536, OFF_G = 2048, OFF_CQ = 2560, OFF_CKV = 2944, OFF_KR = 3200;
constexpr float EPS = 1e-6f;

constexpr size_t WS_CTL = 0;
constexpr size_t WS_WIN_T = 65536;
constexpr size_t WS_WQUP_T = WS_WIN_T + (size_t)3264 * 1024 * 2;
constexpr size_t WS_WKVUP_T = WS_WQUP_T + (size_t)768 * 384 * 2;
constexpr size_t WS_WOUT_T = WS_WKVUP_T + (size_t)1024 * 256 * 2;
constexpr size_t WS_WPQ_T = WS_WOUT_T + (size_t)1024 * 1024 * 2;
constexpr size_t WS_SUBK = WS_WPQ_T + (size_t)2048 * 1024 * 2;
constexpr size_t WS_LB = WS_SUBK + (size_t)16 * 128 * 128 * 2;
constexpr size_t WS_B = 15728640;
constexpr size_t WS_CQN = WS_B;
constexpr size_t WS_CKVN = WS_B + (size_t)T * 384 * 2;
constexpr size_t WS_C = WS_B + 33554432;
constexpr size_t WS_U16 = WS_C;
constexpr size_t WS_V16 = WS_C + 33554432;
constexpr size_t WS_D = WS_C + (size_t)T * INW * 2;
constexpr size_t WS_Q = WS_D + 33554432;
constexpr size_t WS_KN = WS_Q + (size_t)T * 768 * 2;
constexpr size_t WS_VT = WS_KN + (size_t)T * 512 * 2;
constexpr size_t WS_KROPE = WS_VT + (size_t)T * 512 * 2;
constexpr size_t WS_ROPECS = WS_KROPE + (size_t)T * 64 * 2;
constexpr size_t WS_END = WS_ROPECS + (size_t)T * 64 * 4;
constexpr size_t WS_IDX = WS_VT;
constexpr size_t WS_GATE = WS_VT + (size_t)T * 128 * 4;
static_assert(WS_LB + 4096 <= WS_B, "weights overflow");
static_assert(WS_D + (size_t)T * 2048 * 2 <= WS_IDX, "PQ overlaps IDX");
static_assert(WS_GATE + (size_t)T * 128 * 4 <= WS_VT + (size_t)T * 512 * 2, "gate overflow");
static_assert(WS_END <= 268435456, "workspace too big");

struct Args {
    const float* x; const int* pos; const float* attn_norm; const float* w_in; const float* lb_logits; const float* hg_o_norm;
    const float* q_a_norm; const float* w_q_up; const float* kv_a_norm; const float* w_kv_up; const float* q_norm; const float* k_norm;
    const float* mla_o_norm; const float* w_out; const float* ffn_norm; const float* peer_wq; const float* subk; const float* peer_u; const float* peer_v;
    float* out; unsigned char* ws; int ph_lo, ph_hi;
};

__device__ __forceinline__ bf16_t f2bf(float f) { unsigned u = __float_as_uint(f); u += 0x7fffu + ((u >> 16) & 1u); return (bf16_t)(u >> 16); }
__device__ __forceinline__ float bf2f(bf16_t h) { return __uint_as_float(((unsigned)h) << 16); }
__device__ __forceinline__ unsigned pack2(float lo, float hi) { return (unsigned)f2bf(lo) | ((unsigned)f2bf(hi) << 16); }
__device__ __forceinline__ float bflo(unsigned w) { return __uint_as_float(w << 16); }
__device__ __forceinline__ float bfhi(unsigned w) { return __uint_as_float(w & 0xffff0000u); }
__device__ __forceinline__ float wave_sum(float v) {
#pragma unroll
    for (int d = 32; d > 0; d >>= 1) v += __shfl_xor(v, d, 64);
    return v;
}
__device__ __forceinline__ f32x4 mfma16(bf16x8 a, bf16x8 b, f32x4 c) { return __builtin_amdgcn_mfma_f32_16x16x32_bf16(a, b, c, 0, 0, 0); }

__device__ const float ROPE_INV_FREQ[32] = {
    1.000000000e+00f, 7.498942018e-01f, 5.623413324e-01f, 4.216965139e-01f, 3.162277639e-01f, 2.371373922e-01f, 1.778279394e-01f, 1.333521456e-01f,
    1.000000015e-01f, 7.498941571e-02f, 5.623412877e-02f, 4.216964915e-02f, 3.162277862e-02f, 2.371373586e-02f, 1.778279431e-02f, 1.333521493e-02f,
    9.999999776e-03f, 7.498942316e-03f, 5.623413250e-03f, 4.216964822e-03f, 3.162277862e-03f, 2.371373819e-03f, 1.778279431e-03f, 1.333521446e-03f,
    1.000000047e-03f, 7.498941850e-04f, 5.623413017e-04f, 4.216965463e-04f, 3.162277862e-04f, 2.371373848e-04f, 1.778279402e-04f, 1.333521504e-04f};

template <int WAVES_M, int WAVES_N, int WM, int WN, class Epi>
__device__ __forceinline__ void gemm_block(const bf16_t* __restrict__ A, int lda, const bf16_t* __restrict__ Bt, int ldb, int K,
                                           int m0, int n0, int nrows_bt, unsigned char* lds, Epi& epi) {
    constexpr int BM = WAVES_M * WM * 16, BN = WAVES_N * WN * 16;
    constexpr int AI = BM / 64, BI = BN / 64;
    static_assert(WAVES_M * WAVES_N == 8, "8 waves");
    const int tid = threadIdx.x, lane = tid & 63, wave = tid >> 6;
    const int wm = wave / WAVES_N, wn = wave % WAVES_N;
    const int r16 = lane & 15, g = lane >> 4;
    unsigned char* As = lds;
    unsigned char* Bs = lds + BM * 144;
    f32x4 acc[WM][WN];
#pragma unroll
    for (int i = 0; i < WM; ++i)
#pragma unroll
        for (int j = 0; j < WN; ++j) acc[i][j] = (f32x4){0.f, 0.f, 0.f, 0.f};
    uint4 ra0, ra1, rb0, rb1, rb2, rb3;
    static_assert(AI <= 2 && BI <= 4, "stage regs");
#define GA_LOAD(i, k0) if constexpr (AI > i) { const int c = tid + i * NT, row = c >> 3, kc = c & 7; ra##i = *(const uint4*)(A + (size_t)(m0 + row) * lda + (k0) + kc * 8); }
#define GB_LOAD(i, k0) if constexpr (BI > i) { const int c = tid + i * NT, row = c >> 3, kc = c & 7; int rg = n0 + row; rg = rg < nrows_bt ? rg : nrows_bt - 1; rb##i = *(const uint4*)(Bt + (size_t)rg * ldb + (k0) + kc * 8); }
#define GA_STORE(i) if constexpr (AI > i) { const int c = tid + i * NT, row = c >> 3, kc = c & 7; *(uint4*)(As + row * 144 + kc * 16) = ra##i; }
#define GB_STORE(i) if constexpr (BI > i) { const int c = tid + i * NT, row = c >> 3, kc = c & 7; *(uint4*)(Bs + row * 144 + kc * 16) = rb##i; }
    GA_LOAD(0, 0) GA_LOAD(1, 0) GB_LOAD(0, 0) GB_LOAD(1, 0) GB_LOAD(2, 0) GB_LOAD(3, 0)
    const int nk = K / 64;
    for (int kt = 0; kt < nk; ++kt) {
        __syncthreads();
        GA_STORE(0) GA_STORE(1) GB_STORE(0) GB_STORE(1) GB_STORE(2) GB_STORE(3)
        __syncthreads();
        if (kt + 1 < nk) {
            const int k0 = (kt + 1) * 64;
            GA_LOAD(0, k0) GA_LOAD(1, k0) GB_LOAD(0, k0) GB_LOAD(1, k0) GB_LOAD(2, k0) GB_LOAD(3, k0)
        }
#pragma unroll
        for (int kk = 0; kk < 2; ++kk) {
            bf16x8 af[WM];
#pragma unroll
            for (int i = 0; i < WM; ++i) af[i] = *(const bf16x8*)(As + ((wm * WM + i) * 16 + r16) * 144 + kk * 64 + g * 16);
#pragma unroll
            for (int j = 0; j < WN; ++j) {
                const bf16x8 bfr = *(const bf16x8*)(Bs + ((wn * WN + j) * 16 + r16) * 144 + kk * 64 + g * 16);
#pragma unroll
                for (int i = 0; i < WM; ++i) acc[i][j] = mfma16(bfr, af[i], acc[i][j]);
            }
        }
    }
#undef GA_LOAD
#undef GB_LOAD
#undef GA_STORE
#undef GB_STORE
    epi(acc, m0 + wm * WM * 16, n0 + wn * WN * 16, lane);
}

struct EpiBf16 {
    bf16_t* O; int ldc; int ncols;
    __device__ __forceinline__ void operator()(const f32x4 (&acc)[4][2], int mb, int nb, int lane) const {
        const int r16 = lane & 15, g = lane >> 4;
#pragma unroll
        for (int i = 0; i < 4; ++i)
#pragma unroll
            for (int j = 0; j < 2; ++j) {
                const int row = mb + i * 16 + r16, col = nb + j * 16 + 4 * g;
                if (col < ncols) { uint2 w; w.x = pack2(acc[i][j][0], acc[i][j][1]); w.y = pack2(acc[i][j][2], acc[i][j][3]); *(uint2*)(O + (size_t)row * ldc + col) = w; }
            }
    }
};
struct EpiResid {
    const float* X; float* O;
    __device__ __forceinline__ void operator()(const f32x4 (&acc)[4][2], int mb, int nb, int lane) const {
        const int r16 = lane & 15, g = lane >> 4;
#pragma unroll
        for (int i = 0; i < 4; ++i)
#pragma unroll
            for (int j = 0; j < 2; ++j) {
                const size_t off = (size_t)(mb + i * 16 + r16) * DM + nb + j * 16 + 4 * g;
                const f32x4 xv = *(const f32x4*)(X + off);
                *(f32x4*)(O + off) = xv + acc[i][j];
            }
    }
};
struct EpiQ {
    bf16_t* Q; const float* q_norm; const float* ropecs;
    __device__ __forceinline__ void operator()(const f32x4 (&acc)[1][12], int mb, int nb, int lane) const {
        const int r16 = lane & 15, g = lane >> 4;
        const int row = mb + r16, h = nb / 192;
        float ssn = 0.f, ssr = 0.f;
#pragma unroll
        for (int j = 0; j < 8; ++j)
#pragma unroll
            for (int r = 0; r < 4; ++r) ssn += acc[0][j][r] * acc[0][j][r];
#pragma unroll
        for (int j = 8; j < 12; ++j)
#pragma unroll
            for (int r = 0; r < 4; ++r) ssr += acc[0][j][r] * acc[0][j][r];
        ssn += __shfl_xor(ssn, 16, 64); ssn += __shfl_xor(ssn, 32, 64);
        ssr += __shfl_xor(ssr, 16, 64); ssr += __shfl_xor(ssr, 32, 64);
        const float SC = 0.07216878364870322f * 1.4426950408889634f;
        const float rn = rsqrtf(ssn * (1.f / 128.f) + EPS) * SC, rr = rsqrtf(ssr * (1.f / 64.f) + EPS) * SC;
        bf16_t* qrow = Q + ((size_t)row * 4 + h) * 192;
#pragma unroll
        for (int j = 0; j < 8; ++j) {
            const int c = j * 16 + 4 * g;
            const f32x4 gn = *(const f32x4*)(q_norm + c);
            uint2 w; w.x = pack2(acc[0][j][0] * rn * gn[0], acc[0][j][1] * rn * gn[1]); w.y = pack2(acc[0][j][2] * rn * gn[2], acc[0][j][3] * rn * gn[3]);
            *(uint2*)(qrow + c) = w;
        }
#pragma unroll
        for (int j = 0; j < 2; ++j) {
            const int jj = j * 16 + 4 * g;
            const f32x4 g1 = *(const f32x4*)(q_norm + 128 + jj), g2 = *(const f32x4*)(q_norm + 160 + jj);
            float o1[4], o2[4];
#pragma unroll
            for (int r = 0; r < 4; ++r) {
                const float2 cs = *(const float2*)(ropecs + ((size_t)row * 32 + jj + r) * 2);
                const float a1 = acc[0][8 + j][r] * rr * g1[r], a2 = acc[0][10 + j][r] * rr * g2[r];
                o1[r] = a1 * cs.x - a2 * cs.y; o2[r] = a2 * cs.x + a1 * cs.y;
            }
            uint2 w; w.x = pack2(o1[0], o1[1]); w.y = pack2(o1[2], o1[3]); *(uint2*)(qrow + 128 + jj) = w;
            w.x = pack2(o2[0], o2[1]); w.y = pack2(o2[2], o2[3]); *(uint2*)(qrow + 160 + jj) = w;
        }
    }
};
struct EpiKV {
    bf16_t* KN; bf16_t* VT; const float* k_norm;
    __device__ __forceinline__ void operator()(const f32x4 (&acc)[1][16], int mb, int nb, int lane) const {
        const int r16 = lane & 15, g = lane >> 4;
        const int row = mb + r16, h = nb / 256;
        float ssn = 0.f;
#pragma unroll
        for (int j = 0; j < 8; ++j)
#pragma unroll
            for (int r = 0; r < 4; ++r) ssn += acc[0][j][r] * acc[0][j][r];
        ssn += __shfl_xor(ssn, 16, 64); ssn += __shfl_xor(ssn, 32, 64);
        const float rn = rsqrtf(ssn * (1.f / 128.f) + EPS);
        bf16_t* krow = KN + ((size_t)row * 4 + h) * 128;
#pragma unroll
        for (int j = 0; j < 8; ++j) {
            const int c = j * 16 + 4 * g;
            const f32x4 gn = *(const f32x4*)(k_norm + c);
            uint2 w; w.x = pack2(acc[0][j][0] * rn * gn[0], acc[0][j][1] * rn * gn[1]); w.y = pack2(acc[0][j][2] * rn * gn[2], acc[0][j][3] * rn * gn[3]);
            *(uint2*)(krow + c) = w;
        }
        const int b = row >> 11, s = row & 2047;
        bf16_t* vp = VT + ((size_t)(b * 4 + h) * 128 + 4 * g) * SEQ + s;
#pragma unroll
        for (int j = 0; j < 8; ++j) {
            asm volatile("" : "+v"(vp));
            vp[0] = f2bf(acc[0][8 + j][0]); vp[SEQ] = f2bf(acc[0][8 + j][1]); vp[2 * SEQ] = f2bf(acc[0][8 + j][2]); vp[3 * SEQ] = f2bf(acc[0][8 + j][3]);
            vp += 16 * SEQ;
        }
    }
};

__device__ void transpose_convert(const float* __restrict__ W, bf16_t* __restrict__ Wt, int K, int N, unsigned char* lds, int bid, int nblk) {
    bf16_t* tile = (bf16_t*)lds;
    const int tid = threadIdx.x;
    const int tk = K / 64, tn = N / 64;
    for (int t = bid; t < tk * tn; t += nblk) {
        const int k0 = (t / tn) * 64, n0 = (t % tn) * 64;
        __syncthreads();
#pragma unroll
        for (int p = 0; p < 2; ++p) {
            const int kk = (tid >> 4) + p * 32, n4 = (tid & 15) * 4;
            const f32x4 v = *(const f32x4*)(W + (size_t)(k0 + kk) * N + n0 + n4);
#pragma unroll
            for (int r = 0; r < 4; ++r) tile[(n4 + r) * 66 + kk] = f2bf(v[r]);
        }
        __syncthreads();
        {
            const int nn = tid >> 3, k8 = (tid & 7) * 8;
            unsigned w[4];
#pragma unroll
            for (int r = 0; r < 4; ++r) w[r] = (unsigned)tile[nn * 66 + k8 + 2 * r] | ((unsigned)tile[nn * 66 + k8 + 2 * r + 1] << 16);
            *(uint4*)(Wt + (size_t)(n0 + nn) * K + k0 + k8) = make_uint4(w[0], w[1], w[2], w[3]);
        }
    }
    __syncthreads();
}

__device__ void rmsnorm_rows(const float* __restrict__ X, const float* __restrict__ gain, bf16_t* __restrict__ O, int gw, int nw) {
    const int lane = threadIdx.x & 63;
    for (int row = gw; row < T; row += nw) {
        const float* xr = X + (size_t)row * DM;
        f32x4 v[4]; float ss = 0.f;
#pragma unroll
        for (int i = 0; i < 4; ++i) { v[i] = *(const f32x4*)(xr + i * 256 + lane * 4); ss += v[i][0] * v[i][0] + v[i][1] * v[i][1] + v[i][2] * v[i][2] + v[i][3] * v[i][3]; }
        ss = wave_sum(ss);
        const float rs = rsqrtf(ss * (1.f / 1024.f) + EPS);
#pragma unroll
        for (int i = 0; i < 4; ++i) {
            const f32x4 gn = *(const f32x4*)(gain + i * 256 + lane * 4);
            uint2 w; w.x = pack2(v[i][0] * rs * gn[0], v[i][1] * rs * gn[1]); w.y = pack2(v[i][2] * rs * gn[2], v[i][3] * rs * gn[3]);
            *(uint2*)(O + (size_t)row * DM + i * 256 + lane * 4) = w;
        }
    }
}

__device__ void phase0(const Args& a, unsigned char* lds) {
    unsigned char* ws = a.ws;
    const int bid = blockIdx.x, nblk = gridDim.x, tid = threadIdx.x;
    transpose_convert(a.w_in, (bf16_t*)(ws + WS_WIN_T), 1024, 3264, lds, bid, nblk);
    transpose_convert(a.w_q_up, (bf16_t*)(ws + WS_WQUP_T), 384, 768, lds, bid, nblk);
    transpose_convert(a.w_kv_up, (bf16_t*)(ws + WS_WKVUP_T), 256, 1024, lds, bid, nblk);
    transpose_convert(a.w_out, (bf16_t*)(ws + WS_WOUT_T), 1024, 1024, lds, bid, nblk);
    transpose_convert(a.peer_wq, (bf16_t*)(ws + WS_WPQ_T), 1024, 2048, lds, bid, nblk);
    const int gt = bid * NT + tid, ngt = nblk * NT;
    bf16_t* sk = (bf16_t*)(ws + WS_SUBK);
    for (int i = gt; i < 16 * 128 * 128; i += ngt) sk[i] = f2bf(a.subk[i]);
    float* lb = (float*)(ws + WS_LB);
    for (int i = gt; i < 1024; i += ngt) { const float l0 = a.lb_logits[i], l1 = a.lb_logits[1024 + i]; lb[i] = 1.f / (1.f + expf(l1 - l0)); }
    rmsnorm_rows(a.x, a.attn_norm, (bf16_t*)(ws + WS_B), bid * 8 + (tid >> 6), nblk * 8);
}

__device__ void phase1(const Args& a, unsigned char* lds) {
    unsigned char* ws = a.ws;
    EpiBf16 e{(bf16_t*)(ws + WS_C), INW, INW};
    const int ntn = 26, ntiles = 128 * ntn;
    for (int t = blockIdx.x; t < ntiles; t += gridDim.x) {
        const int mt = t / ntn, nt = t % ntn;
        gemm_block<2, 4, 4, 2>((const bf16_t*)(ws + WS_B), DM, (const bf16_t*)(ws + WS_WIN_T), DM, DM, mt * 128, nt * 128, INW, lds, e);
    }
}

__device__ void phase2(const Args& a) {
    unsigned char* ws = a.ws;
    const bf16_t* PROJ = (const bf16_t*)(ws + WS_C);
    bf16_t* CQN = (bf16_t*)(ws + WS_CQN); bf16_t* CKVN = (bf16_t*)(ws + WS_CKVN); bf16_t* KROPE = (bf16_t*)(ws + WS_KROPE);
    float* ROPECS = (float*)(ws + WS_ROPECS);
    const int lane = threadIdx.x & 63;
    for (int t = blockIdx.x * 8 + (threadIdx.x >> 6); t < T; t += gridDim.x * 8) {
        const bf16_t* pr = PROJ + (size_t)t * INW;
        {
            unsigned w[3]; float ss = 0.f;
#pragma unroll
            for (int i = 0; i < 3; ++i) { w[i] = *(const unsigned*)(pr + OFF_CQ + i * 128 + lane * 2); const float x0 = bflo(w[i]), x1 = bfhi(w[i]); ss += x0 * x0 + x1 * x1; }
            ss = wave_sum(ss); const float rs = rsqrtf(ss * (1.f / 384.f) + EPS);
#pragma unroll
            for (int i = 0; i < 3; ++i) { const int c = i * 128 + lane * 2; *(unsigned*)(CQN + (size_t)t * 384 + c) = pack2(bflo(w[i]) * rs * a.q_a_norm[c], bfhi(w[i]) * rs * a.q_a_norm[c + 1]); }
        }
        {
            unsigned w[2]; float ss = 0.f;
#pragma unroll
            for (int i = 0; i < 2; ++i) { w[i] = *(const unsigned*)(pr + OFF_CKV + i * 128 + lane * 2); const float x0 = bflo(w[i]), x1 = bfhi(w[i]); ss += x0 * x0 + x1 * x1; }
            ss = wave_sum(ss); const float rs = rsqrtf(ss * (1.f / 256.f) + EPS);
#pragma unroll
            for (int i = 0; i < 2; ++i) { const int c = i * 128 + lane * 2; *(unsigned*)(CKVN + (size_t)t * 256 + c) = pack2(bflo(w[i]) * rs * a.kv_a_norm[c], bfhi(w[i]) * rs * a.kv_a_norm[c + 1]); }
        }
        {
            const float v = bf2f(pr[OFF_KR + lane]);
            const float ss = wave_sum(v * v); const float rs = rsqrtf(ss * (1.f / 64.f) + EPS);
            const float xn = v * rs * a.k_norm[128 + lane];
            const float other = __shfl_xor(xn, 32, 64);
            const int j = lane & 31;
            const float ang = (float)a.pos[t] * ROPE_INV_FREQ[j];
            float sn, cs; sincosf(ang, &sn, &cs);
            const float o = (lane < 32) ? (xn * cs - other * sn) : (xn * cs + other * sn);
            KROPE[(size_t)t * 64 + lane] = f2bf(o);
            if (lane < 32) { *(float2*)(ROPECS + ((size_t)t * 32 + j) * 2) = make_float2(cs, sn); }
        }
    }
}

__device__ void phase3(const Args& a, unsigned char* lds) {
    unsigned char* ws = a.ws;
    EpiQ eq{(bf16_t*)(ws + WS_Q), a.q_norm, (const float*)(ws + WS_ROPECS)};
    EpiKV ekv{(bf16_t*)(ws + WS_KN), (bf16_t*)(ws + WS_VT), a.k_norm};
    for (int t = blockIdx.x; t < 1024; t += gridDim.x) {
        if (t < 512) { const int mt = t >> 2, h = t & 3;
            gemm_block<8, 1, 1, 12>((const bf16_t*)(ws + WS_CQN), 384, (const bf16_t*)(ws + WS_WQUP_T), 384, 384, mt * 128, h * 192, 768, lds, eq);
        } else { const int u = t - 512, mt = u >> 2, h = u & 3;
            gemm_block<8, 1, 1, 16>((const bf16_t*)(ws + WS_CKVN), 256, (const bf16_t*)(ws + WS_WKVUP_T), 256, 256, mt * 128, h * 256, 1024, lds, ekv);
        }
    }
}

__device__ void attn_item(const Args& a, int item) {
    unsigned char* ws = a.ws;
    const bf16_t* Q = (const bf16_t*)(ws + WS_Q); const bf16_t* KN = (const bf16_t*)(ws + WS_KN);
    const bf16_t* KR = (const bf16_t*)(ws + WS_KROPE); const bf16_t* VT = (const bf16_t*)(ws + WS_VT);
    bf16_t* YCAT = (bf16_t*)(ws + WS_B);
    const int qb = item & 15, h = (item >> 4) & 3, b = item >> 6;
    const int lane = threadIdx.x & 63, wave = threadIdx.x >> 6, r16 = lane & 15, g = lane >> 4;
    const int qrow = qb * 128 + wave * 16 + r16;
    const size_t tq = (size_t)b * SEQ + qrow;
    bf16x8 qf[6];
#pragma unroll
    for (int kk = 0; kk < 6; ++kk) qf[kk] = *(const bf16x8*)(Q + (tq * 4 + h) * 192 + kk * 32 + 8 * g);
    f32x4 O[8];
#pragma unroll
    for (int d = 0; d < 8; ++d) O[d] = (f32x4){0.f, 0.f, 0.f, 0.f};
    float m_run = -1e30f, l_part = 0.f;
    const bf16_t* vbase = VT + ((size_t)(b * 4 + h) * 128 + r16) * SEQ + 4 * g;
    for (int k0 = 0; k0 < SEQ; k0 += 32) {
        f32x4 s[2];
#pragma unroll
        for (int sub = 0; sub < 2; ++sub) {
            s[sub] = (f32x4){0.f, 0.f, 0.f, 0.f};
            const size_t tk = (size_t)b * SEQ + k0 + sub * 16 + r16;
#pragma unroll
            for (int kk = 0; kk < 4; ++kk) { const bf16x8 kf = *(const bf16x8*)(KN + (tk * 4 + h) * 128 + kk * 32 + 8 * g); s[sub] = mfma16(kf, qf[kk], s[sub]); }
#pragma unroll
            for (int kk = 0; kk < 2; ++kk) { const bf16x8 kf = *(const bf16x8*)(KR + tk * 64 + kk * 32 + 8 * g); s[sub] = mfma16(kf, qf[4 + kk], s[sub]); }
        }
        float mx = fmaxf(fmaxf(fmaxf(s[0][0], s[0][1]), fmaxf(s[0][2], s[0][3])), fmaxf(fmaxf(s[1][0], s[1][1]), fmaxf(s[1][2], s[1][3])));
        mx = fmaxf(mx, __shfl_xor(mx, 16, 64)); mx = fmaxf(mx, __shfl_xor(mx, 32, 64));
        const float m_new = fmaxf(m_run, mx);
        const float alpha = exp2f(m_run - m_new);
        m_run = m_new;
        float p[8]; float ps = 0.f;
#pragma unroll
        for (int j = 0; j < 8; ++j) { p[j] = exp2f(s[j >> 2][j & 3] - m_new); ps += p[j]; }
        l_part = l_part * alpha + ps;
        bf16x8 pf;
#pragma unroll
        for (int j = 0; j < 8; ++j) pf[j] = (short)f2bf(p[j]);
#pragma unroll
        for (int d = 0; d < 8; ++d) {
            O[d] *= alpha;
            const bf16_t* vp = vbase + (size_t)d * 16 * SEQ + k0;
            const uint2 v0 = *(const uint2*)vp, v1 = *(const uint2*)(vp + 16);
            union { uint4 u; bf16x8 v; } cv; cv.u = make_uint4(v0.x, v0.y, v1.x, v1.y);
            O[d] = mfma16(cv.v, pf, O[d]);
        }
    }
    float l = l_part; l += __shfl_xor(l, 16, 64); l += __shfl_xor(l, 32, 64);
    const float inv = 1.f / l;
    float ss = 0.f;
#pragma unroll
    for (int d = 0; d < 8; ++d) { O[d] *= inv; ss += O[d][0] * O[d][0] + O[d][1] * O[d][1] + O[d][2] * O[d][2] + O[d][3] * O[d][3]; }
    ss += __shfl_xor(ss, 16, 64); ss += __shfl_xor(ss, 32, 64);
    const float rs = rsqrtf(ss * (1.f / 128.f) + EPS);
#pragma unroll
    for (int d = 0; d < 8; ++d) {
        const int dv = d * 16 + 4 * g;
        const f32x4 gn = *(const f32x4*)(a.mla_o_norm + h * 128 + dv);
        uint2 w; w.x = pack2(O[d][0] * rs * gn[0], O[d][1] * rs * gn[1]); w.y = pack2(O[d][2] * rs * gn[2], O[d][3] * rs * gn[3]);
        *(uint2*)(YCAT + tq * DM + 512 + h * 128 + dv) = w;
    }
}

constexpr int HG_G = 0, HG_QT = 32768, HG_QH = HG_QT + 17408, HG_KD = HG_QH + 17408, HG_K10 = HG_KD + 17408, HG_KBT = HG_K10 + 8704,
              HG_VT = HG_KBT + 18432, HG_SM = HG_VT + 4608, HG_STB = HG_SM + 9216, HG_EL = HG_STB + 8704, HG_LDS = HG_EL + 1024;
__device__ void hgrn_item(const Args& a, int item, unsigned char* lds) {
    unsigned char* ws = a.ws;
    const bf16_t* PROJ = (const bf16_t*)(ws + WS_C);
    const float* LB = (const float*)(ws + WS_LB);
    bf16_t* OHG = (bf16_t*)(ws + WS_D);
    const int vs = item & 3, dir = (item >> 2) & 1, h = (item >> 3) & 3, b = item >> 5;
    const int tid = threadIdx.x, lane = tid & 63, wave = tid >> 6, r16 = lane & 15, g = lane >> 4;
    float* G = (float*)(lds + HG_G);
    bf16_t* Qt = (bf16_t*)(lds + HG_QT); bf16_t* Qh = (bf16_t*)(lds + HG_QH); bf16_t* Kd = (bf16_t*)(lds + HG_KD); bf16_t* K10 = (bf16_t*)(lds + HG_K10);
    bf16_t* KbT = (bf16_t*)(lds + HG_KBT); bf16_t* vT = (bf16_t*)(lds + HG_VT); bf16_t* Sm = (bf16_t*)(lds + HG_SM); bf16_t* STb = (bf16_t*)(lds + HG_STB);
    float* EL = (float*)(lds + HG_EL);
    const int kcol = tid & 127, irow0 = tid >> 7;
    const float lbk = LB[dir * 512 + h * 128 + kcol];
    const int offf = dir ? OFF_FB : OFF_FF;
    __syncthreads();
    for (int i = tid; i < 32 * 136; i += NT) STb[i] = 0;
    f32x4 accS[2]; accS[0] = (f32x4){0.f, 0.f, 0.f, 0.f}; accS[1] = accS[0];
    for (int n = 0; n < 32; ++n) {
        float qv[16], kv[16];
#pragma unroll
        for (int j = 0; j < 16; ++j) {
            const int i = irow0 + 4 * j, tau = n * 64 + i, tt = dir ? (SEQ - 1 - tau) : tau;
            const bf16_t* pr = PROJ + ((size_t)b * SEQ + tt) * INW + h * 128 + kcol;
            const float qr = bf2f(pr[OFF_Q]), fr = bf2f(pr[offf]);
            qv[j] = qr / (1.f + __expf(-qr));
            const float f = lbk + (1.f - lbk) / (1.f + __expf(-fr));
            kv[j] = 1.f - f;
            G[i * 128 + kcol] = __logf(f);
        }
#pragma unroll
        for (int j = 0; j < 4; ++j) {
            const int e = tid + j * NT, i = e >> 5, vc = e & 31, tau = n * 64 + i, tt = dir ? (SEQ - 1 - tau) : tau;
            vT[vc * 72 + i] = PROJ[((size_t)b * SEQ + tt) * INW + OFF_I + h * 128 + vs * 32 + vc];
        }
        __syncthreads();
        if (tid < 256) {
            const int half = tid >> 7; float run = 0.f;
            for (int i = 0; i < 32; ++i) { run += G[(half * 32 + i) * 128 + kcol]; G[(half * 32 + i) * 128 + kcol] = __expf(run); }
            EL[half * 128 + kcol] = __expf(run);
        }
        __syncthreads();
        {
            const float e31 = EL[kcol], e63 = EL[128 + kcol];
#pragma unroll
            for (int j = 0; j < 16; ++j) {
                const int i = irow0 + 4 * j;
                const float e = G[i * 128 + kcol];
                const float qt = qv[j] * e, kd = kv[j] / e;
                Qt[i * 136 + kcol] = f2bf(qt);
                Kd[i * 136 + kcol] = f2bf(kd);
                if (i < 32) { Qh[i * 136 + kcol] = f2bf(qt); K10[i * 136 + kcol] = f2bf(kd * e31); KbT[kcol * 72 + i] = f2bf(kd * e31 * e63); }
                else { Qh[i * 136 + kcol] = f2bf(qt * e31); KbT[kcol * 72 + i] = f2bf(kd * e63); }
            }
        }
        __syncthreads();
#pragma unroll
        for (int q2 = 0; q2 < 2; ++q2) {
            const int tix = wave * 2 + q2, ti = tix >> 2, si = tix & 3;
            f32x4 sc = (f32x4){0.f, 0.f, 0.f, 0.f};
            if (si <= ti) {
                const bf16_t* kb = (ti >= 2 && si < 2) ? K10 : Kd;
#pragma unroll
                for (int kk = 0; kk < 4; ++kk) {
                    const bf16x8 af = *(const bf16x8*)(Qt + (ti * 16 + r16) * 136 + kk * 32 + 8 * g);
                    const bf16x8 bfr = *(const bf16x8*)(kb + (si * 16 + r16) * 136 + kk * 32 + 8 * g);
                    sc = mfma16(bfr, af, sc);
                }
                if (si == ti) {
#pragma unroll
                    for (int r = 0; r < 4; ++r) if (4 * g + r > r16) sc[r] = 0.f;
                }
            }
            uint2 w; w.x = pack2(sc[0], sc[1]); w.y = pack2(sc[2], sc[3]);
            *(uint2*)(Sm + (ti * 16 + r16) * 72 + si * 16 + 4 * g) = w;
        }
        __syncthreads();
        {
            const int ti = wave >> 1, vi = wave & 1;
            f32x4 o = (f32x4){0.f, 0.f, 0.f, 0.f};
#pragma unroll
            for (int kk = 0; kk < 2; ++kk) {
                const bf16x8 af = *(const bf16x8*)(Sm + (ti * 16 + r16) * 72 + kk * 32 + 8 * g);
                const bf16x8 bfr = *(const bf16x8*)(vT + (vi * 16 + r16) * 72 + kk * 32 + 8 * g);
                o = mfma16(bfr, af, o);
            }
#pragma unroll
            for (int kk = 0; kk < 4; ++kk) {
                const bf16x8 af = *(const bf16x8*)(Qh + (ti * 16 + r16) * 136 + kk * 32 + 8 * g);
                const bf16x8 bfr = *(const bf16x8*)(STb + (vi * 16 + r16) * 136 + kk * 32 + 8 * g);
                o = mfma16(bfr, af, o);
            }
            const int tau = n * 64 + ti * 16 + r16, tt = dir ? (SEQ - 1 - tau) : tau;
            uint2 w; w.x = pack2(o[0], o[1]); w.y = pack2(o[2], o[3]);
            *(uint2*)(OHG + ((size_t)dir * T + (size_t)b * SEQ + tt) * 512 + h * 128 + vs * 32 + vi * 16 + 4 * g) = w;
#pragma unroll
            for (int q2 = 0; q2 < 2; ++q2) {
                const int kt = (wave >> 1) * 2 + q2;
                const f32x4 e31 = *(const f32x4*)(EL + kt * 16 + 4 * g), e63 = *(const f32x4*)(EL + 128 + kt * 16 + 4 * g);
                f32x4 c = accS[q2] * (e31 * e63);
#pragma unroll
                for (int kk = 0; kk < 2; ++kk) {
                    const bf16x8 af = *(const bf16x8*)(vT + (vi * 16 + r16) * 72 + kk * 32 + 8 * g);
                    const bf16x8 bfr = *(const bf16x8*)(KbT + (kt * 16 + r16) * 72 + kk * 32 + 8 * g);
                    c = mfma16(bfr, af, c);
                }
                accS[q2] = c;
            }
        }
        __syncthreads();
        {
            const int vi = wave & 1;
#pragma unroll
            for (int q2 = 0; q2 < 2; ++q2) {
                const int kt = (wave >> 1) * 2 + q2;
                uint2 w; w.x = pack2(accS[q2][0], accS[q2][1]); w.y = pack2(accS[q2][2], accS[q2][3]);
                *(uint2*)(STb + (vi * 16 + r16) * 136 + kt * 16 + 4 * g) = w;
            }
        }
    }
    __syncthreads();
}

__device__ void phase6(const Args& a) {
    unsigned char* ws = a.ws;
    const bf16_t* OHG = (const bf16_t*)(ws + WS_D); const bf16_t* PROJ = (const bf16_t*)(ws + WS_C);
    bf16_t* YCAT = (bf16_t*)(ws + WS_B);
    const int lane = threadIdx.x & 63;
    for (int t = blockIdx.x * 8 + (threadIdx.x >> 6); t < T; t += gridDim.x * 8) {
        const int c0 = lane * 8;
        const uint4 f = *(const uint4*)(OHG + (size_t)t * 512 + c0), bw = *(const uint4*)(OHG + ((size_t)T + t) * 512 + c0);
        const uint4 gg = *(const uint4*)(PROJ + (size_t)t * INW + OFF_G + c0);
        float o[8];
        o[0] = bflo(f.x) + bflo(bw.x); o[1] = bfhi(f.x) + bfhi(bw.x); o[2] = bflo(f.y) + bflo(bw.y); o[3] = bfhi(f.y) + bfhi(bw.y);
        o[4] = bflo(f.z) + bflo(bw.z); o[5] = bfhi(f.z) + bfhi(bw.z); o[6] = bflo(f.w) + bflo(bw.w); o[7] = bfhi(f.w) + bfhi(bw.w);
        float gr[8] = {bflo(gg.x), bfhi(gg.x), bflo(gg.y), bfhi(gg.y), bflo(gg.z), bfhi(gg.z), bflo(gg.w), bfhi(gg.w)};
        float ss = 0.f;
#pragma unroll
        for (int i = 0; i < 8; ++i) ss += o[i] * o[i];
        ss += __shfl_xor(ss, 1, 64); ss += __shfl_xor(ss, 2, 64); ss += __shfl_xor(ss, 4, 64); ss += __shfl_xor(ss, 8, 64);
        const float rs = rsqrtf(ss * (1.f / 128.f) + EPS);
        float y[8];
#pragma unroll
        for (int i = 0; i < 8; ++i) { const float gt = gr[i] / (1.f + __expf(-gr[i])); y[i] = o[i] * rs * a.hg_o_norm[c0 + i] * gt; }
        *(uint4*)(YCAT + (size_t)t * DM + c0) = make_uint4(pack2(y[0], y[1]), pack2(y[2], y[3]), pack2(y[4], y[5]), pack2(y[6], y[7]));
    }
}

__device__ void phase7(const Args& a, unsigned char* lds) {
    unsigned char* ws = a.ws;
    EpiResid e{a.x, a.out};
    for (int t = blockIdx.x; t < 128 * 8; t += gridDim.x) {
        const int mt = t >> 3, nt = t & 7;
        gemm_block<2, 4, 4, 2>((const bf16_t*)(ws + WS_B), DM, (const bf16_t*)(ws + WS_WOUT_T), DM, DM, mt * 128, nt * 128, DM, lds, e);
    }
    const size_t gt = (size_t)blockIdx.x * NT + threadIdx.x, ngt = (size_t)gridDim.x * NT;
    for (size_t i = gt; i < (size_t)16384 * 1024 / 8; i += ngt) {
        const f32x4 u0 = *(const f32x4*)(a.peer_u + i * 8), u1 = *(const f32x4*)(a.peer_u + i * 8 + 4);
        *(uint4*)((bf16_t*)(ws + WS_U16) + i * 8) = make_uint4(pack2(u0[0], u0[1]), pack2(u0[2], u0[3]), pack2(u1[0], u1[1]), pack2(u1[2], u1[3]));
        const f32x4 v0 = *(const f32x4*)(a.peer_v + i * 8), v1 = *(const f32x4*)(a.peer_v + i * 8 + 4);
        *(uint4*)((bf16_t*)(ws + WS_V16) + i * 8) = make_uint4(pack2(v0[0], v0[1]), pack2(v0[2], v0[3]), pack2(v1[0], v1[1]), pack2(v1[2], v1[3]));
    }
}

__device__ void phase9(const Args& a, unsigned char* lds) {
    unsigned char* ws = a.ws;
    EpiBf16 e{(bf16_t*)(ws + WS_D), 2048, 2048};
    for (int t = blockIdx.x; t < 128 * 16; t += gridDim.x) {
        const int mt = t >> 4, nt = t & 15;
        gemm_block<2, 4, 4, 2>((const bf16_t*)(ws + WS_B), DM, (const bf16_t*)(ws + WS_WPQ_T), DM, DM, mt * 128, nt * 128, 2048, lds, e);
    }
}

__device__ void peer_route_item(const Args& a, int item, unsigned char* lds) {
    unsigned char* ws = a.ws;
    const bf16_t* PQ = (const bf16_t*)(ws + WS_D); const bf16_t* SK = (const bf16_t*)(ws + WS_SUBK);
    int* IDX = (int*)(ws + WS_IDX); float* GATE = (float*)(ws + WS_GATE);
    const int p = item & 7, t0 = (item >> 3) * 64;
    const int tid = threadIdx.x, lane = tid & 63, wave = tid >> 6, r16 = lane & 15, g = lane >> 4;
    float* SC = (float*)lds;
    float* TOP = (float*)(lds + 2 * 64 * 129 * 4);
    __syncthreads();
#pragma unroll 1
    for (int q = 0; q < 8; ++q) {
        const int tix = wave * 8 + q, c = tix >> 5, ti = (tix >> 3) & 3, ni = tix & 7;
        f32x4 sc = (f32x4){0.f, 0.f, 0.f, 0.f};
#pragma unroll
        for (int kk = 0; kk < 4; ++kk) {
            const bf16x8 af = *(const bf16x8*)(PQ + (size_t)(t0 + ti * 16 + r16) * 2048 + p * 256 + c * 128 + kk * 32 + 8 * g);
            const bf16x8 bfr = *(const bf16x8*)(SK + ((size_t)(p * 2 + c) * 128 + ni * 16 + r16) * 128 + kk * 32 + 8 * g);
            sc = mfma16(bfr, af, sc);
        }
        float* dst = SC + (c * 64 + ti * 16 + r16) * 129 + ni * 16 + 4 * g;
        dst[0] = sc[0]; dst[1] = sc[1]; dst[2] = sc[2]; dst[3] = sc[3];
    }
    __syncthreads();
    if (tid < 128) {
        const float* row = SC + tid * 129;
        float v[16];
#pragma unroll
        for (int i = 0; i < 16; ++i) v[i] = -3.0e38f;
        for (int j = 0; j < 128; ++j) {
            float x = __uint_as_float((__float_as_uint(row[j]) & 0xffffff80u) | (unsigned)j);
#pragma unroll
            for (int i = 0; i < 16; ++i) { const float hi = fmaxf(v[i], x); x = fminf(v[i], x); v[i] = hi; }
        }
#pragma unroll
        for (int i = 0; i < 16; ++i) TOP[tid * 16 + i] = v[i];
    }
    __syncthreads();
    if (tid < 64) {
        const float* ta = TOP + tid * 16; const float* tb = TOP + (64 + tid) * 16;
        float va[16], vb[16];
#pragma unroll
        for (int i = 0; i < 16; ++i) { va[i] = __uint_as_float(__float_as_uint(ta[i]) & 0xffffff80u); vb[i] = __uint_as_float(__float_as_uint(tb[i]) & 0xffffff80u); }
        float v[16];
#pragma unroll
        for (int i = 0; i < 16; ++i) v[i] = -3.0e38f;
#pragma unroll
        for (int i = 0; i < 16; ++i)
#pragma unroll
            for (int j = 0; j < 16; ++j)
                if ((i + 1) * (j + 1) <= 16) {
                    float x = __uint_as_float((__float_as_uint(va[i] + vb[j]) & 0xffffff00u) | (unsigned)(i * 16 + j));
#pragma unroll
                    for (int q = 0; q < 16; ++q) { const float hi = fmaxf(v[q], x); x = fminf(v[q], x); v[q] = hi; }
                }
        float e[16], sum = 0.f;
        const float m = __uint_as_float(__float_as_uint(v[0]) & 0xffffff00u);
#pragma unroll
        for (int q = 0; q < 16; ++q) { e[q] = __expf(__uint_as_float(__float_as_uint(v[q]) & 0xffffff00u) - m); sum += e[q]; }
        const float inv = 1.f / sum;
        const size_t o = (size_t)(t0 + tid) * 128 + p * 16;
#pragma unroll
        for (int q = 0; q < 16; ++q) {
            const unsigned pos = __float_as_uint(v[q]) & 255u;
            const unsigned ia = __float_as_uint(ta[pos >> 4]) & 127u, ib = __float_as_uint(tb[pos & 15]) & 127u;
            IDX[o + q] = (int)(ia * 128 + ib);
            GATE[o + q] = e[q] * inv;
        }
    }
}

__device__ void phase11(const Args& a) {
    unsigned char* ws = a.ws;
    const bf16_t* H2 = (const bf16_t*)(ws + WS_B); const bf16_t* U16 = (const bf16_t*)(ws + WS_U16); const bf16_t* V16 = (const bf16_t*)(ws + WS_V16);
    const int* IDX = (const int*)(ws + WS_IDX); const float* GATE = (const float*)(ws + WS_GATE);
    const int lane = threadIdx.x & 63;
    for (int t = blockIdx.x * 8 + (threadIdx.x >> 6); t < T; t += gridDim.x * 8) {
        float hv[16];
        {
            const uint4 h0 = *(const uint4*)(H2 + (size_t)t * DM + lane * 16), h1 = *(const uint4*)(H2 + (size_t)t * DM + lane * 16 + 8);
            hv[0] = bflo(h0.x); hv[1] = bfhi(h0.x); hv[2] = bflo(h0.y); hv[3] = bfhi(h0.y); hv[4] = bflo(h0.z); hv[5] = bfhi(h0.z); hv[6] = bflo(h0.w); hv[7] = bfhi(h0.w);
            hv[8] = bflo(h1.x); hv[9] = bfhi(h1.x); hv[10] = bflo(h1.y); hv[11] = bfhi(h1.y); hv[12] = bflo(h1.z); hv[13] = bfhi(h1.z); hv[14] = bflo(h1.w); hv[15] = bfhi(h1.w);
        }
        float y[16];
#pragma unroll
        for (int i = 0; i < 16; ++i) y[i] = 0.f;
        const int my_idx0 = IDX[(size_t)t * 128 + lane], my_idx1 = IDX[(size_t)t * 128 + 64 + lane];
        const float my_g0 = GATE[(size_t)t * 128 + lane], my_g1 = GATE[(size_t)t * 128 + 64 + lane];
#pragma unroll 2
        for (int e = 0; e < 128; ++e) {
            const int idx = __shfl((e < 64) ? my_idx0 : my_idx1, e & 63, 64);
            const float gate = __shfl((e < 64) ? my_g0 : my_g1, e & 63, 64);
            const uint4 u0 = *(const uint4*)(U16 + (size_t)idx * DM + lane * 16), u1 = *(const uint4*)(U16 + (size_t)idx * DM + lane * 16 + 8);
            const uint4 v0 = *(const uint4*)(V16 + (size_t)idx * DM + lane * 16), v1 = *(const uint4*)(V16 + (size_t)idx * DM + lane * 16 + 8);
            float d = 0.f;
            d += hv[0] * bflo(u0.x) + hv[1] * bfhi(u0.x) + hv[2] * bflo(u0.y) + hv[3] * bfhi(u0.y) + hv[4] * bflo(u0.z) + hv[5] * bfhi(u0.z) + hv[6] * bflo(u0.w) + hv[7] * bfhi(u0.w);
            d += hv[8] * bflo(u1.x) + hv[9] * bfhi(u1.x) + hv[10] * bflo(u1.y) + hv[11] * bfhi(u1.y) + hv[12] * bflo(u1.z) + hv[13] * bfhi(u1.z) + hv[14] * bflo(u1.w) + hv[15] * bfhi(u1.w);
            d = wave_sum(d);
            const float act = 0.5f * d * (1.f + erff(d * 0.70710678118654752f));
            const float w = gate * act;
            y[0] += w * bflo(v0.x); y[1] += w * bfhi(v0.x); y[2] += w * bflo(v0.y); y[3] += w * bfhi(v0.y); y[4] += w * bflo(v0.z); y[5] += w * bfhi(v0.z); y[6] += w * bflo(v0.w); y[7] += w * bfhi(v0.w);
            y[8] += w * bflo(v1.x); y[9] += w * bfhi(v1.x); y[10] += w * bflo(v1.y); y[11] += w * bfhi(v1.y); y[12] += w * bflo(v1.z); y[13] += w * bfhi(v1.z); y[14] += w * bflo(v1.w); y[15] += w * bfhi(v1.w);
        }
        float* orow = a.out + (size_t)t * DM + lane * 16;
#pragma unroll
        for (int i = 0; i < 4; ++i) {
            f32x4 o = *(const f32x4*)(orow + i * 4);
            o[0] += y[i * 4]; o[1] += y[i * 4 + 1]; o[2] += y[i * 4 + 2]; o[3] += y[i * 4 + 3];
            *(f32x4*)(orow + i * 4) = o;
        }
    }
}

constexpr int LDS_BYTES = HG_LDS;
constexpr int N_PHASES = 12;

__global__ void __launch_bounds__(NT, 2) fwd_kernel(Args a) {
    extern __shared__ __attribute__((aligned(16))) unsigned char lds[];
#if N_LAUNCH_MODE == 1
    cg::grid_group grid = cg::this_grid();
#define SEAM(k) do { if (a.ph_lo <= (k) && (k) + 1 < a.ph_hi) grid.sync(); } while (0)
#else
#define SEAM(k) do { } while (0)
#endif
#define IN(k) (a.ph_lo <= (k) && (k) < a.ph_hi)
    if (IN(0)) { phase0(a, lds); } SEAM(0);
    if (IN(1)) { phase1(a, lds); } SEAM(1);
    if (IN(2)) { phase2(a); } SEAM(2);
    if (IN(3)) { phase3(a, lds); } SEAM(3);
    if (IN(4)) { for (int it = blockIdx.x; it < 512; it += gridDim.x) attn_item(a, it); } SEAM(4);
    if (IN(5)) { for (int it = blockIdx.x; it < 256; it += gridDim.x) hgrn_item(a, it, lds); } SEAM(5);
    if (IN(6)) { phase6(a); } SEAM(6);
    if (IN(7)) { phase7(a, lds); } SEAM(7);
    if (IN(8)) { rmsnorm_rows(a.out, a.ffn_norm, (bf16_t*)(a.ws + WS_B), blockIdx.x * 8 + (threadIdx.x >> 6), gridDim.x * 8); } SEAM(8);
    if (IN(9)) { phase9(a, lds); } SEAM(9);
    if (IN(10)) { for (int it = blockIdx.x; it < 2048; it += gridDim.x) peer_route_item(a, it, lds); } SEAM(10);
    if (IN(11)) { phase11(a); }
}

extern "C" void kernel_launch(void* const* d_in, const int* in_sizes, int n_in, void* d_out, int out_size, void* d_ws, size_t ws_size, hipStream_t stream) {
    static int grid = 0;
    if (grid == 0) {
        if (n_in != 19 || out_size != T * DM || ws_size < WS_END) { fprintf(stderr, "kernel_launch: unexpected shapes (n_in %d out %d ws %zu)\n", n_in, out_size, ws_size); grid = -1; return; }
        int dev = 0, cus = 0, per_cu = 0;
        (void)hipGetDevice(&dev); (void)hipDeviceGetAttribute(&cus, hipDeviceAttributeMultiprocessorCount, dev);
        (void)hipFuncSetAttribute((const void*)fwd_kernel, hipFuncAttributeMaxDynamicSharedMemorySize, LDS_BYTES);
        (void)hipOccupancyMaxActiveBlocksPerMultiprocessor(&per_cu, (const void*)fwd_kernel, NT, LDS_BYTES);
        if (per_cu < 1) { fprintf(stderr, "kernel_launch: occupancy query says %d blocks/CU\n", per_cu); per_cu = 1; }
        grid = cus;
        (void)hipGetLastError();
    }
    if (grid < 0) return;
    Args a{};
    a.x = (const float*)d_in[0]; a.pos = (const int*)d_in[1]; a.attn_norm = (const float*)d_in[2]; a.w_in = (const float*)d_in[3];
    a.lb_logits = (const float*)d_in[4]; a.hg_o_norm = (const float*)d_in[5]; a.q_a_norm = (const float*)d_in[6]; a.w_q_up = (const float*)d_in[7];
    a.kv_a_norm = (const float*)d_in[8]; a.w_kv_up = (const float*)d_in[9]; a.q_norm = (const float*)d_in[10]; a.k_norm = (const float*)d_in[11];
    a.mla_o_norm = (const float*)d_in[12]; a.w_out = (const float*)d_in[13]; a.ffn_norm = (const float*)d_in[14]; a.peer_wq = (const float*)d_in[15];
    a.subk = (const float*)d_in[16]; a.peer_u = (const float*)d_in[17]; a.peer_v = (const float*)d_in[18];
    a.out = (float*)d_out; a.ws = (unsigned char*)d_ws;
    const int last = (STOP_AFTER < N_PHASES - 1) ? STOP_AFTER : N_PHASES - 1;
#if N_LAUNCH_MODE == 1
    a.ph_lo = 0; a.ph_hi = last + 1;
    void* args[] = {&a};
    hipError_t e = hipLaunchCooperativeKernel((const void*)fwd_kernel, dim3(grid), dim3(NT), args, LDS_BYTES, stream);
    if (e != hipSuccess) fprintf(stderr, "cooperative launch failed: %s (grid %d)\n", hipGetErrorString(e), grid);
#else
    for (int ph = 0; ph <= last; ++ph) {
        a.ph_lo = ph; a.ph_hi = ph + 1;
        hipLaunchKernelGGL(fwd_kernel, dim3(grid), dim3(NT), LDS_BYTES, stream, a);
    }
#endif
}
```

```cpp
#include <hip/hip_runtime.h>
#include <hip/hip_cooperative_groups.h>
#include <cstdio>
#include <cstdint>
namespace cg = cooperative_groups;

#ifndef N_LAUNCH_MODE
#define N_LAUNCH_MODE 1
#endif
#ifndef REPEAT_PHASE
#define REPEAT_PHASE -1
#endif
#ifndef STOP_AFTER
#define STOP_AFTER 99
#endif

typedef unsigned short bf16_t;
typedef short bf16x8 __attribute__((ext_vector_type(8)));
typedef float f32x4 __attribute__((ext_vector_type(4)));

constexpr int NT = 512;
constexpr int T = 16384, SEQ = 2048, NB = 8, DM = 1024, INW = 3264;
constexpr int OFF_Q = 0, OFF_FF = 512, OFF_FB = 1024, OFF_I = 1536, OFF_G = 2048, OFF_CQ = 2560, OFF_CKV = 2944, OFF_KR = 3200;
constexpr float EPS = 1e-6f;

constexpr size_t WS_CTL = 0;
constexpr size_t WS_WIN_T = 65536;
constexpr size_t WS_WQUP_T = WS_WIN_T + (size_t)3264 * 1024 * 2;
constexpr size_t WS_WKVUP_T = WS_WQUP_T + (size_t)768 * 384 * 2;
constexpr size_t WS_WOUT_T = WS_WKVUP_T + (size_t)1024 * 256 * 2;
constexpr size_t WS_WPQ_T = WS_WOUT_T + (size_t)1024 * 1024 * 2;
constexpr size_t WS_SUBK = WS_WPQ_T + (size_t)2048 * 1024 * 2;
constexpr size_t WS_LB = WS_SUBK + (size_t)16 * 128 * 128 * 2;
constexpr size_t WS_B = 15728640;
constexpr size_t WS_CQN = WS_B;
constexpr size_t WS_CKVN = WS_B + (size_t)T * 384 * 2;
constexpr size_t WS_C = WS_B + 33554432;
constexpr size_t WS_U16 = WS_C;
constexpr size_t WS_V16 = WS_C + 33554432;
constexpr size_t WS_V8 = WS_C + 33554432;
constexpr size_t WS_VSCALE = WS_V8 + (size_t)16384 * 1024;
constexpr size_t WS_USCALE = WS_VSCALE + 65536;
constexpr size_t WS_U8 = WS_C;
constexpr size_t WS_D = WS_C + (size_t)T * INW * 2;
constexpr size_t WS_Q = WS_D + 33554432;
constexpr size_t WS_KN = WS_Q + (size_t)T * 768 * 2;
constexpr size_t WS_VT = WS_KN + (size_t)T * 512 * 2;
constexpr size_t WS_KROPE = WS_VT + (size_t)T * 512 * 2;
constexpr size_t WS_ROPECS = WS_KROPE + (size_t)T * 64 * 2;
constexpr size_t WS_END = WS_ROPECS + (size_t)T * 64 * 4;
constexpr size_t WS_W16 = WS_KROPE;
constexpr size_t WS_IDX = WS_VT;
constexpr size_t WS_GATE = WS_VT + (size_t)T * 128 * 4;
constexpr size_t WS_ELIST = WS_D + 67108864;
constexpr size_t WS_COUNTS = WS_CTL + 16384;
constexpr size_t WS_BSTART = WS_CTL + 16384 + 32768;
static_assert(WS_ELIST + (size_t)T * 128 * 4 <= WS_VT, "edge list overflow");
static_assert(WS_LB + 4096 <= WS_B, "weights overflow");
static_assert(WS_D + (size_t)T * 2048 * 2 <= WS_IDX, "PQ overlaps IDX");
static_assert(WS_GATE + (size_t)T * 128 * 4 <= WS_VT + (size_t)T * 512 * 2, "gate overflow");
static_assert(WS_END <= 268435456, "workspace too big");

struct Args {
    const float* x; const int* pos; const float* attn_norm; const float* w_in; const float* lb_logits; const float* hg_o_norm;
    const float* q_a_norm; const float* w_q_up; const float* kv_a_norm; const float* w_kv_up; const float* q_norm; const float* k_norm;
    const float* mla_o_norm; const float* w_out; const float* ffn_norm; const float* peer_wq; const float* subk; const float* peer_u; const float* peer_v;
    float* out; unsigned char* ws; int ph_lo, ph_hi;
};

typedef __bf16 bf16v2 __attribute__((ext_vector_type(2)));
typedef float f32v2 __attribute__((ext_vector_type(2)));
__device__ __forceinline__ unsigned pack2(float lo, float hi) { const f32v2 v = {lo, hi}; return __builtin_bit_cast(unsigned, __builtin_convertvector(v, bf16v2)); }
__device__ __forceinline__ bf16_t f2bf(float f) { return (bf16_t)(pack2(f, 0.f) & 0xffffu); }
typedef _Float16 f16v2 __attribute__((ext_vector_type(2)));
__device__ __forceinline__ float frcp(float x) { return __builtin_amdgcn_rcpf(x); }
__device__ __forceinline__ float fexp2(float x) { return __builtin_amdgcn_exp2f(x); }
__device__ __forceinline__ float bf2f(bf16_t h) { return __uint_as_float(((unsigned)h) << 16); }
__device__ __forceinline__ float bflo(unsigned w) { return __uint_as_float(w << 16); }
__device__ __forceinline__ float bfhi(unsigned w) { return __uint_as_float(w & 0xffff0000u); }
__device__ __forceinline__ float wave_sum(float v) {
#pragma unroll
    for (int d = 32; d > 0; d >>= 1) v += __shfl_xor(v, d, 64);
    return v;
}
__device__ __forceinline__ f32x4 mfma16(bf16x8 a, bf16x8 b, f32x4 c) { return __builtin_amdgcn_mfma_f32_16x16x32_bf16(a, b, c, 0, 0, 0); }

__device__ const float ROPE_INV_FREQ[32] = {
    1.000000000e+00f, 7.498942018e-01f, 5.623413324e-01f, 4.216965139e-01f, 3.162277639e-01f, 2.371373922e-01f, 1.778279394e-01f, 1.333521456e-01f,
    1.000000015e-01f, 7.498941571e-02f, 5.623412877e-02f, 4.216964915e-02f, 3.162277862e-02f, 2.371373586e-02f, 1.778279431e-02f, 1.333521493e-02f,
    9.999999776e-03f, 7.498942316e-03f, 5.623413250e-03f, 4.216964822e-03f, 3.162277862e-03f, 2.371373819e-03f, 1.778279431e-03f, 1.333521446e-03f,
    1.000000047e-03f, 7.498941850e-04f, 5.623413017e-04f, 4.216965463e-04f, 3.162277862e-04f, 2.371373848e-04f, 1.778279402e-04f, 1.333521504e-04f};

template <int WAVES_M, int WAVES_N, int WM, int WN, class Epi>
__device__ __forceinline__ void gemm_block(const bf16_t* __restrict__ A, int lda, const bf16_t* __restrict__ Bt, int ldb, int K,
                                           int m0, int n0, int nrows_bt, unsigned char* lds, Epi& epi) {
    constexpr int BM = WAVES_M * WM * 16, BN = WAVES_N * WN * 16;
    constexpr int AI = BM / 64, BI = BN / 64;
    static_assert(WAVES_M * WAVES_N == 8, "8 waves");
    const int tid = threadIdx.x, lane = tid & 63, wave = tid >> 6;
    const int wm = wave / WAVES_N, wn = wave % WAVES_N;
    const int r16 = lane & 15, g = lane >> 4;
    unsigned char* As = lds;
    unsigned char* Bs = lds + BM * 144;
    f32x4 acc[WM][WN];
#pragma unroll
    for (int i = 0; i < WM; ++i)
#pragma unroll
        for (int j = 0; j < WN; ++j) acc[i][j] = (f32x4){0.f, 0.f, 0.f, 0.f};
    uint4 ra0, ra1, ra2, ra3, rb0, rb1, rb2, rb3;
    static_assert(AI <= 4 && BI <= 4, "stage regs");
#define GA_LOAD(i, k0) if constexpr (AI > i) { const int c = tid + i * NT, row = c >> 3, kc = c & 7; ra##i = *(const uint4*)(A + (size_t)(m0 + row) * lda + (k0) + kc * 8); }
#define GB_LOAD(i, k0) if constexpr (BI > i) { const int c = tid + i * NT, row = c >> 3, kc = c & 7; int rg = n0 + row; rg = rg < nrows_bt ? rg : nrows_bt - 1; rb##i = *(const uint4*)(Bt + (size_t)rg * ldb + (k0) + kc * 8); }
#define GA_STORE(i) if constexpr (AI > i) { const int c = tid + i * NT, row = c >> 3, kc = c & 7; *(uint4*)(As + row * 144 + kc * 16) = ra##i; }
#define GB_STORE(i) if constexpr (BI > i) { const int c = tid + i * NT, row = c >> 3, kc = c & 7; *(uint4*)(Bs + row * 144 + kc * 16) = rb##i; }
    GA_LOAD(0, 0) GA_LOAD(1, 0) GA_LOAD(2, 0) GA_LOAD(3, 0) GB_LOAD(0, 0) GB_LOAD(1, 0) GB_LOAD(2, 0) GB_LOAD(3, 0)
    const int nk = K / 64;
    for (int kt = 0; kt < nk; ++kt) {
        __syncthreads();
        GA_STORE(0) GA_STORE(1) GA_STORE(2) GA_STORE(3) GB_STORE(0) GB_STORE(1) GB_STORE(2) GB_STORE(3)
        __syncthreads();
        if (kt + 1 < nk) {
            const int k0 = (kt + 1) * 64;
            GA_LOAD(0, k0) GA_LOAD(1, k0) GA_LOAD(2, k0) GA_LOAD(3, k0) GB_LOAD(0, k0) GB_LOAD(1, k0) GB_LOAD(2, k0) GB_LOAD(3, k0)
        }
#pragma unroll
        for (int kk = 0; kk < 2; ++kk) {
            bf16x8 af[WM];
#pragma unroll
            for (int i = 0; i < WM; ++i) af[i] = *(const bf16x8*)(As + ((wm * WM + i) * 16 + r16) * 144 + kk * 64 + g * 16);
#pragma unroll
            for (int j = 0; j < WN; ++j) {
                const bf16x8 bfr = *(const bf16x8*)(Bs + ((wn * WN + j) * 16 + r16) * 144 + kk * 64 + g * 16);
#pragma unroll
                for (int i = 0; i < WM; ++i) acc[i][j] = mfma16(bfr, af[i], acc[i][j]);
            }
        }
    }
#undef GA_LOAD
#undef GB_LOAD
#undef GA_STORE
#undef GB_STORE
    epi(acc, m0 + wm * WM * 16, n0 + wn * WN * 16, lane);
}

namespace g256 {
constexpr int BM = 256, BK = 64, HALF = 128, HT = HALF * BK;
__device__ __forceinline__ int lds_byte(int r, int c) { const int st = (r >> 4) * 2 + (c >> 5), rr = r & 15, cc = c & 31, ob = rr * 64 + cc * 2; return st * 1024 + (ob ^ (((ob >> 9) & 1) << 5)); }
__device__ __forceinline__ void stage_rc(int b, int& R, int& C) { const int st = b / 1024, sb = b % 1024, swz = sb ^ (((sb >> 9) & 1) << 5); R = (st >> 1) * 16 + swz / 64; C = (st & 1) * 32 + (swz % 64) / 2; }

template <class Epi>
__device__ __forceinline__ void tile(const bf16_t* __restrict__ A, const bf16_t* __restrict__ Bt, int K, int brow, int bcol, unsigned char* lds, Epi& epi) {
    bf16_t* shm = (bf16_t*)lds;
#define G_SA(b, h) (shm + ((b) * 2 + (h)) * HT)
#define G_SB(b, h) (shm + (4 + (b) * 2 + (h)) * HT)
#define G_STAGE(P, BASE, br, kt) do { const long _g = (long)(br) * K + (long)(kt) * BK; \
    _Pragma("unroll") for (int _i = 0; _i < 2; ++_i) { const int _b = tix * 16 + _i * 8192; int _r, _c; stage_rc(_b, _r, _c); \
      __builtin_amdgcn_global_load_lds((const unsigned*)(BASE + _g + (long)_r * K + _c), (unsigned*)((char*)(P) + _b), 16, 0, 0); } } while (0)
#define G_LDA(dst, b, h) _Pragma("unroll") for (int m = 0; m < 4; ++m) _Pragma("unroll") for (int k = 0; k < 2; ++k) \
    dst[m][k] = *reinterpret_cast<const bf16x8*>((char*)G_SA(b, h) + lds_byte(wr * 64 + m * 16 + fr, k * 32 + fq * 8))
#define G_LDB(dst, b, h) _Pragma("unroll") for (int n = 0; n < 2; ++n) _Pragma("unroll") for (int k = 0; k < 2; ++k) \
    dst[n][k] = *reinterpret_cast<const bf16x8*>((char*)G_SB(b, h) + lds_byte(wc * 32 + n * 16 + fr, k * 32 + fq * 8))
#define G_MMA(ai, bj, At, Bt_) do { __builtin_amdgcn_s_setprio(1); \
    _Pragma("unroll") for (int m = 0; m < 4; ++m) _Pragma("unroll") for (int n = 0; n < 2; ++n) _Pragma("unroll") for (int k = 0; k < 2; ++k) \
      acc[ai][bj][m][n] = __builtin_amdgcn_mfma_f32_16x16x32_bf16(Bt_[n][k], At[m][k], acc[ai][bj][m][n], 0, 0, 0); \
    __builtin_amdgcn_s_setprio(0); } while (0)
#define G_WAIT_V(n) asm volatile("s_waitcnt vmcnt(" #n ")" ::: "memory")
#define G_WAIT_L(n) asm volatile("s_waitcnt lgkmcnt(" #n ")" ::: "memory")
#define G_BAR __builtin_amdgcn_s_barrier()
#define G_SCHED __builtin_amdgcn_sched_barrier(0)
    int tix = threadIdx.x; asm volatile("" : "+v"(tix));
    const int wid = tix >> 6, lane = tix & 63, wr = wid >> 2, wc = wid & 3, fr = lane & 15, fq = lane >> 4;
    f32x4 acc[2][2][4][2];
#pragma unroll
    for (int i0 = 0; i0 < 2; ++i0)
#pragma unroll
        for (int i1 = 0; i1 < 2; ++i1)
#pragma unroll
            for (int i2 = 0; i2 < 4; ++i2)
#pragma unroll
                for (int i3 = 0; i3 < 2; ++i3) acc[i0][i1][i2][i3] = (f32x4){0.f, 0.f, 0.f, 0.f};
    bf16x8 At[4][2], B0[2][2], B1[2][2];
    const int nt = K / BK;
    G_STAGE(G_SB(0, 0), Bt, bcol, 0); G_STAGE(G_SA(0, 0), A, brow, 0);
    G_STAGE(G_SB(0, 1), Bt, bcol + HALF, 0); G_STAGE(G_SA(0, 1), A, brow + HALF, 0);
    if (wr == 1) G_BAR;
    G_WAIT_V(4); G_BAR;
    G_STAGE(G_SB(1, 0), Bt, bcol, 1); G_STAGE(G_SA(1, 0), A, brow, 1); G_STAGE(G_SB(1, 1), Bt, bcol + HALF, 1);
    G_WAIT_V(6); G_BAR;
    for (int t = 0; t < nt - 2; t += 2) {
        G_LDB(B0, 0, 0); G_SCHED; G_LDA(At, 0, 0); G_STAGE(G_SA(1, 1), A, brow + HALF, t + 1);
        G_WAIT_L(8); G_BAR; G_WAIT_L(0); G_MMA(0, 0, At, B0); G_BAR; G_SCHED;
        G_LDB(B1, 0, 1); G_STAGE(G_SB(0, 0), Bt, bcol, t + 2);
        G_BAR; G_WAIT_L(0); G_MMA(0, 1, At, B1); G_BAR;
        G_LDA(At, 0, 1); G_STAGE(G_SA(0, 0), A, brow, t + 2);
        G_BAR; G_WAIT_L(0); G_MMA(1, 0, At, B0); G_BAR; G_SCHED;
        G_STAGE(G_SB(0, 1), Bt, bcol + HALF, t + 2);
        G_WAIT_V(6); G_BAR; G_MMA(1, 1, At, B1); G_BAR;
        G_LDB(B0, 1, 0); G_SCHED; G_LDA(At, 1, 0); G_STAGE(G_SA(0, 1), A, brow + HALF, t + 2);
        G_WAIT_L(8); G_BAR; G_WAIT_L(0); G_MMA(0, 0, At, B0); G_BAR; G_SCHED;
        G_LDB(B1, 1, 1); G_STAGE(G_SB(1, 0), Bt, bcol, t + 3);
        G_BAR; G_WAIT_L(0); G_MMA(0, 1, At, B1); G_BAR;
        G_LDA(At, 1, 1); G_STAGE(G_SA(1, 0), A, brow, t + 3);
        G_BAR; G_WAIT_L(0); G_MMA(1, 0, At, B0); G_BAR; G_SCHED;
        G_STAGE(G_SB(1, 1), Bt, bcol + HALF, t + 3);
        G_WAIT_V(6); G_BAR; G_MMA(1, 1, At, B1); G_BAR;
    }
    { G_LDB(B0, 0, 0); G_LDA(At, 0, 0); G_STAGE(G_SA(1, 1), A, brow + HALF, nt - 1);
      G_BAR; G_WAIT_L(0); G_MMA(0, 0, At, B0); G_BAR;
      G_LDB(B1, 0, 1); G_BAR; G_WAIT_L(0); G_MMA(0, 1, At, B1); G_BAR;
      G_LDA(At, 0, 1); G_WAIT_V(4); G_BAR; G_WAIT_L(0); G_MMA(1, 0, At, B0); G_MMA(1, 1, At, B1); G_BAR; }
    { G_LDB(B0, 1, 0); G_LDA(At, 1, 0); G_WAIT_V(2); G_BAR; G_WAIT_L(0); G_MMA(0, 0, At, B0); G_BAR;
      G_LDB(B1, 1, 1); G_WAIT_V(0); G_BAR; G_WAIT_L(0); G_MMA(0, 1, At, B1); G_BAR;
      G_LDA(At, 1, 1); G_BAR; G_WAIT_L(0); G_MMA(1, 0, At, B0); G_MMA(1, 1, At, B1); G_BAR; }
    if (wr == 0) G_BAR;
    epi(acc, brow + wr * 64 + fr, bcol + wc * 32 + 4 * fq);
#undef G_SA
#undef G_SB
#undef G_STAGE
#undef G_LDA
#undef G_LDB
#undef G_MMA
#undef G_WAIT_V
#undef G_WAIT_L
#undef G_BAR
#undef G_SCHED
}
__device__ __forceinline__ bool next_tile(int L, int nM, int nN, int& pm, int& pn) {
    const int nwg = nM * nN; if (L >= nwg) return false;
    int wgid = L; { const int q = nwg / 8, r = nwg % 8, xcd = wgid % 8, off = wgid / 8; wgid = (xcd < r ? xcd * (q + 1) : r * (q + 1) + (xcd - r) * q) + off; }
    const int WGM = 8, nig = WGM * nN, gid = wgid / nig, fm = gid * WGM, gsz = (nM - fm) < WGM ? (nM - fm) : WGM;
    pm = fm + ((wgid % nig) % gsz); pn = (wgid % nig) / gsz; return true;
}
struct EpiBf16 { bf16_t* O; int ldc;
    __device__ __forceinline__ void operator()(const f32x4 (&acc)[2][2][4][2], int row0, int col0) const {
#pragma unroll
        for (int ai = 0; ai < 2; ++ai)
#pragma unroll
            for (int m = 0; m < 4; ++m) { bf16_t* rp = O + (size_t)(row0 + ai * 128 + m * 16) * ldc + col0;
#pragma unroll
                for (int bj = 0; bj < 2; ++bj)
#pragma unroll
                    for (int n = 0; n < 2; ++n) { const f32x4 v = acc[ai][bj][m][n]; uint2 w; w.x = pack2(v[0], v[1]); w.y = pack2(v[2], v[3]); *(uint2*)(rp + bj * 128 + n * 16) = w; } }
    }
};
struct EpiResid { const float* X; float* O;
    __device__ __forceinline__ void operator()(const f32x4 (&acc)[2][2][4][2], int row0, int col0) const {
#pragma unroll
        for (int ai = 0; ai < 2; ++ai)
#pragma unroll
            for (int m = 0; m < 4; ++m) { const size_t ro = (size_t)(row0 + ai * 128 + m * 16) * DM + col0;
#pragma unroll
                for (int bj = 0; bj < 2; ++bj)
#pragma unroll
                    for (int n = 0; n < 2; ++n) { const size_t off = ro + bj * 128 + n * 16; const f32x4 xv = *(const f32x4*)(X + off); *(f32x4*)(O + off) = xv + acc[ai][bj][m][n]; } }
    }
};
struct EpiBf16Silu { bf16_t* O; int ldc; int nsilu;
    __device__ __forceinline__ void operator()(const f32x4 (&acc)[2][2][4][2], int row0, int col0) const {
        const bool sl = col0 < nsilu;
#pragma unroll
        for (int ai = 0; ai < 2; ++ai)
#pragma unroll
            for (int m = 0; m < 4; ++m) { bf16_t* rp = O + (size_t)(row0 + ai * 128 + m * 16) * ldc + col0;
#pragma unroll
                for (int bj = 0; bj < 2; ++bj)
#pragma unroll
                    for (int n = 0; n < 2; ++n) { f32x4 v = acc[ai][bj][m][n];
                        if (sl) {
#pragma unroll
                            for (int r = 0; r < 4; ++r) v[r] = v[r] * frcp(1.f + __expf(-v[r])); }
                        uint2 w; w.x = pack2(v[0], v[1]); w.y = pack2(v[2], v[3]); *(uint2*)(rp + bj * 128 + n * 16) = w; } }
    }
};
}

template <int WM_, int WN_> struct EpiBf16 {
    bf16_t* O; int ldc; int ncols;
    __device__ __forceinline__ void operator()(const f32x4 (&acc)[WM_][WN_], int mb, int nb, int lane) const {
        const int r16 = lane & 15, g = lane >> 4;
#pragma unroll
        for (int i = 0; i < WM_; ++i)
#pragma unroll
            for (int j = 0; j < WN_; ++j) {
                const int row = mb + i * 16 + r16, col = nb + j * 16 + 4 * g;
                if (col < ncols) { uint2 w; w.x = pack2(acc[i][j][0], acc[i][j][1]); w.y = pack2(acc[i][j][2], acc[i][j][3]); *(uint2*)(O + (size_t)row * ldc + col) = w; }
            }
    }
};
struct EpiResid {
    const float* X; float* O;
    __device__ __forceinline__ void operator()(const f32x4 (&acc)[4][2], int mb, int nb, int lane) const {
        const int r16 = lane & 15, g = lane >> 4;
#pragma unroll
        for (int i = 0; i < 4; ++i)
#pragma unroll
            for (int j = 0; j < 2; ++j) {
                const size_t off = (size_t)(mb + i * 16 + r16) * DM + nb + j * 16 + 4 * g;
                const f32x4 xv = *(const f32x4*)(X + off);
                *(f32x4*)(O + off) = xv + acc[i][j];
            }
    }
};
struct EpiQ {
    bf16_t* Q; const float* q_norm; const float* ropecs;
    __device__ __forceinline__ void operator()(const f32x4 (&accs)[2][12], int mb, int nb, int lane) const {
      const int r16 = lane & 15, g = lane >> 4;
#pragma unroll
      for (int mi = 0; mi < 2; ++mi) {
        const f32x4 (&accm)[12] = accs[mi];
        const int row = mb + mi * 16 + r16, h = nb / 192;
        float ssn = 0.f, ssr = 0.f;
#pragma unroll
        for (int j = 0; j < 8; ++j)
#pragma unroll
            for (int r = 0; r < 4; ++r) ssn += accm[j][r] * accm[j][r];
#pragma unroll
        for (int j = 8; j < 12; ++j)
#pragma unroll
            for (int r = 0; r < 4; ++r) ssr += accm[j][r] * accm[j][r];
        ssn += __shfl_xor(ssn, 16, 64); ssn += __shfl_xor(ssn, 32, 64);
        ssr += __shfl_xor(ssr, 16, 64); ssr += __shfl_xor(ssr, 32, 64);
        const float SC = 0.07216878364870322f * 1.4426950408889634f;
        const float rn = rsqrtf(ssn * (1.f / 128.f) + EPS) * SC, rr = rsqrtf(ssr * (1.f / 64.f) + EPS) * SC;
        bf16_t* qrow = Q + ((size_t)row * 4 + h) * 192;
#pragma unroll
        for (int j = 0; j < 8; ++j) {
            const int c = j * 16 + 4 * g;
            const f32x4 gn = *(const f32x4*)(q_norm + c);
            uint2 w; w.x = pack2(accm[j][0] * rn * gn[0], accm[j][1] * rn * gn[1]); w.y = pack2(accm[j][2] * rn * gn[2], accm[j][3] * rn * gn[3]);
            *(uint2*)(qrow + c) = w;
        }
#pragma unroll
        for (int j = 0; j < 2; ++j) {
            const int jj = j * 16 + 4 * g;
            const f32x4 g1 = *(const f32x4*)(q_norm + 128 + jj), g2 = *(const f32x4*)(q_norm + 160 + jj);
            float o1[4], o2[4];
#pragma unroll
            for (int r = 0; r < 4; ++r) {
                const float2 cs = *(const float2*)(ropecs + ((size_t)row * 32 + jj + r) * 2);
                const float a1 = accm[8 + j][r] * rr * g1[r], a2 = accm[10 + j][r] * rr * g2[r];
                o1[r] = a1 * cs.x - a2 * cs.y; o2[r] = a2 * cs.x + a1 * cs.y;
            }
            uint2 w; w.x = pack2(o1[0], o1[1]); w.y = pack2(o1[2], o1[3]); *(uint2*)(qrow + 128 + jj) = w;
            w.x = pack2(o2[0], o2[1]); w.y = pack2(o2[2], o2[3]); *(uint2*)(qrow + 160 + jj) = w;
        }
      }
    }
};
template <int WMK> struct EpiKV {
    bf16_t* KN; bf16_t* VT; const float* k_norm;
    __device__ __forceinline__ void operator()(const f32x4 (&accs)[WMK][16], int mb, int nb, int lane) const {
      const int r16 = lane & 15, g = lane >> 4;
#pragma unroll
      for (int mi = 0; mi < WMK; ++mi) {
        const f32x4 (&accm)[16] = accs[mi];
        const int row = mb + mi * 16 + r16, h = nb / 256;
        float ssn = 0.f;
#pragma unroll
        for (int j = 0; j < 8; ++j)
#pragma unroll
            for (int r = 0; r < 4; ++r) ssn += accm[j][r] * accm[j][r];
        ssn += __shfl_xor(ssn, 16, 64); ssn += __shfl_xor(ssn, 32, 64);
        const float rn = rsqrtf(ssn * (1.f / 128.f) + EPS);
        bf16_t* krow = KN + ((size_t)row * 4 + h) * 128;
#pragma unroll
        for (int j = 0; j < 8; ++j) {
            const int c = j * 16 + 4 * g;
            const f32x4 gn = *(const f32x4*)(k_norm + c);
            uint2 w; w.x = pack2(accm[j][0] * rn * gn[0], accm[j][1] * rn * gn[1]); w.y = pack2(accm[j][2] * rn * gn[2], accm[j][3] * rn * gn[3]);
            *(uint2*)(krow + c) = w;
        }
        const int b = row >> 11, s = row & 2047;
        bf16_t* vp = VT + ((size_t)(b * 4 + h) * 128 + 4 * g) * SEQ + s;
#pragma unroll
        for (int j = 0; j < 8; ++j) {
            asm volatile("" : "+v"(vp));
            vp[0] = f2bf(accm[8 + j][0]); vp[SEQ] = f2bf(accm[8 + j][1]); vp[2 * SEQ] = f2bf(accm[8 + j][2]); vp[3 * SEQ] = f2bf(accm[8 + j][3]);
            vp += 16 * SEQ;
        }
      }
    }
};

__device__ void transpose_convert(const float* __restrict__ W, bf16_t* __restrict__ Wt, int K, int N, unsigned char* lds, int bid, int nblk) {
    bf16_t* tile = (bf16_t*)lds;
    const int tid = threadIdx.x;
    const int tk = K / 64, tn = N / 64;
    for (int t = bid; t < tk * tn; t += nblk) {
        const int k0 = (t / tn) * 64, n0 = (t % tn) * 64;
        __syncthreads();
#pragma unroll
        for (int p = 0; p < 2; ++p) {
            const int kk = (tid >> 4) + p * 32, n4 = (tid & 15) * 4;
            const f32x4 v = *(const f32x4*)(W + (size_t)(k0 + kk) * N + n0 + n4);
#pragma unroll
            for (int r = 0; r < 4; ++r) tile[(n4 + r) * 66 + kk] = f2bf(v[r]);
        }
        __syncthreads();
        {
            const int nn = tid >> 3, k8 = (tid & 7) * 8;
            unsigned w[4];
#pragma unroll
            for (int r = 0; r < 4; ++r) w[r] = (unsigned)tile[nn * 66 + k8 + 2 * r] | ((unsigned)tile[nn * 66 + k8 + 2 * r + 1] << 16);
            *(uint4*)(Wt + (size_t)(n0 + nn) * K + k0 + k8) = make_uint4(w[0], w[1], w[2], w[3]);
        }
    }
    __syncthreads();
}

__device__ void rmsnorm_rows(const float* __restrict__ X, const float* __restrict__ gain, bf16_t* __restrict__ O, int gw, int nw) {
    const int lane = threadIdx.x & 63;
    for (int row = gw; row < T; row += nw) {
        const float* xr = X + (size_t)row * DM;
        f32x4 v[4]; float ss = 0.f;
#pragma unroll
        for (int i = 0; i < 4; ++i) { v[i] = *(const f32x4*)(xr + i * 256 + lane * 4); ss += v[i][0] * v[i][0] + v[i][1] * v[i][1] + v[i][2] * v[i][2] + v[i][3] * v[i][3]; }
        ss = wave_sum(ss);
        const float rs = rsqrtf(ss * (1.f / 1024.f) + EPS);
#pragma unroll
        for (int i = 0; i < 4; ++i) {
            const f32x4 gn = *(const f32x4*)(gain + i * 256 + lane * 4);
            uint2 w; w.x = pack2(v[i][0] * rs * gn[0], v[i][1] * rs * gn[1]); w.y = pack2(v[i][2] * rs * gn[2], v[i][3] * rs * gn[3]);
            *(uint2*)(O + (size_t)row * DM + i * 256 + lane * 4) = w;
        }
    }
}

__device__ void phase0(const Args& a, unsigned char* lds) {
    unsigned char* ws = a.ws;
    const int bid = blockIdx.x, nblk = gridDim.x, tid = threadIdx.x;
    transpose_convert(a.w_in, (bf16_t*)(ws + WS_WIN_T), 1024, 3264, lds, bid, nblk);
    transpose_convert(a.w_q_up, (bf16_t*)(ws + WS_WQUP_T), 384, 768, lds, bid, nblk);
    transpose_convert(a.w_kv_up, (bf16_t*)(ws + WS_WKVUP_T), 256, 1024, lds, bid, nblk);
    transpose_convert(a.w_out, (bf16_t*)(ws + WS_WOUT_T), 1024, 1024, lds, bid, nblk);
    transpose_convert(a.peer_wq, (bf16_t*)(ws + WS_WPQ_T), 1024, 2048, lds, bid, nblk);
    const int gt = bid * NT + tid, ngt = nblk * NT;
    bf16_t* sk = (bf16_t*)(ws + WS_SUBK);
    for (int i = gt; i < 16 * 128 * 128; i += ngt) sk[i] = f2bf(a.subk[i]);
    float* lb = (float*)(ws + WS_LB);
    for (int i = gt; i < 1024; i += ngt) { const float l0 = a.lb_logits[i], l1 = a.lb_logits[1024 + i]; lb[i] = 1.f / (1.f + expf(l1 - l0)); }
    rmsnorm_rows(a.x, a.attn_norm, (bf16_t*)(ws + WS_B), bid * 8 + (tid >> 6), nblk * 8);
}

__device__ void phase1(const Args& a, unsigned char* lds) {
    unsigned char* ws = a.ws;
    const bf16_t* H = (const bf16_t*)(ws + WS_B); const bf16_t* W = (const bf16_t*)(ws + WS_WIN_T);
    g256::EpiBf16Silu e{(bf16_t*)(ws + WS_C), INW, 512};
    for (int i = 0;; ++i) { int pm, pn; if (!g256::next_tile(i * gridDim.x + blockIdx.x, 64, 12, pm, pn)) break;
        __syncthreads();
        g256::tile(H, W, DM, pm * 256, pn * 256, lds, e); }
    __syncthreads();
    EpiBf16<1, 6> e2{(bf16_t*)(ws + WS_C), INW, INW};
    for (int t = blockIdx.x; t < 256; t += gridDim.x)
        gemm_block<4, 2, 1, 6>(H, DM, W, DM, DM, t * 64, 3072, INW, lds, e2);
}

__device__ void phase2(const Args& a) {
    unsigned char* ws = a.ws;
    const bf16_t* PROJ = (const bf16_t*)(ws + WS_C);
    bf16_t* CQN = (bf16_t*)(ws + WS_CQN); bf16_t* CKVN = (bf16_t*)(ws + WS_CKVN); bf16_t* KROPE = (bf16_t*)(ws + WS_KROPE);
    float* ROPECS = (float*)(ws + WS_ROPECS);
    const int lane = threadIdx.x & 63;
    const float2 gq0 = *(const float2*)(a.q_a_norm + lane * 2), gq1 = *(const float2*)(a.q_a_norm + 128 + lane * 2), gq2 = *(const float2*)(a.q_a_norm + 256 + lane * 2);
    const float2 gk0 = *(const float2*)(a.kv_a_norm + lane * 2), gk1 = *(const float2*)(a.kv_a_norm + 128 + lane * 2);
    const float gr = a.k_norm[128 + lane];
    const float invf = ROPE_INV_FREQ[lane & 31];
    const int nw = gridDim.x * 8;
    for (int t0 = blockIdx.x * 8 + (threadIdx.x >> 6); t0 < T; t0 += nw * 4) {
        unsigned wq[4][3], wk[4][2]; float vr[4], ps[4];
#pragma unroll
        for (int u = 0; u < 4; ++u) {
            const int t = min(t0 + u * nw, T - 1);
            const bf16_t* pr = PROJ + (size_t)t * INW;
#pragma unroll
            for (int i = 0; i < 3; ++i) wq[u][i] = *(const unsigned*)(pr + OFF_CQ + i * 128 + lane * 2);
#pragma unroll
            for (int i = 0; i < 2; ++i) wk[u][i] = *(const unsigned*)(pr + OFF_CKV + i * 128 + lane * 2);
            vr[u] = bf2f(pr[OFF_KR + lane]);
            ps[u] = (float)a.pos[t];
        }
        float sq[4], sk[4], sr[4];
#pragma unroll
        for (int u = 0; u < 4; ++u) {
            sq[u] = 0.f; sk[u] = 0.f;
#pragma unroll
            for (int i = 0; i < 3; ++i) { const float x0 = bflo(wq[u][i]), x1 = bfhi(wq[u][i]); sq[u] += x0 * x0 + x1 * x1; }
#pragma unroll
            for (int i = 0; i < 2; ++i) { const float x0 = bflo(wk[u][i]), x1 = bfhi(wk[u][i]); sk[u] += x0 * x0 + x1 * x1; }
            sr[u] = vr[u] * vr[u];
        }
#pragma unroll
        for (int d = 32; d > 0; d >>= 1)
#pragma unroll
            for (int u = 0; u < 4; ++u) { sq[u] += __shfl_xor(sq[u], d, 64); sk[u] += __shfl_xor(sk[u], d, 64); sr[u] += __shfl_xor(sr[u], d, 64); }
#pragma unroll
        for (int u = 0; u < 4; ++u) {
            const int t = t0 + u * nw;
            if (t < T) {
                const float rq = rsqrtf(sq[u] * (1.f / 384.f) + EPS), rk = rsqrtf(sk[u] * (1.f / 256.f) + EPS), rr = rsqrtf(sr[u] * (1.f / 64.f) + EPS);
                bf16_t* cq = CQN + (size_t)t * 384 + lane * 2; bf16_t* ck = CKVN + (size_t)t * 256 + lane * 2;
                *(unsigned*)(cq) = pack2(bflo(wq[u][0]) * rq * gq0.x, bfhi(wq[u][0]) * rq * gq0.y);
                *(unsigned*)(cq + 128) = pack2(bflo(wq[u][1]) * rq * gq1.x, bfhi(wq[u][1]) * rq * gq1.y);
                *(unsigned*)(cq + 256) = pack2(bflo(wq[u][2]) * rq * gq2.x, bfhi(wq[u][2]) * rq * gq2.y);
                *(unsigned*)(ck) = pack2(bflo(wk[u][0]) * rk * gk0.x, bfhi(wk[u][0]) * rk * gk0.y);
                *(unsigned*)(ck + 128) = pack2(bflo(wk[u][1]) * rk * gk1.x, bfhi(wk[u][1]) * rk * gk1.y);
                const float xn = vr[u] * rr * gr;
                const float other = __shfl_xor(xn, 32, 64);
                float sn, cs; sincosf(ps[u] * invf, &sn, &cs);
                const float o = (lane < 32) ? (xn * cs - other * sn) : (xn * cs + other * sn);
                KROPE[(size_t)t * 64 + lane] = f2bf(o);
                if (lane < 32) { *(float2*)(ROPECS + ((size_t)t * 32 + lane) * 2) = make_float2(cs, sn); }
            }
        }
    }
}

__device__ void phase3(const Args& a, unsigned char* lds) {
    unsigned char* ws = a.ws;
    EpiQ eq{(bf16_t*)(ws + WS_Q), a.q_norm, (const float*)(ws + WS_ROPECS)};
    EpiKV<1> ekv{(bf16_t*)(ws + WS_KN), (bf16_t*)(ws + WS_VT), a.k_norm};
    for (int t = blockIdx.x; t < 768; t += gridDim.x) {
        if (t < 256) { const int mt = t >> 2, h = t & 3;
            gemm_block<8, 1, 2, 12>((const bf16_t*)(ws + WS_CQN), 384, (const bf16_t*)(ws + WS_WQUP_T), 384, 384, mt * 256, h * 192, 768, lds, eq);
        } else { const int u = t - 256, mt = u >> 2, h = u & 3;
            gemm_block<8, 1, 1, 16>((const bf16_t*)(ws + WS_CKVN), 256, (const bf16_t*)(ws + WS_WKVUP_T), 256, 256, mt * 128, h * 256, 1024, lds, ekv);
        }
    }
}

constexpr int AT_KROW = 400, AT_VROW = 144, AT_KBYTES = 64 * AT_KROW, AT_VBYTES = 128 * AT_VROW, AT_BUF = AT_KBYTES + AT_VBYTES;
__device__ void attn_item(const Args& a, int item, unsigned char* lds) {
    unsigned char* ws = a.ws;
    const bf16_t* Q = (const bf16_t*)(ws + WS_Q); const bf16_t* KN = (const bf16_t*)(ws + WS_KN);
    const bf16_t* KR = (const bf16_t*)(ws + WS_KROPE); const bf16_t* VT = (const bf16_t*)(ws + WS_VT);
    bf16_t* YCAT = (bf16_t*)(ws + WS_B);
    const int qb = item & 7, h = (item >> 3) & 3, b = item >> 5;
    const int tid = threadIdx.x, lane = tid & 63, wave = tid >> 6, r16 = lane & 15, g = lane >> 4;
    const unsigned kn_off = (unsigned)((((size_t)b * SEQ + (tid >> 4)) * 4 + h) * 128 + (tid & 15) * 8);
    const unsigned kr_off = (unsigned)(((size_t)b * SEQ + (tid >> 3)) * 64 + (tid & 7) * 8);
    const unsigned vt_off = (unsigned)(((size_t)(b * 4 + h) * 128 + (tid >> 3)) * SEQ + (tid & 7) * 8);
    const int kn_dst = (tid >> 4) * AT_KROW + (tid & 15) * 16, kr_dst = (tid >> 3) * AT_KROW + 256 + (tid & 7) * 16;
    const int v_dst = AT_KBYTES + (tid >> 3) * AT_VROW + (tid & 7) * 16;
    bf16x8 qf[2][6];
#pragma unroll
    for (int qs = 0; qs < 2; ++qs) {
        const size_t tq = (size_t)b * SEQ + qb * 256 + wave * 32 + qs * 16 + r16;
#pragma unroll
        for (int kk = 0; kk < 6; ++kk) qf[qs][kk] = *(const bf16x8*)(Q + (tq * 4 + h) * 192 + kk * 32 + 8 * g);
    }
    f32x4 O[2][8];
#pragma unroll
    for (int qs = 0; qs < 2; ++qs)
#pragma unroll
        for (int d = 0; d < 8; ++d) O[qs][d] = (f32x4){0.f, 0.f, 0.f, 0.f};
    float m_run[2] = {0.f, 0.f}, l_part[2] = {0.f, 0.f};
    uint4 sk0, sk1, sk2, sv0, sv1;
#define AT_GLOADK(tile) do { \
        sk0 = *(const uint4*)(KN + kn_off + (size_t)(tile) * (64 * 512)); sk1 = *(const uint4*)(KN + kn_off + 32 * 512 + (size_t)(tile) * (64 * 512)); \
        sk2 = *(const uint4*)(KR + kr_off + (size_t)(tile) * (64 * 64)); } while (0)
#define AT_GLOADV(tile) do { \
        sv0 = *(const uint4*)(VT + vt_off + (size_t)(tile) * 64); sv1 = *(const uint4*)(VT + vt_off + (size_t)64 * SEQ + (size_t)(tile) * 64); } while (0)
#define AT_LSTOREK(buf) do { unsigned char* bb = lds + (buf) * AT_BUF; \
        *(uint4*)(bb + kn_dst) = sk0; *(uint4*)(bb + kn_dst + 32 * AT_KROW) = sk1; *(uint4*)(bb + kr_dst) = sk2; } while (0)
#define AT_LSTOREV(buf) do { unsigned char* bb = lds + (buf) * AT_BUF; \
        *(uint4*)(bb + v_dst) = sv0; *(uint4*)(bb + v_dst + 64 * AT_VROW) = sv1; } while (0)
    __syncthreads();
    AT_GLOADK(0); AT_GLOADV(0);
    AT_LSTOREK(0); AT_LSTOREV(0);
    __syncthreads();
    constexpr int NTILE = SEQ / 64;
    for (int t = 0; t < NTILE; ++t) {
        if (t + 1 < NTILE) AT_GLOADK(t + 1);
        const unsigned char* kb = lds + (t & 1) * AT_BUF;
        const unsigned char* vb = kb + AT_KBYTES;
        f32x4 S[2][4];
#pragma unroll
        for (int qs = 0; qs < 2; ++qs)
#pragma unroll
            for (int j = 0; j < 4; ++j) { const float nm = -m_run[qs]; S[qs][j] = (f32x4){nm, nm, nm, nm}; }
#pragma unroll
        for (int j = 0; j < 4; ++j) {
            const int krow = (j >> 1) * 32 + 8 * (r16 >> 2) + 4 * (j & 1) + (r16 & 3);
#pragma unroll
            for (int kk = 0; kk < 6; ++kk) {
                const bf16x8 kf = *(const bf16x8*)(kb + krow * AT_KROW + kk * 64 + g * 16);
                S[0][j] = mfma16(kf, qf[0][kk], S[0][j]);
                S[1][j] = mfma16(kf, qf[1][kk], S[1][j]);
            }
        }
        if (t + 1 < NTILE) { AT_LSTOREK((t + 1) & 1); AT_GLOADV(t + 1); }
        bf16x8 pf[2][2];
#pragma unroll
        for (int qs = 0; qs < 2; ++qs) {
            float mx = -1e30f;
#pragma unroll
            for (int j = 0; j < 4; ++j) mx = fmaxf(mx, fmaxf(fmaxf(S[qs][j][0], S[qs][j][1]), fmaxf(S[qs][j][2], S[qs][j][3])));
            mx = fmaxf(mx, __shfl_xor(mx, 16, 64)); mx = fmaxf(mx, __shfl_xor(mx, 32, 64));
            if (t == 0 || !__all(mx <= 8.f)) {
                const float delta = (t == 0) ? mx : fmaxf(mx, 0.f);
                m_run[qs] += delta;
#pragma unroll
                for (int j = 0; j < 4; ++j) { S[qs][j][0] -= delta; S[qs][j][1] -= delta; S[qs][j][2] -= delta; S[qs][j][3] -= delta; }
                if (t != 0) {
                    const float alpha = fexp2(-delta);
                    l_part[qs] *= alpha;
#pragma unroll
                    for (int d = 0; d < 8; ++d) O[qs][d] *= alpha;
                }
            }
            float ps = 0.f;
#pragma unroll
            for (int grp = 0; grp < 2; ++grp) {
                float pv[8];
#pragma unroll
                for (int jj = 0; jj < 8; ++jj) { pv[jj] = fexp2(S[qs][grp * 2 + (jj >> 2)][jj & 3]); ps += pv[jj]; }
                union { uint4 u; bf16x8 v; } cv; cv.u = make_uint4(pack2(pv[0], pv[1]), pack2(pv[2], pv[3]), pack2(pv[4], pv[5]), pack2(pv[6], pv[7]));
                pf[qs][grp] = cv.v;
            }
            l_part[qs] += ps;
        }
        __builtin_amdgcn_s_setprio(1);
#pragma unroll
        for (int grp = 0; grp < 2; ++grp)
#pragma unroll
            for (int d = 0; d < 8; ++d) {
                const bf16x8 vf = *(const bf16x8*)(vb + (d * 16 + r16) * AT_VROW + grp * 64 + g * 16);
                O[0][d] = mfma16(vf, pf[0][grp], O[0][d]);
                O[1][d] = mfma16(vf, pf[1][grp], O[1][d]);
            }
        __builtin_amdgcn_s_setprio(0);
        if (t + 1 < NTILE) AT_LSTOREV((t + 1) & 1);
        __syncthreads();
    }
#undef AT_GLOADK
#undef AT_GLOADV
#undef AT_LSTOREK
#undef AT_LSTOREV
#pragma unroll
    for (int qs = 0; qs < 2; ++qs) {
        float l = l_part[qs]; l += __shfl_xor(l, 16, 64); l += __shfl_xor(l, 32, 64);
        const float inv = frcp(l);
        float ss = 0.f;
#pragma unroll
        for (int d = 0; d < 8; ++d) { O[qs][d] *= inv; ss += O[qs][d][0] * O[qs][d][0] + O[qs][d][1] * O[qs][d][1] + O[qs][d][2] * O[qs][d][2] + O[qs][d][3] * O[qs][d][3]; }
        ss += __shfl_xor(ss, 16, 64); ss += __shfl_xor(ss, 32, 64);
        const float rs = rsqrtf(ss * (1.f / 128.f) + EPS);
        const size_t tq = (size_t)b * SEQ + qb * 256 + wave * 32 + qs * 16 + r16;
#pragma unroll
        for (int d = 0; d < 8; ++d) {
            const int dv = d * 16 + 4 * g;
            const f32x4 gn = *(const f32x4*)(a.mla_o_norm + h * 128 + dv);
            uint2 w; w.x = pack2(O[qs][d][0] * rs * gn[0], O[qs][d][1] * rs * gn[1]); w.y = pack2(O[qs][d][2] * rs * gn[2], O[qs][d][3] * rs * gn[3]);
            *(uint2*)(YCAT + tq * DM + 512 + h * 128 + dv) = w;
        }
    }
}

constexpr int HG_E = 0;
constexpr int HG_EL = HG_E + 64 * 132 * 4;
constexpr int HG_QT = HG_EL + 1024;
constexpr int HG_QH = HG_QT + 17408;
constexpr int HG_KD = HG_QH + 17408;
constexpr int HG_K10 = HG_KD + 17408;
constexpr int HG_VT = HG_K10 + 8704;
constexpr int HG_SM = HG_VT + 2 * 9216;
constexpr int HG_STB = HG_SM + 9216;
constexpr int HG_LDS = HG_STB + 2 * 17408;
__device__ void hgrn_item(const Args& a, int item, unsigned char* lds) {
    unsigned char* ws = a.ws;
    const bf16_t* PROJ = (const bf16_t*)(ws + WS_C);
    const float* LB = (const float*)(ws + WS_LB);
    bf16_t* OHG = (bf16_t*)(ws + WS_D);
    const int vs = item & 1, dir = (item >> 1) & 1, h = (item >> 2) & 3, b = item >> 4;
    const int tid = threadIdx.x, lane = tid & 63, wave = tid >> 6, r16 = lane & 15, g = lane >> 4;
    float* E = (float*)(lds + HG_E); float* EL = (float*)(lds + HG_EL);
    bf16_t* Qt = (bf16_t*)(lds + HG_QT); bf16_t* Qh = (bf16_t*)(lds + HG_QH); bf16_t* Kd = (bf16_t*)(lds + HG_KD); bf16_t* K10 = (bf16_t*)(lds + HG_K10);
    bf16_t* vT = (bf16_t*)(lds + HG_VT); bf16_t* Sm = (bf16_t*)(lds + HG_SM); bf16_t* STb = (bf16_t*)(lds + HG_STB);
    const int kB = wave * 16 + r16;
    const float lbk = LB[dir * 512 + h * 128 + kB];
    const int offf = dir ? OFF_FB : OFF_FF;
    const int rowA = tid >> 4, k8A = (tid & 15) * 8;
    const int vrow = tid >> 3, vc8 = (tid & 7) * 8;
    const size_t tokbase = (size_t)b * SEQ;
    __syncthreads();
    for (int i = tid; i < 2 * 64 * 136; i += NT) STb[i] = 0;
    f32x4 accS[4]; accS[0] = (f32x4){0.f, 0.f, 0.f, 0.f}; accS[1] = accS[0]; accS[2] = accS[0]; accS[3] = accS[0];
    unsigned short fB[16]; uint4 qA0, qA1, vA;
#define HG_PREFETCH(n) do { \
        _Pragma("unroll") for (int sc = 0; sc < 2; ++sc) _Pragma("unroll") for (int jj = 0; jj < 8; ++jj) { \
            const int tau = (n) * 64 + sc * 32 + g * 8 + jj, tt = dir ? (SEQ - 1 - tau) : tau; \
            fB[sc * 8 + jj] = PROJ[(tokbase + tt) * INW + offf + h * 128 + kB]; } \
        { const int tau = (n) * 64 + rowA, tt = dir ? (SEQ - 1 - tau) : tau; qA0 = *(const uint4*)(PROJ + (tokbase + tt) * INW + OFF_Q + h * 128 + k8A); } \
        { const int tau = (n) * 64 + rowA + 32, tt = dir ? (SEQ - 1 - tau) : tau; qA1 = *(const uint4*)(PROJ + (tokbase + tt) * INW + OFF_Q + h * 128 + k8A); } \
        { const int tau = (n) * 64 + vrow, tt = dir ? (SEQ - 1 - tau) : tau; vA = *(const uint4*)(PROJ + (tokbase + tt) * INW + OFF_I + h * 128 + vs * 64 + vc8); } \
    } while (0)
    HG_PREFETCH(0);
    for (int n = 0; n < 32; ++n) {
        bf16_t* vTn = vT + (n & 1) * (64 * 72);
        bf16x8 kbf[2];
        {
            float kd[16], ev[16], elast[2];
#pragma unroll
            for (int sc = 0; sc < 2; ++sc) {
                float run = 1.f, runi = 1.f, bb[8], bi[8];
#pragma unroll
                for (int jj = 0; jj < 8; ++jj) {
                    const float u = __expf(-bf2f(fB[sc * 8 + jj]));
                    const float a1 = 1.f + u, a2 = 1.f + lbk * u, r = frcp(a1 * a2);
                    const float f = a2 * a2 * r, fi = a1 * a1 * r;
                    kd[sc * 8 + jj] = 1.f - f;
                    run *= f; bb[jj] = run; runi *= fi; bi[jj] = runi;
                }
                float incl = run, inci = runi;
                { const float t1 = __shfl_up(incl, 16, 64), s1 = __shfl_up(inci, 16, 64); if (g >= 1) { incl *= t1; inci *= s1; } }
                { const float t2 = __shfl_up(incl, 32, 64), s2 = __shfl_up(inci, 32, 64); if (g >= 2) { incl *= t2; inci *= s2; } }
                float excl = __shfl_up(incl, 16, 64), exci = __shfl_up(inci, 16, 64); if (g == 0) { excl = 1.f; exci = 1.f; }
                elast[sc] = __shfl(incl, 48 + r16, 64);
#pragma unroll
                for (int jj = 0; jj < 8; ++jj) {
                    ev[sc * 8 + jj] = bb[jj] * excl;
                    kd[sc * 8 + jj] = kd[sc * 8 + jj] * (bi[jj] * exci);
                }
            }
#pragma unroll
            for (int sc = 0; sc < 2; ++sc)
#pragma unroll
                for (int jj = 0; jj < 8; ++jj) {
                    const int row = sc * 32 + g * 8 + jj;
                    E[row * 132 + kB] = ev[sc * 8 + jj];
                    Kd[row * 136 + kB] = f2bf(kd[sc * 8 + jj]);
                    if (sc == 0) K10[row * 136 + kB] = f2bf(kd[jj] * elast[0]);
                }
            if (g == 3) { EL[kB] = elast[0]; EL[128 + kB] = elast[1]; }
#pragma unroll
            for (int jj = 0; jj < 8; ++jj) { kbf[0][jj] = (short)f2bf(kd[jj] * elast[0] * elast[1]); kbf[1][jj] = (short)f2bf(kd[8 + jj] * elast[1]); }
        }
        {
            const unsigned w4[4] = {vA.x, vA.y, vA.z, vA.w};
#pragma unroll
            for (int q = 0; q < 4; ++q) { vTn[(vc8 + 2 * q) * 72 + vrow] = (bf16_t)(w4[q] & 0xffffu); vTn[(vc8 + 2 * q + 1) * 72 + vrow] = (bf16_t)(w4[q] >> 16); }
        }
        const uint4 qc0 = qA0, qc1 = qA1;
        if (n + 1 < 32) HG_PREFETCH(n + 1);
        __syncthreads();
        {
            const f32x4 d31 = *(const f32x4*)(EL + wave * 16 + 4 * g), d63 = *(const f32x4*)(EL + 128 + wave * 16 + 4 * g);
            const f32x4 dk = d31 * d63;
            bf16_t* stw = STb + (n & 1) * (64 * 136);
#pragma unroll
            for (int vt = 0; vt < 4; ++vt) {
                f32x4 c = accS[vt] * dk;
#pragma unroll
                for (int sc = 0; sc < 2; ++sc) {
                    const bf16x8 vf = *(const bf16x8*)(vTn + (vt * 16 + r16) * 72 + sc * 32 + 8 * g);
                    c = mfma16(kbf[sc], vf, c);
                }
                accS[vt] = c;
                uint2 w; w.x = pack2(c[0], c[1]); w.y = pack2(c[2], c[3]);
                *(uint2*)(stw + (vt * 16 + r16) * 136 + wave * 16 + 4 * g) = w;
            }
        }
        {
            const f32x4 e31a = *(const f32x4*)(EL + k8A), e31b = *(const f32x4*)(EL + k8A + 4);
#pragma unroll
            for (int u = 0; u < 2; ++u) {
                const int row = rowA + u * 32;
                const uint4 qq = u ? qc1 : qc0;
                const f32x4 ea = *(const f32x4*)(E + row * 132 + k8A), eb = *(const f32x4*)(E + row * 132 + k8A + 4);
                const float qr[8] = {bflo(qq.x), bfhi(qq.x), bflo(qq.y), bfhi(qq.y), bflo(qq.z), bfhi(qq.z), bflo(qq.w), bfhi(qq.w)};
                float qt[8], qh[8];
#pragma unroll
                for (int i = 0; i < 8; ++i) {
                    const float qs = qr[i];
                    qt[i] = qs * (i < 4 ? ea[i] : eb[i - 4]);
                    qh[i] = u ? qt[i] * (i < 4 ? e31a[i] : e31b[i - 4]) : qt[i];
                }
                *(uint4*)(Qt + row * 136 + k8A) = make_uint4(pack2(qt[0], qt[1]), pack2(qt[2], qt[3]), pack2(qt[4], qt[5]), pack2(qt[6], qt[7]));
                *(uint4*)(Qh + row * 136 + k8A) = make_uint4(pack2(qh[0], qh[1]), pack2(qh[2], qh[3]), pack2(qh[4], qh[5]), pack2(qh[6], qh[7]));
            }
        }
        __syncthreads();
#pragma unroll
        for (int q2 = 0; q2 < 2; ++q2) {
            const int tix = wave * 2 + q2, ti = tix >> 2, si = tix & 3;
            f32x4 sc = (f32x4){0.f, 0.f, 0.f, 0.f};
            if (si <= ti) {
                const bf16_t* kb = (ti >= 2 && si < 2) ? K10 : Kd;
#pragma unroll
                for (int kk = 0; kk < 4; ++kk) {
                    const bf16x8 af = *(const bf16x8*)(Qt + (ti * 16 + r16) * 136 + kk * 32 + 8 * g);
                    const bf16x8 bfr = *(const bf16x8*)(kb + (si * 16 + r16) * 136 + kk * 32 + 8 * g);
                    sc = mfma16(bfr, af, sc);
                }
                if (si == ti) {
#pragma unroll
                    for (int r = 0; r < 4; ++r) if (4 * g + r > r16) sc[r] = 0.f;
                }
            }
            uint2 w; w.x = pack2(sc[0], sc[1]); w.y = pack2(sc[2], sc[3]);
            *(uint2*)(Sm + (ti * 16 + r16) * 72 + si * 16 + 4 * g) = w;
        }
        __syncthreads();
#pragma unroll
        for (int q2 = 0; q2 < 2; ++q2) {
            const int ti = wave >> 1, vi = (wave & 1) * 2 + q2;
            const bf16_t* stp = STb + ((n + 1) & 1) * (64 * 136);
            f32x4 o = (f32x4){0.f, 0.f, 0.f, 0.f};
#pragma unroll
            for (int kk = 0; kk < 2; ++kk) {
                const bf16x8 af = *(const bf16x8*)(Sm + (ti * 16 + r16) * 72 + kk * 32 + 8 * g);
                const bf16x8 bfr = *(const bf16x8*)(vTn + (vi * 16 + r16) * 72 + kk * 32 + 8 * g);
                o = mfma16(bfr, af, o);
            }
#pragma unroll
            for (int kk = 0; kk < 4; ++kk) {
                const bf16x8 af = *(const bf16x8*)(Qh + (ti * 16 + r16) * 136 + kk * 32 + 8 * g);
                const bf16x8 bfr = *(const bf16x8*)(stp + (vi * 16 + r16) * 136 + kk * 32 + 8 * g);
                o = mfma16(bfr, af, o);
            }
            const int tau = n * 64 + ti * 16 + r16, tt = dir ? (SEQ - 1 - tau) : tau;
            uint2 w; w.x = pack2(o[0], o[1]); w.y = pack2(o[2], o[3]);
            *(uint2*)(OHG + ((size_t)dir * T + tokbase + tt) * 512 + h * 128 + vs * 64 + vi * 16 + 4 * g) = w;
        }
    }
#undef HG_PREFETCH
    __syncthreads();
}

__device__ void phase6(const Args& a) {
    unsigned char* ws = a.ws;
    const bf16_t* OHG = (const bf16_t*)(ws + WS_D); const bf16_t* PROJ = (const bf16_t*)(ws + WS_C);
    bf16_t* YCAT = (bf16_t*)(ws + WS_B);
    const int lane = threadIdx.x & 63;
    for (int t = blockIdx.x * 8 + (threadIdx.x >> 6); t < T; t += gridDim.x * 8) {
        const int c0 = lane * 8;
        const uint4 f = *(const uint4*)(OHG + (size_t)t * 512 + c0), bw = *(const uint4*)(OHG + ((size_t)T + t) * 512 + c0);
        const uint4 gg = *(const uint4*)(PROJ + (size_t)t * INW + OFF_G + c0);
        float o[8];
        o[0] = bflo(f.x) + bflo(bw.x); o[1] = bfhi(f.x) + bfhi(bw.x); o[2] = bflo(f.y) + bflo(bw.y); o[3] = bfhi(f.y) + bfhi(bw.y);
        o[4] = bflo(f.z) + bflo(bw.z); o[5] = bfhi(f.z) + bfhi(bw.z); o[6] = bflo(f.w) + bflo(bw.w); o[7] = bfhi(f.w) + bfhi(bw.w);
        float gr[8] = {bflo(gg.x), bfhi(gg.x), bflo(gg.y), bfhi(gg.y), bflo(gg.z), bfhi(gg.z), bflo(gg.w), bfhi(gg.w)};
        float ss = 0.f;
#pragma unroll
        for (int i = 0; i < 8; ++i) ss += o[i] * o[i];
        ss += __shfl_xor(ss, 1, 64); ss += __shfl_xor(ss, 2, 64); ss += __shfl_xor(ss, 4, 64); ss += __shfl_xor(ss, 8, 64);
        const float rs = rsqrtf(ss * (1.f / 128.f) + EPS);
        float y[8];
#pragma unroll
        for (int i = 0; i < 8; ++i) { const float gt = gr[i] * frcp(1.f + __expf(-gr[i])); y[i] = o[i] * rs * a.hg_o_norm[c0 + i] * gt; }
        *(uint4*)(YCAT + (size_t)t * DM + c0) = make_uint4(pack2(y[0], y[1]), pack2(y[2], y[3]), pack2(y[4], y[5]), pack2(y[6], y[7]));
    }
}

__device__ void phase7(const Args& a, unsigned char* lds) {
    unsigned char* ws = a.ws;
    g256::EpiResid e{a.x, a.out};
    for (int i = 0;; ++i) { int pm, pn; if (!g256::next_tile(i * gridDim.x + blockIdx.x, 64, 4, pm, pn)) break;
        __syncthreads();
        g256::tile((const bf16_t*)(ws + WS_B), (const bf16_t*)(ws + WS_WOUT_T), DM, pm * 256, pn * 256, lds, e); }
    __syncthreads();
    {
        const int lane = threadIdx.x & 63;
        for (int rr = blockIdx.x * 8 + (threadIdx.x >> 6); rr < 32768; rr += gridDim.x * 8) {
            const bool isv = rr >= 16384; const int row = rr & 16383;
            const float* src = (isv ? a.peer_v : a.peer_u) + (size_t)row * DM + lane * 16;
            unsigned char* dst = ws + (isv ? WS_V8 : WS_U8); float* SC = (float*)(ws + (isv ? WS_VSCALE : WS_USCALE));
            f32x4 x[4]; float amax = 0.f;
#pragma unroll
            for (int q = 0; q < 4; ++q) { x[q] = *(const f32x4*)(src + q * 4); amax = fmaxf(amax, fmaxf(fmaxf(fabsf(x[q][0]), fabsf(x[q][1])), fmaxf(fabsf(x[q][2]), fabsf(x[q][3])))); }
#pragma unroll
            for (int d = 32; d > 0; d >>= 1) amax = fmaxf(amax, __shfl_xor(amax, d, 64));
            const float sc = amax > 0.f ? 240.f / amax : 0.f;
            unsigned w[4];
#pragma unroll
            for (int q = 0; q < 4; ++q) { int pk = 0; pk = __builtin_amdgcn_cvt_pk_fp8_f32(x[q][0] * sc, x[q][1] * sc, pk, false); pk = __builtin_amdgcn_cvt_pk_fp8_f32(x[q][2] * sc, x[q][3] * sc, pk, true); w[q] = (unsigned)pk; }
            *(uint4*)(dst + (size_t)row * DM + lane * 16) = make_uint4(w[0], w[1], w[2], w[3]);
            if (lane == 0) SC[row] = amax * (1.f / 240.f);
        }
    }
}

__device__ void phase9(const Args& a, unsigned char* lds) {
    unsigned char* ws = a.ws;
    g256::EpiBf16 e{(bf16_t*)(ws + WS_D), 2048};
    for (int i = 0;; ++i) { int pm, pn; if (!g256::next_tile(i * gridDim.x + blockIdx.x, 64, 8, pm, pn)) break;
        __syncthreads();
        g256::tile((const bf16_t*)(ws + WS_B), (const bf16_t*)(ws + WS_WPQ_T), DM, pm * 256, pn * 256, lds, e); }
    __syncthreads();
}

__device__ __forceinline__ void ce_desc(float& x, float& y) { const float hi = fmaxf(x, y), lo = fminf(x, y); x = hi; y = lo; }
template <int N> __device__ __forceinline__ void bitonic_sort_desc(float (&v)[N]) {
#pragma unroll
    for (int k = 2; k <= N; k <<= 1)
#pragma unroll
        for (int j = k >> 1; j > 0; j >>= 1)
#pragma unroll
            for (int i = 0; i < N; ++i) { const int l = i ^ j; if (l > i) { if ((i & k) == 0) ce_desc(v[i], v[l]); else ce_desc(v[l], v[i]); } }
}
template <int N> __device__ __forceinline__ void bitonic_merge_desc(float (&v)[N]) {
#pragma unroll
    for (int j = N >> 1; j > 0; j >>= 1)
#pragma unroll
        for (int i = 0; i < N; ++i) { const int l = i ^ j; if (l > i) ce_desc(v[i], v[l]); }
}
__device__ __forceinline__ void xlane_merge16(float (&v)[16], int mask) {
    float o[16];
#pragma unroll
    for (int i = 0; i < 16; ++i) o[i] = __shfl_xor(v[15 - i], mask, 64);
#pragma unroll
    for (int i = 0; i < 16; ++i) v[i] = fmaxf(v[i], o[i]);
    bitonic_merge_desc<16>(v);
}
__device__ __forceinline__ unsigned bsel(unsigned m, unsigned x1, unsigned x0) { return x0 ^ ((x1 ^ x0) & m); }
__device__ __forceinline__ float sel16(const float (&v)[16], unsigned i) {
    const unsigned m0 = 0u - (i & 1u), m1 = 0u - ((i >> 1) & 1u), m2 = 0u - ((i >> 2) & 1u), m3 = 0u - ((i >> 3) & 1u);
    unsigned t8[8], t4[4], t2[2];
#pragma unroll
    for (int q = 0; q < 8; ++q) t8[q] = bsel(m0, __float_as_uint(v[2 * q + 1]), __float_as_uint(v[2 * q]));
#pragma unroll
    for (int q = 0; q < 4; ++q) t4[q] = bsel(m1, t8[2 * q + 1], t8[2 * q]);
#pragma unroll
    for (int q = 0; q < 2; ++q) t2[q] = bsel(m2, t4[2 * q + 1], t4[2 * q]);
    return __uint_as_float(bsel(m3, t2[1], t2[0]));
}
__device__ __forceinline__ float sel4(int g, float x0, float x1, float x2, float x3) {
    const unsigned m0 = 0u - ((unsigned)g & 1u), m1 = 0u - (((unsigned)g >> 1) & 1u);
    const unsigned lo = bsel(m0, __float_as_uint(x1), __float_as_uint(x0)), hi = bsel(m0, __float_as_uint(x3), __float_as_uint(x2));
    return __uint_as_float(bsel(m1, hi, lo));
}

static constexpr int PI[52] = {0,0,0,0,0,0,0,0,0,0,0,0,0,0,0,0,1,1,1,1,1,1,1,1,2,2,2,2,2,3,3,3,3,4,4,4,5,5,6,6,7,7,8,9,10,11,12,13,14,15,0,0};
static constexpr int PJ[52] = {0,1,2,3,4,5,6,7,8,9,10,11,12,13,14,15,0,1,2,3,4,5,6,7,0,1,2,3,4,0,1,2,3,0,1,2,0,1,0,1,0,1,0,0,0,0,0,0,0,0,0,0};
constexpr int RT_ROW = 272;
__device__ __forceinline__ void peer_half_top16(const bf16_t* __restrict__ PQ, const unsigned char* __restrict__ skl, int t0, int p, int c, int r16, int g, float (&out)[16]) {
    f32x4 sc[8];
#pragma unroll
    for (int ni = 0; ni < 8; ++ni) sc[ni] = (f32x4){0.f, 0.f, 0.f, 0.f};
    bf16x8 af[4];
#pragma unroll
    for (int kk = 0; kk < 4; ++kk) af[kk] = *(const bf16x8*)(PQ + (size_t)(t0 + r16) * 2048 + p * 256 + c * 128 + kk * 32 + 8 * g);
#pragma unroll
    for (int kk = 0; kk < 4; ++kk) {
        asm volatile("" ::: "memory");
#pragma unroll
        for (int ni = 0; ni < 8; ++ni) {
            const bf16x8 bfr = *(const bf16x8*)(skl + (c * 128 + ni * 16 + r16) * RT_ROW + kk * 64 + 16 * g);
            sc[ni] = mfma16(bfr, af[kk], sc[ni]);
        }
    }
    float hi[16];
#pragma unroll
    for (int ni = 0; ni < 4; ++ni)
#pragma unroll
        for (int r = 0; r < 4; ++r) {
            out[ni * 4 + r] = __uint_as_float((__float_as_uint(sc[ni][r]) & 0xffffff80u) | (unsigned)(ni * 16 + 4 * g + r));
            hi[ni * 4 + r] = __uint_as_float((__float_as_uint(sc[ni + 4][r]) & 0xffffff80u) | (unsigned)((ni + 4) * 16 + 4 * g + r));
        }
    bitonic_sort_desc<16>(out);
    bitonic_sort_desc<16>(hi);
#pragma unroll
    for (int i = 0; i < 16; ++i) out[i] = fmaxf(out[i], hi[15 - i]);
    bitonic_merge_desc<16>(out);
    xlane_merge16(out, 16);
    xlane_merge16(out, 32);
}
__device__ __forceinline__ void peer_route_finish(const Args& a, int p, int t0, const float (&ab0)[16], const float (&ab1)[16]) {
    unsigned char* ws = a.ws;
    int* IDX = (int*)(ws + WS_IDX); float* GATE = (float*)(ws + WS_GATE);
    int tix_ = threadIdx.x; asm volatile("" : "+v"(tix_));
    const int lane = tix_ & 63, r16 = lane & 15, g = lane >> 4;
    float va[16], vb[16];
#pragma unroll
    for (int i = 0; i < 16; ++i) { va[i] = __uint_as_float(__float_as_uint(ab0[i]) & 0xffffff80u); vb[i] = __uint_as_float(__float_as_uint(ab1[i]) & 0xffffff80u); }
    float v[16];
#pragma unroll
    for (int s = 0; s < 13; ++s) {
        const float x0 = __uint_as_float((__float_as_uint(va[PI[4 * s]] + vb[PJ[4 * s]]) & 0xffffff00u) | (unsigned)(PI[4 * s] * 16 + PJ[4 * s]));
        const float x1 = __uint_as_float((__float_as_uint(va[PI[4 * s + 1]] + vb[PJ[4 * s + 1]]) & 0xffffff00u) | (unsigned)(PI[4 * s + 1] * 16 + PJ[4 * s + 1]));
        const float x2 = (4 * s + 2 < 50) ? __uint_as_float((__float_as_uint(va[PI[4 * s + 2]] + vb[PJ[4 * s + 2]]) & 0xffffff00u) | (unsigned)(PI[4 * s + 2] * 16 + PJ[4 * s + 2])) : -3.0e38f;
        const float x3 = (4 * s + 3 < 50) ? __uint_as_float((__float_as_uint(va[PI[4 * s + 3]] + vb[PJ[4 * s + 3]]) & 0xffffff00u) | (unsigned)(PI[4 * s + 3] * 16 + PJ[4 * s + 3])) : -3.0e38f;
        v[s] = sel4(g, x0, x1, x2, x3);
    }
    v[13] = -3.0e38f; v[14] = -3.0e38f; v[15] = -3.0e38f;
    bitonic_sort_desc<16>(v);
    xlane_merge16(v, 16);
    xlane_merge16(v, 32);
    float e[16], sum = 0.f;
    const float mtop = __uint_as_float(__float_as_uint(v[0]) & 0xffffff00u);
#pragma unroll
    for (int q = 0; q < 16; ++q) { e[q] = __expf(__uint_as_float(__float_as_uint(v[q]) & 0xffffff00u) - mtop); sum += e[q]; }
    const float inv = 1.f / sum;
    int oi[4]; float og[4];
#pragma unroll
    for (int r = 0; r < 4; ++r) {
        const unsigned key = __float_as_uint(sel4(g, v[r], v[4 + r], v[8 + r], v[12 + r]));
        const unsigned pos = key & 255u;
        const unsigned ia = __float_as_uint(sel16(ab0, pos >> 4)) & 127u, ib = __float_as_uint(sel16(ab1, pos & 15u)) & 127u;
        oi[r] = (int)(ia * 128u + ib);
        og[r] = sel4(g, e[r], e[4 + r], e[8 + r], e[12 + r]) * inv;
    }
    const size_t o = (size_t)(t0 + r16) * 128 + p * 16 + 4 * g;
    *(int4*)(IDX + o) = make_int4(oi[0], oi[1], oi[2], oi[3]);
    *(f32x4*)(GATE + o) = (f32x4){og[0], og[1], og[2], og[3]};
}

__device__ __forceinline__ float dpp_xor1(float v) { return __builtin_bit_cast(float, __builtin_amdgcn_mov_dpp(__builtin_bit_cast(int, v), 0xB1, 0xF, 0xF, true)); }
__device__ __forceinline__ float dpp_xor2(float v) { return __builtin_bit_cast(float, __builtin_amdgcn_mov_dpp(__builtin_bit_cast(int, v), 0x4E, 0xF, 0xF, true)); }
__device__ __forceinline__ float dpp_hmirror(float v) { return __builtin_bit_cast(float, __builtin_amdgcn_mov_dpp(__builtin_bit_cast(int, v), 0x141, 0xF, 0xF, true)); }

__device__ void peer_u_phase(const Args& a) {
    unsigned char* ws = a.ws;
    const bf16_t* H2 = (const bf16_t*)(ws + WS_B); const bf16_t* U16 = (const bf16_t*)(ws + WS_U16);
    const int* IDX = (const int*)(ws + WS_IDX); float* P = (float*)(ws + WS_D);
    const int lane = threadIdx.x & 63, m = lane & 7, j = lane >> 3;
    const int v = blockIdx.x & 7, rank = blockIdx.x >> 3, nrank = (gridDim.x - v + 7) >> 3;
    const int wg = rank * 8 + (threadIdx.x >> 6), nwg = nrank * 8;
    for (int pass = 0; pass < 2; ++pass) {
        const int slice = v + 8 * pass;
        for (int t = wg; t < T; t += nwg) {
            const uint4 hq = *(const uint4*)(H2 + (size_t)t * DM + slice * 64 + 8 * m);
            const float h0 = bflo(hq.x), h1 = bfhi(hq.x), h2 = bflo(hq.y), h3 = bfhi(hq.y), h4 = bflo(hq.z), h5 = bfhi(hq.z), h6 = bflo(hq.w), h7 = bfhi(hq.w);
            int id[16];
#pragma unroll
            for (int q = 0; q < 4; ++q) { const uint4 iv = *(const uint4*)(IDX + (size_t)t * 128 + j * 16 + q * 4); id[q * 4] = iv.x; id[q * 4 + 1] = iv.y; id[q * 4 + 2] = iv.z; id[q * 4 + 3] = iv.w; }
            uint4 uq[16];
#pragma unroll
            for (int it = 0; it < 16; ++it) uq[it] = *(const uint4*)(U16 + (size_t)id[it] * DM + slice * 64 + 8 * m);
            float val0 = 0.f, val1 = 0.f;
#pragma unroll
            for (int it = 0; it < 16; ++it) {
                float d = h0 * bflo(uq[it].x) + h1 * bfhi(uq[it].x) + h2 * bflo(uq[it].y) + h3 * bfhi(uq[it].y) + h4 * bflo(uq[it].z) + h5 * bfhi(uq[it].z) + h6 * bflo(uq[it].w) + h7 * bfhi(uq[it].w);
                d += dpp_xor1(d); d += dpp_xor2(d); d += dpp_hmirror(d);
                if ((it >> 1) == m) { if (it & 1) val1 = d; else val0 = d; }
            }
            float2* dst = (float2*)(P + ((size_t)v * T + t) * 128 + j * 16 + 2 * m);
            if (pass == 1) { const float2 prev = *dst; val0 += prev.x; val1 += prev.y; }
            *dst = make_float2(val0, val1);
        }
    }
}

__device__ __forceinline__ void peer_rowcount(const int* __restrict__ IDX, int chunk, unsigned char* lds, int (&e)[16]) {
    const int r = threadIdx.x, t = chunk * 64 + (r >> 3), p = r & 7;
    unsigned char* rowcnt = lds + r * 32;
    *(uint4*)rowcnt = make_uint4(0u, 0u, 0u, 0u); *(uint4*)(rowcnt + 16) = make_uint4(0u, 0u, 0u, 0u);
#pragma unroll
    for (int q = 0; q < 4; ++q) { const int4 iv = *(const int4*)(IDX + (size_t)t * 128 + p * 16 + q * 4); e[q * 4] = iv.x; e[q * 4 + 1] = iv.y; e[q * 4 + 2] = iv.z; e[q * 4 + 3] = iv.w; }
#pragma unroll
    for (int k = 0; k < 16; ++k) rowcnt[e[k] >> 9] += 1;
}
__device__ void peer_count_phase(const Args& a, unsigned char* lds) {
    unsigned char* ws = a.ws;
    const int* IDX = (const int*)(ws + WS_IDX); int* COUNTS = (int*)(ws + WS_COUNTS);
    int* segsum = (int*)(lds + 16384);
    const int tid = threadIdx.x;
    for (int chunk = blockIdx.x; chunk < 256; chunk += gridDim.x) {
        __syncthreads();
        int e[16];
        peer_rowcount(IDX, chunk, lds, e);
        __syncthreads();
        { const int B = tid & 31, seg = tid >> 5; int sacc = 0;
#pragma unroll 8
          for (int i = 0; i < 32; ++i) sacc += lds[(seg * 32 + i) * 32 + B];
          segsum[seg * 32 + B] = sacc; }
        __syncthreads();
        if (tid < 32) { int tot = 0;
#pragma unroll
            for (int sg = 0; sg < 16; ++sg) tot += segsum[sg * 32 + tid];
            COUNTS[chunk * 32 + tid] = tot; }
    }
}
__device__ void peer_scatter_phase(const Args& a, unsigned char* lds) {
    unsigned char* ws = a.ws;
    const int* IDX = (const int*)(ws + WS_IDX); const int* COUNTS = (const int*)(ws + WS_COUNTS);
    int* BSTART = (int*)(ws + WS_BSTART); unsigned* ELIST = (unsigned*)(ws + WS_ELIST);
    int* segsum = (int*)(lds + 16384);
    int* ps = (int*)(lds + 16384 + 2048);
    int* chunkoff = (int*)(lds + 16384 + 4096);
    unsigned* off = (unsigned*)(lds + 32768);
    const int tid = threadIdx.x;
    for (int chunk = blockIdx.x; chunk < 256; chunk += gridDim.x) {
        __syncthreads();
        int e[16];
        peer_rowcount(IDX, chunk, lds, e);
        { const int B = tid & 31, part = tid >> 5; int sacc = 0;
#pragma unroll 4
          for (int c = 0; c < 16; ++c) sacc += COUNTS[(part * 16 + c) * 32 + B];
          ps[part * 32 + B] = sacc; }
        __syncthreads();
        { const int B = tid & 31, seg = tid >> 5; int sacc = 0;
#pragma unroll 8
          for (int i = 0; i < 32; ++i) sacc += lds[(seg * 32 + i) * 32 + B];
          segsum[seg * 32 + B] = sacc; }
        if (tid < 32) {
            int tot = 0, before = 0;
            const int mypart = chunk >> 4;
#pragma unroll
            for (int pt = 0; pt < 16; ++pt) { const int x = ps[pt * 32 + tid]; tot += x; if (pt < mypart) before += x; }
            for (int c = mypart * 16; c < chunk; ++c) before += COUNTS[c * 32 + tid];
            int incl = tot;
#pragma unroll
            for (int d = 1; d < 32; d <<= 1) { const int o = __shfl_up(incl, d, 64); if (tid >= d) incl += o; }
            const int bstart = incl - tot;
            chunkoff[tid] = bstart + before;
            if (chunk == 0) { BSTART[tid] = bstart; if (tid == 31) BSTART[32] = incl; }
        }
        __syncthreads();
        { const int B = tid & 31, seg = tid >> 5;
          int run = chunkoff[B];
          for (int sg = 0; sg < seg; ++sg) run += segsum[sg * 32 + B];
#pragma unroll 8
          for (int i = 0; i < 32; ++i) { const int row = seg * 32 + i; off[row * 32 + B] = (unsigned)run; run += lds[row * 32 + B]; } }
        __syncthreads();
        { const int r = tid, t = chunk * 64 + (r >> 3), p = r & 7;
#pragma unroll
          for (int k = 0; k < 16; ++k) {
              const int b = e[k] >> 9;
              const unsigned pos = off[r * 32 + b]; off[r * 32 + b] = pos + 1u;
              ELIST[pos] = (unsigned)t | ((unsigned)(e[k] & 511) << 14) | ((unsigned)(p * 16 + k) << 23);
          } }
    }
}

constexpr int PU_ROW = 272;
__device__ __forceinline__ float dot2bf(unsigned x, unsigned y, float acc) { return __builtin_amdgcn_fdot2_f32_bf16(__builtin_bit_cast(bf16v2, x), __builtin_bit_cast(bf16v2, y), acc, false); }
__device__ void peer_u_lds_phase(const Args& a, unsigned char* lds) {
    unsigned char* ws = a.ws;
    const bf16_t* H2 = (const bf16_t*)(ws + WS_B);
    const unsigned* ELIST = (const unsigned*)(ws + WS_ELIST); const int* BSTART = (const int*)(ws + WS_BSTART);
    float* P = (float*)(ws + WS_D);
    const int tid = threadIdx.x, lane = tid & 63, wave = tid >> 6, m = lane & 7;
    for (int job = blockIdx.x; job < 256; job += gridDim.x) {
        const int v = job & 7, jb = job >> 3;
        __syncthreads();
        for (int c = tid; c < 512 * 32; c += NT) {
            const int row = c >> 5, q = c & 31;
            const f32x4 x = *(const f32x4*)(a.peer_u + (size_t)(jb * 512 + row) * DM + v * 128 + q * 4);
            *(uint2*)(lds + row * PU_ROW + q * 8) = make_uint2(pack2(x[0], x[1]), pack2(x[2], x[3]));
        }
        __syncthreads();
        const int bs = BSTART[jb], be = BSTART[jb + 1];
        const bf16_t* hbase = H2 + v * 128 + m * 16;
        int base = bs + wave * 64;
        uint4 ra = *(const uint4*)(ELIST + base + (lane & ~7)), rb = *(const uint4*)(ELIST + base + (lane & ~7) + 4);
        for (; base < be; base += 8 * 64) {
            const int nb = (base + 512 < be) ? base + 512 : base;
            const uint4 na = *(const uint4*)(ELIST + nb + (lane & ~7)), nbv = *(const uint4*)(ELIST + nb + (lane & ~7) + 4);
            const unsigned recs[8] = {ra.x, ra.y, ra.z, ra.w, rb.x, rb.y, rb.z, rb.w};
            uint4 h0[8], h1[8];
#pragma unroll
            for (int it = 0; it < 8; ++it) { const bf16_t* hp = hbase + (size_t)(recs[it] & 16383u) * DM; h0[it] = *(const uint4*)hp; h1[it] = *(const uint4*)(hp + 8); }
            float val = 0.f;
#pragma unroll
            for (int it = 0; it < 8; ++it) {
                const unsigned el = (recs[it] >> 14) & 511u;
                const uint4 u0 = *(const uint4*)(lds + el * PU_ROW + m * 32), u1 = *(const uint4*)(lds + el * PU_ROW + m * 32 + 16);
                float d = 0.f;
                d = dot2bf(h0[it].x, u0.x, d); d = dot2bf(h0[it].y, u0.y, d); d = dot2bf(h0[it].z, u0.z, d); d = dot2bf(h0[it].w, u0.w, d);
                d = dot2bf(h1[it].x, u1.x, d); d = dot2bf(h1[it].y, u1.y, d); d = dot2bf(h1[it].z, u1.z, d); d = dot2bf(h1[it].w, u1.w, d);
                d += dpp_xor1(d); d += dpp_xor2(d); d += dpp_hmirror(d);
                if (it == m) val = d;
            }
            if (base + lane < be) P[(size_t)v * ((size_t)T * 128) + base + lane] = val;
            ra = na; rb = nbv;
        }
    }
}

__device__ void peer_act_phase(const Args& a) {
    unsigned char* ws = a.ws;
    const float* P = (const float*)(ws + WS_D); float* GATE = (float*)(ws + WS_GATE); const unsigned* ELIST = (const unsigned*)(ws + WS_ELIST);
    const int* IDX = (const int*)(ws + WS_IDX); const float* VS = (const float*)(ws + WS_VSCALE); _Float16* W16 = (_Float16*)(ws + WS_W16);
    const size_t n = (size_t)T * 128;
    for (size_t i = (size_t)blockIdx.x * NT + threadIdx.x; i < n; i += (size_t)gridDim.x * NT) {
        float sacc = P[i];
#pragma unroll
        for (int v = 1; v < 8; ++v) sacc += P[(size_t)v * n + i];
        const unsigned r = ELIST[i];
        const size_t o = (size_t)(r & 16383u) * 128 + (r >> 23);
        W16[o] = (_Float16)(GATE[o] * 0.5f * sacc * (1.f + erff(sacc * 0.70710678118654752f)) * VS[IDX[o]]);
    }
}


__device__ void peer_route_task(const Args& a, int p, int t0, const unsigned char* skl) {
    const bf16_t* PQ = (const bf16_t*)(a.ws + WS_D);
    const int lane = threadIdx.x & 63, r16 = lane & 15, g = lane >> 4;
    float ab0[16], ab1[16];
    peer_half_top16(PQ, skl, t0, p, 0, r16, g, ab0);
    peer_half_top16(PQ, skl, t0, p, 1, r16, g, ab1);
    peer_route_finish(a, p, t0, ab0, ab1);
}
__device__ __forceinline__ void peer_half_top16_lds(const unsigned char* __restrict__ qs, const unsigned char* __restrict__ skl, int r16, int g, float (&out)[16]) {
    f32x4 sc[8];
#pragma unroll
    for (int ni = 0; ni < 8; ++ni) sc[ni] = (f32x4){0.f, 0.f, 0.f, 0.f};
#pragma unroll
    for (int kk = 0; kk < 4; ++kk) {
        asm volatile("" ::: "memory");
        const bf16x8 af = *(const bf16x8*)(qs + r16 * RT_ROW + kk * 64 + 16 * g);
#pragma unroll
        for (int ni = 0; ni < 8; ++ni) {
            const bf16x8 bfr = *(const bf16x8*)(skl + (ni * 16 + r16) * RT_ROW + kk * 64 + 16 * g);
            sc[ni] = mfma16(bfr, af, sc[ni]);
        }
    }
    float hi[16];
#pragma unroll
    for (int ni = 0; ni < 4; ++ni)
#pragma unroll
        for (int r = 0; r < 4; ++r) {
            out[ni * 4 + r] = __uint_as_float((__float_as_uint(sc[ni][r]) & 0xffffff80u) | (unsigned)(ni * 16 + 4 * g + r));
            hi[ni * 4 + r] = __uint_as_float((__float_as_uint(sc[ni + 4][r]) & 0xffffff80u) | (unsigned)((ni + 4) * 16 + 4 * g + r));
        }
    bitonic_sort_desc<16>(out);
    bitonic_sort_desc<16>(hi);
#pragma unroll
    for (int i = 0; i < 16; ++i) out[i] = fmaxf(out[i], hi[15 - i]);
    bitonic_merge_desc<16>(out);
    xlane_merge16(out, 16);
    xlane_merge16(out, 32);
}
struct EpiRoute { const Args* ap; unsigned char* lds; int p; int brow;
    __device__ __forceinline__ void operator()(const f32x4 (&acc)[2][2][4][2], int row0, int col0) const {
        int tix = threadIdx.x; asm volatile("" : "+v"(tix));
        const int lane = tix & 63, wave = tix >> 6, r16 = lane & 15, g = lane >> 4;
        unsigned char* qs = lds;
        unsigned char* skl = lds + 256 * RT_ROW;
        const int rl0 = row0 - brow, cl0 = (col0 - p * 256);
        float* tl = (float*)(lds + 384 * RT_ROW);
#pragma unroll 1
        for (int c = 0; c < 2; ++c) {
            __syncthreads();
#pragma unroll
            for (int ai = 0; ai < 2; ++ai)
#pragma unroll
                for (int m = 0; m < 4; ++m)
#pragma unroll
                    for (int n = 0; n < 2; ++n) { const f32x4 v = c ? acc[ai][1][m][n] : acc[ai][0][m][n]; uint2 w; w.x = pack2(v[0], v[1]); w.y = pack2(v[2], v[3]);
                        *(uint2*)(qs + (rl0 + ai * 128 + m * 16) * RT_ROW + (cl0 + n * 16) * 2) = w; }
            { const bf16_t* SK = (const bf16_t*)(ap->ws + WS_SUBK) + ((size_t)p * 2 + c) * 128 * 128;
              for (int ch = tix; ch < 128 * 16; ch += NT) { const int row = ch >> 4, q = ch & 15; *(uint4*)(skl + row * RT_ROW + q * 16) = *(const uint4*)(SK + row * 128 + q * 8); } }
            __syncthreads();
#pragma unroll 1
            for (int k = 0; k < 2; ++k) {
                float lst[16];
                peer_half_top16_lds(qs + ((wave * 2 + k) * 16) * RT_ROW, skl, r16, g, lst);
                if (g == 0) { float* d = tl + (((wave * 2 + k) * 16 + r16) * 2 + c) * 16;
#pragma unroll
                    for (int q = 0; q < 4; ++q) *(f32x4*)(d + q * 4) = (f32x4){lst[q * 4], lst[q * 4 + 1], lst[q * 4 + 2], lst[q * 4 + 3]}; }
            }
        }
        __syncthreads();
#pragma unroll 1
        for (int k = 0; k < 2; ++k) {
            float ab0[16], ab1[16];
            const float* d = tl + (((wave * 2 + k) * 16 + r16) * 2) * 16;
#pragma unroll
            for (int q = 0; q < 4; ++q) { const f32x4 x0 = *(const f32x4*)(d + q * 4), x1 = *(const f32x4*)(d + 16 + q * 4);
                ab0[q * 4] = x0[0]; ab0[q * 4 + 1] = x0[1]; ab0[q * 4 + 2] = x0[2]; ab0[q * 4 + 3] = x0[3]; ab1[q * 4] = x1[0]; ab1[q * 4 + 1] = x1[1]; ab1[q * 4 + 2] = x1[2]; ab1[q * 4 + 3] = x1[3]; }
            peer_route_finish(*ap, p, brow + (wave * 2 + k) * 16, ab0, ab1);
        }
    }
};

__device__ void phase9_fused(const Args& a, unsigned char* lds) {
    unsigned char* ws = a.ws;
    for (int i = 0;; ++i) { int pm, pn; if (!g256::next_tile(i * gridDim.x + blockIdx.x, 64, 8, pm, pn)) break;
        EpiRoute e{&a, lds, pn, pm * 256};
        __syncthreads();
        g256::tile((const bf16_t*)(ws + WS_B), (const bf16_t*)(ws + WS_WPQ_T), DM, pm * 256, pn * 256, lds, e); }
    __syncthreads();
}

__device__ void peer_u_gather_phase(const Args& a) {
    unsigned char* ws = a.ws;
    const bf16_t* H2 = (const bf16_t*)(ws + WS_B); const unsigned char* U8 = ws + WS_U8;
    const unsigned* IDX = (const unsigned*)(ws + WS_IDX); float* P = (float*)(ws + WS_D);
    int tix = threadIdx.x; asm volatile("" : "+v"(tix));
    const int lane = tix & 63, m = lane & 7, j = lane >> 3;
    const int v = blockIdx.x & 7, rank = blockIdx.x >> 3, nrank = (gridDim.x - v + 7) >> 3;
    const int wg = rank * 8 + (tix >> 6), nwg = nrank * 8;
    const unsigned uoff = (unsigned)(v * 128 + 16 * m);
    for (int tp = wg; tp < T / 2; tp += nwg) {
        uint4 hq[2][2]; uint4 iq[2][4];
#pragma unroll
        for (int tt = 0; tt < 2; ++tt) {
            const size_t t = (size_t)tp * 2 + tt;
            hq[tt][0] = *(const uint4*)(H2 + t * DM + v * 128 + 16 * m); hq[tt][1] = *(const uint4*)(H2 + t * DM + v * 128 + 16 * m + 8);
#pragma unroll
            for (int q = 0; q < 4; ++q) iq[tt][q] = *(const uint4*)(IDX + t * 128 + j * 16 + q * 4);
        }
        uint4 uq[2][16];
#pragma unroll
        for (int tt = 0; tt < 2; ++tt)
#pragma unroll
            for (int q = 0; q < 4; ++q) {
                uq[tt][q * 4] = *(const uint4*)(U8 + (iq[tt][q].x * 1024u + uoff)); uq[tt][q * 4 + 1] = *(const uint4*)(U8 + (iq[tt][q].y * 1024u + uoff));
                uq[tt][q * 4 + 2] = *(const uint4*)(U8 + (iq[tt][q].z * 1024u + uoff)); uq[tt][q * 4 + 3] = *(const uint4*)(U8 + (iq[tt][q].w * 1024u + uoff));
            }
#pragma unroll
        for (int tt = 0; tt < 2; ++tt) {
            const unsigned hw[8] = {hq[tt][0].x, hq[tt][0].y, hq[tt][0].z, hq[tt][0].w, hq[tt][1].x, hq[tt][1].y, hq[tt][1].z, hq[tt][1].w};
            float val0 = 0.f, val1 = 0.f;
#pragma unroll
            for (int it = 0; it < 16; ++it) {
                unsigned wd[4] = {uq[tt][it].x, uq[tt][it].y, uq[tt][it].z, uq[tt][it].w};
                asm volatile("" : "+v"(wd[0]), "+v"(wd[1]), "+v"(wd[2]), "+v"(wd[3]), "+v"(val0), "+v"(val1));
                float d0 = 0.f, d1 = 0.f;
#pragma unroll
                for (int q = 0; q < 4; ++q) {
                    const bf16v2 lo = __builtin_amdgcn_cvt_scalef32_pk_bf16_fp8(wd[q], 1.0f, false), hi = __builtin_amdgcn_cvt_scalef32_pk_bf16_fp8(wd[q], 1.0f, true);
                    d0 = __builtin_amdgcn_fdot2_f32_bf16(__builtin_bit_cast(bf16v2, hw[2 * q]), lo, d0, false);
                    d1 = __builtin_amdgcn_fdot2_f32_bf16(__builtin_bit_cast(bf16v2, hw[2 * q + 1]), hi, d1, false);
                }
                float d = d0 + d1;
                d += dpp_xor1(d); d += dpp_xor2(d); d += dpp_hmirror(d);
                if ((it >> 1) == m) { if (it & 1) val1 = d; else val0 = d; }
            }
            *(float2*)(P + ((size_t)v * T + (size_t)tp * 2 + tt) * 128 + j * 16 + 2 * m) = make_float2(val0, val1);
        }
    }
}
__device__ void peer_act_tm_phase(const Args& a) {
    unsigned char* ws = a.ws;
    const float* P = (const float*)(ws + WS_D); const float* GATE = (const float*)(ws + WS_GATE); const int* IDX = (const int*)(ws + WS_IDX);
    const float* VS = (const float*)(ws + WS_VSCALE); const float* US = (const float*)(ws + WS_USCALE); _Float16* W16 = (_Float16*)(ws + WS_W16);
    const size_t n4 = (size_t)T * 128 / 4;
    for (size_t i = (size_t)blockIdx.x * NT + threadIdx.x; i < n4; i += (size_t)gridDim.x * NT) {
        f32x4 sacc = *(const f32x4*)(P + i * 4);
#pragma unroll
        for (int v = 1; v < 8; ++v) sacc += *(const f32x4*)(P + (size_t)v * T * 128 + i * 4);
        const f32x4 gt = *(const f32x4*)(GATE + i * 4); const int4 id = *(const int4*)(IDX + i * 4);
        const int ids[4] = {id.x, id.y, id.z, id.w};
        unsigned short o[4];
#pragma unroll
        for (int r = 0; r < 4; ++r) { const float x = sacc[r] * US[ids[r]]; const _Float16 hv = (_Float16)(gt[r] * 0.5f * x * (1.f + erff(x * 0.70710678118654752f)) * VS[ids[r]]); o[r] = __builtin_bit_cast(unsigned short, hv); }
        *(uint2*)((unsigned short*)W16 + i * 4) = make_uint2((unsigned)o[0] | ((unsigned)o[1] << 16), (unsigned)o[2] | ((unsigned)o[3] << 16));
    }
}

__device__ void peer_v_phase(const Args& a) {
    unsigned char* ws = a.ws;
    const unsigned char* V8 = ws + WS_V8;
    const int* IDX = (const int*)(ws + WS_IDX); const _Float16* W16 = (const _Float16*)(ws + WS_W16);
    int tix = threadIdx.x; asm volatile("" : "+v"(tix));
    const int lane = tix & 63, m = lane & 7, j = lane >> 3;
    const int v = blockIdx.x & 7, rank = blockIdx.x >> 3, nrank = (gridDim.x - v + 7) >> 3;
    const int wg = rank * 8 + (tix >> 6), nwg = nrank * 8;
    const unsigned voff = (unsigned)(v * 128 + 16 * m);
    for (int oct = wg; oct < T / 8; oct += nwg) {
        const int t = oct * 8 + j;
        float y[16];
#pragma unroll
        for (int i = 0; i < 16; ++i) y[i] = 0.f;
        uint4 iq[8]; uint4 wq[4];
#pragma unroll
        for (int q = 0; q < 8; ++q) iq[q] = *(const uint4*)(IDX + (size_t)t * 128 + q * 4);
#pragma unroll
        for (int q = 0; q < 4; ++q) wq[q] = *(const uint4*)(W16 + (size_t)t * 128 + q * 8);
#pragma unroll 1
        for (int grp = 0; grp < 4; ++grp) {
            const int gn = (grp < 3) ? grp + 1 : grp;
            uint4 vq[32];
#pragma unroll
            for (int q = 0; q < 8; ++q) {
                vq[q * 4] = *(const uint4*)(V8 + (iq[q].x * 1024u + voff)); vq[q * 4 + 1] = *(const uint4*)(V8 + (iq[q].y * 1024u + voff));
                vq[q * 4 + 2] = *(const uint4*)(V8 + (iq[q].z * 1024u + voff)); vq[q * 4 + 3] = *(const uint4*)(V8 + (iq[q].w * 1024u + voff));
            }
            uint4 wnx[4];
#pragma unroll
            for (int q = 0; q < 8; ++q) iq[q] = *(const uint4*)(IDX + (size_t)t * 128 + gn * 32 + q * 4);
#pragma unroll
            for (int q = 0; q < 4; ++q) wnx[q] = *(const uint4*)(W16 + (size_t)t * 128 + gn * 32 + q * 8);
#pragma unroll
            for (int it = 0; it < 32; ++it) {
                const uint4 wv4 = wq[it >> 3]; const int wc_ = (it >> 1) & 3;
                const unsigned wword = wc_ == 0 ? wv4.x : (wc_ == 1 ? wv4.y : (wc_ == 2 ? wv4.z : wv4.w));
                const f16v2 wp = __builtin_bit_cast(f16v2, wword);
                const float wt = (float)((it & 1) ? wp[1] : wp[0]);
                const unsigned wd[4] = {vq[it].x, vq[it].y, vq[it].z, vq[it].w};
#pragma unroll
                for (int q = 0; q < 4; ++q) {
                    const f32v2 lo = __builtin_amdgcn_cvt_pk_f32_fp8((int)wd[q], false), hi = __builtin_amdgcn_cvt_pk_f32_fp8((int)wd[q], true);
                    y[q * 4] += wt * lo[0]; y[q * 4 + 1] += wt * lo[1]; y[q * 4 + 2] += wt * hi[0]; y[q * 4 + 3] += wt * hi[1];
                }
            }
#pragma unroll
            for (int q = 0; q < 4; ++q) wq[q] = wnx[q];
        }
        float* orow = a.out + (size_t)t * DM + v * 128 + 16 * m;
#pragma unroll
        for (int q = 0; q < 4; ++q) {
            f32x4 o = *(const f32x4*)(orow + q * 4);
            o[0] += y[q * 4]; o[1] += y[q * 4 + 1]; o[2] += y[q * 4 + 2]; o[3] += y[q * 4 + 3];
            *(f32x4*)(orow + q * 4) = o;
        }
    }
}

#define XB_TMO      128
#define XB_XCNT(j)  (256  + 64 * (j))
#define XB_XSUB(j)  (1280 + 64 * (j))
#define XB_XGEN(j)  (2304 + 64 * (j))
#define XB_TOP      3328
#define XB_TOPGEN   3392
#define XCD_BAR_WORDS 3456
#define XB_SPIN_CAP (1u << 22)
#define LAS __attribute__((address_space(3)))
__device__ __forceinline__ unsigned xb_ld(unsigned* p)              { return __hip_atomic_load(p, __ATOMIC_RELAXED, __HIP_MEMORY_SCOPE_AGENT); }
__device__ __forceinline__ unsigned xb_add(unsigned* p, unsigned v) { return __hip_atomic_fetch_add(p, v, __ATOMIC_RELAXED, __HIP_MEMORY_SCOPE_AGENT); }
__device__ __forceinline__ unsigned xb_xcc_id() { return (unsigned)__builtin_amdgcn_s_getreg((3 << 11) | 20) & 0xFu; }
#define XB_SPIN(cond, bar) do { unsigned _sp = 0; while (cond) { __builtin_amdgcn_s_sleep(1); \
    if ((++_sp & 255u) == 0u) { if (xb_ld(&(bar)[XB_TMO])) break; if (_sp > XB_SPIN_CAP) { atomicAdd(&(bar)[XB_TMO], 1u); break; } } } } while (0)
struct XcdBarrier { unsigned* bar; unsigned x; volatile LAS unsigned* st; };
__device__ __forceinline__ XcdBarrier xcd_barrier_post(unsigned* bar, volatile LAS unsigned* st) {
    XcdBarrier b; b.bar = bar; b.x = xb_xcc_id(); b.st = st;
    if (threadIdx.x == 0) (void)xb_add(&bar[XB_XCNT(b.x)], 1u);
    return b;
}
__device__ __forceinline__ void xcd_barrier_complete(unsigned* bar, unsigned x, unsigned& nloc, unsigned& nx) {
    const unsigned G = gridDim.x * gridDim.y * gridDim.z;
    unsigned sum, cnt, mine, sp = 0u;
    for (;;) {
        sum = 0u; cnt = 0u; mine = 0u;
#pragma unroll
        for (unsigned j = 0; j < 16; ++j) { const unsigned c = xb_ld(&bar[XB_XCNT(j)]); sum += c; cnt += (c > 0u) ? 1u : 0u; mine = (j == x) ? c : mine; }
        if (sum == G) break;
        __builtin_amdgcn_s_sleep(1);
        if ((++sp & 255u) == 0u) { if (xb_ld(&bar[XB_TMO])) break; if (sp > XB_SPIN_CAP) { atomicAdd(&bar[XB_TMO], 1u); break; } }
    }
    nloc = mine > 0u ? mine : 1u; nx = cnt > 0u ? cnt : 1u;
}
__device__ __forceinline__ void xcd_barrier(const XcdBarrier& b) {
    asm volatile("s_waitcnt vmcnt(0)" ::: "memory");
    __syncthreads();
    if (threadIdx.x == 0) {
        unsigned* bar = b.bar;
        __builtin_amdgcn_s_waitcnt(0);
        unsigned nloc = b.st[0], nx = b.st[1];
        if (nloc == 0u) { xcd_barrier_complete(bar, b.x, nloc, nx); b.st[0] = nloc; b.st[1] = nx; }
        const unsigned old = xb_add(&bar[XB_XSUB(b.x)], 1u);
        const unsigned gen = old / nloc;
        if (old + 1u == (gen + 1u) * nloc) {
            __builtin_amdgcn_fence(__ATOMIC_RELEASE, "agent");
            asm volatile("s_waitcnt vmcnt(0)" ::: "memory");
            const unsigned og = xb_add(&bar[XB_TOP], 1u);
            const unsigned tg = og / nx;
            if (og + 1u == (tg + 1u) * nx) xb_add(&bar[XB_TOPGEN], 1u);
            else XB_SPIN(xb_ld(&bar[XB_TOPGEN]) == tg, bar);
            __builtin_amdgcn_fence(__ATOMIC_ACQUIRE, "agent");
            xb_add(&bar[XB_XGEN(b.x)], 1u);
            asm volatile("s_waitcnt vmcnt(0)" ::: "memory");
        } else {
            XB_SPIN(xb_ld(&bar[XB_XGEN(b.x)]) == gen, bar);
            __builtin_amdgcn_fence(__ATOMIC_ACQUIRE, "agent");
            asm volatile("s_waitcnt vmcnt(0)" ::: "memory");
        }
    }
    __syncthreads();
}

constexpr int LDS_MAIN = HG_LDS;
static_assert(LDS_MAIN >= 512 * PU_ROW && LDS_MAIN >= 2 * AT_BUF && LDS_MAIN >= 131072, "LDS_MAIN");
constexpr int LDS_BYTES = LDS_MAIN + 16;
constexpr int N_PHASES = 14;

__global__ void __launch_bounds__(NT, 2) fwd_kernel(Args a) {
    extern __shared__ __attribute__((aligned(16))) unsigned char lds[];
#if N_LAUNCH_MODE == 1
#ifdef USE_CG_SYNC
    cg::grid_group grid = cg::this_grid();
#endif
    volatile LAS unsigned* xst = (volatile LAS unsigned*)(lds + LDS_MAIN);
    if (threadIdx.x < 4) xst[threadIdx.x] = 0u;
    __syncthreads();
    XcdBarrier xbar = xcd_barrier_post((unsigned*)(a.ws + WS_CTL), xst);
#ifdef USE_CG_SYNC
#define SEAM(k) do { if (a.ph_lo <= (k) && (k) + 1 < a.ph_hi) { if ((k) == 0) grid.sync(); else xcd_barrier(xbar); } } while (0)
#else
#define SEAM(k) do { if (a.ph_lo <= (k) && (k) + 1 < a.ph_hi) { xcd_barrier(xbar); } } while (0)
#endif
#else
#define SEAM(k) do { } while (0)
#endif
#define IN(k) (a.ph_lo <= (k) && (k) < a.ph_hi)
#define REPS(k) for (int rep_ = 0; rep_ < ((k) == REPEAT_PHASE ? 2 : 1); ++rep_)
    if (IN(0)) REPS(0) { phase0(a, lds); } SEAM(0);
    if (IN(1)) REPS(1) { phase1(a, lds); } SEAM(1);
    if (IN(2)) REPS(2) { phase2(a); } SEAM(2);
    if (IN(3)) REPS(3) { phase3(a, lds); } SEAM(3);
    if (IN(4)) REPS(4) {
        const int nhalf = gridDim.x >> 1;
        if ((int)blockIdx.x < nhalf) { for (int it = blockIdx.x; it < 256; it += nhalf) attn_item(a, it, lds); }
        else { for (int it = blockIdx.x - nhalf; it < 128; it += gridDim.x - nhalf) hgrn_item(a, it, lds); }
    } SEAM(5);
    if (IN(6)) REPS(6) { phase6(a); } SEAM(6);
    if (IN(7)) REPS(7) { phase7(a, lds); } SEAM(7);
    if (IN(8)) REPS(8) { rmsnorm_rows(a.out, a.ffn_norm, (bf16_t*)(a.ws + WS_B), blockIdx.x * 8 + (threadIdx.x >> 6), gridDim.x * 8); } SEAM(8);
    if (IN(9)) REPS(9) { phase9_fused(a, lds); } SEAM(10);
    if (IN(11)) REPS(11) { peer_u_gather_phase(a); } SEAM(11);
    if (IN(12)) { peer_act_tm_phase(a); } SEAM(12);
    if (IN(13)) { peer_v_phase(a); }
}

extern "C" void kernel_launch(void* const* d_in, const int* in_sizes, int n_in, void* d_out, int out_size, void* d_ws, size_t ws_size, hipStream_t stream) {
    static int grid = 0;
    if (grid == 0) {
        if (n_in != 19 || out_size != T * DM || ws_size < WS_END) { fprintf(stderr, "kernel_launch: unexpected shapes (n_in %d out %d ws %zu)\n", n_in, out_size, ws_size); grid = -1; return; }
        int dev = 0, cus = 0, per_cu = 0;
        (void)hipGetDevice(&dev); (void)hipDeviceGetAttribute(&cus, hipDeviceAttributeMultiprocessorCount, dev);
        (void)hipFuncSetAttribute((const void*)fwd_kernel, hipFuncAttributeMaxDynamicSharedMemorySize, LDS_BYTES);
        (void)hipOccupancyMaxActiveBlocksPerMultiprocessor(&per_cu, (const void*)fwd_kernel, NT, LDS_BYTES);
        if (per_cu < 1) { fprintf(stderr, "kernel_launch: occupancy query says %d blocks/CU\n", per_cu); per_cu = 1; }
        grid = cus;
        (void)hipGetLastError();
    }
    if (grid < 0) return;
    Args a{};
    a.x = (const float*)d_in[0]; a.pos = (const int*)d_in[1]; a.attn_norm = (const float*)d_in[2]; a.w_in = (const float*)d_in[3];
    a.lb_logits = (const float*)d_in[4]; a.hg_o_norm = (const float*)d_in[5]; a.q_a_norm = (const float*)d_in[6]; a.w_q_up = (const float*)d_in[7];
    a.kv_a_norm = (const float*)d_in[8]; a.w_kv_up = (const float*)d_in[9]; a.q_norm = (const float*)d_in[10]; a.k_norm = (const float*)d_in[11];
    a.mla_o_norm = (const float*)d_in[12]; a.w_out = (const float*)d_in[13]; a.ffn_norm = (const float*)d_in[14]; a.peer_wq = (const float*)d_in[15];
    a.subk = (const float*)d_in[16]; a.peer_u = (const float*)d_in[17]; a.peer_v = (const float*)d_in[18];
    a.out = (float*)d_out; a.ws = (unsigned char*)d_ws;
    const int last = (STOP_AFTER < N_PHASES - 1) ? STOP_AFTER : N_PHASES - 1;
#if N_LAUNCH_MODE == 1
    (void)hipMemsetAsync((unsigned char*)d_ws + WS_CTL, 0, 16384, stream);
    a.ph_lo = 0; a.ph_hi = last + 1;
#ifdef USE_CG_SYNC
    void* args[] = {&a};
    hipError_t e = hipLaunchCooperativeKernel((const void*)fwd_kernel, dim3(grid), dim3(NT), args, LDS_BYTES, stream);
    if (e != hipSuccess) fprintf(stderr, "cooperative launch failed: %s (grid %d)\n", hipGetErrorString(e), grid);
#else
    hipLaunchKernelGGL(fwd_kernel, dim3(grid), dim3(NT), LDS_BYTES, stream, a);
#endif
#else
    for (int ph = 0; ph <= last; ++ph) {
        a.ph_lo = ph; a.ph_hi = ph + 1;
        hipLaunchKernelGGL(fwd_kernel, dim3(grid), dim3(NT), LDS_BYTES, stream, a);
    }
#endif
}
```

```cpp
#include <hip/hip_runtime.h>
#include <hip/hip_cooperative_groups.h>
#include <cstdio>
#include <cstdint>
namespace cg = cooperative_groups;

#ifndef N_LAUNCH_MODE
#define N_LAUNCH_MODE 1
#endif
#ifndef REPEAT_PHASE
#define REPEAT_PHASE -1
#endif
#ifndef STOP_AFTER
#define STOP_AFTER 99
#endif

typedef unsigned short bf16_t;
typedef short bf16x8 __attribute__((ext_vector_type(8)));
typedef float f32x4 __attribute__((ext_vector_type(4)));

constexpr int NT = 512;
constexpr int T = 16384, SEQ = 2048, NB = 8, DM = 1024, INW = 3264;
constexpr int OFF_Q = 0, OFF_FF = 512, OFF_FB = 1024, OFF_I = 1536, OFF_G = 2048, OFF_CQ = 2560, OFF_CKV = 2944, OFF_KR = 3200;
constexpr float EPS = 1e-6f;

constexpr size_t WS_CTL = 0;
constexpr size_t WS_WIN_T = 65536;
constexpr size_t WS_WQUP_T = WS_WIN_T + (size_t)3264 * 1024 * 2;
constexpr size_t WS_WKVUP_T = WS_WQUP_T + (size_t)768 * 384 * 2;
constexpr size_t WS_WOUT_T = WS_WKVUP_T + (size_t)1024 * 256 * 2;
constexpr size_t WS_WPQ_T = WS_WOUT_T + (size_t)1024 * 1024 * 2;
constexpr size_t WS_SUBK = WS_WPQ_T + (size_t)2048 * 1024 * 2;
constexpr size_t WS_LB = WS_SUBK + (size_t)16 * 128 * 128 * 2;
constexpr size_t WS_B = 15728640;
constexpr size_t WS_CQN = WS_B;
constexpr size_t WS_CKVN = WS_B + (size_t)T * 384 * 2;
constexpr size_t WS_C = WS_B + 33554432;
constexpr size_t WS_U16 = WS_C;
constexpr size_t WS_V16 = WS_C + 33554432;
constexpr size_t WS_V8 = WS_C + 33554432;
constexpr size_t WS_VSCALE = WS_V8 + (size_t)16384 * 1024;
constexpr size_t WS_USCALE = WS_VSCALE + 65536;
constexpr size_t WS_U8 = WS_C;
constexpr size_t WS_D = WS_C + (size_t)T * INW * 2;
constexpr size_t WS_Q = WS_D + 33554432;
constexpr size_t WS_KN = WS_Q + (size_t)T * 768 * 2;
constexpr size_t WS_VT = WS_KN + (size_t)T * 512 * 2;
constexpr size_t WS_KROPE = WS_VT + (size_t)T * 512 * 2;
constexpr size_t WS_ROPECS = WS_KROPE + (size_t)T * 64 * 2;
constexpr size_t WS_END = WS_ROPECS + (size_t)T * 64 * 4;
constexpr size_t WS_W16 = WS_KROPE;
constexpr size_t WS_IDX = WS_VT;
constexpr size_t WS_GATE = WS_VT + (size_t)T * 128 * 4;
constexpr size_t WS_ELIST = WS_D + 67108864;
constexpr size_t WS_COUNTS = WS_CTL + 16384;
constexpr size_t WS_BSTART = WS_CTL + 16384 + 32768;
static_assert(WS_ELIST + (size_t)T * 128 * 4 <= WS_VT, "edge list overflow");
static_assert(WS_LB + 4096 <= WS_B, "weights overflow");
static_assert(WS_D + (size_t)T * 2048 * 2 <= WS_IDX, "PQ overlaps IDX");
static_assert(WS_GATE + (size_t)T * 128 * 4 <= WS_VT + (size_t)T * 512 * 2, "gate overflow");
static_assert(WS_END <= 268435456, "workspace too big");

struct Args {
    const float* x; const int* pos; const float* attn_norm; const float* w_in; const float* lb_logits; const float* hg_o_norm;
    const float* q_a_norm; const float* w_q_up; const float* kv_a_norm; const float* w_kv_up; const float* q_norm; const float* k_norm;
    const float* mla_o_norm; const float* w_out; const float* ffn_norm; const float* peer_wq; const float* subk; const float* peer_u; const float* peer_v;
    float* out; unsigned char* ws; int ph_lo, ph_hi;
};

typedef __bf16 bf16v2 __attribute__((ext_vector_type(2)));
typedef float f32v2 __attribute__((ext_vector_type(2)));
__device__ __forceinline__ unsigned pack2(float lo, float hi) { const f32v2 v = {lo, hi}; return __builtin_bit_cast(unsigned, __builtin_convertvector(v, bf16v2)); }
__device__ __forceinline__ bf16_t f2bf(float f) { return (bf16_t)(pack2(f, 0.f) & 0xffffu); }
typedef _Float16 f16v2 __attribute__((ext_vector_type(2)));
__device__ __forceinline__ unsigned pack2h(float lo, float hi) { const f32v2 v = {lo, hi}; return __builtin_bit_cast(unsigned, __builtin_convertvector(v, f16v2)); }
__device__ __forceinline__ float frcp(float x) { return __builtin_amdgcn_rcpf(x); }
__device__ __forceinline__ float fexp2(float x) { return __builtin_amdgcn_exp2f(x); }
__device__ __forceinline__ float bf2f(bf16_t h) { return __uint_as_float(((unsigned)h) << 16); }
__device__ __forceinline__ float bflo(unsigned w) { return __uint_as_float(w << 16); }
__device__ __forceinline__ float bfhi(unsigned w) { return __uint_as_float(w & 0xffff0000u); }
__device__ __forceinline__ float wave_sum(float v) {
#pragma unroll
    for (int d = 32; d > 0; d >>= 1) v += __shfl_xor(v, d, 64);
    return v;
}
__device__ __forceinline__ f32x4 mfma16(bf16x8 a, bf16x8 b, f32x4 c) { return __builtin_amdgcn_mfma_f32_16x16x32_bf16(a, b, c, 0, 0, 0); }

__device__ const float ROPE_INV_FREQ[32] = {
    1.000000000e+00f, 7.498942018e-01f, 5.623413324e-01f, 4.216965139e-01f, 3.162277639e-01f, 2.371373922e-01f, 1.778279394e-01f, 1.333521456e-01f,
    1.000000015e-01f, 7.498941571e-02f, 5.623412877e-02f, 4.216964915e-02f, 3.162277862e-02f, 2.371373586e-02f, 1.778279431e-02f, 1.333521493e-02f,
    9.999999776e-03f, 7.498942316e-03f, 5.623413250e-03f, 4.216964822e-03f, 3.162277862e-03f, 2.371373819e-03f, 1.778279431e-03f, 1.333521446e-03f,
    1.000000047e-03f, 7.498941850e-04f, 5.623413017e-04f, 4.216965463e-04f, 3.162277862e-04f, 2.371373848e-04f, 1.778279402e-04f, 1.333521504e-04f};

template <int WAVES_M, int WAVES_N, int WM, int WN, class Epi>
__device__ __forceinline__ void gemm_block(const bf16_t* __restrict__ A, int lda, const bf16_t* __restrict__ Bt, int ldb, int K,
                                           int m0, int n0, int nrows_bt, unsigned char* lds, Epi& epi) {
    constexpr int BM = WAVES_M * WM * 16, BN = WAVES_N * WN * 16;
    constexpr int AI = BM / 64, BI = BN / 64;
    static_assert(WAVES_M * WAVES_N == 8, "8 waves");
    const int tid = threadIdx.x, lane = tid & 63, wave = tid >> 6;
    const int wm = wave / WAVES_N, wn = wave % WAVES_N;
    const int r16 = lane & 15, g = lane >> 4;
    unsigned char* As = lds;
    unsigned char* Bs = lds + BM * 144;
    f32x4 acc[WM][WN];
#pragma unroll
    for (int i = 0; i < WM; ++i)
#pragma unroll
        for (int j = 0; j < WN; ++j) acc[i][j] = (f32x4){0.f, 0.f, 0.f, 0.f};
    uint4 ra0, ra1, ra2, ra3, rb0, rb1, rb2, rb3;
    static_assert(AI <= 4 && BI <= 4, "stage regs");
#define GA_LOAD(i, k0) if constexpr (AI > i) { const int c = tid + i * NT, row = c >> 3, kc = c & 7; ra##i = *(const uint4*)(A + (size_t)(m0 + row) * lda + (k0) + kc * 8); }
#define GB_LOAD(i, k0) if constexpr (BI > i) { const int c = tid + i * NT, row = c >> 3, kc = c & 7; int rg = n0 + row; rg = rg < nrows_bt ? rg : nrows_bt - 1; rb##i = *(const uint4*)(Bt + (size_t)rg * ldb + (k0) + kc * 8); }
#define GA_STORE(i) if constexpr (AI > i) { const int c = tid + i * NT, row = c >> 3, kc = c & 7; *(uint4*)(As + row * 144 + kc * 16) = ra##i; }
#define GB_STORE(i) if constexpr (BI > i) { const int c = tid + i * NT, row = c >> 3, kc = c & 7; *(uint4*)(Bs + row * 144 + kc * 16) = rb##i; }
    GA_LOAD(0, 0) GA_LOAD(1, 0) GA_LOAD(2, 0) GA_LOAD(3, 0) GB_LOAD(0, 0) GB_LOAD(1, 0) GB_LOAD(2, 0) GB_LOAD(3, 0)
    const int nk = K / 64;
    for (int kt = 0; kt < nk; ++kt) {
        __syncthreads();
        GA_STORE(0) GA_STORE(1) GA_STORE(2) GA_STORE(3) GB_STORE(0) GB_STORE(1) GB_STORE(2) GB_STORE(3)
        __syncthreads();
        if (kt + 1 < nk) {
            const int k0 = (kt + 1) * 64;
            GA_LOAD(0, k0) GA_LOAD(1, k0) GA_LOAD(2, k0) GA_LOAD(3, k0) GB_LOAD(0, k0) GB_LOAD(1, k0) GB_LOAD(2, k0) GB_LOAD(3, k0)
        }
#pragma unroll
        for (int kk = 0; kk < 2; ++kk) {
            bf16x8 af[WM];
#pragma unroll
            for (int i = 0; i < WM; ++i) af[i] = *(const bf16x8*)(As + ((wm * WM + i) * 16 + r16) * 144 + kk * 64 + g * 16);
#pragma unroll
            for (int j = 0; j < WN; ++j) {
                const bf16x8 bfr = *(const bf16x8*)(Bs + ((wn * WN + j) * 16 + r16) * 144 + kk * 64 + g * 16);
#pragma unroll
                for (int i = 0; i < WM; ++i) acc[i][j] = mfma16(bfr, af[i], acc[i][j]);
            }
        }
    }
#undef GA_LOAD
#undef GB_LOAD
#undef GA_STORE
#undef GB_STORE
    epi(acc, m0 + wm * WM * 16, n0 + wn * WN * 16, lane);
}

namespace g256 {
constexpr int BM = 256, BK = 64, HALF = 128, HT = HALF * BK;
__device__ __forceinline__ int lds_byte(int r, int c) { const int st = (r >> 4) * 2 + (c >> 5), rr = r & 15, cc = c & 31, ob = rr * 64 + cc * 2; return st * 1024 + (ob ^ (((ob >> 9) & 1) << 5)); }
__device__ __forceinline__ void stage_rc(int b, int& R, int& C) { const int st = b / 1024, sb = b % 1024, swz = sb ^ (((sb >> 9) & 1) << 5); R = (st >> 1) * 16 + swz / 64; C = (st & 1) * 32 + (swz % 64) / 2; }

template <class Epi>
__device__ __forceinline__ void tile(const bf16_t* __restrict__ A, const bf16_t* __restrict__ Bt, int K, int brow, int bcol, unsigned char* lds, Epi& epi) {
    bf16_t* shm = (bf16_t*)lds;
#define G_SA(b, h) (shm + ((b) * 2 + (h)) * HT)
#define G_SB(b, h) (shm + (4 + (b) * 2 + (h)) * HT)
#define G_STAGE(P, BASE, br, kt) do { const long _g = (long)(br) * K + (long)(kt) * BK; \
    _Pragma("unroll") for (int _i = 0; _i < 2; ++_i) { const int _b = tix * 16 + _i * 8192; int _r, _c; stage_rc(_b, _r, _c); \
      __builtin_amdgcn_global_load_lds((const unsigned*)(BASE + _g + (long)_r * K + _c), (unsigned*)((char*)(P) + _b), 16, 0, 0); } } while (0)
#define G_LDA(dst, b, h) _Pragma("unroll") for (int m = 0; m < 4; ++m) _Pragma("unroll") for (int k = 0; k < 2; ++k) \
    dst[m][k] = *reinterpret_cast<const bf16x8*>((char*)G_SA(b, h) + lds_byte(wr * 64 + m * 16 + fr, k * 32 + fq * 8))
#define G_LDB(dst, b, h) _Pragma("unroll") for (int n = 0; n < 2; ++n) _Pragma("unroll") for (int k = 0; k < 2; ++k) \
    dst[n][k] = *reinterpret_cast<const bf16x8*>((char*)G_SB(b, h) + lds_byte(wc * 32 + n * 16 + fr, k * 32 + fq * 8))
#define G_MMA(ai, bj, At, Bt_) do { __builtin_amdgcn_s_setprio(1); \
    _Pragma("unroll") for (int m = 0; m < 4; ++m) _Pragma("unroll") for (int n = 0; n < 2; ++n) _Pragma("unroll") for (int k = 0; k < 2; ++k) \
      acc[ai][bj][m][n] = __builtin_amdgcn_mfma_f32_16x16x32_bf16(Bt_[n][k], At[m][k], acc[ai][bj][m][n], 0, 0, 0); \
    __builtin_amdgcn_s_setprio(0); } while (0)
#define G_WAIT_V(n) asm volatile("s_waitcnt vmcnt(" #n ")" ::: "memory")
#define G_WAIT_L(n) asm volatile("s_waitcnt lgkmcnt(" #n ")" ::: "memory")
#define G_BAR __builtin_amdgcn_s_barrier()
#define G_SCHED __builtin_amdgcn_sched_barrier(0)
    int tix = threadIdx.x; asm volatile("" : "+v"(tix));
    const int wid = tix >> 6, lane = tix & 63, wr = wid >> 2, wc = wid & 3, fr = lane & 15, fq = lane >> 4;
    f32x4 acc[2][2][4][2];
#pragma unroll
    for (int i0 = 0; i0 < 2; ++i0)
#pragma unroll
        for (int i1 = 0; i1 < 2; ++i1)
#pragma unroll
            for (int i2 = 0; i2 < 4; ++i2)
#pragma unroll
                for (int i3 = 0; i3 < 2; ++i3) acc[i0][i1][i2][i3] = (f32x4){0.f, 0.f, 0.f, 0.f};
    bf16x8 At[4][2], B0[2][2], B1[2][2];
    const int nt = K / BK;
    G_STAGE(G_SB(0, 0), Bt, bcol, 0); G_STAGE(G_SA(0, 0), A, brow, 0);
    G_STAGE(G_SB(0, 1), Bt, bcol + HALF, 0); G_STAGE(G_SA(0, 1), A, brow + HALF, 0);
    if (wr == 1) G_BAR;
    G_WAIT_V(4); G_BAR;
    G_STAGE(G_SB(1, 0), Bt, bcol, 1); G_STAGE(G_SA(1, 0), A, brow, 1); G_STAGE(G_SB(1, 1), Bt, bcol + HALF, 1);
    G_WAIT_V(6); G_BAR;
    for (int t = 0; t < nt - 2; t += 2) {
        G_LDB(B0, 0, 0); G_SCHED; G_LDA(At, 0, 0); G_STAGE(G_SA(1, 1), A, brow + HALF, t + 1);
        G_WAIT_L(8); G_BAR; G_WAIT_L(0); G_MMA(0, 0, At, B0); G_BAR; G_SCHED;
        G_LDB(B1, 0, 1); G_STAGE(G_SB(0, 0), Bt, bcol, t + 2);
        G_BAR; G_WAIT_L(0); G_MMA(0, 1, At, B1); G_BAR;
        G_LDA(At, 0, 1); G_STAGE(G_SA(0, 0), A, brow, t + 2);
        G_BAR; G_WAIT_L(0); G_MMA(1, 0, At, B0); G_BAR; G_SCHED;
        G_STAGE(G_SB(0, 1), Bt, bcol + HALF, t + 2);
        G_WAIT_V(6); G_BAR; G_MMA(1, 1, At, B1); G_BAR;
        G_LDB(B0, 1, 0); G_SCHED; G_LDA(At, 1, 0); G_STAGE(G_SA(0, 1), A, brow + HALF, t + 2);
        G_WAIT_L(8); G_BAR; G_WAIT_L(0); G_MMA(0, 0, At, B0); G_BAR; G_SCHED;
        G_LDB(B1, 1, 1); G_STAGE(G_SB(1, 0), Bt, bcol, t + 3);
        G_BAR; G_WAIT_L(0); G_MMA(0, 1, At, B1); G_BAR;
        G_LDA(At, 1, 1); G_STAGE(G_SA(1, 0), A, brow, t + 3);
        G_BAR; G_WAIT_L(0); G_MMA(1, 0, At, B0); G_BAR; G_SCHED;
        G_STAGE(G_SB(1, 1), Bt, bcol + HALF, t + 3);
        G_WAIT_V(6); G_BAR; G_MMA(1, 1, At, B1); G_BAR;
    }
    { G_LDB(B0, 0, 0); G_LDA(At, 0, 0); G_STAGE(G_SA(1, 1), A, brow + HALF, nt - 1);
      G_BAR; G_WAIT_L(0); G_MMA(0, 0, At, B0); G_BAR;
      G_LDB(B1, 0, 1); G_BAR; G_WAIT_L(0); G_MMA(0, 1, At, B1); G_BAR;
      G_LDA(At, 0, 1); G_WAIT_V(4); G_BAR; G_WAIT_L(0); G_MMA(1, 0, At, B0); G_MMA(1, 1, At, B1); G_BAR; }
    { G_LDB(B0, 1, 0); G_LDA(At, 1, 0); G_WAIT_V(2); G_BAR; G_WAIT_L(0); G_MMA(0, 0, At, B0); G_BAR;
      G_LDB(B1, 1, 1); G_WAIT_V(0); G_BAR; G_WAIT_L(0); G_MMA(0, 1, At, B1); G_BAR;
      G_LDA(At, 1, 1); G_BAR; G_WAIT_L(0); G_MMA(1, 0, At, B0); G_MMA(1, 1, At, B1); G_BAR; }
    if (wr == 0) G_BAR;
    epi(acc, brow + wr * 64 + fr, bcol + wc * 32 + 4 * fq);
#undef G_SA
#undef G_SB
#undef G_STAGE
#undef G_LDA
#undef G_LDB
#undef G_MMA
#undef G_WAIT_V
#undef G_WAIT_L
#undef G_BAR
#undef G_SCHED
}
__device__ __forceinline__ bool next_tile(int L, int nM, int nN, int& pm, int& pn) {
    const int nwg = nM * nN; if (L >= nwg) return false;
    int wgid = L; { const int q = nwg / 8, r = nwg % 8, xcd = wgid % 8, off = wgid / 8; wgid = (xcd < r ? xcd * (q + 1) : r * (q + 1) + (xcd - r) * q) + off; }
    const int WGM = 8, nig = WGM * nN, gid = wgid / nig, fm = gid * WGM, gsz = (nM - fm) < WGM ? (nM - fm) : WGM;
    pm = fm + ((wgid % nig) % gsz); pn = (wgid % nig) / gsz; return true;
}
struct EpiBf16 { bf16_t* O; int ldc;
    __device__ __forceinline__ void operator()(const f32x4 (&acc)[2][2][4][2], int row0, int col0) const {
#pragma unroll
        for (int ai = 0; ai < 2; ++ai)
#pragma unroll
            for (int m = 0; m < 4; ++m) { bf16_t* rp = O + (size_t)(row0 + ai * 128 + m * 16) * ldc + col0;
#pragma unroll
                for (int bj = 0; bj < 2; ++bj)
#pragma unroll
                    for (int n = 0; n < 2; ++n) { const f32x4 v = acc[ai][bj][m][n]; uint2 w; w.x = pack2(v[0], v[1]); w.y = pack2(v[2], v[3]); *(uint2*)(rp + bj * 128 + n * 16) = w; } }
    }
};
struct EpiResid { const float* X; float* O;
    __device__ __forceinline__ void operator()(const f32x4 (&acc)[2][2][4][2], int row0, int col0) const {
#pragma unroll
        for (int ai = 0; ai < 2; ++ai)
#pragma unroll
            for (int m = 0; m < 4; ++m) { const size_t ro = (size_t)(row0 + ai * 128 + m * 16) * DM + col0;
#pragma unroll
                for (int bj = 0; bj < 2; ++bj)
#pragma unroll
                    for (int n = 0; n < 2; ++n) { const size_t off = ro + bj * 128 + n * 16; const f32x4 xv = *(const f32x4*)(X + off); *(f32x4*)(O + off) = xv + acc[ai][bj][m][n]; } }
    }
};
struct EpiBf16Silu { bf16_t* O; int ldc; int nsilu;
    __device__ __forceinline__ void operator()(const f32x4 (&acc)[2][2][4][2], int row0, int col0) const {
        const bool sl = col0 < nsilu;
#pragma unroll
        for (int ai = 0; ai < 2; ++ai)
#pragma unroll
            for (int m = 0; m < 4; ++m) { bf16_t* rp = O + (size_t)(row0 + ai * 128 + m * 16) * ldc + col0;
#pragma unroll
                for (int bj = 0; bj < 2; ++bj)
#pragma unroll
                    for (int n = 0; n < 2; ++n) { f32x4 v = acc[ai][bj][m][n];
                        if (sl) {
#pragma unroll
                            for (int r = 0; r < 4; ++r) v[r] = v[r] * frcp(1.f + __expf(-v[r])); }
                        uint2 w; w.x = pack2(v[0], v[1]); w.y = pack2(v[2], v[3]); *(uint2*)(rp + bj * 128 + n * 16) = w; } }
    }
};
}

template <int WM_, int WN_> struct EpiBf16 {
    bf16_t* O; int ldc; int ncols;
    __device__ __forceinline__ void operator()(const f32x4 (&acc)[WM_][WN_], int mb, int nb, int lane) const {
        const int r16 = lane & 15, g = lane >> 4;
#pragma unroll
        for (int i = 0; i < WM_; ++i)
#pragma unroll
            for (int j = 0; j < WN_; ++j) {
                const int row = mb + i * 16 + r16, col = nb + j * 16 + 4 * g;
                if (col < ncols) { uint2 w; w.x = pack2(acc[i][j][0], acc[i][j][1]); w.y = pack2(acc[i][j][2], acc[i][j][3]); *(uint2*)(O + (size_t)row * ldc + col) = w; }
            }
    }
};
struct EpiResid {
    const float* X; float* O;
    __device__ __forceinline__ void operator()(const f32x4 (&acc)[4][2], int mb, int nb, int lane) const {
        const int r16 = lane & 15, g = lane >> 4;
#pragma unroll
        for (int i = 0; i < 4; ++i)
#pragma unroll
            for (int j = 0; j < 2; ++j) {
                const size_t off = (size_t)(mb + i * 16 + r16) * DM + nb + j * 16 + 4 * g;
                const f32x4 xv = *(const f32x4*)(X + off);
                *(f32x4*)(O + off) = xv + acc[i][j];
            }
    }
};
struct EpiQ {
    bf16_t* Q; const float* q_norm; const float* ropecs;
    __device__ __forceinline__ void operator()(const f32x4 (&accs)[2][12], int mb, int nb, int lane) const {
      const int r16 = lane & 15, g = lane >> 4;
#pragma unroll
      for (int mi = 0; mi < 2; ++mi) {
        const f32x4 (&accm)[12] = accs[mi];
        const int row = mb + mi * 16 + r16, h = nb / 192;
        float ssn = 0.f, ssr = 0.f;
#pragma unroll
        for (int j = 0; j < 8; ++j)
#pragma unroll
            for (int r = 0; r < 4; ++r) ssn += accm[j][r] * accm[j][r];
#pragma unroll
        for (int j = 8; j < 12; ++j)
#pragma unroll
            for (int r = 0; r < 4; ++r) ssr += accm[j][r] * accm[j][r];
        ssn += __shfl_xor(ssn, 16, 64); ssn += __shfl_xor(ssn, 32, 64);
        ssr += __shfl_xor(ssr, 16, 64); ssr += __shfl_xor(ssr, 32, 64);
        const float SC = 0.07216878364870322f * 1.4426950408889634f;
        const float rn = rsqrtf(ssn * (1.f / 128.f) + EPS) * SC, rr = rsqrtf(ssr * (1.f / 64.f) + EPS) * SC;
        bf16_t* qrow = Q + ((size_t)row * 4 + h) * 192;
#pragma unroll
        for (int j = 0; j < 8; ++j) {
            const int c = j * 16 + 4 * g;
            const f32x4 gn = *(const f32x4*)(q_norm + c);
            uint2 w; w.x = pack2(accm[j][0] * rn * gn[0], accm[j][1] * rn * gn[1]); w.y = pack2(accm[j][2] * rn * gn[2], accm[j][3] * rn * gn[3]);
            *(uint2*)(qrow + c) = w;
        }
#pragma unroll
        for (int j = 0; j < 2; ++j) {
            const int jj = j * 16 + 4 * g;
            const f32x4 g1 = *(const f32x4*)(q_norm + 128 + jj), g2 = *(const f32x4*)(q_norm + 160 + jj);
            float o1[4], o2[4];
#pragma unroll
            for (int r = 0; r < 4; ++r) {
                const float2 cs = *(const float2*)(ropecs + ((size_t)row * 32 + jj + r) * 2);
                const float a1 = accm[8 + j][r] * rr * g1[r], a2 = accm[10 + j][r] * rr * g2[r];
                o1[r] = a1 * cs.x - a2 * cs.y; o2[r] = a2 * cs.x + a1 * cs.y;
            }
            uint2 w; w.x = pack2(o1[0], o1[1]); w.y = pack2(o1[2], o1[3]); *(uint2*)(qrow + 128 + jj) = w;
            w.x = pack2(o2[0], o2[1]); w.y = pack2(o2[2], o2[3]); *(uint2*)(qrow + 160 + jj) = w;
        }
      }
    }
};
template <int WMK> struct EpiKV {
    bf16_t* KN; bf16_t* VT; const float* k_norm;
    __device__ __forceinline__ void operator()(const f32x4 (&accs)[WMK][16], int mb, int nb, int lane) const {
      const int r16 = lane & 15, g = lane >> 4;
#pragma unroll
      for (int mi = 0; mi < WMK; ++mi) {
        const f32x4 (&accm)[16] = accs[mi];
        const int row = mb + mi * 16 + r16, h = nb / 256;
        float ssn = 0.f;
#pragma unroll
        for (int j = 0; j < 8; ++j)
#pragma unroll
            for (int r = 0; r < 4; ++r) ssn += accm[j][r] * accm[j][r];
        ssn += __shfl_xor(ssn, 16, 64); ssn += __shfl_xor(ssn, 32, 64);
        const float rn = rsqrtf(ssn * (1.f / 128.f) + EPS);
        bf16_t* krow = KN + ((size_t)row * 4 + h) * 128;
#pragma unroll
        for (int j = 0; j < 8; ++j) {
            const int c = j * 16 + 4 * g;
            const f32x4 gn = *(const f32x4*)(k_norm + c);
            uint2 w; w.x = pack2(accm[j][0] * rn * gn[0], accm[j][1] * rn * gn[1]); w.y = pack2(accm[j][2] * rn * gn[2], accm[j][3] * rn * gn[3]);
            *(uint2*)(krow + c) = w;
        }
        const int b = row >> 11, s = row & 2047;
        bf16_t* vp = VT + ((size_t)(b * 4 + h) * 128 + 4 * g) * SEQ + s;
#pragma unroll
        for (int j = 0; j < 8; ++j) {
            asm volatile("" : "+v"(vp));
            vp[0] = f2bf(accm[8 + j][0]); vp[SEQ] = f2bf(accm[8 + j][1]); vp[2 * SEQ] = f2bf(accm[8 + j][2]); vp[3 * SEQ] = f2bf(accm[8 + j][3]);
            vp += 16 * SEQ;
        }
      }
    }
};

__device__ void transpose_convert(const float* __restrict__ W, bf16_t* __restrict__ Wt, int K, int N, unsigned char* lds, int bid, int nblk) {
    bf16_t* tile = (bf16_t*)lds;
    const int tid = threadIdx.x;
    const int tk = K / 64, tn = N / 64;
    for (int t = bid; t < tk * tn; t += nblk) {
        const int k0 = (t / tn) * 64, n0 = (t % tn) * 64;
        __syncthreads();
#pragma unroll
        for (int p = 0; p < 2; ++p) {
            const int kk = (tid >> 4) + p * 32, n4 = (tid & 15) * 4;
            const f32x4 v = *(const f32x4*)(W + (size_t)(k0 + kk) * N + n0 + n4);
#pragma unroll
            for (int r = 0; r < 4; ++r) tile[(n4 + r) * 66 + kk] = f2bf(v[r]);
        }
        __syncthreads();
        {
            const int nn = tid >> 3, k8 = (tid & 7) * 8;
            unsigned w[4];
#pragma unroll
            for (int r = 0; r < 4; ++r) w[r] = (unsigned)tile[nn * 66 + k8 + 2 * r] | ((unsigned)tile[nn * 66 + k8 + 2 * r + 1] << 16);
            *(uint4*)(Wt + (size_t)(n0 + nn) * K + k0 + k8) = make_uint4(w[0], w[1], w[2], w[3]);
        }
    }
    __syncthreads();
}

__device__ void rmsnorm_rows(const float* __restrict__ X, const float* __restrict__ gain, bf16_t* __restrict__ O, int gw, int nw) {
    const int lane = threadIdx.x & 63;
    for (int row = gw; row < T; row += nw) {
        const float* xr = X + (size_t)row * DM;
        f32x4 v[4]; float ss = 0.f;
#pragma unroll
        for (int i = 0; i < 4; ++i) { v[i] = *(const f32x4*)(xr + i * 256 + lane * 4); ss += v[i][0] * v[i][0] + v[i][1] * v[i][1] + v[i][2] * v[i][2] + v[i][3] * v[i][3]; }
        ss = wave_sum(ss);
        const float rs = rsqrtf(ss * (1.f / 1024.f) + EPS);
#pragma unroll
        for (int i = 0; i < 4; ++i) {
            const f32x4 gn = *(const f32x4*)(gain + i * 256 + lane * 4);
            uint2 w; w.x = pack2(v[i][0] * rs * gn[0], v[i][1] * rs * gn[1]); w.y = pack2(v[i][2] * rs * gn[2], v[i][3] * rs * gn[3]);
            *(uint2*)(O + (size_t)row * DM + i * 256 + lane * 4) = w;
        }
    }
}

__device__ void phase0(const Args& a, unsigned char* lds) {
    unsigned char* ws = a.ws;
    const int bid = blockIdx.x, nblk = gridDim.x, tid = threadIdx.x;
    transpose_convert(a.w_in, (bf16_t*)(ws + WS_WIN_T), 1024, 3264, lds, bid, nblk);
    transpose_convert(a.w_q_up, (bf16_t*)(ws + WS_WQUP_T), 384, 768, lds, bid, nblk);
    transpose_convert(a.w_kv_up, (bf16_t*)(ws + WS_WKVUP_T), 256, 1024, lds, bid, nblk);
    transpose_convert(a.w_out, (bf16_t*)(ws + WS_WOUT_T), 1024, 1024, lds, bid, nblk);
    transpose_convert(a.peer_wq, (bf16_t*)(ws + WS_WPQ_T), 1024, 2048, lds, bid, nblk);
    const int gt = bid * NT + tid, ngt = nblk * NT;
    bf16_t* sk = (bf16_t*)(ws + WS_SUBK);
    for (int i = gt; i < 16 * 128 * 128; i += ngt) sk[i] = f2bf(a.subk[i]);
    float* lb = (float*)(ws + WS_LB);
    for (int i = gt; i < 1024; i += ngt) { const float l0 = a.lb_logits[i], l1 = a.lb_logits[1024 + i]; lb[i] = 1.f / (1.f + expf(l1 - l0)); }
    rmsnorm_rows(a.x, a.attn_norm, (bf16_t*)(ws + WS_B), bid * 8 + (tid >> 6), nblk * 8);
}

__device__ void phase1(const Args& a, unsigned char* lds) {
    unsigned char* ws = a.ws;
    const bf16_t* H = (const bf16_t*)(ws + WS_B); const bf16_t* W = (const bf16_t*)(ws + WS_WIN_T);
    g256::EpiBf16Silu e{(bf16_t*)(ws + WS_C), INW, 512};
    for (int i = 0;; ++i) { int pm, pn; if (!g256::next_tile(i * gridDim.x + blockIdx.x, 64, 12, pm, pn)) break;
        __syncthreads();
        g256::tile(H, W, DM, pm * 256, pn * 256, lds, e); }
    __syncthreads();
    EpiBf16<1, 6> e2{(bf16_t*)(ws + WS_C), INW, INW};
    for (int t = blockIdx.x; t < 256; t += gridDim.x)
        gemm_block<4, 2, 1, 6>(H, DM, W, DM, DM, t * 64, 3072, INW, lds, e2);
}

__device__ void phase2(const Args& a) {
    unsigned char* ws = a.ws;
    const bf16_t* PROJ = (const bf16_t*)(ws + WS_C);
    bf16_t* CQN = (bf16_t*)(ws + WS_CQN); bf16_t* CKVN = (bf16_t*)(ws + WS_CKVN); bf16_t* KROPE = (bf16_t*)(ws + WS_KROPE);
    float* ROPECS = (float*)(ws + WS_ROPECS);
    const int lane = threadIdx.x & 63;
    const float2 gq0 = *(const float2*)(a.q_a_norm + lane * 2), gq1 = *(const float2*)(a.q_a_norm + 128 + lane * 2), gq2 = *(const float2*)(a.q_a_norm + 256 + lane * 2);
    const float2 gk0 = *(const float2*)(a.kv_a_norm + lane * 2), gk1 = *(const float2*)(a.kv_a_norm + 128 + lane * 2);
    const float gr = a.k_norm[128 + lane];
    const float invf = ROPE_INV_FREQ[lane & 31];
    const int nw = gridDim.x * 8;
    for (int t0 = blockIdx.x * 8 + (threadIdx.x >> 6); t0 < T; t0 += nw * 4) {
        unsigned wq[4][3], wk[4][2]; float vr[4], ps[4];
#pragma unroll
        for (int u = 0; u < 4; ++u) {
            const int t = min(t0 + u * nw, T - 1);
            const bf16_t* pr = PROJ + (size_t)t * INW;
#pragma unroll
            for (int i = 0; i < 3; ++i) wq[u][i] = *(const unsigned*)(pr + OFF_CQ + i * 128 + lane * 2);
#pragma unroll
            for (int i = 0; i < 2; ++i) wk[u][i] = *(const unsigned*)(pr + OFF_CKV + i * 128 + lane * 2);
            vr[u] = bf2f(pr[OFF_KR + lane]);
            ps[u] = (float)a.pos[t];
        }
        float sq[4], sk[4], sr[4];
#pragma unroll
        for (int u = 0; u < 4; ++u) {
            sq[u] = 0.f; sk[u] = 0.f;
#pragma unroll
            for (int i = 0; i < 3; ++i) { const float x0 = bflo(wq[u][i]), x1 = bfhi(wq[u][i]); sq[u] += x0 * x0 + x1 * x1; }
#pragma unroll
            for (int i = 0; i < 2; ++i) { const float x0 = bflo(wk[u][i]), x1 = bfhi(wk[u][i]); sk[u] += x0 * x0 + x1 * x1; }
            sr[u] = vr[u] * vr[u];
        }
#pragma unroll
        for (int d = 32; d > 0; d >>= 1)
#pragma unroll
            for (int u = 0; u < 4; ++u) { sq[u] += __shfl_xor(sq[u], d, 64); sk[u] += __shfl_xor(sk[u], d, 64); sr[u] += __shfl_xor(sr[u], d, 64); }
#pragma unroll
        for (int u = 0; u < 4; ++u) {
            const int t = t0 + u * nw;
            if (t < T) {
                const float rq = rsqrtf(sq[u] * (1.f / 384.f) + EPS), rk = rsqrtf(sk[u] * (1.f / 256.f) + EPS), rr = rsqrtf(sr[u] * (1.f / 64.f) + EPS);
                bf16_t* cq = CQN + (size_t)t * 384 + lane * 2; bf16_t* ck = CKVN + (size_t)t * 256 + lane * 2;
                *(unsigned*)(cq) = pack2(bflo(wq[u][0]) * rq * gq0.x, bfhi(wq[u][0]) * rq * gq0.y);
                *(unsigned*)(cq + 128) = pack2(bflo(wq[u][1]) * rq * gq1.x, bfhi(wq[u][1]) * rq * gq1.y);
                *(unsigned*)(cq + 256) = pack2(bflo(wq[u][2]) * rq * gq2.x, bfhi(wq[u][2]) * rq * gq2.y);
                *(unsigned*)(ck) = pack2(bflo(wk[u][0]) * rk * gk0.x, bfhi(wk[u][0]) * rk * gk0.y);
                *(unsigned*)(ck + 128) = pack2(bflo(wk[u][1]) * rk * gk1.x, bfhi(wk[u][1]) * rk * gk1.y);
                const float xn = vr[u] * rr * gr;
                const float other = __shfl_xor(xn, 32, 64);
                float sn, cs; sincosf(ps[u] * invf, &sn, &cs);
                const float o = (lane < 32) ? (xn * cs - other * sn) : (xn * cs + other * sn);
                KROPE[(size_t)t * 64 + lane] = f2bf(o);
                if (lane < 32) { *(float2*)(ROPECS + ((size_t)t * 32 + lane) * 2) = make_float2(cs, sn); }
            }
        }
    }
}

__device__ void phase3(const Args& a, unsigned char* lds) {
    unsigned char* ws = a.ws;
    EpiQ eq{(bf16_t*)(ws + WS_Q), a.q_norm, (const float*)(ws + WS_ROPECS)};
    EpiKV<1> ekv{(bf16_t*)(ws + WS_KN), (bf16_t*)(ws + WS_VT), a.k_norm};
    for (int t = blockIdx.x; t < 768; t += gridDim.x) {
        if (t < 256) { const int mt = t >> 2, h = t & 3;
            gemm_block<8, 1, 2, 12>((const bf16_t*)(ws + WS_CQN), 384, (const bf16_t*)(ws + WS_WQUP_T), 384, 384, mt * 256, h * 192, 768, lds, eq);
        } else { const int u = t - 256, mt = u >> 2, h = u & 3;
            gemm_block<8, 1, 1, 16>((const bf16_t*)(ws + WS_CKVN), 256, (const bf16_t*)(ws + WS_WKVUP_T), 256, 256, mt * 128, h * 256, 1024, lds, ekv);
        }
    }
}

constexpr int AT_KROW = 400, AT_VROW = 144, AT_KBYTES = 64 * AT_KROW, AT_VBYTES = 128 * AT_VROW, AT_BUF = AT_KBYTES + AT_VBYTES;
__device__ void attn_item(const Args& a, int item, unsigned char* lds) {
    unsigned char* ws = a.ws;
    const bf16_t* Q = (const bf16_t*)(ws + WS_Q); const bf16_t* KN = (const bf16_t*)(ws + WS_KN);
    const bf16_t* KR = (const bf16_t*)(ws + WS_KROPE); const bf16_t* VT = (const bf16_t*)(ws + WS_VT);
    bf16_t* YCAT = (bf16_t*)(ws + WS_B);
    const int qb = item & 7, h = (item >> 3) & 3, b = item >> 5;
    const int tid = threadIdx.x, lane = tid & 63, wave = tid >> 6, r16 = lane & 15, g = lane >> 4;
    const unsigned kn_off = (unsigned)((((size_t)b * SEQ + (tid >> 4)) * 4 + h) * 128 + (tid & 15) * 8);
    const unsigned kr_off = (unsigned)(((size_t)b * SEQ + (tid >> 3)) * 64 + (tid & 7) * 8);
    const unsigned vt_off = (unsigned)(((size_t)(b * 4 + h) * 128 + (tid >> 3)) * SEQ + (tid & 7) * 8);
    const int kn_dst = (tid >> 4) * AT_KROW + (tid & 15) * 16, kr_dst = (tid >> 3) * AT_KROW + 256 + (tid & 7) * 16;
    const int v_dst = AT_KBYTES + (tid >> 3) * AT_VROW + (tid & 7) * 16;
    bf16x8 qf[2][6];
#pragma unroll
    for (int qs = 0; qs < 2; ++qs) {
        const size_t tq = (size_t)b * SEQ + qb * 256 + wave * 32 + qs * 16 + r16;
#pragma unroll
        for (int kk = 0; kk < 6; ++kk) qf[qs][kk] = *(const bf16x8*)(Q + (tq * 4 + h) * 192 + kk * 32 + 8 * g);
    }
    f32x4 O[2][8];
#pragma unroll
    for (int qs = 0; qs < 2; ++qs)
#pragma unroll
        for (int d = 0; d < 8; ++d) O[qs][d] = (f32x4){0.f, 0.f, 0.f, 0.f};
    float m_run[2] = {0.f, 0.f}, l_part[2] = {0.f, 0.f};
    uint4 sk0, sk1, sk2, sv0, sv1;
#define AT_GLOADK(tile) do { \
        sk0 = *(const uint4*)(KN + kn_off + (size_t)(tile) * (64 * 512)); sk1 = *(const uint4*)(KN + kn_off + 32 * 512 + (size_t)(tile) * (64 * 512)); \
        sk2 = *(const uint4*)(KR + kr_off + (size_t)(tile) * (64 * 64)); } while (0)
#define AT_GLOADV(tile) do { \
        sv0 = *(const uint4*)(VT + vt_off + (size_t)(tile) * 64); sv1 = *(const uint4*)(VT + vt_off + (size_t)64 * SEQ + (size_t)(tile) * 64); } while (0)
#define AT_LSTOREK(buf) do { unsigned char* bb = lds + (buf) * AT_BUF; \
        *(uint4*)(bb + kn_dst) = sk0; *(uint4*)(bb + kn_dst + 32 * AT_KROW) = sk1; *(uint4*)(bb + kr_dst) = sk2; } while (0)
#define AT_LSTOREV(buf) do { unsigned char* bb = lds + (buf) * AT_BUF; \
        *(uint4*)(bb + v_dst) = sv0; *(uint4*)(bb + v_dst + 64 * AT_VROW) = sv1; } while (0)
    __syncthreads();
    AT_GLOADK(0); AT_GLOADV(0);
    AT_LSTOREK(0); AT_LSTOREV(0);
    __syncthreads();
    constexpr int NTILE = SEQ / 64;
    for (int t = 0; t < NTILE; ++t) {
        if (t + 1 < NTILE) AT_GLOADK(t + 1);
        const unsigned char* kb = lds + (t & 1) * AT_BUF;
        const unsigned char* vb = kb + AT_KBYTES;
        f32x4 S[2][4];
#pragma unroll
        for (int qs = 0; qs < 2; ++qs)
#pragma unroll
            for (int j = 0; j < 4; ++j) { const float nm = -m_run[qs]; S[qs][j] = (f32x4){nm, nm, nm, nm}; }
#pragma unroll
        for (int j = 0; j < 4; ++j) {
            const int krow = (j >> 1) * 32 + 8 * (r16 >> 2) + 4 * (j & 1) + (r16 & 3);
#pragma unroll
            for (int kk = 0; kk < 6; ++kk) {
                const bf16x8 kf = *(const bf16x8*)(kb + krow * AT_KROW + kk * 64 + g * 16);
                S[0][j] = mfma16(kf, qf[0][kk], S[0][j]);
                S[1][j] = mfma16(kf, qf[1][kk], S[1][j]);
            }
        }
        if (t + 1 < NTILE) { AT_LSTOREK((t + 1) & 1); AT_GLOADV(t + 1); }
        bf16x8 pf[2][2];
#pragma unroll
        for (int qs = 0; qs < 2; ++qs) {
            float mx = -1e30f;
#pragma unroll
            for (int j = 0; j < 4; ++j) mx = fmaxf(mx, fmaxf(fmaxf(S[qs][j][0], S[qs][j][1]), fmaxf(S[qs][j][2], S[qs][j][3])));
            mx = fmaxf(mx, __shfl_xor(mx, 16, 64)); mx = fmaxf(mx, __shfl_xor(mx, 32, 64));
            if (t == 0 || !__all(mx <= 8.f)) {
                const float delta = (t == 0) ? mx : fmaxf(mx, 0.f);
                m_run[qs] += delta;
#pragma unroll
                for (int j = 0; j < 4; ++j) { S[qs][j][0] -= delta; S[qs][j][1] -= delta; S[qs][j][2] -= delta; S[qs][j][3] -= delta; }
                if (t != 0) {
                    const float alpha = fexp2(-delta);
                    l_part[qs] *= alpha;
#pragma unroll
                    for (int d = 0; d < 8; ++d) O[qs][d] *= alpha;
                }
            }
            float ps = 0.f;
#pragma unroll
            for (int grp = 0; grp < 2; ++grp) {
                float pv[8];
#pragma unroll
                for (int jj = 0; jj < 8; ++jj) { pv[jj] = fexp2(S[qs][grp * 2 + (jj >> 2)][jj & 3]); ps += pv[jj]; }
                union { uint4 u; bf16x8 v; } cv; cv.u = make_uint4(pack2(pv[0], pv[1]), pack2(pv[2], pv[3]), pack2(pv[4], pv[5]), pack2(pv[6], pv[7]));
                pf[qs][grp] = cv.v;
            }
            l_part[qs] += ps;
        }
        __builtin_amdgcn_s_setprio(1);
#pragma unroll
        for (int grp = 0; grp < 2; ++grp)
#pragma unroll
            for (int d = 0; d < 8; ++d) {
                const bf16x8 vf = *(const bf16x8*)(vb + (d * 16 + r16) * AT_VROW + grp * 64 + g * 16);
                O[0][d] = mfma16(vf, pf[0][grp], O[0][d]);
                O[1][d] = mfma16(vf, pf[1][grp], O[1][d]);
            }
        __builtin_amdgcn_s_setprio(0);
        if (t + 1 < NTILE) AT_LSTOREV((t + 1) & 1);
        __syncthreads();
    }
#undef AT_GLOADK
#undef AT_GLOADV
#undef AT_LSTOREK
#undef AT_LSTOREV
#pragma unroll
    for (int qs = 0; qs < 2; ++qs) {
        float l = l_part[qs]; l += __shfl_xor(l, 16, 64); l += __shfl_xor(l, 32, 64);
        const float inv = frcp(l);
        float ss = 0.f;
#pragma unroll
        for (int d = 0; d < 8; ++d) { O[qs][d] *= inv; ss += O[qs][d][0] * O[qs][d][0] + O[qs][d][1] * O[qs][d][1] + O[qs][d][2] * O[qs][d][2] + O[qs][d][3] * O[qs][d][3]; }
        ss += __shfl_xor(ss, 16, 64); ss += __shfl_xor(ss, 32, 64);
        const float rs = rsqrtf(ss * (1.f / 128.f) + EPS);
        const size_t tq = (size_t)b * SEQ + qb * 256 + wave * 32 + qs * 16 + r16;
#pragma unroll
        for (int d = 0; d < 8; ++d) {
            const int dv = d * 16 + 4 * g;
            const f32x4 gn = *(const f32x4*)(a.mla_o_norm + h * 128 + dv);
            uint2 w; w.x = pack2(O[qs][d][0] * rs * gn[0], O[qs][d][1] * rs * gn[1]); w.y = pack2(O[qs][d][2] * rs * gn[2], O[qs][d][3] * rs * gn[3]);
            *(uint2*)(YCAT + tq * DM + 512 + h * 128 + dv) = w;
        }
    }
}

constexpr int HG_E = 0;
constexpr int HG_EL = HG_E + 64 * 132 * 4;
constexpr int HG_QT = HG_EL + 1024;
constexpr int HG_QH = HG_QT + 17408;
constexpr int HG_KD = HG_QH + 17408;
constexpr int HG_K10 = HG_KD + 17408;
constexpr int HG_VT = HG_K10 + 8704;
constexpr int HG_SM = HG_VT + 2 * 9216;
constexpr int HG_STB = HG_SM + 9216;
constexpr int HG_LDS = HG_STB + 2 * 17408;
__device__ void hgrn_item(const Args& a, int item, unsigned char* lds) {
    unsigned char* ws = a.ws;
    const bf16_t* PROJ = (const bf16_t*)(ws + WS_C);
    const float* LB = (const float*)(ws + WS_LB);
    bf16_t* OHG = (bf16_t*)(ws + WS_D);
    const int vs = item & 1, dir = (item >> 1) & 1, h = (item >> 2) & 3, b = item >> 4;
    const int tid = threadIdx.x, lane = tid & 63, wave = tid >> 6, r16 = lane & 15, g = lane >> 4;
    float* E = (float*)(lds + HG_E); float* EL = (float*)(lds + HG_EL);
    bf16_t* Qt = (bf16_t*)(lds + HG_QT); bf16_t* Qh = (bf16_t*)(lds + HG_QH); bf16_t* Kd = (bf16_t*)(lds + HG_KD); bf16_t* K10 = (bf16_t*)(lds + HG_K10);
    bf16_t* vT = (bf16_t*)(lds + HG_VT); bf16_t* Sm = (bf16_t*)(lds + HG_SM); bf16_t* STb = (bf16_t*)(lds + HG_STB);
    const int kB = wave * 16 + r16;
    const float lbk = LB[dir * 512 + h * 128 + kB];
    const int offf = dir ? OFF_FB : OFF_FF;
    const int rowA = tid >> 4, k8A = (tid & 15) * 8;
    const int vrow = tid >> 3, vc8 = (tid & 7) * 8;
    const size_t tokbase = (size_t)b * SEQ;
    __syncthreads();
    for (int i = tid; i < 2 * 64 * 136; i += NT) STb[i] = 0;
    f32x4 accS[4]; accS[0] = (f32x4){0.f, 0.f, 0.f, 0.f}; accS[1] = accS[0]; accS[2] = accS[0]; accS[3] = accS[0];
    unsigned short fB[16]; uint4 qA0, qA1, vA;
#define HG_PREFETCH(n) do { \
        _Pragma("unroll") for (int sc = 0; sc < 2; ++sc) _Pragma("unroll") for (int jj = 0; jj < 8; ++jj) { \
            const int tau = (n) * 64 + sc * 32 + g * 8 + jj, tt = dir ? (SEQ - 1 - tau) : tau; \
            fB[sc * 8 + jj] = PROJ[(tokbase + tt) * INW + offf + h * 128 + kB]; } \
        { const int tau = (n) * 64 + rowA, tt = dir ? (SEQ - 1 - tau) : tau; qA0 = *(const uint4*)(PROJ + (tokbase + tt) * INW + OFF_Q + h * 128 + k8A); } \
        { const int tau = (n) * 64 + rowA + 32, tt = dir ? (SEQ - 1 - tau) : tau; qA1 = *(const uint4*)(PROJ + (tokbase + tt) * INW + OFF_Q + h * 128 + k8A); } \
        { const int tau = (n) * 64 + vrow, tt = dir ? (SEQ - 1 - tau) : tau; vA = *(const uint4*)(PROJ + (tokbase + tt) * INW + OFF_I + h * 128 + vs * 64 + vc8); } \
    } while (0)
    HG_PREFETCH(0);
    for (int n = 0; n < 32; ++n) {
        bf16_t* vTn = vT + (n & 1) * (64 * 72);
        bf16x8 kbf[2];
        {
            float kd[16], ev[16], elast[2];
#pragma unroll
            for (int sc = 0; sc < 2; ++sc) {
                float run = 1.f, runi = 1.f, bb[8], bi[8];
#pragma unroll
                for (int jj = 0; jj < 8; ++jj) {
                    const float u = __expf(-bf2f(fB[sc * 8 + jj]));
                    const float a1 = 1.f + u, a2 = 1.f + lbk * u, r = frcp(a1 * a2);
                    const float f = a2 * a2 * r, fi = a1 * a1 * r;
                    kd[sc * 8 + jj] = 1.f - f;
                    run *= f; bb[jj] = run; runi *= fi; bi[jj] = runi;
                }
                float incl = run, inci = runi;
                { const float t1 = __shfl_up(incl, 16, 64), s1 = __shfl_up(inci, 16, 64); if (g >= 1) { incl *= t1; inci *= s1; } }
                { const float t2 = __shfl_up(incl, 32, 64), s2 = __shfl_up(inci, 32, 64); if (g >= 2) { incl *= t2; inci *= s2; } }
                float excl = __shfl_up(incl, 16, 64), exci = __shfl_up(inci, 16, 64); if (g == 0) { excl = 1.f; exci = 1.f; }
                elast[sc] = __shfl(incl, 48 + r16, 64);
#pragma unroll
                for (int jj = 0; jj < 8; ++jj) {
                    ev[sc * 8 + jj] = bb[jj] * excl;
                    kd[sc * 8 + jj] = kd[sc * 8 + jj] * (bi[jj] * exci);
                }
            }
#pragma unroll
            for (int sc = 0; sc < 2; ++sc)
#pragma unroll
                for (int jj = 0; jj < 8; ++jj) {
                    const int row = sc * 32 + g * 8 + jj;
                    E[row * 132 + kB] = ev[sc * 8 + jj];
                    Kd[row * 136 + kB] = f2bf(kd[sc * 8 + jj]);
                    if (sc == 0) K10[row * 136 + kB] = f2bf(kd[jj] * elast[0]);
                }
            if (g == 3) { EL[kB] = elast[0]; EL[128 + kB] = elast[1]; }
#pragma unroll
            for (int jj = 0; jj < 8; ++jj) { kbf[0][jj] = (short)f2bf(kd[jj] * elast[0] * elast[1]); kbf[1][jj] = (short)f2bf(kd[8 + jj] * elast[1]); }
        }
        {
            const unsigned w4[4] = {vA.x, vA.y, vA.z, vA.w};
#pragma unroll
            for (int q = 0; q < 4; ++q) { vTn[(vc8 + 2 * q) * 72 + vrow] = (bf16_t)(w4[q] & 0xffffu); vTn[(vc8 + 2 * q + 1) * 72 + vrow] = (bf16_t)(w4[q] >> 16); }
        }
        const uint4 qc0 = qA0, qc1 = qA1;
        if (n + 1 < 32) HG_PREFETCH(n + 1);
        __syncthreads();
        {
            const f32x4 d31 = *(const f32x4*)(EL + wave * 16 + 4 * g), d63 = *(const f32x4*)(EL + 128 + wave * 16 + 4 * g);
            const f32x4 dk = d31 * d63;
            bf16_t* stw = STb + (n & 1) * (64 * 136);
#pragma unroll
            for (int vt = 0; vt < 4; ++vt) {
                f32x4 c = accS[vt] * dk;
#pragma unroll
                for (int sc = 0; sc < 2; ++sc) {
                    const bf16x8 vf = *(const bf16x8*)(vTn + (vt * 16 + r16) * 72 + sc * 32 + 8 * g);
                    c = mfma16(kbf[sc], vf, c);
                }
                accS[vt] = c;
                uint2 w; w.x = pack2(c[0], c[1]); w.y = pack2(c[2], c[3]);
                *(uint2*)(stw + (vt * 16 + r16) * 136 + wave * 16 + 4 * g) = w;
            }
        }
        {
            const f32x4 e31a = *(const f32x4*)(EL + k8A), e31b = *(const f32x4*)(EL + k8A + 4);
#pragma unroll
            for (int u = 0; u < 2; ++u) {
                const int row = rowA + u * 32;
                const uint4 qq = u ? qc1 : qc0;
                const f32x4 ea = *(const f32x4*)(E + row * 132 + k8A), eb = *(const f32x4*)(E + row * 132 + k8A + 4);
                const float qr[8] = {bflo(qq.x), bfhi(qq.x), bflo(qq.y), bfhi(qq.y), bflo(qq.z), bfhi(qq.z), bflo(qq.w), bfhi(qq.w)};
                float qt[8], qh[8];
#pragma unroll
                for (int i = 0; i < 8; ++i) {
                    const float qs = qr[i];
                    qt[i] = qs * (i < 4 ? ea[i] : eb[i - 4]);
                    qh[i] = u ? qt[i] * (i < 4 ? e31a[i] : e31b[i - 4]) : qt[i];
                }
                *(uint4*)(Qt + row * 136 + k8A) = make_uint4(pack2(qt[0], qt[1]), pack2(qt[2], qt[3]), pack2(qt[4], qt[5]), pack2(qt[6], qt[7]));
                *(uint4*)(Qh + row * 136 + k8A) = make_uint4(pack2(qh[0], qh[1]), pack2(qh[2], qh[3]), pack2(qh[4], qh[5]), pack2(qh[6], qh[7]));
            }
        }
        __syncthreads();
#pragma unroll
        for (int q2 = 0; q2 < 2; ++q2) {
            const int tix = wave * 2 + q2, ti = tix >> 2, si = tix & 3;
            f32x4 sc = (f32x4){0.f, 0.f, 0.f, 0.f};
            if (si <= ti) {
                const bf16_t* kb = (ti >= 2 && si < 2) ? K10 : Kd;
#pragma unroll
                for (int kk = 0; kk < 4; ++kk) {
                    const bf16x8 af = *(const bf16x8*)(Qt + (ti * 16 + r16) * 136 + kk * 32 + 8 * g);
                    const bf16x8 bfr = *(const bf16x8*)(kb + (si * 16 + r16) * 136 + kk * 32 + 8 * g);
                    sc = mfma16(bfr, af, sc);
                }
                if (si == ti) {
#pragma unroll
                    for (int r = 0; r < 4; ++r) if (4 * g + r > r16) sc[r] = 0.f;
                }
            }
            uint2 w; w.x = pack2(sc[0], sc[1]); w.y = pack2(sc[2], sc[3]);
            *(uint2*)(Sm + (ti * 16 + r16) * 72 + si * 16 + 4 * g) = w;
        }
        __syncthreads();
#pragma unroll
        for (int q2 = 0; q2 < 2; ++q2) {
            const int ti = wave >> 1, vi = (wave & 1) * 2 + q2;
            const bf16_t* stp = STb + ((n + 1) & 1) * (64 * 136);
            f32x4 o = (f32x4){0.f, 0.f, 0.f, 0.f};
#pragma unroll
            for (int kk = 0; kk < 2; ++kk) {
                const bf16x8 af = *(const bf16x8*)(Sm + (ti * 16 + r16) * 72 + kk * 32 + 8 * g);
                const bf16x8 bfr = *(const bf16x8*)(vTn + (vi * 16 + r16) * 72 + kk * 32 + 8 * g);
                o = mfma16(bfr, af, o);
            }
#pragma unroll
            for (int kk = 0; kk < 4; ++kk) {
                const bf16x8 af = *(const bf16x8*)(Qh + (ti * 16 + r16) * 136 + kk * 32 + 8 * g);
                const bf16x8 bfr = *(const bf16x8*)(stp + (vi * 16 + r16) * 136 + kk * 32 + 8 * g);
                o = mfma16(bfr, af, o);
            }
            const int tau = n * 64 + ti * 16 + r16, tt = dir ? (SEQ - 1 - tau) : tau;
            uint2 w; w.x = pack2(o[0], o[1]); w.y = pack2(o[2], o[3]);
            *(uint2*)(OHG + ((size_t)dir * T + tokbase + tt) * 512 + h * 128 + vs * 64 + vi * 16 + 4 * g) = w;
        }
    }
#undef HG_PREFETCH
    __syncthreads();
}

__device__ void phase6(const Args& a) {
    unsigned char* ws = a.ws;
    const bf16_t* OHG = (const bf16_t*)(ws + WS_D); const bf16_t* PROJ = (const bf16_t*)(ws + WS_C);
    bf16_t* YCAT = (bf16_t*)(ws + WS_B);
    const int lane = threadIdx.x & 63;
    for (int t = blockIdx.x * 8 + (threadIdx.x >> 6); t < T; t += gridDim.x * 8) {
        const int c0 = lane * 8;
        const uint4 f = *(const uint4*)(OHG + (size_t)t * 512 + c0), bw = *(const uint4*)(OHG + ((size_t)T + t) * 512 + c0);
        const uint4 gg = *(const uint4*)(PROJ + (size_t)t * INW + OFF_G + c0);
        float o[8];
        o[0] = bflo(f.x) + bflo(bw.x); o[1] = bfhi(f.x) + bfhi(bw.x); o[2] = bflo(f.y) + bflo(bw.y); o[3] = bfhi(f.y) + bfhi(bw.y);
        o[4] = bflo(f.z) + bflo(bw.z); o[5] = bfhi(f.z) + bfhi(bw.z); o[6] = bflo(f.w) + bflo(bw.w); o[7] = bfhi(f.w) + bfhi(bw.w);
        float gr[8] = {bflo(gg.x), bfhi(gg.x), bflo(gg.y), bfhi(gg.y), bflo(gg.z), bfhi(gg.z), bflo(gg.w), bfhi(gg.w)};
        float ss = 0.f;
#pragma unroll
        for (int i = 0; i < 8; ++i) ss += o[i] * o[i];
        ss += __shfl_xor(ss, 1, 64); ss += __shfl_xor(ss, 2, 64); ss += __shfl_xor(ss, 4, 64); ss += __shfl_xor(ss, 8, 64);
        const float rs = rsqrtf(ss * (1.f / 128.f) + EPS);
        float y[8];
#pragma unroll
        for (int i = 0; i < 8; ++i) { const float gt = gr[i] * frcp(1.f + __expf(-gr[i])); y[i] = o[i] * rs * a.hg_o_norm[c0 + i] * gt; }
        *(uint4*)(YCAT + (size_t)t * DM + c0) = make_uint4(pack2(y[0], y[1]), pack2(y[2], y[3]), pack2(y[4], y[5]), pack2(y[6], y[7]));
    }
}

__device__ void phase7(const Args& a, unsigned char* lds) {
    unsigned char* ws = a.ws;
    g256::EpiResid e{a.x, a.out};
    for (int i = 0;; ++i) { int pm, pn; if (!g256::next_tile(i * gridDim.x + blockIdx.x, 64, 4, pm, pn)) break;
        __syncthreads();
        g256::tile((const bf16_t*)(ws + WS_B), (const bf16_t*)(ws + WS_WOUT_T), DM, pm * 256, pn * 256, lds, e); }
    __syncthreads();
    {
        const int lane = threadIdx.x & 63;
        for (int rr = blockIdx.x * 8 + (threadIdx.x >> 6); rr < 32768; rr += gridDim.x * 8) {
            const bool isv = rr >= 16384; const int row = rr & 16383;
            const float* src = (isv ? a.peer_v : a.peer_u) + (size_t)row * DM + lane * 4;
            unsigned char* dst = ws + (isv ? WS_V8 : WS_U8); float* SC = (float*)(ws + (isv ? WS_VSCALE : WS_USCALE));
            f32x4 x[4]; float amax = 0.f;
#pragma unroll
            for (int q = 0; q < 4; ++q) { x[q] = *(const f32x4*)(src + q * 256); amax = fmaxf(amax, fmaxf(fmaxf(fabsf(x[q][0]), fabsf(x[q][1])), fmaxf(fabsf(x[q][2]), fabsf(x[q][3])))); }
#pragma unroll
            for (int d = 32; d > 0; d >>= 1) amax = fmaxf(amax, __shfl_xor(amax, d, 64));
            const float sc = amax > 0.f ? 240.f / amax : 0.f;
            unsigned w[4];
#pragma unroll
            for (int q = 0; q < 4; ++q) { int pk = 0; pk = __builtin_amdgcn_cvt_pk_fp8_f32(x[q][0] * sc, x[q][1] * sc, pk, false); pk = __builtin_amdgcn_cvt_pk_fp8_f32(x[q][2] * sc, x[q][3] * sc, pk, true); w[q] = (unsigned)pk; }
#pragma unroll
            for (int q = 0; q < 4; ++q) *(unsigned*)(dst + (size_t)row * DM + q * 256 + lane * 4) = w[q];
            if (lane == 0) SC[row] = amax * (1.f / 240.f);
        }
    }
}

__device__ void phase9(const Args& a, unsigned char* lds) {
    unsigned char* ws = a.ws;
    g256::EpiBf16 e{(bf16_t*)(ws + WS_D), 2048};
    for (int i = 0;; ++i) { int pm, pn; if (!g256::next_tile(i * gridDim.x + blockIdx.x, 64, 8, pm, pn)) break;
        __syncthreads();
        g256::tile((const bf16_t*)(ws + WS_B), (const bf16_t*)(ws + WS_WPQ_T), DM, pm * 256, pn * 256, lds, e); }
    __syncthreads();
}

__device__ __forceinline__ void ce_desc(float& x, float& y) { const float hi = fmaxf(x, y), lo = fminf(x, y); x = hi; y = lo; }
template <int N> __device__ __forceinline__ void bitonic_sort_desc(float (&v)[N]) {
#pragma unroll
    for (int k = 2; k <= N; k <<= 1)
#pragma unroll
        for (int j = k >> 1; j > 0; j >>= 1)
#pragma unroll
            for (int i = 0; i < N; ++i) { const int l = i ^ j; if (l > i) { if ((i & k) == 0) ce_desc(v[i], v[l]); else ce_desc(v[l], v[i]); } }
}
template <int N> __device__ __forceinline__ void bitonic_merge_desc(float (&v)[N]) {
#pragma unroll
    for (int j = N >> 1; j > 0; j >>= 1)
#pragma unroll
        for (int i = 0; i < N; ++i) { const int l = i ^ j; if (l > i) ce_desc(v[i], v[l]); }
}
__device__ __forceinline__ void xlane_merge16(float (&v)[16], int mask) {
    float o[16];
#pragma unroll
    for (int i = 0; i < 16; ++i) o[i] = __shfl_xor(v[15 - i], mask, 64);
#pragma unroll
    for (int i = 0; i < 16; ++i) v[i] = fmaxf(v[i], o[i]);
    bitonic_merge_desc<16>(v);
}
__device__ __forceinline__ unsigned bsel(unsigned m, unsigned x1, unsigned x0) { return x0 ^ ((x1 ^ x0) & m); }
__device__ __forceinline__ float sel16(const float (&v)[16], unsigned i) {
    const unsigned m0 = 0u - (i & 1u), m1 = 0u - ((i >> 1) & 1u), m2 = 0u - ((i >> 2) & 1u), m3 = 0u - ((i >> 3) & 1u);
    unsigned t8[8], t4[4], t2[2];
#pragma unroll
    for (int q = 0; q < 8; ++q) t8[q] = bsel(m0, __float_as_uint(v[2 * q + 1]), __float_as_uint(v[2 * q]));
#pragma unroll
    for (int q = 0; q < 4; ++q) t4[q] = bsel(m1, t8[2 * q + 1], t8[2 * q]);
#pragma unroll
    for (int q = 0; q < 2; ++q) t2[q] = bsel(m2, t4[2 * q + 1], t4[2 * q]);
    return __uint_as_float(bsel(m3, t2[1], t2[0]));
}
__device__ __forceinline__ float sel4(int g, float x0, float x1, float x2, float x3) {
    const unsigned m0 = 0u - ((unsigned)g & 1u), m1 = 0u - (((unsigned)g >> 1) & 1u);
    const unsigned lo = bsel(m0, __float_as_uint(x1), __float_as_uint(x0)), hi = bsel(m0, __float_as_uint(x3), __float_as_uint(x2));
    return __uint_as_float(bsel(m1, hi, lo));
}

static constexpr int PI[52] = {0,0,0,0,0,0,0,0,0,0,0,0,0,0,0,0,1,1,1,1,1,1,1,1,2,2,2,2,2,3,3,3,3,4,4,4,5,5,6,6,7,7,8,9,10,11,12,13,14,15,0,0};
static constexpr int PJ[52] = {0,1,2,3,4,5,6,7,8,9,10,11,12,13,14,15,0,1,2,3,4,5,6,7,0,1,2,3,4,0,1,2,3,0,1,2,0,1,0,1,0,1,0,0,0,0,0,0,0,0,0,0};
constexpr int RT_ROW = 272;
__device__ __forceinline__ void peer_half_top16(const bf16_t* __restrict__ PQ, const unsigned char* __restrict__ skl, int t0, int p, int c, int r16, int g, float (&out)[16]) {
    f32x4 sc[8];
#pragma unroll
    for (int ni = 0; ni < 8; ++ni) sc[ni] = (f32x4){0.f, 0.f, 0.f, 0.f};
    bf16x8 af[4];
#pragma unroll
    for (int kk = 0; kk < 4; ++kk) af[kk] = *(const bf16x8*)(PQ + (size_t)(t0 + r16) * 2048 + p * 256 + c * 128 + kk * 32 + 8 * g);
#pragma unroll
    for (int kk = 0; kk < 4; ++kk) {
        asm volatile("" ::: "memory");
#pragma unroll
        for (int ni = 0; ni < 8; ++ni) {
            const bf16x8 bfr = *(const bf16x8*)(skl + (c * 128 + ni * 16 + r16) * RT_ROW + kk * 64 + 16 * g);
            sc[ni] = mfma16(bfr, af[kk], sc[ni]);
        }
    }
    float hi[16];
#pragma unroll
    for (int ni = 0; ni < 4; ++ni)
#pragma unroll
        for (int r = 0; r < 4; ++r) {
            out[ni * 4 + r] = __uint_as_float((__float_as_uint(sc[ni][r]) & 0xffffff80u) | (unsigned)(ni * 16 + 4 * g + r));
            hi[ni * 4 + r] = __uint_as_float((__float_as_uint(sc[ni + 4][r]) & 0xffffff80u) | (unsigned)((ni + 4) * 16 + 4 * g + r));
        }
    bitonic_sort_desc<16>(out);
    bitonic_sort_desc<16>(hi);
#pragma unroll
    for (int i = 0; i < 16; ++i) out[i] = fmaxf(out[i], hi[15 - i]);
    bitonic_merge_desc<16>(out);
    xlane_merge16(out, 16);
    xlane_merge16(out, 32);
}
__device__ __forceinline__ void peer_route_finish(const Args& a, int p, int t0, const float (&ab0)[16], const float (&ab1)[16]) {
    unsigned char* ws = a.ws;
    int* IDX = (int*)(ws + WS_IDX); float* GATE = (float*)(ws + WS_GATE);
    int tix_ = threadIdx.x; asm volatile("" : "+v"(tix_));
    const int lane = tix_ & 63, r16 = lane & 15, g = lane >> 4;
    float va[16], vb[16];
#pragma unroll
    for (int i = 0; i < 16; ++i) { va[i] = __uint_as_float(__float_as_uint(ab0[i]) & 0xffffff80u); vb[i] = __uint_as_float(__float_as_uint(ab1[i]) & 0xffffff80u); }
    float v[16];
#pragma unroll
    for (int s = 0; s < 13; ++s) {
        const float x0 = __uint_as_float((__float_as_uint(va[PI[4 * s]] + vb[PJ[4 * s]]) & 0xffffff00u) | (unsigned)(PI[4 * s] * 16 + PJ[4 * s]));
        const float x1 = __uint_as_float((__float_as_uint(va[PI[4 * s + 1]] + vb[PJ[4 * s + 1]]) & 0xffffff00u) | (unsigned)(PI[4 * s + 1] * 16 + PJ[4 * s + 1]));
        const float x2 = (4 * s + 2 < 50) ? __uint_as_float((__float_as_uint(va[PI[4 * s + 2]] + vb[PJ[4 * s + 2]]) & 0xffffff00u) | (unsigned)(PI[4 * s + 2] * 16 + PJ[4 * s + 2])) : -3.0e38f;
        const float x3 = (4 * s + 3 < 50) ? __uint_as_float((__float_as_uint(va[PI[4 * s + 3]] + vb[PJ[4 * s + 3]]) & 0xffffff00u) | (unsigned)(PI[4 * s + 3] * 16 + PJ[4 * s + 3])) : -3.0e38f;
        v[s] = sel4(g, x0, x1, x2, x3);
    }
    v[13] = -3.0e38f; v[14] = -3.0e38f; v[15] = -3.0e38f;
    bitonic_sort_desc<16>(v);
    xlane_merge16(v, 16);
    xlane_merge16(v, 32);
    float e[16], sum = 0.f;
    const float mtop = __uint_as_float(__float_as_uint(v[0]) & 0xffffff00u);
#pragma unroll
    for (int q = 0; q < 16; ++q) { e[q] = __expf(__uint_as_float(__float_as_uint(v[q]) & 0xffffff00u) - mtop); sum += e[q]; }
    const float inv = 1.f / sum;
    int oi[4]; float og[4];
#pragma unroll
    for (int r = 0; r < 4; ++r) {
        const unsigned key = __float_as_uint(sel4(g, v[r], v[4 + r], v[8 + r], v[12 + r]));
        const unsigned pos = key & 255u;
        const unsigned ia = __float_as_uint(sel16(ab0, pos >> 4)) & 127u, ib = __float_as_uint(sel16(ab1, pos & 15u)) & 127u;
        oi[r] = (int)(ia * 128u + ib);
        og[r] = sel4(g, e[r], e[4 + r], e[8 + r], e[12 + r]) * inv;
    }
    const size_t o = (size_t)(t0 + r16) * 128 + p * 16 + 4 * g;
    *(int4*)(IDX + o) = make_int4(oi[0], oi[1], oi[2], oi[3]);
    *(f32x4*)(GATE + o) = (f32x4){og[0], og[1], og[2], og[3]};
}

__device__ __forceinline__ float dpp_xor1(float v) { return __builtin_bit_cast(float, __builtin_amdgcn_mov_dpp(__builtin_bit_cast(int, v), 0xB1, 0xF, 0xF, true)); }
__device__ __forceinline__ float dpp_xor2(float v) { return __builtin_bit_cast(float, __builtin_amdgcn_mov_dpp(__builtin_bit_cast(int, v), 0x4E, 0xF, 0xF, true)); }
__device__ __forceinline__ float dpp_hmirror(float v) { return __builtin_bit_cast(float, __builtin_amdgcn_mov_dpp(__builtin_bit_cast(int, v), 0x141, 0xF, 0xF, true)); }

__device__ void peer_u_phase(const Args& a) {
    unsigned char* ws = a.ws;
    const bf16_t* H2 = (const bf16_t*)(ws + WS_B); const bf16_t* U16 = (const bf16_t*)(ws + WS_U16);
    const int* IDX = (const int*)(ws + WS_IDX); float* P = (float*)(ws + WS_D);
    const int lane = threadIdx.x & 63, m = lane & 7, j = lane >> 3;
    const int v = blockIdx.x & 7, rank = blockIdx.x >> 3, nrank = (gridDim.x - v + 7) >> 3;
    const int wg = rank * 8 + (threadIdx.x >> 6), nwg = nrank * 8;
    for (int pass = 0; pass < 2; ++pass) {
        const int slice = v + 8 * pass;
        for (int t = wg; t < T; t += nwg) {
            const uint4 hq = *(const uint4*)(H2 + (size_t)t * DM + slice * 64 + 8 * m);
            const float h0 = bflo(hq.x), h1 = bfhi(hq.x), h2 = bflo(hq.y), h3 = bfhi(hq.y), h4 = bflo(hq.z), h5 = bfhi(hq.z), h6 = bflo(hq.w), h7 = bfhi(hq.w);
            int id[16];
#pragma unroll
            for (int q = 0; q < 4; ++q) { const uint4 iv = *(const uint4*)(IDX + (size_t)t * 128 + j * 16 + q * 4); id[q * 4] = iv.x; id[q * 4 + 1] = iv.y; id[q * 4 + 2] = iv.z; id[q * 4 + 3] = iv.w; }
            uint4 uq[16];
#pragma unroll
            for (int it = 0; it < 16; ++it) uq[it] = *(const uint4*)(U16 + (size_t)id[it] * DM + slice * 64 + 8 * m);
            float val0 = 0.f, val1 = 0.f;
#pragma unroll
            for (int it = 0; it < 16; ++it) {
                float d = h0 * bflo(uq[it].x) + h1 * bfhi(uq[it].x) + h2 * bflo(uq[it].y) + h3 * bfhi(uq[it].y) + h4 * bflo(uq[it].z) + h5 * bfhi(uq[it].z) + h6 * bflo(uq[it].w) + h7 * bfhi(uq[it].w);
                d += dpp_xor1(d); d += dpp_xor2(d); d += dpp_hmirror(d);
                if ((it >> 1) == m) { if (it & 1) val1 = d; else val0 = d; }
            }
            float2* dst = (float2*)(P + ((size_t)v * T + t) * 128 + j * 16 + 2 * m);
            if (pass == 1) { const float2 prev = *dst; val0 += prev.x; val1 += prev.y; }
            *dst = make_float2(val0, val1);
        }
    }
}

__device__ __forceinline__ void peer_rowcount(const int* __restrict__ IDX, int chunk, unsigned char* lds, int (&e)[16]) {
    const int r = threadIdx.x, t = chunk * 64 + (r >> 3), p = r & 7;
    unsigned char* rowcnt = lds + r * 32;
    *(uint4*)rowcnt = make_uint4(0u, 0u, 0u, 0u); *(uint4*)(rowcnt + 16) = make_uint4(0u, 0u, 0u, 0u);
#pragma unroll
    for (int q = 0; q < 4; ++q) { const int4 iv = *(const int4*)(IDX + (size_t)t * 128 + p * 16 + q * 4); e[q * 4] = iv.x; e[q * 4 + 1] = iv.y; e[q * 4 + 2] = iv.z; e[q * 4 + 3] = iv.w; }
#pragma unroll
    for (int k = 0; k < 16; ++k) rowcnt[e[k] >> 9] += 1;
}
__device__ void peer_count_phase(const Args& a, unsigned char* lds) {
    unsigned char* ws = a.ws;
    const int* IDX = (const int*)(ws + WS_IDX); int* COUNTS = (int*)(ws + WS_COUNTS);
    int* segsum = (int*)(lds + 16384);
    const int tid = threadIdx.x;
    for (int chunk = blockIdx.x; chunk < 256; chunk += gridDim.x) {
        __syncthreads();
        int e[16];
        peer_rowcount(IDX, chunk, lds, e);
        __syncthreads();
        { const int B = tid & 31, seg = tid >> 5; int sacc = 0;
#pragma unroll 8
          for (int i = 0; i < 32; ++i) sacc += lds[(seg * 32 + i) * 32 + B];
          segsum[seg * 32 + B] = sacc; }
        __syncthreads();
        if (tid < 32) { int tot = 0;
#pragma unroll
            for (int sg = 0; sg < 16; ++sg) tot += segsum[sg * 32 + tid];
            COUNTS[chunk * 32 + tid] = tot; }
    }
}
__device__ void peer_scatter_phase(const Args& a, unsigned char* lds) {
    unsigned char* ws = a.ws;
    const int* IDX = (const int*)(ws + WS_IDX); const int* COUNTS = (const int*)(ws + WS_COUNTS);
    int* BSTART = (int*)(ws + WS_BSTART); unsigned* ELIST = (unsigned*)(ws + WS_ELIST);
    int* segsum = (int*)(lds + 16384);
    int* ps = (int*)(lds + 16384 + 2048);
    int* chunkoff = (int*)(lds + 16384 + 4096);
    unsigned* off = (unsigned*)(lds + 32768);
    const int tid = threadIdx.x;
    for (int chunk = blockIdx.x; chunk < 256; chunk += gridDim.x) {
        __syncthreads();
        int e[16];
        peer_rowcount(IDX, chunk, lds, e);
        { const int B = tid & 31, part = tid >> 5; int sacc = 0;
#pragma unroll 4
          for (int c = 0; c < 16; ++c) sacc += COUNTS[(part * 16 + c) * 32 + B];
          ps[part * 32 + B] = sacc; }
        __syncthreads();
        { const int B = tid & 31, seg = tid >> 5; int sacc = 0;
#pragma unroll 8
          for (int i = 0; i < 32; ++i) sacc += lds[(seg * 32 + i) * 32 + B];
          segsum[seg * 32 + B] = sacc; }
        if (tid < 32) {
            int tot = 0, before = 0;
            const int mypart = chunk >> 4;
#pragma unroll
            for (int pt = 0; pt < 16; ++pt) { const int x = ps[pt * 32 + tid]; tot += x; if (pt < mypart) before += x; }
            for (int c = mypart * 16; c < chunk; ++c) before += COUNTS[c * 32 + tid];
            int incl = tot;
#pragma unroll
            for (int d = 1; d < 32; d <<= 1) { const int o = __shfl_up(incl, d, 64); if (tid >= d) incl += o; }
            const int bstart = incl - tot;
            chunkoff[tid] = bstart + before;
            if (chunk == 0) { BSTART[tid] = bstart; if (tid == 31) BSTART[32] = incl; }
        }
        __syncthreads();
        { const int B = tid & 31, seg = tid >> 5;
          int run = chunkoff[B];
          for (int sg = 0; sg < seg; ++sg) run += segsum[sg * 32 + B];
#pragma unroll 8
          for (int i = 0; i < 32; ++i) { const int row = seg * 32 + i; off[row * 32 + B] = (unsigned)run; run += lds[row * 32 + B]; } }
        __syncthreads();
        { const int r = tid, t = chunk * 64 + (r >> 3), p = r & 7;
#pragma unroll
          for (int k = 0; k < 16; ++k) {
              const int b = e[k] >> 9;
              const unsigned pos = off[r * 32 + b]; off[r * 32 + b] = pos + 1u;
              ELIST[pos] = (unsigned)t | ((unsigned)(e[k] & 511) << 14) | ((unsigned)(p * 16 + k) << 23);
          } }
    }
}

constexpr int PU_ROW = 272;
__device__ __forceinline__ float dot2bf(unsigned x, unsigned y, float acc) { return __builtin_amdgcn_fdot2_f32_bf16(__builtin_bit_cast(bf16v2, x), __builtin_bit_cast(bf16v2, y), acc, false); }
__device__ void peer_u_lds_phase(const Args& a, unsigned char* lds) {
    unsigned char* ws = a.ws;
    const bf16_t* H2 = (const bf16_t*)(ws + WS_B);
    const unsigned* ELIST = (const unsigned*)(ws + WS_ELIST); const int* BSTART = (const int*)(ws + WS_BSTART);
    float* P = (float*)(ws + WS_D);
    const int tid = threadIdx.x, lane = tid & 63, wave = tid >> 6, m = lane & 7;
    for (int job = blockIdx.x; job < 256; job += gridDim.x) {
        const int v = job & 7, jb = job >> 3;
        __syncthreads();
        for (int c = tid; c < 512 * 32; c += NT) {
            const int row = c >> 5, q = c & 31;
            const f32x4 x = *(const f32x4*)(a.peer_u + (size_t)(jb * 512 + row) * DM + v * 128 + q * 4);
            *(uint2*)(lds + row * PU_ROW + q * 8) = make_uint2(pack2(x[0], x[1]), pack2(x[2], x[3]));
        }
        __syncthreads();
        const int bs = BSTART[jb], be = BSTART[jb + 1];
        const bf16_t* hbase = H2 + v * 128 + m * 16;
        int base = bs + wave * 64;
        uint4 ra = *(const uint4*)(ELIST + base + (lane & ~7)), rb = *(const uint4*)(ELIST + base + (lane & ~7) + 4);
        for (; base < be; base += 8 * 64) {
            const int nb = (base + 512 < be) ? base + 512 : base;
            const uint4 na = *(const uint4*)(ELIST + nb + (lane & ~7)), nbv = *(const uint4*)(ELIST + nb + (lane & ~7) + 4);
            const unsigned recs[8] = {ra.x, ra.y, ra.z, ra.w, rb.x, rb.y, rb.z, rb.w};
            uint4 h0[8], h1[8];
#pragma unroll
            for (int it = 0; it < 8; ++it) { const bf16_t* hp = hbase + (size_t)(recs[it] & 16383u) * DM; h0[it] = *(const uint4*)hp; h1[it] = *(const uint4*)(hp + 8); }
            float val = 0.f;
#pragma unroll
            for (int it = 0; it < 8; ++it) {
                const unsigned el = (recs[it] >> 14) & 511u;
                const uint4 u0 = *(const uint4*)(lds + el * PU_ROW + m * 32), u1 = *(const uint4*)(lds + el * PU_ROW + m * 32 + 16);
                float d = 0.f;
                d = dot2bf(h0[it].x, u0.x, d); d = dot2bf(h0[it].y, u0.y, d); d = dot2bf(h0[it].z, u0.z, d); d = dot2bf(h0[it].w, u0.w, d);
                d = dot2bf(h1[it].x, u1.x, d); d = dot2bf(h1[it].y, u1.y, d); d = dot2bf(h1[it].z, u1.z, d); d = dot2bf(h1[it].w, u1.w, d);
                d += dpp_xor1(d); d += dpp_xor2(d); d += dpp_hmirror(d);
                if (it == m) val = d;
            }
            if (base + lane < be) P[(size_t)v * ((size_t)T * 128) + base + lane] = val;
            ra = na; rb = nbv;
        }
    }
}

__device__ void peer_act_phase(const Args& a) {
    unsigned char* ws = a.ws;
    const float* P = (const float*)(ws + WS_D); float* GATE = (float*)(ws + WS_GATE); const unsigned* ELIST = (const unsigned*)(ws + WS_ELIST);
    const int* IDX = (const int*)(ws + WS_IDX); const float* VS = (const float*)(ws + WS_VSCALE); _Float16* W16 = (_Float16*)(ws + WS_W16);
    const size_t n = (size_t)T * 128;
    for (size_t i = (size_t)blockIdx.x * NT + threadIdx.x; i < n; i += (size_t)gridDim.x * NT) {
        float sacc = P[i];
#pragma unroll
        for (int v = 1; v < 8; ++v) sacc += P[(size_t)v * n + i];
        const unsigned r = ELIST[i];
        const size_t o = (size_t)(r & 16383u) * 128 + (r >> 23);
        W16[o] = (_Float16)(GATE[o] * 0.5f * sacc * (1.f + erff(sacc * 0.70710678118654752f)) * VS[IDX[o]]);
    }
}


__device__ void peer_route_task(const Args& a, int p, int t0, const unsigned char* skl) {
    const bf16_t* PQ = (const bf16_t*)(a.ws + WS_D);
    const int lane = threadIdx.x & 63, r16 = lane & 15, g = lane >> 4;
    float ab0[16], ab1[16];
    peer_half_top16(PQ, skl, t0, p, 0, r16, g, ab0);
    peer_half_top16(PQ, skl, t0, p, 1, r16, g, ab1);
    peer_route_finish(a, p, t0, ab0, ab1);
}
__device__ __forceinline__ void peer_half_top16_lds(const unsigned char* __restrict__ qs, const unsigned char* __restrict__ skl, int r16, int g, float (&out)[16]) {
    f32x4 sc[8];
#pragma unroll
    for (int ni = 0; ni < 8; ++ni) sc[ni] = (f32x4){0.f, 0.f, 0.f, 0.f};
#pragma unroll
    for (int kk = 0; kk < 4; ++kk) {
        asm volatile("" ::: "memory");
        const bf16x8 af = *(const bf16x8*)(qs + r16 * RT_ROW + kk * 64 + 16 * g);
#pragma unroll
        for (int ni = 0; ni < 8; ++ni) {
            const bf16x8 bfr = *(const bf16x8*)(skl + (ni * 16 + r16) * RT_ROW + kk * 64 + 16 * g);
            sc[ni] = mfma16(bfr, af, sc[ni]);
        }
    }
    float hi[16];
#pragma unroll
    for (int ni = 0; ni < 4; ++ni)
#pragma unroll
        for (int r = 0; r < 4; ++r) {
            out[ni * 4 + r] = __uint_as_float((__float_as_uint(sc[ni][r]) & 0xffffff80u) | (unsigned)(ni * 16 + 4 * g + r));
            hi[ni * 4 + r] = __uint_as_float((__float_as_uint(sc[ni + 4][r]) & 0xffffff80u) | (unsigned)((ni + 4) * 16 + 4 * g + r));
        }
    bitonic_sort_desc<16>(out);
    bitonic_sort_desc<16>(hi);
#pragma unroll
    for (int i = 0; i < 16; ++i) out[i] = fmaxf(out[i], hi[15 - i]);
    bitonic_merge_desc<16>(out);
    xlane_merge16(out, 16);
    xlane_merge16(out, 32);
}
struct EpiRoute { const Args* ap; unsigned char* lds; int p; int brow;
    __device__ __forceinline__ void operator()(const f32x4 (&acc)[2][2][4][2], int row0, int col0) const {
        int tix = threadIdx.x; asm volatile("" : "+v"(tix));
        const int lane = tix & 63, wave = tix >> 6, r16 = lane & 15, g = lane >> 4;
        unsigned char* qs = lds;
        unsigned char* skl = lds + 256 * RT_ROW;
        const int rl0 = row0 - brow, cl0 = (col0 - p * 256);
        float* tl = (float*)(lds + 384 * RT_ROW);
#pragma unroll 1
        for (int c = 0; c < 2; ++c) {
            __syncthreads();
#pragma unroll
            for (int ai = 0; ai < 2; ++ai)
#pragma unroll
                for (int m = 0; m < 4; ++m)
#pragma unroll
                    for (int n = 0; n < 2; ++n) { const f32x4 v = c ? acc[ai][1][m][n] : acc[ai][0][m][n]; uint2 w; w.x = pack2(v[0], v[1]); w.y = pack2(v[2], v[3]);
                        *(uint2*)(qs + (rl0 + ai * 128 + m * 16) * RT_ROW + (cl0 + n * 16) * 2) = w; }
            { const bf16_t* SK = (const bf16_t*)(ap->ws + WS_SUBK) + ((size_t)p * 2 + c) * 128 * 128;
              for (int ch = tix; ch < 128 * 16; ch += NT) { const int row = ch >> 4, q = ch & 15; *(uint4*)(skl + row * RT_ROW + q * 16) = *(const uint4*)(SK + row * 128 + q * 8); } }
            __syncthreads();
#pragma unroll 1
            for (int k = 0; k < 2; ++k) {
                float lst[16];
                peer_half_top16_lds(qs + ((wave * 2 + k) * 16) * RT_ROW, skl, r16, g, lst);
                if (g == 0) { float* d = tl + (((wave * 2 + k) * 16 + r16) * 2 + c) * 16;
#pragma unroll
                    for (int q = 0; q < 4; ++q) *(f32x4*)(d + q * 4) = (f32x4){lst[q * 4], lst[q * 4 + 1], lst[q * 4 + 2], lst[q * 4 + 3]}; }
            }
        }
        __syncthreads();
#pragma unroll 1
        for (int k = 0; k < 2; ++k) {
            float ab0[16], ab1[16];
            const float* d = tl + (((wave * 2 + k) * 16 + r16) * 2) * 16;
#pragma unroll
            for (int q = 0; q < 4; ++q) { const f32x4 x0 = *(const f32x4*)(d + q * 4), x1 = *(const f32x4*)(d + 16 + q * 4);
                ab0[q * 4] = x0[0]; ab0[q * 4 + 1] = x0[1]; ab0[q * 4 + 2] = x0[2]; ab0[q * 4 + 3] = x0[3]; ab1[q * 4] = x1[0]; ab1[q * 4 + 1] = x1[1]; ab1[q * 4 + 2] = x1[2]; ab1[q * 4 + 3] = x1[3]; }
            peer_route_finish(*ap, p, brow + (wave * 2 + k) * 16, ab0, ab1);
        }
    }
};

__device__ void phase9_fused(const Args& a, unsigned char* lds) {
    unsigned char* ws = a.ws;
    for (int i = 0;; ++i) { int pm, pn; if (!g256::next_tile(i * gridDim.x + blockIdx.x, 64, 8, pm, pn)) break;
        EpiRoute e{&a, lds, pn, pm * 256};
        __syncthreads();
        g256::tile((const bf16_t*)(ws + WS_B), (const bf16_t*)(ws + WS_WPQ_T), DM, pm * 256, pn * 256, lds, e); }
    __syncthreads();
}

__device__ void peer_u_gather_phase(const Args& a) {
    unsigned char* ws = a.ws;
    const bf16_t* H2 = (const bf16_t*)(ws + WS_B); const unsigned char* U8 = ws + WS_U8;
    const unsigned* IDX = (const unsigned*)(ws + WS_IDX); float* P = (float*)(ws + WS_D);
    int tix = threadIdx.x; asm volatile("" : "+v"(tix));
    const int lane = tix & 63, m = lane & 7, j = lane >> 3;
    const int v = blockIdx.x & 7, rank = blockIdx.x >> 3, nrank = (gridDim.x - v + 7) >> 3;
    const int wg = rank * 8 + (tix >> 6), nwg = nrank * 8;
    const unsigned uoff = (unsigned)(v * 128 + 16 * m);
    for (int tp = wg; tp < T / 2; tp += nwg) {
        uint4 hq[2][2]; uint4 iq[2][4];
#pragma unroll
        for (int tt = 0; tt < 2; ++tt) {
            const size_t t = (size_t)tp * 2 + tt;
            hq[tt][0] = *(const uint4*)(H2 + t * DM + v * 128 + 16 * m); hq[tt][1] = *(const uint4*)(H2 + t * DM + v * 128 + 16 * m + 8);
#pragma unroll
            for (int q = 0; q < 4; ++q) iq[tt][q] = *(const uint4*)(IDX + t * 128 + j * 16 + q * 4);
        }
        uint4 uq[2][16];
#pragma unroll
        for (int tt = 0; tt < 2; ++tt)
#pragma unroll
            for (int q = 0; q < 4; ++q) {
                uq[tt][q * 4] = *(const uint4*)(U8 + (iq[tt][q].x * 1024u + uoff)); uq[tt][q * 4 + 1] = *(const uint4*)(U8 + (iq[tt][q].y * 1024u + uoff));
                uq[tt][q * 4 + 2] = *(const uint4*)(U8 + (iq[tt][q].z * 1024u + uoff)); uq[tt][q * 4 + 3] = *(const uint4*)(U8 + (iq[tt][q].w * 1024u + uoff));
            }
#pragma unroll
        for (int tt = 0; tt < 2; ++tt) {
            const unsigned hw[8] = {hq[tt][0].x, hq[tt][0].y, hq[tt][0].z, hq[tt][0].w, hq[tt][1].x, hq[tt][1].y, hq[tt][1].z, hq[tt][1].w};
            float val0 = 0.f, val1 = 0.f;
#pragma unroll
            for (int it = 0; it < 16; ++it) {
                unsigned wd[4] = {uq[tt][it].x, uq[tt][it].y, uq[tt][it].z, uq[tt][it].w};
                asm volatile("" : "+v"(wd[0]), "+v"(wd[1]), "+v"(wd[2]), "+v"(wd[3]), "+v"(val0), "+v"(val1));
                float d0 = 0.f, d1 = 0.f;
#pragma unroll
                for (int q = 0; q < 4; ++q) {
                    const bf16v2 lo = __builtin_amdgcn_cvt_scalef32_pk_bf16_fp8(wd[q], 1.0f, false), hi = __builtin_amdgcn_cvt_scalef32_pk_bf16_fp8(wd[q], 1.0f, true);
                    d0 = __builtin_amdgcn_fdot2_f32_bf16(__builtin_bit_cast(bf16v2, hw[2 * q]), lo, d0, false);
                    d1 = __builtin_amdgcn_fdot2_f32_bf16(__builtin_bit_cast(bf16v2, hw[2 * q + 1]), hi, d1, false);
                }
                float d = d0 + d1;
                d += dpp_xor1(d); d += dpp_xor2(d); d += dpp_hmirror(d);
                if ((it >> 1) == m) { if (it & 1) val1 = d; else val0 = d; }
            }
            *(float2*)(P + ((size_t)v * T + (size_t)tp * 2 + tt) * 128 + j * 16 + 2 * m) = make_float2(val0, val1);
        }
    }
}
__device__ void peer_u_fused_phase(const Args& a) {
    unsigned char* ws = a.ws;
    const bf16_t* H2 = (const bf16_t*)(ws + WS_B); const unsigned char* U8 = ws + WS_U8;
    const unsigned* IDX = (const unsigned*)(ws + WS_IDX); const float* GATE = (const float*)(ws + WS_GATE);
    const float* VS = (const float*)(ws + WS_VSCALE); const float* US = (const float*)(ws + WS_USCALE); unsigned* W16 = (unsigned*)(ws + WS_W16);
    int tix = threadIdx.x; asm volatile("" : "+v"(tix));
    const int lane = tix & 63, m = lane & 7, j = lane >> 3;
    const int v = blockIdx.x & 7, rank = blockIdx.x >> 3;
    const int wg = rank * 8 + (tix >> 6);
    const size_t tp0 = (size_t)v * 1024 + wg;
    float acc[4][2][2];
#pragma unroll
    for (int k = 0; k < 4; ++k) { acc[k][0][0] = 0.f; acc[k][0][1] = 0.f; acc[k][1][0] = 0.f; acc[k][1][1] = 0.f; }
#pragma unroll 1
    for (int sl = 0; sl < 8; ++sl) {
        const unsigned uoff = (unsigned)(sl * 128 + 16 * m);
#pragma unroll
        for (int k = 0; k < 4; ++k) {
            const size_t tp = tp0 + 256 * k;
            uint4 hq[2][2]; uint4 iq[2][4];
#pragma unroll
            for (int tt = 0; tt < 2; ++tt) {
                const size_t t = tp * 2 + tt;
                hq[tt][0] = *(const uint4*)(H2 + t * DM + sl * 128 + 16 * m); hq[tt][1] = *(const uint4*)(H2 + t * DM + sl * 128 + 16 * m + 8);
#pragma unroll
                for (int q = 0; q < 4; ++q) iq[tt][q] = *(const uint4*)(IDX + t * 128 + j * 16 + q * 4);
            }
            uint4 uq[2][16];
#pragma unroll
            for (int tt = 0; tt < 2; ++tt)
#pragma unroll
                for (int q = 0; q < 4; ++q) {
                    uq[tt][q * 4] = *(const uint4*)(U8 + (iq[tt][q].x * 1024u + uoff)); uq[tt][q * 4 + 1] = *(const uint4*)(U8 + (iq[tt][q].y * 1024u + uoff));
                    uq[tt][q * 4 + 2] = *(const uint4*)(U8 + (iq[tt][q].z * 1024u + uoff)); uq[tt][q * 4 + 3] = *(const uint4*)(U8 + (iq[tt][q].w * 1024u + uoff));
                }
#pragma unroll
            for (int tt = 0; tt < 2; ++tt) {
                const unsigned hw[8] = {hq[tt][0].x, hq[tt][0].y, hq[tt][0].z, hq[tt][0].w, hq[tt][1].x, hq[tt][1].y, hq[tt][1].z, hq[tt][1].w};
                float val0 = 0.f, val1 = 0.f;
#pragma unroll
                for (int it = 0; it < 16; ++it) {
                    unsigned wd[4] = {uq[tt][it].x, uq[tt][it].y, uq[tt][it].z, uq[tt][it].w};
                    asm volatile("" : "+v"(wd[0]), "+v"(wd[1]), "+v"(wd[2]), "+v"(wd[3]), "+v"(val0), "+v"(val1));
                    float d0 = 0.f, d1 = 0.f;
#pragma unroll
                    for (int q = 0; q < 4; ++q) {
                        const bf16v2 lo = __builtin_amdgcn_cvt_scalef32_pk_bf16_fp8(wd[q], 1.0f, false), hi = __builtin_amdgcn_cvt_scalef32_pk_bf16_fp8(wd[q], 1.0f, true);
                        d0 = __builtin_amdgcn_fdot2_f32_bf16(__builtin_bit_cast(bf16v2, hw[2 * q]), lo, d0, false);
                        d1 = __builtin_amdgcn_fdot2_f32_bf16(__builtin_bit_cast(bf16v2, hw[2 * q + 1]), hi, d1, false);
                    }
                    float d = d0 + d1;
                    d += dpp_xor1(d); d += dpp_xor2(d); d += dpp_hmirror(d);
                    if ((it >> 1) == m) { if (it & 1) val1 = d; else val0 = d; }
                }
                acc[k][tt][0] += val0; acc[k][tt][1] += val1;
            }
        }
    }
#pragma unroll
    for (int k = 0; k < 4; ++k)
#pragma unroll
        for (int tt = 0; tt < 2; ++tt) {
            const size_t o = ((tp0 + 256 * k) * 2 + tt) * 128 + j * 16 + 2 * m;
            const float2 gt = *(const float2*)(GATE + o); const uint2 id = *(const uint2*)(IDX + o);
            const float x0 = acc[k][tt][0] * US[id.x], x1 = acc[k][tt][1] * US[id.y];
            const float w0 = gt.x * 0.5f * x0 * (1.f + erff(x0 * 0.70710678118654752f)) * VS[id.x];
            const float w1 = gt.y * 0.5f * x1 * (1.f + erff(x1 * 0.70710678118654752f)) * VS[id.y];
            W16[o >> 1] = pack2h(w0, w1);
        }
}
__device__ void peer_act_tm_phase(const Args& a) {
    unsigned char* ws = a.ws;
    const float* P = (const float*)(ws + WS_D); const float* GATE = (const float*)(ws + WS_GATE); const int* IDX = (const int*)(ws + WS_IDX);
    const float* VS = (const float*)(ws + WS_VSCALE); const float* US = (const float*)(ws + WS_USCALE); _Float16* W16 = (_Float16*)(ws + WS_W16);
    const size_t n4 = (size_t)T * 128 / 4;
    for (size_t i = (size_t)blockIdx.x * NT + threadIdx.x; i < n4; i += (size_t)gridDim.x * NT) {
        f32x4 sacc = *(const f32x4*)(P + i * 4);
#pragma unroll
        for (int v = 1; v < 8; ++v) sacc += *(const f32x4*)(P + (size_t)v * T * 128 + i * 4);
        const f32x4 gt = *(const f32x4*)(GATE + i * 4); const int4 id = *(const int4*)(IDX + i * 4);
        const int ids[4] = {id.x, id.y, id.z, id.w};
        unsigned short o[4];
#pragma unroll
        for (int r = 0; r < 4; ++r) { const float x = sacc[r] * US[ids[r]]; const _Float16 hv = (_Float16)(gt[r] * 0.5f * x * (1.f + erff(x * 0.70710678118654752f)) * VS[ids[r]]); o[r] = __builtin_bit_cast(unsigned short, hv); }
        *(uint2*)((unsigned short*)W16 + i * 4) = make_uint2((unsigned)o[0] | ((unsigned)o[1] << 16), (unsigned)o[2] | ((unsigned)o[3] << 16));
    }
}

__device__ void peer_v_phase(const Args& a) {
    unsigned char* ws = a.ws;
    const unsigned char* V8 = ws + WS_V8;
    const int* IDX = (const int*)(ws + WS_IDX); const _Float16* W16 = (const _Float16*)(ws + WS_W16);
    int tix = threadIdx.x; asm volatile("" : "+v"(tix));
    const int lane = tix & 63, m = lane & 7, j = lane >> 3;
    const int v = blockIdx.x & 7, rank = blockIdx.x >> 3, nrank = (gridDim.x - v + 7) >> 3;
    const int wg = rank * 8 + (tix >> 6), nwg = nrank * 8;
    const unsigned voff = (unsigned)(v * 128 + 16 * m);
    for (int oct = wg; oct < T / 8; oct += nwg) {
        const int t = oct * 8 + j;
        float y[16];
#pragma unroll
        for (int i = 0; i < 16; ++i) y[i] = 0.f;
        uint4 iq[8]; uint4 wq[4];
#pragma unroll
        for (int q = 0; q < 8; ++q) iq[q] = *(const uint4*)(IDX + (size_t)t * 128 + q * 4);
#pragma unroll
        for (int q = 0; q < 4; ++q) wq[q] = *(const uint4*)(W16 + (size_t)t * 128 + q * 8);
#pragma unroll 1
        for (int grp = 0; grp < 4; ++grp) {
            const int gn = (grp < 3) ? grp + 1 : grp;
            uint4 vq[32];
#pragma unroll
            for (int q = 0; q < 8; ++q) {
                vq[q * 4] = *(const uint4*)(V8 + (iq[q].x * 1024u + voff)); vq[q * 4 + 1] = *(const uint4*)(V8 + (iq[q].y * 1024u + voff));
                vq[q * 4 + 2] = *(const uint4*)(V8 + (iq[q].z * 1024u + voff)); vq[q * 4 + 3] = *(const uint4*)(V8 + (iq[q].w * 1024u + voff));
            }
            uint4 wnx[4];
#pragma unroll
            for (int q = 0; q < 8; ++q) iq[q] = *(const uint4*)(IDX + (size_t)t * 128 + gn * 32 + q * 4);
#pragma unroll
            for (int q = 0; q < 4; ++q) wnx[q] = *(const uint4*)(W16 + (size_t)t * 128 + gn * 32 + q * 8);
#pragma unroll
            for (int it = 0; it < 32; ++it) {
                const uint4 wv4 = wq[it >> 3]; const int wc_ = (it >> 1) & 3;
                const unsigned wword = wc_ == 0 ? wv4.x : (wc_ == 1 ? wv4.y : (wc_ == 2 ? wv4.z : wv4.w));
                const f16v2 wp = __builtin_bit_cast(f16v2, wword);
                const float wt = (float)((it & 1) ? wp[1] : wp[0]);
                const unsigned wd[4] = {vq[it].x, vq[it].y, vq[it].z, vq[it].w};
#pragma unroll
                for (int q = 0; q < 4; ++q) {
                    const f32v2 lo = __builtin_amdgcn_cvt_pk_f32_fp8((int)wd[q], false), hi = __builtin_amdgcn_cvt_pk_f32_fp8((int)wd[q], true);
                    y[q * 4] += wt * lo[0]; y[q * 4 + 1] += wt * lo[1]; y[q * 4 + 2] += wt * hi[0]; y[q * 4 + 3] += wt * hi[1];
                }
            }
#pragma unroll
            for (int q = 0; q < 4; ++q) wq[q] = wnx[q];
        }
        float* orow = a.out + (size_t)t * DM + v * 128 + 16 * m;
#pragma unroll
        for (int q = 0; q < 4; ++q) {
            f32x4 o = *(const f32x4*)(orow + q * 4);
            o[0] += y[q * 4]; o[1] += y[q * 4 + 1]; o[2] += y[q * 4 + 2]; o[3] += y[q * 4 + 3];
            *(f32x4*)(orow + q * 4) = o;
        }
    }
}

#define XB_TMO      128
#define XB_XCNT(j)  (256  + 64 * (j))
#define XB_XSUB(j)  (1280 + 64 * (j))
#define XB_XGEN(j)  (2304 + 64 * (j))
#define XB_TOP      3328
#define XB_TOPGEN   3392
#define XCD_BAR_WORDS 3456
#define XB_SPIN_CAP (1u << 22)
#define LAS __attribute__((address_space(3)))
__device__ __forceinline__ unsigned xb_ld(unsigned* p)              { return __hip_atomic_load(p, __ATOMIC_RELAXED, __HIP_MEMORY_SCOPE_AGENT); }
__device__ __forceinline__ unsigned xb_add(unsigned* p, unsigned v) { return __hip_atomic_fetch_add(p, v, __ATOMIC_RELAXED, __HIP_MEMORY_SCOPE_AGENT); }
__device__ __forceinline__ unsigned xb_xcc_id() { return (unsigned)__builtin_amdgcn_s_getreg((3 << 11) | 20) & 0xFu; }
#define XB_SPIN(cond, bar) do { unsigned _sp = 0; while (cond) { __builtin_amdgcn_s_sleep(1); \
    if ((++_sp & 255u) == 0u) { if (xb_ld(&(bar)[XB_TMO])) break; if (_sp > XB_SPIN_CAP) { atomicAdd(&(bar)[XB_TMO], 1u); break; } } } } while (0)
struct XcdBarrier { unsigned* bar; unsigned x; volatile LAS unsigned* st; };
__device__ __forceinline__ XcdBarrier xcd_barrier_post(unsigned* bar, volatile LAS unsigned* st) {
    XcdBarrier b; b.bar = bar; b.x = xb_xcc_id(); b.st = st;
    if (threadIdx.x == 0) (void)xb_add(&bar[XB_XCNT(b.x)], 1u);
    return b;
}
__device__ __forceinline__ void xcd_barrier_complete(unsigned* bar, unsigned x, unsigned& nloc, unsigned& nx) {
    const unsigned G = gridDim.x * gridDim.y * gridDim.z;
    unsigned sum, cnt, mine, sp = 0u;
    for (;;) {
        sum = 0u; cnt = 0u; mine = 0u;
#pragma unroll
        for (unsigned j = 0; j < 16; ++j) { const unsigned c = xb_ld(&bar[XB_XCNT(j)]); sum += c; cnt += (c > 0u) ? 1u : 0u; mine = (j == x) ? c : mine; }
        if (sum == G) break;
        __builtin_amdgcn_s_sleep(1);
        if ((++sp & 255u) == 0u) { if (xb_ld(&bar[XB_TMO])) break; if (sp > XB_SPIN_CAP) { atomicAdd(&bar[XB_TMO], 1u); break; } }
    }
    nloc = mine > 0u ? mine : 1u; nx = cnt > 0u ? cnt : 1u;
}
__device__ __forceinline__ void xcd_barrier(const XcdBarrier& b) {
    asm volatile("s_waitcnt vmcnt(0)" ::: "memory");
    __syncthreads();
    if (threadIdx.x == 0) {
        unsigned* bar = b.bar;
        __builtin_amdgcn_s_waitcnt(0);
        unsigned nloc = b.st[0], nx = b.st[1];
        if (nloc == 0u) { xcd_barrier_complete(bar, b.x, nloc, nx); b.st[0] = nloc; b.st[1] = nx; }
        const unsigned old = xb_add(&bar[XB_XSUB(b.x)], 1u);
        const unsigned gen = old / nloc;
        if (old + 1u == (gen + 1u) * nloc) {
            __builtin_amdgcn_fence(__ATOMIC_RELEASE, "agent");
            asm volatile("s_waitcnt vmcnt(0)" ::: "memory");
            const unsigned og = xb_add(&bar[XB_TOP], 1u);
            const unsigned tg = og / nx;
            if (og + 1u == (tg + 1u) * nx) xb_add(&bar[XB_TOPGEN], 1u);
            else XB_SPIN(xb_ld(&bar[XB_TOPGEN]) == tg, bar);
            __builtin_amdgcn_fence(__ATOMIC_ACQUIRE, "agent");
            xb_add(&bar[XB_XGEN(b.x)], 1u);
            asm volatile("s_waitcnt vmcnt(0)" ::: "memory");
        } else {
            XB_SPIN(xb_ld(&bar[XB_XGEN(b.x)]) == gen, bar);
            __builtin_amdgcn_fence(__ATOMIC_ACQUIRE, "agent");
            asm volatile("s_waitcnt vmcnt(0)" ::: "memory");
        }
    }
    __syncthreads();
}

constexpr int LDS_MAIN = HG_LDS;
static_assert(LDS_MAIN >= 512 * PU_ROW && LDS_MAIN >= 2 * AT_BUF && LDS_MAIN >= 131072, "LDS_MAIN");
constexpr int LDS_BYTES = LDS_MAIN + 16;
constexpr int N_PHASES = 14;

__global__ void __launch_bounds__(NT, 2) fwd_kernel(Args a) {
    extern __shared__ __attribute__((aligned(16))) unsigned char lds[];
#if N_LAUNCH_MODE == 1
#ifdef USE_CG_SYNC
    cg::grid_group grid = cg::this_grid();
#endif
    volatile LAS unsigned* xst = (volatile LAS unsigned*)(lds + LDS_MAIN);
    if (threadIdx.x < 4) xst[threadIdx.x] = 0u;
    __syncthreads();
    XcdBarrier xbar = xcd_barrier_post((unsigned*)(a.ws + WS_CTL), xst);
#ifdef USE_CG_SYNC
#define SEAM(k) do { if (a.ph_lo <= (k) && (k) + 1 < a.ph_hi) { if ((k) == 0) grid.sync(); else xcd_barrier(xbar); } } while (0)
#else
#define SEAM(k) do { if (a.ph_lo <= (k) && (k) + 1 < a.ph_hi) { xcd_barrier(xbar); } } while (0)
#endif
#else
#define SEAM(k) do { } while (0)
#endif
#define IN(k) (a.ph_lo <= (k) && (k) < a.ph_hi)
#define REPS(k) for (int rep_ = 0; rep_ < ((k) == REPEAT_PHASE ? 2 : 1); ++rep_)
    if (IN(0)) REPS(0) { phase0(a, lds); } SEAM(0);
    if (IN(1)) REPS(1) { phase1(a, lds); } SEAM(1);
    if (IN(2)) REPS(2) { phase2(a); } SEAM(2);
    if (IN(3)) REPS(3) { phase3(a, lds); } SEAM(3);
    if (IN(4)) REPS(4) {
        const int nhalf = gridDim.x >> 1;
        if ((int)blockIdx.x < nhalf) { for (int it = blockIdx.x; it < 256; it += nhalf) attn_item(a, it, lds); }
        else { for (int it = blockIdx.x - nhalf; it < 128; it += gridDim.x - nhalf) hgrn_item(a, it, lds); }
    } SEAM(5);
    if (IN(6)) REPS(6) { phase6(a); } SEAM(6);
    if (IN(7)) REPS(7) { phase7(a, lds); } SEAM(7);
    if (IN(8)) REPS(8) { rmsnorm_rows(a.out, a.ffn_norm, (bf16_t*)(a.ws + WS_B), blockIdx.x * 8 + (threadIdx.x >> 6), gridDim.x * 8); } SEAM(8);
    if (IN(9)) REPS(9) { phase9_fused(a, lds); } SEAM(10);
    if (gridDim.x == 256) { if (IN(11)) REPS(11) { peer_u_fused_phase(a); } SEAM(12); }
    else {
    if (IN(11)) { peer_u_gather_phase(a); } SEAM(11);
    if (IN(12)) { peer_act_tm_phase(a); } SEAM(12); }
    if (IN(13)) { peer_v_phase(a); }
}

extern "C" void kernel_launch(void* const* d_in, const int* in_sizes, int n_in, void* d_out, int out_size, void* d_ws, size_t ws_size, hipStream_t stream) {
    static int grid = 0;
    if (grid == 0) {
        if (n_in != 19 || out_size != T * DM || ws_size < WS_END) { fprintf(stderr, "kernel_launch: unexpected shapes (n_in %d out %d ws %zu)\n", n_in, out_size, ws_size); grid = -1; return; }
        int dev = 0, cus = 0, per_cu = 0;
        (void)hipGetDevice(&dev); (void)hipDeviceGetAttribute(&cus, hipDeviceAttributeMultiprocessorCount, dev);
        (void)hipFuncSetAttribute((const void*)fwd_kernel, hipFuncAttributeMaxDynamicSharedMemorySize, LDS_BYTES);
        (void)hipOccupancyMaxActiveBlocksPerMultiprocessor(&per_cu, (const void*)fwd_kernel, NT, LDS_BYTES);
        if (per_cu < 1) { fprintf(stderr, "kernel_launch: occupancy query says %d blocks/CU\n", per_cu); per_cu = 1; }
        grid = cus;
        (void)hipGetLastError();
    }
    if (grid < 0) return;
    Args a{};
    a.x = (const float*)d_in[0]; a.pos = (const int*)d_in[1]; a.attn_norm = (const float*)d_in[2]; a.w_in = (const float*)d_in[3];
    a.lb_logits = (const float*)d_in[4]; a.hg_o_norm = (const float*)d_in[5]; a.q_a_norm = (const float*)d_in[6]; a.w_q_up = (const float*)d_in[7];
    a.kv_a_norm = (const float*)d_in[8]; a.w_kv_up = (const float*)d_in[9]; a.q_norm = (const float*)d_in[10]; a.k_norm = (const float*)d_in[11];
    a.mla_o_norm = (const float*)d_in[12]; a.w_out = (const float*)d_in[13]; a.ffn_norm = (const float*)d_in[14]; a.peer_wq = (const float*)d_in[15];
    a.subk = (const float*)d_in[16]; a.peer_u = (const float*)d_in[17]; a.peer_v = (const float*)d_in[18];
    a.out = (float*)d_out; a.ws = (unsigned char*)d_ws;
    const int last = (STOP_AFTER < N_PHASES - 1) ? STOP_AFTER : N_PHASES - 1;
#if N_LAUNCH_MODE == 1
    (void)hipMemsetAsync((unsigned char*)d_ws + WS_CTL, 0, 16384, stream);
    a.ph_lo = 0; a.ph_hi = last + 1;
#ifdef USE_CG_SYNC
    void* args[] = {&a};
    hipError_t e = hipLaunchCooperativeKernel((const void*)fwd_kernel, dim3(grid), dim3(NT), args, LDS_BYTES, stream);
    if (e != hipSuccess) fprintf(stderr, "cooperative launch failed: %s (grid %d)\n", hipGetErrorString(e), grid);
#else
    hipLaunchKernelGGL(fwd_kernel, dim3(grid), dim3(NT), LDS_BYTES, stream, a);
#endif
#else
    for (int ph = 0; ph <= last; ++ph) {
        a.ph_lo = ph; a.ph_hi = ph + 1;
        hipLaunchKernelGGL(fwd_kernel, dim3(grid), dim3(NT), LDS_BYTES, stream, a);
    }
#endif
}
```

```cpp
#include <hip/hip_runtime.h>
#include <hip/hip_cooperative_groups.h>
#include <cstdio>
#include <cstdint>
namespace cg = cooperative_groups;

#ifndef N_LAUNCH_MODE
#define N_LAUNCH_MODE 1
#endif
#ifndef REPEAT_PHASE
#define REPEAT_PHASE -1
#endif
#ifndef STOP_AFTER
#define STOP_AFTER 99
#endif

typedef unsigned short bf16_t;
typedef short bf16x8 __attribute__((ext_vector_type(8)));
typedef float f32x4 __attribute__((ext_vector_type(4)));

constexpr int NT = 512;
constexpr int T = 16384, SEQ = 2048, NB = 8, DM = 1024, INW = 3264;
constexpr int OFF_Q = 0, OFF_FF = 512, OFF_FB = 1024, OFF_I = 1536, OFF_G = 2048, OFF_CQ = 2560, OFF_CKV = 2944, OFF_KR = 3200;
constexpr float EPS = 1e-6f;

constexpr size_t WS_CTL = 0;
constexpr size_t WS_WIN_T = 65536;
constexpr size_t WS_WQUP_T = WS_WIN_T + (size_t)3264 * 1024 * 2;
constexpr size_t WS_WKVUP_T = WS_WQUP_T + (size_t)768 * 384 * 2;
constexpr size_t WS_WOUT_T = WS_WKVUP_T + (size_t)1024 * 256 * 2;
constexpr size_t WS_WPQ_T = WS_WOUT_T + (size_t)1024 * 1024 * 2;
constexpr size_t WS_SUBK = WS_WPQ_T + (size_t)2048 * 1024 * 2;
constexpr size_t WS_LB = WS_SUBK + (size_t)16 * 128 * 128 * 2;
constexpr size_t WS_B = 15728640;
constexpr size_t WS_CQN = WS_B;
constexpr size_t WS_CKVN = WS_B + (size_t)T * 384 * 2;
constexpr size_t WS_C = WS_B + 33554432;
constexpr size_t WS_U16 = WS_C;
constexpr size_t WS_V16 = WS_C + 33554432;
constexpr size_t WS_V8 = WS_C + 33554432;
constexpr size_t WS_VSCALE = WS_V8 + (size_t)16384 * 1024;
constexpr size_t WS_USCALE = WS_VSCALE + 65536;
constexpr size_t WS_U8 = WS_C;
constexpr size_t WS_D = WS_C + (size_t)T * INW * 2;
constexpr size_t WS_Q = WS_D + 33554432;
constexpr size_t WS_KN = WS_Q + (size_t)T * 768 * 2;
constexpr size_t WS_VT = WS_KN + (size_t)T * 512 * 2;
constexpr size_t WS_KROPE = WS_VT + (size_t)T * 512 * 2;
constexpr size_t WS_ROPECS = WS_KROPE + (size_t)T * 64 * 2;
constexpr size_t WS_END = WS_ROPECS + (size_t)T * 64 * 4;
constexpr size_t WS_W16 = WS_KROPE;
constexpr size_t WS_IDX = WS_VT;
constexpr size_t WS_GATE = WS_VT + (size_t)T * 128 * 4;
constexpr size_t WS_ELIST = WS_D + 67108864;
constexpr size_t WS_COUNTS = WS_CTL + 16384;
constexpr size_t WS_BSTART = WS_CTL + 16384 + 32768;
static_assert(WS_ELIST + (size_t)T * 128 * 4 <= WS_VT, "edge list overflow");
static_assert(WS_LB + 4096 <= WS_B, "weights overflow");
static_assert(WS_D + (size_t)T * 2048 * 2 <= WS_IDX, "PQ overlaps IDX");
static_assert(WS_GATE + (size_t)T * 128 * 4 <= WS_VT + (size_t)T * 512 * 2, "gate overflow");
static_assert(WS_END <= 268435456, "workspace too big");

struct Args {
    const float* x; const int* pos; const float* attn_norm; const float* w_in; const float* lb_logits; const float* hg_o_norm;
    const float* q_a_norm; const float* w_q_up; const float* kv_a_norm; const float* w_kv_up; const float* q_norm; const float* k_norm;
    const float* mla_o_norm; const float* w_out; const float* ffn_norm; const float* peer_wq; const float* subk; const float* peer_u; const float* peer_v;
    float* out; unsigned char* ws; int ph_lo, ph_hi;
};

typedef __bf16 bf16v2 __attribute__((ext_vector_type(2)));
typedef float f32v2 __attribute__((ext_vector_type(2)));
__device__ __forceinline__ unsigned pack2(float lo, float hi) { const f32v2 v = {lo, hi}; return __builtin_bit_cast(unsigned, __builtin_convertvector(v, bf16v2)); }
__device__ __forceinline__ bf16_t f2bf(float f) { return (bf16_t)(pack2(f, 0.f) & 0xffffu); }
typedef _Float16 f16v2 __attribute__((ext_vector_type(2)));
__device__ __forceinline__ unsigned pack2h(float lo, float hi) { const f32v2 v = {lo, hi}; return __builtin_bit_cast(unsigned, __builtin_convertvector(v, f16v2)); }
__device__ __forceinline__ float frcp(float x) { return __builtin_amdgcn_rcpf(x); }
__device__ __forceinline__ float fexp2(float x) { return __builtin_amdgcn_exp2f(x); }
__device__ __forceinline__ float bf2f(bf16_t h) { return __uint_as_float(((unsigned)h) << 16); }
__device__ __forceinline__ float bflo(unsigned w) { return __uint_as_float(w << 16); }
__device__ __forceinline__ float bfhi(unsigned w) { return __uint_as_float(w & 0xffff0000u); }
__device__ __forceinline__ float wave_sum(float v) {
#pragma unroll
    for (int d = 32; d > 0; d >>= 1) v += __shfl_xor(v, d, 64);
    return v;
}
__device__ __forceinline__ f32x4 mfma16(bf16x8 a, bf16x8 b, f32x4 c) { return __builtin_amdgcn_mfma_f32_16x16x32_bf16(a, b, c, 0, 0, 0); }

__device__ const float ROPE_INV_FREQ[32] = {
    1.000000000e+00f, 7.498942018e-01f, 5.623413324e-01f, 4.216965139e-01f, 3.162277639e-01f, 2.371373922e-01f, 1.778279394e-01f, 1.333521456e-01f,
    1.000000015e-01f, 7.498941571e-02f, 5.623412877e-02f, 4.216964915e-02f, 3.162277862e-02f, 2.371373586e-02f, 1.778279431e-02f, 1.333521493e-02f,
    9.999999776e-03f, 7.498942316e-03f, 5.623413250e-03f, 4.216964822e-03f, 3.162277862e-03f, 2.371373819e-03f, 1.778279431e-03f, 1.333521446e-03f,
    1.000000047e-03f, 7.498941850e-04f, 5.623413017e-04f, 4.216965463e-04f, 3.162277862e-04f, 2.371373848e-04f, 1.778279402e-04f, 1.333521504e-04f};

template <int WAVES_M, int WAVES_N, int WM, int WN, class Epi>
__device__ __forceinline__ void gemm_block(const bf16_t* __restrict__ A, int lda, const bf16_t* __restrict__ Bt, int ldb, int K,
                                           int m0, int n0, int nrows_bt, unsigned char* lds, Epi& epi) {
    constexpr int BM = WAVES_M * WM * 16, BN = WAVES_N * WN * 16;
    constexpr int AI = BM / 64, BI = BN / 64;
    static_assert(WAVES_M * WAVES_N == 8, "8 waves");
    const int tid = threadIdx.x, lane = tid & 63, wave = tid >> 6;
    const int wm = wave / WAVES_N, wn = wave % WAVES_N;
    const int r16 = lane & 15, g = lane >> 4;
    unsigned char* As = lds;
    unsigned char* Bs = lds + BM * 144;
    f32x4 acc[WM][WN];
#pragma unroll
    for (int i = 0; i < WM; ++i)
#pragma unroll
        for (int j = 0; j < WN; ++j) acc[i][j] = (f32x4){0.f, 0.f, 0.f, 0.f};
    uint4 ra0, ra1, ra2, ra3, rb0, rb1, rb2, rb3;
    static_assert(AI <= 4 && BI <= 4, "stage regs");
#define GA_LOAD(i, k0) if constexpr (AI > i) { const int c = tid + i * NT, row = c >> 3, kc = c & 7; ra##i = *(const uint4*)(A + (size_t)(m0 + row) * lda + (k0) + kc * 8); }
#define GB_LOAD(i, k0) if constexpr (BI > i) { const int c = tid + i * NT, row = c >> 3, kc = c & 7; int rg = n0 + row; rg = rg < nrows_bt ? rg : nrows_bt - 1; rb##i = *(const uint4*)(Bt + (size_t)rg * ldb + (k0) + kc * 8); }
#define GA_STORE(i) if constexpr (AI > i) { const int c = tid + i * NT, row = c >> 3, kc = c & 7; *(uint4*)(As + row * 144 + kc * 16) = ra##i; }
#define GB_STORE(i) if constexpr (BI > i) { const int c = tid + i * NT, row = c >> 3, kc = c & 7; *(uint4*)(Bs + row * 144 + kc * 16) = rb##i; }
    GA_LOAD(0, 0) GA_LOAD(1, 0) GA_LOAD(2, 0) GA_LOAD(3, 0) GB_LOAD(0, 0) GB_LOAD(1, 0) GB_LOAD(2, 0) GB_LOAD(3, 0)
    const int nk = K / 64;
    for (int kt = 0; kt < nk; ++kt) {
        __syncthreads();
        GA_STORE(0) GA_STORE(1) GA_STORE(2) GA_STORE(3) GB_STORE(0) GB_STORE(1) GB_STORE(2) GB_STORE(3)
        __syncthreads();
        if (kt + 1 < nk) {
            const int k0 = (kt + 1) * 64;
            GA_LOAD(0, k0) GA_LOAD(1, k0) GA_LOAD(2, k0) GA_LOAD(3, k0) GB_LOAD(0, k0) GB_LOAD(1, k0) GB_LOAD(2, k0) GB_LOAD(3, k0)
        }
#pragma unroll
        for (int kk = 0; kk < 2; ++kk) {
            bf16x8 af[WM];
#pragma unroll
            for (int i = 0; i < WM; ++i) af[i] = *(const bf16x8*)(As + ((wm * WM + i) * 16 + r16) * 144 + kk * 64 + g * 16);
#pragma unroll
            for (int j = 0; j < WN; ++j) {
                const bf16x8 bfr = *(const bf16x8*)(Bs + ((wn * WN + j) * 16 + r16) * 144 + kk * 64 + g * 16);
#pragma unroll
                for (int i = 0; i < WM; ++i) acc[i][j] = mfma16(bfr, af[i], acc[i][j]);
            }
        }
    }
#undef GA_LOAD
#undef GB_LOAD
#undef GA_STORE
#undef GB_STORE
    epi(acc, m0 + wm * WM * 16, n0 + wn * WN * 16, lane);
}

namespace g256 {
constexpr int BM = 256, BK = 64, HALF = 128, HT = HALF * BK;
__device__ __forceinline__ int lds_byte(int r, int c) { const int st = (r >> 4) * 2 + (c >> 5), rr = r & 15, cc = c & 31, ob = rr * 64 + cc * 2; return st * 1024 + (ob ^ (((ob >> 9) & 1) << 5)); }
__device__ __forceinline__ void stage_rc(int b, int& R, int& C) { const int st = b / 1024, sb = b % 1024, swz = sb ^ (((sb >> 9) & 1) << 5); R = (st >> 1) * 16 + swz / 64; C = (st & 1) * 32 + (swz % 64) / 2; }

template <class Epi>
__device__ __forceinline__ void tile(const bf16_t* __restrict__ A, const bf16_t* __restrict__ Bt, int K, int brow, int bcol, unsigned char* lds, Epi& epi) {
    bf16_t* shm = (bf16_t*)lds;
#define G_SA(b, h) (shm + ((b) * 2 + (h)) * HT)
#define G_SB(b, h) (shm + (4 + (b) * 2 + (h)) * HT)
#define G_STAGE(P, BASE, br, kt) do { const long _g = (long)(br) * K + (long)(kt) * BK; \
    _Pragma("unroll") for (int _i = 0; _i < 2; ++_i) { const int _b = tix * 16 + _i * 8192; int _r, _c; stage_rc(_b, _r, _c); \
      __builtin_amdgcn_global_load_lds((const unsigned*)(BASE + _g + (long)_r * K + _c), (unsigned*)((char*)(P) + _b), 16, 0, 0); } } while (0)
#define G_LDA(dst, b, h) _Pragma("unroll") for (int m = 0; m < 4; ++m) _Pragma("unroll") for (int k = 0; k < 2; ++k) \
    dst[m][k] = *reinterpret_cast<const bf16x8*>((char*)G_SA(b, h) + lds_byte(wr * 64 + m * 16 + fr, k * 32 + fq * 8))
#define G_LDB(dst, b, h) _Pragma("unroll") for (int n = 0; n < 2; ++n) _Pragma("unroll") for (int k = 0; k < 2; ++k) \
    dst[n][k] = *reinterpret_cast<const bf16x8*>((char*)G_SB(b, h) + lds_byte(wc * 32 + n * 16 + fr, k * 32 + fq * 8))
#define G_MMA(ai, bj, At, Bt_) do { __builtin_amdgcn_s_setprio(1); \
    _Pragma("unroll") for (int m = 0; m < 4; ++m) _Pragma("unroll") for (int n = 0; n < 2; ++n) _Pragma("unroll") for (int k = 0; k < 2; ++k) \
      acc[ai][bj][m][n] = __builtin_amdgcn_mfma_f32_16x16x32_bf16(Bt_[n][k], At[m][k], acc[ai][bj][m][n], 0, 0, 0); \
    __builtin_amdgcn_s_setprio(0); } while (0)
#define G_WAIT_V(n) asm volatile("s_waitcnt vmcnt(" #n ")" ::: "memory")
#define G_WAIT_L(n) asm volatile("s_waitcnt lgkmcnt(" #n ")" ::: "memory")
#define G_BAR __builtin_amdgcn_s_barrier()
#define G_SCHED __builtin_amdgcn_sched_barrier(0)
    int tix = threadIdx.x; asm volatile("" : "+v"(tix));
    const int wid = tix >> 6, lane = tix & 63, wr = wid >> 2, wc = wid & 3, fr = lane & 15, fq = lane >> 4;
    f32x4 acc[2][2][4][2];
#pragma unroll
    for (int i0 = 0; i0 < 2; ++i0)
#pragma unroll
        for (int i1 = 0; i1 < 2; ++i1)
#pragma unroll
            for (int i2 = 0; i2 < 4; ++i2)
#pragma unroll
                for (int i3 = 0; i3 < 2; ++i3) acc[i0][i1][i2][i3] = (f32x4){0.f, 0.f, 0.f, 0.f};
    bf16x8 At[4][2], B0[2][2], B1[2][2];
    const int nt = K / BK;
    G_STAGE(G_SB(0, 0), Bt, bcol, 0); G_STAGE(G_SA(0, 0), A, brow, 0);
    G_STAGE(G_SB(0, 1), Bt, bcol + HALF, 0); G_STAGE(G_SA(0, 1), A, brow + HALF, 0);
    if (wr == 1) G_BAR;
    G_WAIT_V(4); G_BAR;
    G_STAGE(G_SB(1, 0), Bt, bcol, 1); G_STAGE(G_SA(1, 0), A, brow, 1); G_STAGE(G_SB(1, 1), Bt, bcol + HALF, 1);
    G_WAIT_V(6); G_BAR;
    for (int t = 0; t < nt - 2; t += 2) {
        G_LDB(B0, 0, 0); G_SCHED; G_LDA(At, 0, 0); G_STAGE(G_SA(1, 1), A, brow + HALF, t + 1);
        G_WAIT_L(8); G_BAR; G_WAIT_L(0); G_MMA(0, 0, At, B0); G_BAR; G_SCHED;
        G_LDB(B1, 0, 1); G_STAGE(G_SB(0, 0), Bt, bcol, t + 2);
        G_BAR; G_WAIT_L(0); G_MMA(0, 1, At, B1); G_BAR;
        G_LDA(At, 0, 1); G_STAGE(G_SA(0, 0), A, brow, t + 2);
        G_BAR; G_WAIT_L(0); G_MMA(1, 0, At, B0); G_BAR; G_SCHED;
        G_STAGE(G_SB(0, 1), Bt, bcol + HALF, t + 2);
        G_WAIT_V(6); G_BAR; G_MMA(1, 1, At, B1); G_BAR;
        G_LDB(B0, 1, 0); G_SCHED; G_LDA(At, 1, 0); G_STAGE(G_SA(0, 1), A, brow + HALF, t + 2);
        G_WAIT_L(8); G_BAR; G_WAIT_L(0); G_MMA(0, 0, At, B0); G_BAR; G_SCHED;
        G_LDB(B1, 1, 1); G_STAGE(G_SB(1, 0), Bt, bcol, t + 3);
        G_BAR; G_WAIT_L(0); G_MMA(0, 1, At, B1); G_BAR;
        G_LDA(At, 1, 1); G_STAGE(G_SA(1, 0), A, brow, t + 3);
        G_BAR; G_WAIT_L(0); G_MMA(1, 0, At, B0); G_BAR; G_SCHED;
        G_STAGE(G_SB(1, 1), Bt, bcol + HALF, t + 3);
        G_WAIT_V(6); G_BAR; G_MMA(1, 1, At, B1); G_BAR;
    }
    { G_LDB(B0, 0, 0); G_LDA(At, 0, 0); G_STAGE(G_SA(1, 1), A, brow + HALF, nt - 1);
      G_BAR; G_WAIT_L(0); G_MMA(0, 0, At, B0); G_BAR;
      G_LDB(B1, 0, 1); G_BAR; G_WAIT_L(0); G_MMA(0, 1, At, B1); G_BAR;
      G_LDA(At, 0, 1); G_WAIT_V(4); G_BAR; G_WAIT_L(0); G_MMA(1, 0, At, B0); G_MMA(1, 1, At, B1); G_BAR; }
    { G_LDB(B0, 1, 0); G_LDA(At, 1, 0); G_WAIT_V(2); G_BAR; G_WAIT_L(0); G_MMA(0, 0, At, B0); G_BAR;
      G_LDB(B1, 1, 1); G_WAIT_V(0); G_BAR; G_WAIT_L(0); G_MMA(0, 1, At, B1); G_BAR;
      G_LDA(At, 1, 1); G_BAR; G_WAIT_L(0); G_MMA(1, 0, At, B0); G_MMA(1, 1, At, B1); G_BAR; }
    if (wr == 0) G_BAR;
    epi(acc, brow + wr * 64 + fr, bcol + wc * 32 + 4 * fq);
#undef G_SA
#undef G_SB
#undef G_STAGE
#undef G_LDA
#undef G_LDB
#undef G_MMA
#undef G_WAIT_V
#undef G_WAIT_L
#undef G_BAR
#undef G_SCHED
}
__device__ __forceinline__ bool next_tile(int L, int nM, int nN, int& pm, int& pn) {
    const int nwg = nM * nN; if (L >= nwg) return false;
    int wgid = L; { const int q = nwg / 8, r = nwg % 8, xcd = wgid % 8, off = wgid / 8; wgid = (xcd < r ? xcd * (q + 1) : r * (q + 1) + (xcd - r) * q) + off; }
    const int WGM = 8, nig = WGM * nN, gid = wgid / nig, fm = gid * WGM, gsz = (nM - fm) < WGM ? (nM - fm) : WGM;
    pm = fm + ((wgid % nig) % gsz); pn = (wgid % nig) / gsz; return true;
}
struct EpiBf16 { bf16_t* O; int ldc;
    __device__ __forceinline__ void operator()(const f32x4 (&acc)[2][2][4][2], int row0, int col0) const {
#pragma unroll
        for (int ai = 0; ai < 2; ++ai)
#pragma unroll
            for (int m = 0; m < 4; ++m) { bf16_t* rp = O + (size_t)(row0 + ai * 128 + m * 16) * ldc + col0;
#pragma unroll
                for (int bj = 0; bj < 2; ++bj)
#pragma unroll
                    for (int n = 0; n < 2; ++n) { const f32x4 v = acc[ai][bj][m][n]; uint2 w; w.x = pack2(v[0], v[1]); w.y = pack2(v[2], v[3]); *(uint2*)(rp + bj * 128 + n * 16) = w; } }
    }
};
struct EpiResid { const float* X; float* O;
    __device__ __forceinline__ void operator()(const f32x4 (&acc)[2][2][4][2], int row0, int col0) const {
#pragma unroll
        for (int ai = 0; ai < 2; ++ai)
#pragma unroll
            for (int m = 0; m < 4; ++m) { const size_t ro = (size_t)(row0 + ai * 128 + m * 16) * DM + col0;
#pragma unroll
                for (int bj = 0; bj < 2; ++bj)
#pragma unroll
                    for (int n = 0; n < 2; ++n) { const size_t off = ro + bj * 128 + n * 16; const f32x4 xv = *(const f32x4*)(X + off); *(f32x4*)(O + off) = xv + acc[ai][bj][m][n]; } }
    }
};
struct EpiBf16Silu { bf16_t* O; int ldc; int nsilu;
    __device__ __forceinline__ void operator()(const f32x4 (&acc)[2][2][4][2], int row0, int col0) const {
        const bool sl = col0 < nsilu;
#pragma unroll
        for (int ai = 0; ai < 2; ++ai)
#pragma unroll
            for (int m = 0; m < 4; ++m) { bf16_t* rp = O + (size_t)(row0 + ai * 128 + m * 16) * ldc + col0;
#pragma unroll
                for (int bj = 0; bj < 2; ++bj)
#pragma unroll
                    for (int n = 0; n < 2; ++n) { f32x4 v = acc[ai][bj][m][n];
                        if (sl) {
#pragma unroll
                            for (int r = 0; r < 4; ++r) v[r] = v[r] * frcp(1.f + __expf(-v[r])); }
                        uint2 w; w.x = pack2(v[0], v[1]); w.y = pack2(v[2], v[3]); *(uint2*)(rp + bj * 128 + n * 16) = w; } }
    }
};
}

template <int WM_, int WN_> struct EpiBf16 {
    bf16_t* O; int ldc; int ncols;
    __device__ __forceinline__ void operator()(const f32x4 (&acc)[WM_][WN_], int mb, int nb, int lane) const {
        const int r16 = lane & 15, g = lane >> 4;
#pragma unroll
        for (int i = 0; i < WM_; ++i)
#pragma unroll
            for (int j = 0; j < WN_; ++j) {
                const int row = mb + i * 16 + r16, col = nb + j * 16 + 4 * g;
                if (col < ncols) { uint2 w; w.x = pack2(acc[i][j][0], acc[i][j][1]); w.y = pack2(acc[i][j][2], acc[i][j][3]); *(uint2*)(O + (size_t)row * ldc + col) = w; }
            }
    }
};
struct EpiResid {
    const float* X; float* O;
    __device__ __forceinline__ void operator()(const f32x4 (&acc)[4][2], int mb, int nb, int lane) const {
        const int r16 = lane & 15, g = lane >> 4;
#pragma unroll
        for (int i = 0; i < 4; ++i)
#pragma unroll
            for (int j = 0; j < 2; ++j) {
                const size_t off = (size_t)(mb + i * 16 + r16) * DM + nb + j * 16 + 4 * g;
                const f32x4 xv = *(const f32x4*)(X + off);
                *(f32x4*)(O + off) = xv + acc[i][j];
            }
    }
};
struct EpiQ {
    bf16_t* Q; const float* q_norm; const float* ropecs;
    __device__ __forceinline__ void operator()(const f32x4 (&accs)[2][12], int mb, int nb, int lane) const {
      const int r16 = lane & 15, g = lane >> 4;
#pragma unroll
      for (int mi = 0; mi < 2; ++mi) {
        const f32x4 (&accm)[12] = accs[mi];
        const int row = mb + mi * 16 + r16, h = nb / 192;
        float ssn = 0.f, ssr = 0.f;
#pragma unroll
        for (int j = 0; j < 8; ++j)
#pragma unroll
            for (int r = 0; r < 4; ++r) ssn += accm[j][r] * accm[j][r];
#pragma unroll
        for (int j = 8; j < 12; ++j)
#pragma unroll
            for (int r = 0; r < 4; ++r) ssr += accm[j][r] * accm[j][r];
        ssn += __shfl_xor(ssn, 16, 64); ssn += __shfl_xor(ssn, 32, 64);
        ssr += __shfl_xor(ssr, 16, 64); ssr += __shfl_xor(ssr, 32, 64);
        const float SC = 0.07216878364870322f * 1.4426950408889634f;
        const float rn = rsqrtf(ssn * (1.f / 128.f) + EPS) * SC, rr = rsqrtf(ssr * (1.f / 64.f) + EPS) * SC;
        bf16_t* qrow = Q + ((size_t)row * 4 + h) * 192;
#pragma unroll
        for (int j = 0; j < 8; ++j) {
            const int c = j * 16 + 4 * g;
            const f32x4 gn = *(const f32x4*)(q_norm + c);
            uint2 w; w.x = pack2(accm[j][0] * rn * gn[0], accm[j][1] * rn * gn[1]); w.y = pack2(accm[j][2] * rn * gn[2], accm[j][3] * rn * gn[3]);
            *(uint2*)(qrow + c) = w;
        }
#pragma unroll
        for (int j = 0; j < 2; ++j) {
            const int jj = j * 16 + 4 * g;
            const f32x4 g1 = *(const f32x4*)(q_norm + 128 + jj), g2 = *(const f32x4*)(q_norm + 160 + jj);
            float o1[4], o2[4];
#pragma unroll
            for (int r = 0; r < 4; ++r) {
                const float2 cs = *(const float2*)(ropecs + ((size_t)row * 32 + jj + r) * 2);
                const float a1 = accm[8 + j][r] * rr * g1[r], a2 = accm[10 + j][r] * rr * g2[r];
                o1[r] = a1 * cs.x - a2 * cs.y; o2[r] = a2 * cs.x + a1 * cs.y;
            }
            uint2 w; w.x = pack2(o1[0], o1[1]); w.y = pack2(o1[2], o1[3]); *(uint2*)(qrow + 128 + jj) = w;
            w.x = pack2(o2[0], o2[1]); w.y = pack2(o2[2], o2[3]); *(uint2*)(qrow + 160 + jj) = w;
        }
      }
    }
};
template <int WMK> struct EpiKV {
    bf16_t* KN; bf16_t* VT; const float* k_norm;
    __device__ __forceinline__ void operator()(const f32x4 (&accs)[WMK][16], int mb, int nb, int lane) const {
      const int r16 = lane & 15, g = lane >> 4;
#pragma unroll
      for (int mi = 0; mi < WMK; ++mi) {
        const f32x4 (&accm)[16] = accs[mi];
        const int row = mb + mi * 16 + r16, h = nb / 256;
        float ssn = 0.f;
#pragma unroll
        for (int j = 0; j < 8; ++j)
#pragma unroll
            for (int r = 0; r < 4; ++r) ssn += accm[j][r] * accm[j][r];
        ssn += __shfl_xor(ssn, 16, 64); ssn += __shfl_xor(ssn, 32, 64);
        const float rn = rsqrtf(ssn * (1.f / 128.f) + EPS);
        bf16_t* krow = KN + ((size_t)row * 4 + h) * 128;
#pragma unroll
        for (int j = 0; j < 8; ++j) {
            const int c = j * 16 + 4 * g;
            const f32x4 gn = *(const f32x4*)(k_norm + c);
            uint2 w; w.x = pack2(accm[j][0] * rn * gn[0], accm[j][1] * rn * gn[1]); w.y = pack2(accm[j][2] * rn * gn[2], accm[j][3] * rn * gn[3]);
            *(uint2*)(krow + c) = w;
        }
        const int b = row >> 11, s = row & 2047;
        bf16_t* vp = VT + ((size_t)(b * 4 + h) * 128 + 4 * g) * SEQ + s;
#pragma unroll
        for (int j = 0; j < 8; ++j) {
            asm volatile("" : "+v"(vp));
            vp[0] = f2bf(accm[8 + j][0]); vp[SEQ] = f2bf(accm[8 + j][1]); vp[2 * SEQ] = f2bf(accm[8 + j][2]); vp[3 * SEQ] = f2bf(accm[8 + j][3]);
            vp += 16 * SEQ;
        }
      }
    }
};

__device__ void transpose_convert(const float* __restrict__ W, bf16_t* __restrict__ Wt, int K, int N, unsigned char* lds, int bid, int nblk) {
    bf16_t* tile = (bf16_t*)lds;
    const int tid = threadIdx.x;
    const int tk = K / 64, tn = N / 64;
    for (int t = bid; t < tk * tn; t += nblk) {
        const int k0 = (t / tn) * 64, n0 = (t % tn) * 64;
        __syncthreads();
#pragma unroll
        for (int p = 0; p < 2; ++p) {
            const int kk = (tid >> 4) + p * 32, n4 = (tid & 15) * 4;
            const f32x4 v = *(const f32x4*)(W + (size_t)(k0 + kk) * N + n0 + n4);
#pragma unroll
            for (int r = 0; r < 4; ++r) tile[(n4 + r) * 66 + kk] = f2bf(v[r]);
        }
        __syncthreads();
        {
            const int nn = tid >> 3, k8 = (tid & 7) * 8;
            unsigned w[4];
#pragma unroll
            for (int r = 0; r < 4; ++r) w[r] = (unsigned)tile[nn * 66 + k8 + 2 * r] | ((unsigned)tile[nn * 66 + k8 + 2 * r + 1] << 16);
            *(uint4*)(Wt + (size_t)(n0 + nn) * K + k0 + k8) = make_uint4(w[0], w[1], w[2], w[3]);
        }
    }
    __syncthreads();
}

__device__ void rmsnorm_rows(const float* __restrict__ X, const float* __restrict__ gain, bf16_t* __restrict__ O, int gw, int nw) {
    const int lane = threadIdx.x & 63;
    for (int row = gw; row < T; row += nw) {
        const float* xr = X + (size_t)row * DM;
        f32x4 v[4]; float ss = 0.f;
#pragma unroll
        for (int i = 0; i < 4; ++i) { v[i] = *(const f32x4*)(xr + i * 256 + lane * 4); ss += v[i][0] * v[i][0] + v[i][1] * v[i][1] + v[i][2] * v[i][2] + v[i][3] * v[i][3]; }
        ss = wave_sum(ss);
        const float rs = rsqrtf(ss * (1.f / 1024.f) + EPS);
#pragma unroll
        for (int i = 0; i < 4; ++i) {
            const f32x4 gn = *(const f32x4*)(gain + i * 256 + lane * 4);
            uint2 w; w.x = pack2(v[i][0] * rs * gn[0], v[i][1] * rs * gn[1]); w.y = pack2(v[i][2] * rs * gn[2], v[i][3] * rs * gn[3]);
            *(uint2*)(O + (size_t)row * DM + i * 256 + lane * 4) = w;
        }
    }
}

__device__ void phase0(const Args& a, unsigned char* lds) {
    unsigned char* ws = a.ws;
    const int bid = blockIdx.x, nblk = gridDim.x, tid = threadIdx.x;
    transpose_convert(a.w_in, (bf16_t*)(ws + WS_WIN_T), 1024, 3264, lds, bid, nblk);
    transpose_convert(a.w_q_up, (bf16_t*)(ws + WS_WQUP_T), 384, 768, lds, bid, nblk);
    transpose_convert(a.w_kv_up, (bf16_t*)(ws + WS_WKVUP_T), 256, 1024, lds, bid, nblk);
    transpose_convert(a.w_out, (bf16_t*)(ws + WS_WOUT_T), 1024, 1024, lds, bid, nblk);
    transpose_convert(a.peer_wq, (bf16_t*)(ws + WS_WPQ_T), 1024, 2048, lds, bid, nblk);
    const int gt = bid * NT + tid, ngt = nblk * NT;
    bf16_t* sk = (bf16_t*)(ws + WS_SUBK);
    for (int i = gt; i < 16 * 128 * 128; i += ngt) sk[i] = f2bf(a.subk[i]);
    float* lb = (float*)(ws + WS_LB);
    for (int i = gt; i < 1024; i += ngt) { const float l0 = a.lb_logits[i], l1 = a.lb_logits[1024 + i]; lb[i] = 1.f / (1.f + expf(l1 - l0)); }
    rmsnorm_rows(a.x, a.attn_norm, (bf16_t*)(ws + WS_B), bid * 8 + (tid >> 6), nblk * 8);
}

__device__ void phase1(const Args& a, unsigned char* lds) {
    unsigned char* ws = a.ws;
    const bf16_t* H = (const bf16_t*)(ws + WS_B); const bf16_t* W = (const bf16_t*)(ws + WS_WIN_T);
    g256::EpiBf16Silu e{(bf16_t*)(ws + WS_C), INW, 512};
    for (int i = 0;; ++i) { int pm, pn; if (!g256::next_tile(i * gridDim.x + blockIdx.x, 64, 12, pm, pn)) break;
        __syncthreads();
        g256::tile(H, W, DM, pm * 256, pn * 256, lds, e); }
    __syncthreads();
    EpiBf16<1, 6> e2{(bf16_t*)(ws + WS_C), INW, INW};
    for (int t = blockIdx.x; t < 256; t += gridDim.x)
        gemm_block<4, 2, 1, 6>(H, DM, W, DM, DM, t * 64, 3072, INW, lds, e2);
}

__device__ void phase2(const Args& a) {
    unsigned char* ws = a.ws;
    const bf16_t* PROJ = (const bf16_t*)(ws + WS_C);
    bf16_t* CQN = (bf16_t*)(ws + WS_CQN); bf16_t* CKVN = (bf16_t*)(ws + WS_CKVN); bf16_t* KROPE = (bf16_t*)(ws + WS_KROPE);
    float* ROPECS = (float*)(ws + WS_ROPECS);
    const int lane = threadIdx.x & 63;
    const float2 gq0 = *(const float2*)(a.q_a_norm + lane * 2), gq1 = *(const float2*)(a.q_a_norm + 128 + lane * 2), gq2 = *(const float2*)(a.q_a_norm + 256 + lane * 2);
    const float2 gk0 = *(const float2*)(a.kv_a_norm + lane * 2), gk1 = *(const float2*)(a.kv_a_norm + 128 + lane * 2);
    const float gr = a.k_norm[128 + lane];
    const float invf = ROPE_INV_FREQ[lane & 31];
    const int nw = gridDim.x * 8;
    for (int t0 = blockIdx.x * 8 + (threadIdx.x >> 6); t0 < T; t0 += nw * 4) {
        unsigned wq[4][3], wk[4][2]; float vr[4], ps[4];
#pragma unroll
        for (int u = 0; u < 4; ++u) {
            const int t = min(t0 + u * nw, T - 1);
            const bf16_t* pr = PROJ + (size_t)t * INW;
#pragma unroll
            for (int i = 0; i < 3; ++i) wq[u][i] = *(const unsigned*)(pr + OFF_CQ + i * 128 + lane * 2);
#pragma unroll
            for (int i = 0; i < 2; ++i) wk[u][i] = *(const unsigned*)(pr + OFF_CKV + i * 128 + lane * 2);
            vr[u] = bf2f(pr[OFF_KR + lane]);
            ps[u] = (float)a.pos[t];
        }
        float sq[4], sk[4], sr[4];
#pragma unroll
        for (int u = 0; u < 4; ++u) {
            sq[u] = 0.f; sk[u] = 0.f;
#pragma unroll
            for (int i = 0; i < 3; ++i) { const float x0 = bflo(wq[u][i]), x1 = bfhi(wq[u][i]); sq[u] += x0 * x0 + x1 * x1; }
#pragma unroll
            for (int i = 0; i < 2; ++i) { const float x0 = bflo(wk[u][i]), x1 = bfhi(wk[u][i]); sk[u] += x0 * x0 + x1 * x1; }
            sr[u] = vr[u] * vr[u];
        }
#pragma unroll
        for (int d = 32; d > 0; d >>= 1)
#pragma unroll
            for (int u = 0; u < 4; ++u) { sq[u] += __shfl_xor(sq[u], d, 64); sk[u] += __shfl_xor(sk[u], d, 64); sr[u] += __shfl_xor(sr[u], d, 64); }
#pragma unroll
        for (int u = 0; u < 4; ++u) {
            const int t = t0 + u * nw;
            if (t < T) {
                const float rq = rsqrtf(sq[u] * (1.f / 384.f) + EPS), rk = rsqrtf(sk[u] * (1.f / 256.f) + EPS), rr = rsqrtf(sr[u] * (1.f / 64.f) + EPS);
                bf16_t* cq = CQN + (size_t)t * 384 + lane * 2; bf16_t* ck = CKVN + (size_t)t * 256 + lane * 2;
                *(unsigned*)(cq) = pack2(bflo(wq[u][0]) * rq * gq0.x, bfhi(wq[u][0]) * rq * gq0.y);
                *(unsigned*)(cq + 128) = pack2(bflo(wq[u][1]) * rq * gq1.x, bfhi(wq[u][1]) * rq * gq1.y);
                *(unsigned*)(cq + 256) = pack2(bflo(wq[u][2]) * rq * gq2.x, bfhi(wq[u][2]) * rq * gq2.y);
                *(unsigned*)(ck) = pack2(bflo(wk[u][0]) * rk * gk0.x, bfhi(wk[u][0]) * rk * gk0.y);
                *(unsigned*)(ck + 128) = pack2(bflo(wk[u][1]) * rk * gk1.x, bfhi(wk[u][1]) * rk * gk1.y);
                const float xn = vr[u] * rr * gr;
                const float other = __shfl_xor(xn, 32, 64);
                float sn, cs; sincosf(ps[u] * invf, &sn, &cs);
                const float o = (lane < 32) ? (xn * cs - other * sn) : (xn * cs + other * sn);
                KROPE[(size_t)t * 64 + lane] = f2bf(o);
                if (lane < 32) { *(float2*)(ROPECS + ((size_t)t * 32 + lane) * 2) = make_float2(cs, sn); }
            }
        }
    }
}

__device__ void phase3(const Args& a, unsigned char* lds) {
    unsigned char* ws = a.ws;
    EpiQ eq{(bf16_t*)(ws + WS_Q), a.q_norm, (const float*)(ws + WS_ROPECS)};
    EpiKV<1> ekv{(bf16_t*)(ws + WS_KN), (bf16_t*)(ws + WS_VT), a.k_norm};
    for (int t = blockIdx.x; t < 768; t += gridDim.x) {
        if (t < 256) { const int mt = t >> 2, h = t & 3;
            gemm_block<8, 1, 2, 12>((const bf16_t*)(ws + WS_CQN), 384, (const bf16_t*)(ws + WS_WQUP_T), 384, 384, mt * 256, h * 192, 768, lds, eq);
        } else { const int u = t - 256, mt = u >> 2, h = u & 3;
            gemm_block<8, 1, 1, 16>((const bf16_t*)(ws + WS_CKVN), 256, (const bf16_t*)(ws + WS_WKVUP_T), 256, 256, mt * 128, h * 256, 1024, lds, ekv);
        }
    }
}

constexpr int AT_KROW = 400, AT_VROW = 144, AT_KBYTES = 64 * AT_KROW, AT_VBYTES = 128 * AT_VROW, AT_BUF = AT_KBYTES + AT_VBYTES;
__device__ void attn_item(const Args& a, int item, unsigned char* lds) {
    unsigned char* ws = a.ws;
    const bf16_t* Q = (const bf16_t*)(ws + WS_Q); const bf16_t* KN = (const bf16_t*)(ws + WS_KN);
    const bf16_t* KR = (const bf16_t*)(ws + WS_KROPE); const bf16_t* VT = (const bf16_t*)(ws + WS_VT);
    bf16_t* YCAT = (bf16_t*)(ws + WS_B);
    const int qb = item & 7, h = (item >> 3) & 3, b = item >> 5;
    const int tid = threadIdx.x, lane = tid & 63, wave = tid >> 6, r16 = lane & 15, g = lane >> 4;
    const unsigned kn_off = (unsigned)((((size_t)b * SEQ + (tid >> 4)) * 4 + h) * 128 + (tid & 15) * 8);
    const unsigned kr_off = (unsigned)(((size_t)b * SEQ + (tid >> 3)) * 64 + (tid & 7) * 8);
    const unsigned vt_off = (unsigned)(((size_t)(b * 4 + h) * 128 + (tid >> 3)) * SEQ + (tid & 7) * 8);
    const int kn_dst = (tid >> 4) * AT_KROW + (tid & 15) * 16, kr_dst = (tid >> 3) * AT_KROW + 256 + (tid & 7) * 16;
    const int v_dst = AT_KBYTES + (tid >> 3) * AT_VROW + (tid & 7) * 16;
    bf16x8 qf[2][6];
#pragma unroll
    for (int qs = 0; qs < 2; ++qs) {
        const size_t tq = (size_t)b * SEQ + qb * 256 + wave * 32 + qs * 16 + r16;
#pragma unroll
        for (int kk = 0; kk < 6; ++kk) qf[qs][kk] = *(const bf16x8*)(Q + (tq * 4 + h) * 192 + kk * 32 + 8 * g);
    }
    f32x4 O[2][8];
#pragma unroll
    for (int qs = 0; qs < 2; ++qs)
#pragma unroll
        for (int d = 0; d < 8; ++d) O[qs][d] = (f32x4){0.f, 0.f, 0.f, 0.f};
    float m_run[2] = {0.f, 0.f}, l_part[2] = {0.f, 0.f};
    uint4 sk0, sk1, sk2, sv0, sv1;
#define AT_GLOADK(tile) do { \
        sk0 = *(const uint4*)(KN + kn_off + (size_t)(tile) * (64 * 512)); sk1 = *(const uint4*)(KN + kn_off + 32 * 512 + (size_t)(tile) * (64 * 512)); \
        sk2 = *(const uint4*)(KR + kr_off + (size_t)(tile) * (64 * 64)); } while (0)
#define AT_GLOADV(tile) do { \
        sv0 = *(const uint4*)(VT + vt_off + (size_t)(tile) * 64); sv1 = *(const uint4*)(VT + vt_off + (size_t)64 * SEQ + (size_t)(tile) * 64); } while (0)
#define AT_LSTOREK(buf) do { unsigned char* bb = lds + (buf) * AT_BUF; \
        *(uint4*)(bb + kn_dst) = sk0; *(uint4*)(bb + kn_dst + 32 * AT_KROW) = sk1; *(uint4*)(bb + kr_dst) = sk2; } while (0)
#define AT_LSTOREV(buf) do { unsigned char* bb = lds + (buf) * AT_BUF; \
        *(uint4*)(bb + v_dst) = sv0; *(uint4*)(bb + v_dst + 64 * AT_VROW) = sv1; } while (0)
    __syncthreads();
    AT_GLOADK(0); AT_GLOADV(0);
    AT_LSTOREK(0); AT_LSTOREV(0);
    __syncthreads();
    constexpr int NTILE = SEQ / 64;
    for (int t = 0; t < NTILE; ++t) {
        if (t + 1 < NTILE) AT_GLOADK(t + 1);
        const unsigned char* kb = lds + (t & 1) * AT_BUF;
        const unsigned char* vb = kb + AT_KBYTES;
        f32x4 S[2][4];
#pragma unroll
        for (int qs = 0; qs < 2; ++qs)
#pragma unroll
            for (int j = 0; j < 4; ++j) { const float nm = -m_run[qs]; S[qs][j] = (f32x4){nm, nm, nm, nm}; }
#pragma unroll
        for (int j = 0; j < 4; ++j) {
            const int krow = (j >> 1) * 32 + 8 * (r16 >> 2) + 4 * (j & 1) + (r16 & 3);
#pragma unroll
            for (int kk = 0; kk < 6; ++kk) {
                const bf16x8 kf = *(const bf16x8*)(kb + krow * AT_KROW + kk * 64 + g * 16);
                S[0][j] = mfma16(kf, qf[0][kk], S[0][j]);
                S[1][j] = mfma16(kf, qf[1][kk], S[1][j]);
            }
        }
        if (t + 1 < NTILE) { AT_LSTOREK((t + 1) & 1); AT_GLOADV(t + 1); }
        bf16x8 pf[2][2];
#pragma unroll
        for (int qs = 0; qs < 2; ++qs) {
            float mx = -1e30f;
#pragma unroll
            for (int j = 0; j < 4; ++j) mx = fmaxf(mx, fmaxf(fmaxf(S[qs][j][0], S[qs][j][1]), fmaxf(S[qs][j][2], S[qs][j][3])));
            mx = fmaxf(mx, __shfl_xor(mx, 16, 64)); mx = fmaxf(mx, __shfl_xor(mx, 32, 64));
            if (t == 0 || !__all(mx <= 8.f)) {
                const float delta = (t == 0) ? mx : fmaxf(mx, 0.f);
                m_run[qs] += delta;
#pragma unroll
                for (int j = 0; j < 4; ++j) { S[qs][j][0] -= delta; S[qs][j][1] -= delta; S[qs][j][2] -= delta; S[qs][j][3] -= delta; }
                if (t != 0) {
                    const float alpha = fexp2(-delta);
                    l_part[qs] *= alpha;
#pragma unroll
                    for (int d = 0; d < 8; ++d) O[qs][d] *= alpha;
                }
            }
            float ps = 0.f;
#pragma unroll
            for (int grp = 0; grp < 2; ++grp) {
                float pv[8];
#pragma unroll
                for (int jj = 0; jj < 8; ++jj) { pv[jj] = fexp2(S[qs][grp * 2 + (jj >> 2)][jj & 3]); ps += pv[jj]; }
                union { uint4 u; bf16x8 v; } cv; cv.u = make_uint4(pack2(pv[0], pv[1]), pack2(pv[2], pv[3]), pack2(pv[4], pv[5]), pack2(pv[6], pv[7]));
                pf[qs][grp] = cv.v;
            }
            l_part[qs] += ps;
        }
        __builtin_amdgcn_s_setprio(1);
#pragma unroll
        for (int grp = 0; grp < 2; ++grp)
#pragma unroll
            for (int d = 0; d < 8; ++d) {
                const bf16x8 vf = *(const bf16x8*)(vb + (d * 16 + r16) * AT_VROW + grp * 64 + g * 16);
                O[0][d] = mfma16(vf, pf[0][grp], O[0][d]);
                O[1][d] = mfma16(vf, pf[1][grp], O[1][d]);
            }
        __builtin_amdgcn_s_setprio(0);
        if (t + 1 < NTILE) AT_LSTOREV((t + 1) & 1);
        __syncthreads();
    }
#undef AT_GLOADK
#undef AT_GLOADV
#undef AT_LSTOREK
#undef AT_LSTOREV
#pragma unroll
    for (int qs = 0; qs < 2; ++qs) {
        float l = l_part[qs]; l += __shfl_xor(l, 16, 64); l += __shfl_xor(l, 32, 64);
        const float inv = frcp(l);
        float ss = 0.f;
#pragma unroll
        for (int d = 0; d < 8; ++d) { O[qs][d] *= inv; ss += O[qs][d][0] * O[qs][d][0] + O[qs][d][1] * O[qs][d][1] + O[qs][d][2] * O[qs][d][2] + O[qs][d][3] * O[qs][d][3]; }
        ss += __shfl_xor(ss, 16, 64); ss += __shfl_xor(ss, 32, 64);
        const float rs = rsqrtf(ss * (1.f / 128.f) + EPS);
        const size_t tq = (size_t)b * SEQ + qb * 256 + wave * 32 + qs * 16 + r16;
#pragma unroll
        for (int d = 0; d < 8; ++d) {
            const int dv = d * 16 + 4 * g;
            const f32x4 gn = *(const f32x4*)(a.mla_o_norm + h * 128 + dv);
            uint2 w; w.x = pack2(O[qs][d][0] * rs * gn[0], O[qs][d][1] * rs * gn[1]); w.y = pack2(O[qs][d][2] * rs * gn[2], O[qs][d][3] * rs * gn[3]);
            *(uint2*)(YCAT + tq * DM + 512 + h * 128 + dv) = w;
        }
    }
}

constexpr int HG_E = 0;
constexpr int HG_EL = HG_E + 64 * 132 * 4;
constexpr int HG_QT = HG_EL + 1024;
constexpr int HG_QH = HG_QT + 17408;
constexpr int HG_KD = HG_QH + 17408;
constexpr int HG_K10 = HG_KD + 17408;
constexpr int HG_VT = HG_K10 + 8704;
constexpr int HG_SM = HG_VT + 2 * 9216;
constexpr int HG_STB = HG_SM + 9216;
constexpr int HG_LDS = HG_STB + 2 * 17408;
__device__ void hgrn_item(const Args& a, int item, unsigned char* lds) {
    unsigned char* ws = a.ws;
    const bf16_t* PROJ = (const bf16_t*)(ws + WS_C);
    const float* LB = (const float*)(ws + WS_LB);
    bf16_t* OHG = (bf16_t*)(ws + WS_D);
    const int vs = item & 1, dir = (item >> 1) & 1, h = (item >> 2) & 3, b = item >> 4;
    const int tid = threadIdx.x, lane = tid & 63, wave = tid >> 6, r16 = lane & 15, g = lane >> 4;
    float* E = (float*)(lds + HG_E); float* EL = (float*)(lds + HG_EL);
    bf16_t* Qt = (bf16_t*)(lds + HG_QT); bf16_t* Qh = (bf16_t*)(lds + HG_QH); bf16_t* Kd = (bf16_t*)(lds + HG_KD); bf16_t* K10 = (bf16_t*)(lds + HG_K10);
    bf16_t* vT = (bf16_t*)(lds + HG_VT); bf16_t* Sm = (bf16_t*)(lds + HG_SM); bf16_t* STb = (bf16_t*)(lds + HG_STB);
    const int kB = wave * 16 + r16;
    const float lbk = LB[dir * 512 + h * 128 + kB];
    const int offf = dir ? OFF_FB : OFF_FF;
    const int rowA = tid >> 4, k8A = (tid & 15) * 8;
    const int vrow = tid >> 3, vc8 = (tid & 7) * 8;
    const size_t tokbase = (size_t)b * SEQ;
    __syncthreads();
    for (int i = tid; i < 2 * 64 * 136; i += NT) STb[i] = 0;
    f32x4 accS[4]; accS[0] = (f32x4){0.f, 0.f, 0.f, 0.f}; accS[1] = accS[0]; accS[2] = accS[0]; accS[3] = accS[0];
    unsigned short fB[16]; uint4 qA0, qA1, vA;
#define HG_PREFETCH(n) do { \
        _Pragma("unroll") for (int sc = 0; sc < 2; ++sc) _Pragma("unroll") for (int jj = 0; jj < 8; ++jj) { \
            const int tau = (n) * 64 + sc * 32 + g * 8 + jj, tt = dir ? (SEQ - 1 - tau) : tau; \
            fB[sc * 8 + jj] = PROJ[(tokbase + tt) * INW + offf + h * 128 + kB]; } \
        { const int tau = (n) * 64 + rowA, tt = dir ? (SEQ - 1 - tau) : tau; qA0 = *(const uint4*)(PROJ + (tokbase + tt) * INW + OFF_Q + h * 128 + k8A); } \
        { const int tau = (n) * 64 + rowA + 32, tt = dir ? (SEQ - 1 - tau) : tau; qA1 = *(const uint4*)(PROJ + (tokbase + tt) * INW + OFF_Q + h * 128 + k8A); } \
        { const int tau = (n) * 64 + vrow, tt = dir ? (SEQ - 1 - tau) : tau; vA = *(const uint4*)(PROJ + (tokbase + tt) * INW + OFF_I + h * 128 + vs * 64 + vc8); } \
    } while (0)
    HG_PREFETCH(0);
    for (int n = 0; n < 32; ++n) {
        bf16_t* vTn = vT + (n & 1) * (64 * 72);
        bf16x8 kbf[2];
        {
            float kd[16], ev[16], elast[2];
#pragma unroll
            for (int sc = 0; sc < 2; ++sc) {
                float run = 1.f, runi = 1.f, bb[8], bi[8];
#pragma unroll
                for (int jj = 0; jj < 8; ++jj) {
                    const float u = __expf(-bf2f(fB[sc * 8 + jj]));
                    const float a1 = 1.f + u, a2 = 1.f + lbk * u, r = frcp(a1 * a2);
                    const float f = a2 * a2 * r, fi = a1 * a1 * r;
                    kd[sc * 8 + jj] = 1.f - f;
                    run *= f; bb[jj] = run; runi *= fi; bi[jj] = runi;
                }
                float incl = run, inci = runi;
                { const float t1 = __shfl_up(incl, 16, 64), s1 = __shfl_up(inci, 16, 64); if (g >= 1) { incl *= t1; inci *= s1; } }
                { const float t2 = __shfl_up(incl, 32, 64), s2 = __shfl_up(inci, 32, 64); if (g >= 2) { incl *= t2; inci *= s2; } }
                float excl = __shfl_up(incl, 16, 64), exci = __shfl_up(inci, 16, 64); if (g == 0) { excl = 1.f; exci = 1.f; }
                elast[sc] = __shfl(incl, 48 + r16, 64);
#pragma unroll
                for (int jj = 0; jj < 8; ++jj) {
                    ev[sc * 8 + jj] = bb[jj] * excl;
                    kd[sc * 8 + jj] = kd[sc * 8 + jj] * (bi[jj] * exci);
                }
            }
#pragma unroll
            for (int sc = 0; sc < 2; ++sc)
#pragma unroll
                for (int jj = 0; jj < 8; ++jj) {
                    const int row = sc * 32 + g * 8 + jj;
                    E[row * 132 + kB] = ev[sc * 8 + jj];
                    Kd[row * 136 + kB] = f2bf(kd[sc * 8 + jj]);
                    if (sc == 0) K10[row * 136 + kB] = f2bf(kd[jj] * elast[0]);
                }
            if (g == 3) { EL[kB] = elast[0]; EL[128 + kB] = elast[1]; }
#pragma unroll
            for (int jj = 0; jj < 8; ++jj) { kbf[0][jj] = (short)f2bf(kd[jj] * elast[0] * elast[1]); kbf[1][jj] = (short)f2bf(kd[8 + jj] * elast[1]); }
        }
        {
            const unsigned w4[4] = {vA.x, vA.y, vA.z, vA.w};
#pragma unroll
            for (int q = 0; q < 4; ++q) { vTn[(vc8 + 2 * q) * 72 + vrow] = (bf16_t)(w4[q] & 0xffffu); vTn[(vc8 + 2 * q + 1) * 72 + vrow] = (bf16_t)(w4[q] >> 16); }
        }
        const uint4 qc0 = qA0, qc1 = qA1;
        if (n + 1 < 32) HG_PREFETCH(n + 1);
        __syncthreads();
        {
            const f32x4 d31 = *(const f32x4*)(EL + wave * 16 + 4 * g), d63 = *(const f32x4*)(EL + 128 + wave * 16 + 4 * g);
            const f32x4 dk = d31 * d63;
            bf16_t* stw = STb + (n & 1) * (64 * 136);
#pragma unroll
            for (int vt = 0; vt < 4; ++vt) {
                f32x4 c = accS[vt] * dk;
#pragma unroll
                for (int sc = 0; sc < 2; ++sc) {
                    const bf16x8 vf = *(const bf16x8*)(vTn + (vt * 16 + r16) * 72 + sc * 32 + 8 * g);
                    c = mfma16(kbf[sc], vf, c);
                }
                accS[vt] = c;
                uint2 w; w.x = pack2(c[0], c[1]); w.y = pack2(c[2], c[3]);
                *(uint2*)(stw + (vt * 16 + r16) * 136 + wave * 16 + 4 * g) = w;
            }
        }
        {
            const f32x4 e31a = *(const f32x4*)(EL + k8A), e31b = *(const f32x4*)(EL + k8A + 4);
#pragma unroll
            for (int u = 0; u < 2; ++u) {
                const int row = rowA + u * 32;
                const uint4 qq = u ? qc1 : qc0;
                const f32x4 ea = *(const f32x4*)(E + row * 132 + k8A), eb = *(const f32x4*)(E + row * 132 + k8A + 4);
                const float qr[8] = {bflo(qq.x), bfhi(qq.x), bflo(qq.y), bfhi(qq.y), bflo(qq.z), bfhi(qq.z), bflo(qq.w), bfhi(qq.w)};
                float qt[8], qh[8];
#pragma unroll
                for (int i = 0; i < 8; ++i) {
                    const float qs = qr[i];
                    qt[i] = qs * (i < 4 ? ea[i] : eb[i - 4]);
                    qh[i] = u ? qt[i] * (i < 4 ? e31a[i] : e31b[i - 4]) : qt[i];
                }
                *(uint4*)(Qt + row * 136 + k8A) = make_uint4(pack2(qt[0], qt[1]), pack2(qt[2], qt[3]), pack2(qt[4], qt[5]), pack2(qt[6], qt[7]));
                *(uint4*)(Qh + row * 136 + k8A) = make_uint4(pack2(qh[0], qh[1]), pack2(qh[2], qh[3]), pack2(qh[4], qh[5]), pack2(qh[6], qh[7]));
            }
        }
        __syncthreads();
#pragma unroll
        for (int q2 = 0; q2 < 2; ++q2) {
            const int tix = wave * 2 + q2, ti = tix >> 2, si = tix & 3;
            f32x4 sc = (f32x4){0.f, 0.f, 0.f, 0.f};
            if (si <= ti) {
                const bf16_t* kb = (ti >= 2 && si < 2) ? K10 : Kd;
#pragma unroll
                for (int kk = 0; kk < 4; ++kk) {
                    const bf16x8 af = *(const bf16x8*)(Qt + (ti * 16 + r16) * 136 + kk * 32 + 8 * g);
                    const bf16x8 bfr = *(const bf16x8*)(kb + (si * 16 + r16) * 136 + kk * 32 + 8 * g);
                    sc = mfma16(bfr, af, sc);
                }
                if (si == ti) {
#pragma unroll
                    for (int r = 0; r < 4; ++r) if (4 * g + r > r16) sc[r] = 0.f;
                }
            }
            uint2 w; w.x = pack2(sc[0], sc[1]); w.y = pack2(sc[2], sc[3]);
            *(uint2*)(Sm + (ti * 16 + r16) * 72 + si * 16 + 4 * g) = w;
        }
        __syncthreads();
#pragma unroll
        for (int q2 = 0; q2 < 2; ++q2) {
            const int ti = wave >> 1, vi = (wave & 1) * 2 + q2;
            const bf16_t* stp = STb + ((n + 1) & 1) * (64 * 136);
            f32x4 o = (f32x4){0.f, 0.f, 0.f, 0.f};
#pragma unroll
            for (int kk = 0; kk < 2; ++kk) {
                const bf16x8 af = *(const bf16x8*)(Sm + (ti * 16 + r16) * 72 + kk * 32 + 8 * g);
                const bf16x8 bfr = *(const bf16x8*)(vTn + (vi * 16 + r16) * 72 + kk * 32 + 8 * g);
                o = mfma16(bfr, af, o);
            }
#pragma unroll
            for (int kk = 0; kk < 4; ++kk) {
                const bf16x8 af = *(const bf16x8*)(Qh + (ti * 16 + r16) * 136 + kk * 32 + 8 * g);
                const bf16x8 bfr = *(const bf16x8*)(stp + (vi * 16 + r16) * 136 + kk * 32 + 8 * g);
                o = mfma16(bfr, af, o);
            }
            const int tau = n * 64 + ti * 16 + r16, tt = dir ? (SEQ - 1 - tau) : tau;
            uint2 w; w.x = pack2(o[0], o[1]); w.y = pack2(o[2], o[3]);
            *(uint2*)(OHG + ((size_t)dir * T + tokbase + tt) * 512 + h * 128 + vs * 64 + vi * 16 + 4 * g) = w;
        }
    }
#undef HG_PREFETCH
    __syncthreads();
}

__device__ void phase6(const Args& a) {
    unsigned char* ws = a.ws;
    const bf16_t* OHG = (const bf16_t*)(ws + WS_D); const bf16_t* PROJ = (const bf16_t*)(ws + WS_C);
    bf16_t* YCAT = (bf16_t*)(ws + WS_B);
    const int lane = threadIdx.x & 63;
    for (int t = blockIdx.x * 8 + (threadIdx.x >> 6); t < T; t += gridDim.x * 8) {
        const int c0 = lane * 8;
        const uint4 f = *(const uint4*)(OHG + (size_t)t * 512 + c0), bw = *(const uint4*)(OHG + ((size_t)T + t) * 512 + c0);
        const uint4 gg = *(const uint4*)(PROJ + (size_t)t * INW + OFF_G + c0);
        float o[8];
        o[0] = bflo(f.x) + bflo(bw.x); o[1] = bfhi(f.x) + bfhi(bw.x); o[2] = bflo(f.y) + bflo(bw.y); o[3] = bfhi(f.y) + bfhi(bw.y);
        o[4] = bflo(f.z) + bflo(bw.z); o[5] = bfhi(f.z) + bfhi(bw.z); o[6] = bflo(f.w) + bflo(bw.w); o[7] = bfhi(f.w) + bfhi(bw.w);
        float gr[8] = {bflo(gg.x), bfhi(gg.x), bflo(gg.y), bfhi(gg.y), bflo(gg.z), bfhi(gg.z), bflo(gg.w), bfhi(gg.w)};
        float ss = 0.f;
#pragma unroll
        for (int i = 0; i < 8; ++i) ss += o[i] * o[i];
        ss += __shfl_xor(ss, 1, 64); ss += __shfl_xor(ss, 2, 64); ss += __shfl_xor(ss, 4, 64); ss += __shfl_xor(ss, 8, 64);
        const float rs = rsqrtf(ss * (1.f / 128.f) + EPS);
        float y[8];
#pragma unroll
        for (int i = 0; i < 8; ++i) { const float gt = gr[i] * frcp(1.f + __expf(-gr[i])); y[i] = o[i] * rs * a.hg_o_norm[c0 + i] * gt; }
        *(uint4*)(YCAT + (size_t)t * DM + c0) = make_uint4(pack2(y[0], y[1]), pack2(y[2], y[3]), pack2(y[4], y[5]), pack2(y[6], y[7]));
    }
}

__device__ void phase7(const Args& a, unsigned char* lds) {
    unsigned char* ws = a.ws;
    g256::EpiResid e{a.x, a.out};
    for (int i = 0;; ++i) { int pm, pn; if (!g256::next_tile(i * gridDim.x + blockIdx.x, 64, 4, pm, pn)) break;
        __syncthreads();
        g256::tile((const bf16_t*)(ws + WS_B), (const bf16_t*)(ws + WS_WOUT_T), DM, pm * 256, pn * 256, lds, e); }
    __syncthreads();
    {
        const int lane = threadIdx.x & 63;
        for (int rr = blockIdx.x * 8 + (threadIdx.x >> 6); rr < 32768; rr += gridDim.x * 8) {
            const bool isv = rr >= 16384; const int row = rr & 16383;
            const float* src = (isv ? a.peer_v : a.peer_u) + (size_t)row * DM + lane * 4;
            unsigned char* dst = ws + (isv ? WS_V8 : WS_U8); float* SC = (float*)(ws + (isv ? WS_VSCALE : WS_USCALE));
            f32x4 x[4]; float amax = 0.f;
#pragma unroll
            for (int q = 0; q < 4; ++q) { x[q] = *(const f32x4*)(src + q * 256); amax = fmaxf(amax, fmaxf(fmaxf(fabsf(x[q][0]), fabsf(x[q][1])), fmaxf(fabsf(x[q][2]), fabsf(x[q][3])))); }
#pragma unroll
            for (int d = 32; d > 0; d >>= 1) amax = fmaxf(amax, __shfl_xor(amax, d, 64));
            const float sc = amax > 0.f ? 240.f / amax : 0.f;
            unsigned w[4];
#pragma unroll
            for (int q = 0; q < 4; ++q) { int pk = 0; pk = __builtin_amdgcn_cvt_pk_fp8_f32(x[q][0] * sc, x[q][1] * sc, pk, false); pk = __builtin_amdgcn_cvt_pk_fp8_f32(x[q][2] * sc, x[q][3] * sc, pk, true); w[q] = (unsigned)pk; }
#pragma unroll
            for (int q = 0; q < 4; ++q) *(unsigned*)(dst + (size_t)row * DM + q * 256 + lane * 4) = w[q];
            if (lane == 0) SC[row] = amax * (1.f / 240.f);
        }
    }
}

__device__ void phase9(const Args& a, unsigned char* lds) {
    unsigned char* ws = a.ws;
    g256::EpiBf16 e{(bf16_t*)(ws + WS_D), 2048};
    for (int i = 0;; ++i) { int pm, pn; if (!g256::next_tile(i * gridDim.x + blockIdx.x, 64, 8, pm, pn)) break;
        __syncthreads();
        g256::tile((const bf16_t*)(ws + WS_B), (const bf16_t*)(ws + WS_WPQ_T), DM, pm * 256, pn * 256, lds, e); }
    __syncthreads();
}

__device__ __forceinline__ void ce_desc(float& x, float& y) { const float hi = fmaxf(x, y), lo = fminf(x, y); x = hi; y = lo; }
template <int N> __device__ __forceinline__ void bitonic_sort_desc(float (&v)[N]) {
#pragma unroll
    for (int k = 2; k <= N; k <<= 1)
#pragma unroll
        for (int j = k >> 1; j > 0; j >>= 1)
#pragma unroll
            for (int i = 0; i < N; ++i) { const int l = i ^ j; if (l > i) { if ((i & k) == 0) ce_desc(v[i], v[l]); else ce_desc(v[l], v[i]); } }
}
template <int N> __device__ __forceinline__ void bitonic_merge_desc(float (&v)[N]) {
#pragma unroll
    for (int j = N >> 1; j > 0; j >>= 1)
#pragma unroll
        for (int i = 0; i < N; ++i) { const int l = i ^ j; if (l > i) ce_desc(v[i], v[l]); }
}
__device__ __forceinline__ void xlane_merge16(float (&v)[16], int mask) {
    float o[16];
#pragma unroll
    for (int i = 0; i < 16; ++i) o[i] = __shfl_xor(v[15 - i], mask, 64);
#pragma unroll
    for (int i = 0; i < 16; ++i) v[i] = fmaxf(v[i], o[i]);
    bitonic_merge_desc<16>(v);
}
__device__ __forceinline__ unsigned bsel(unsigned m, unsigned x1, unsigned x0) { return x0 ^ ((x1 ^ x0) & m); }
__device__ __forceinline__ float sel16(const float (&v)[16], unsigned i) {
    const unsigned m0 = 0u - (i & 1u), m1 = 0u - ((i >> 1) & 1u), m2 = 0u - ((i >> 2) & 1u), m3 = 0u - ((i >> 3) & 1u);
    unsigned t8[8], t4[4], t2[2];
#pragma unroll
    for (int q = 0; q < 8; ++q) t8[q] = bsel(m0, __float_as_uint(v[2 * q + 1]), __float_as_uint(v[2 * q]));
#pragma unroll
    for (int q = 0; q < 4; ++q) t4[q] = bsel(m1, t8[2 * q + 1], t8[2 * q]);
#pragma unroll
    for (int q = 0; q < 2; ++q) t2[q] = bsel(m2, t4[2 * q + 1], t4[2 * q]);
    return __uint_as_float(bsel(m3, t2[1], t2[0]));
}
__device__ __forceinline__ float sel4(int g, float x0, float x1, float x2, float x3) {
    const unsigned m0 = 0u - ((unsigned)g & 1u), m1 = 0u - (((unsigned)g >> 1) & 1u);
    const unsigned lo = bsel(m0, __float_as_uint(x1), __float_as_uint(x0)), hi = bsel(m0, __float_as_uint(x3), __float_as_uint(x2));
    return __uint_as_float(bsel(m1, hi, lo));
}

static constexpr int PI[52] = {0,0,0,0,0,0,0,0,0,0,0,0,0,0,0,0,1,1,1,1,1,1,1,1,2,2,2,2,2,3,3,3,3,4,4,4,5,5,6,6,7,7,8,9,10,11,12,13,14,15,0,0};
static constexpr int PJ[52] = {0,1,2,3,4,5,6,7,8,9,10,11,12,13,14,15,0,1,2,3,4,5,6,7,0,1,2,3,4,0,1,2,3,0,1,2,0,1,0,1,0,1,0,0,0,0,0,0,0,0,0,0};
constexpr int RT_ROW = 272;
__device__ __forceinline__ void peer_half_top16(const bf16_t* __restrict__ PQ, const unsigned char* __restrict__ skl, int t0, int p, int c, int r16, int g, float (&out)[16]) {
    f32x4 sc[8];
#pragma unroll
    for (int ni = 0; ni < 8; ++ni) sc[ni] = (f32x4){0.f, 0.f, 0.f, 0.f};
    bf16x8 af[4];
#pragma unroll
    for (int kk = 0; kk < 4; ++kk) af[kk] = *(const bf16x8*)(PQ + (size_t)(t0 + r16) * 2048 + p * 256 + c * 128 + kk * 32 + 8 * g);
#pragma unroll
    for (int kk = 0; kk < 4; ++kk) {
        asm volatile("" ::: "memory");
#pragma unroll
        for (int ni = 0; ni < 8; ++ni) {
            const bf16x8 bfr = *(const bf16x8*)(skl + (c * 128 + ni * 16 + r16) * RT_ROW + kk * 64 + 16 * g);
            sc[ni] = mfma16(bfr, af[kk], sc[ni]);
        }
    }
    float hi[16];
#pragma unroll
    for (int ni = 0; ni < 4; ++ni)
#pragma unroll
        for (int r = 0; r < 4; ++r) {
            out[ni * 4 + r] = __uint_as_float((__float_as_uint(sc[ni][r]) & 0xffffff80u) | (unsigned)(ni * 16 + 4 * g + r));
            hi[ni * 4 + r] = __uint_as_float((__float_as_uint(sc[ni + 4][r]) & 0xffffff80u) | (unsigned)((ni + 4) * 16 + 4 * g + r));
        }
    bitonic_sort_desc<16>(out);
    bitonic_sort_desc<16>(hi);
#pragma unroll
    for (int i = 0; i < 16; ++i) out[i] = fmaxf(out[i], hi[15 - i]);
    bitonic_merge_desc<16>(out);
    xlane_merge16(out, 16);
    xlane_merge16(out, 32);
}
__device__ __forceinline__ void peer_route_finish(const Args& a, int p, int t0, const float (&ab0)[16], const float (&ab1)[16]) {
    unsigned char* ws = a.ws;
    int* IDX = (int*)(ws + WS_IDX); float* GATE = (float*)(ws + WS_GATE);
    int tix_ = threadIdx.x; asm volatile("" : "+v"(tix_));
    const int lane = tix_ & 63, r16 = lane & 15, g = lane >> 4;
    float va[16], vb[16];
#pragma unroll
    for (int i = 0; i < 16; ++i) { va[i] = __uint_as_float(__float_as_uint(ab0[i]) & 0xffffff80u); vb[i] = __uint_as_float(__float_as_uint(ab1[i]) & 0xffffff80u); }
    float v[16];
#pragma unroll
    for (int s = 0; s < 13; ++s) {
        const float x0 = __uint_as_float((__float_as_uint(va[PI[4 * s]] + vb[PJ[4 * s]]) & 0xffffff00u) | (unsigned)(PI[4 * s] * 16 + PJ[4 * s]));
        const float x1 = __uint_as_float((__float_as_uint(va[PI[4 * s + 1]] + vb[PJ[4 * s + 1]]) & 0xffffff00u) | (unsigned)(PI[4 * s + 1] * 16 + PJ[4 * s + 1]));
        const float x2 = (4 * s + 2 < 50) ? __uint_as_float((__float_as_uint(va[PI[4 * s + 2]] + vb[PJ[4 * s + 2]]) & 0xffffff00u) | (unsigned)(PI[4 * s + 2] * 16 + PJ[4 * s + 2])) : -3.0e38f;
        const float x3 = (4 * s + 3 < 50) ? __uint_as_float((__float_as_uint(va[PI[4 * s + 3]] + vb[PJ[4 * s + 3]]) & 0xffffff00u) | (unsigned)(PI[4 * s + 3] * 16 + PJ[4 * s + 3])) : -3.0e38f;
        v[s] = sel4(g, x0, x1, x2, x3);
    }
    v[13] = -3.0e38f; v[14] = -3.0e38f; v[15] = -3.0e38f;
    bitonic_sort_desc<16>(v);
    xlane_merge16(v, 16);
    xlane_merge16(v, 32);
    float e[16], sum = 0.f;
    const float mtop = __uint_as_float(__float_as_uint(v[0]) & 0xffffff00u);
#pragma unroll
    for (int q = 0; q < 16; ++q) { e[q] = __expf(__uint_as_float(__float_as_uint(v[q]) & 0xffffff00u) - mtop); sum += e[q]; }
    const float inv = 1.f / sum;
    int oi[4]; float og[4];
#pragma unroll
    for (int r = 0; r < 4; ++r) {
        const unsigned key = __float_as_uint(sel4(g, v[r], v[4 + r], v[8 + r], v[12 + r]));
        const unsigned pos = key & 255u;
        const unsigned ia = __float_as_uint(sel16(ab0, pos >> 4)) & 127u, ib = __float_as_uint(sel16(ab1, pos & 15u)) & 127u;
        oi[r] = (int)(ia * 128u + ib);
        og[r] = sel4(g, e[r], e[4 + r], e[8 + r], e[12 + r]) * inv;
    }
    const size_t o = (size_t)(t0 + r16) * 128 + p * 16 + 4 * g;
    *(int4*)(IDX + o) = make_int4(oi[0], oi[1], oi[2], oi[3]);
    *(f32x4*)(GATE + o) = (f32x4){og[0], og[1], og[2], og[3]};
}

__device__ __forceinline__ float dpp_xor1(float v) { return __builtin_bit_cast(float, __builtin_amdgcn_mov_dpp(__builtin_bit_cast(int, v), 0xB1, 0xF, 0xF, true)); }
__device__ __forceinline__ float dpp_xor2(float v) { return __builtin_bit_cast(float, __builtin_amdgcn_mov_dpp(__builtin_bit_cast(int, v), 0x4E, 0xF, 0xF, true)); }
__device__ __forceinline__ float dpp_hmirror(float v) { return __builtin_bit_cast(float, __builtin_amdgcn_mov_dpp(__builtin_bit_cast(int, v), 0x141, 0xF, 0xF, true)); }

__device__ void peer_u_phase(const Args& a) {
    unsigned char* ws = a.ws;
    const bf16_t* H2 = (const bf16_t*)(ws + WS_B); const bf16_t* U16 = (const bf16_t*)(ws + WS_U16);
    const int* IDX = (const int*)(ws + WS_IDX); float* P = (float*)(ws + WS_D);
    const int lane = threadIdx.x & 63, m = lane & 7, j = lane >> 3;
    const int v = blockIdx.x & 7, rank = blockIdx.x >> 3, nrank = (gridDim.x - v + 7) >> 3;
    const int wg = rank * 8 + (threadIdx.x >> 6), nwg = nrank * 8;
    for (int pass = 0; pass < 2; ++pass) {
        const int slice = v + 8 * pass;
        for (int t = wg; t < T; t += nwg) {
            const uint4 hq = *(const uint4*)(H2 + (size_t)t * DM + slice * 64 + 8 * m);
            const float h0 = bflo(hq.x), h1 = bfhi(hq.x), h2 = bflo(hq.y), h3 = bfhi(hq.y), h4 = bflo(hq.z), h5 = bfhi(hq.z), h6 = bflo(hq.w), h7 = bfhi(hq.w);
            int id[16];
#pragma unroll
            for (int q = 0; q < 4; ++q) { const uint4 iv = *(const uint4*)(IDX + (size_t)t * 128 + j * 16 + q * 4); id[q * 4] = iv.x; id[q * 4 + 1] = iv.y; id[q * 4 + 2] = iv.z; id[q * 4 + 3] = iv.w; }
            uint4 uq[16];
#pragma unroll
            for (int it = 0; it < 16; ++it) uq[it] = *(const uint4*)(U16 + (size_t)id[it] * DM + slice * 64 + 8 * m);
            float val0 = 0.f, val1 = 0.f;
#pragma unroll
            for (int it = 0; it < 16; ++it) {
                float d = h0 * bflo(uq[it].x) + h1 * bfhi(uq[it].x) + h2 * bflo(uq[it].y) + h3 * bfhi(uq[it].y) + h4 * bflo(uq[it].z) + h5 * bfhi(uq[it].z) + h6 * bflo(uq[it].w) + h7 * bfhi(uq[it].w);
                d += dpp_xor1(d); d += dpp_xor2(d); d += dpp_hmirror(d);
                if ((it >> 1) == m) { if (it & 1) val1 = d; else val0 = d; }
            }
            float2* dst = (float2*)(P + ((size_t)v * T + t) * 128 + j * 16 + 2 * m);
            if (pass == 1) { const float2 prev = *dst; val0 += prev.x; val1 += prev.y; }
            *dst = make_float2(val0, val1);
        }
    }
}

__device__ __forceinline__ void peer_rowcount(const int* __restrict__ IDX, int chunk, unsigned char* lds, int (&e)[16]) {
    const int r = threadIdx.x, t = chunk * 64 + (r >> 3), p = r & 7;
    unsigned char* rowcnt = lds + r * 32;
    *(uint4*)rowcnt = make_uint4(0u, 0u, 0u, 0u); *(uint4*)(rowcnt + 16) = make_uint4(0u, 0u, 0u, 0u);
#pragma unroll
    for (int q = 0; q < 4; ++q) { const int4 iv = *(const int4*)(IDX + (size_t)t * 128 + p * 16 + q * 4); e[q * 4] = iv.x; e[q * 4 + 1] = iv.y; e[q * 4 + 2] = iv.z; e[q * 4 + 3] = iv.w; }
#pragma unroll
    for (int k = 0; k < 16; ++k) rowcnt[e[k] >> 9] += 1;
}
__device__ void peer_count_phase(const Args& a, unsigned char* lds) {
    unsigned char* ws = a.ws;
    const int* IDX = (const int*)(ws + WS_IDX); int* COUNTS = (int*)(ws + WS_COUNTS);
    int* segsum = (int*)(lds + 16384);
    const int tid = threadIdx.x;
    for (int chunk = blockIdx.x; chunk < 256; chunk += gridDim.x) {
        __syncthreads();
        int e[16];
        peer_rowcount(IDX, chunk, lds, e);
        __syncthreads();
        { const int B = tid & 31, seg = tid >> 5; int sacc = 0;
#pragma unroll 8
          for (int i = 0; i < 32; ++i) sacc += lds[(seg * 32 + i) * 32 + B];
          segsum[seg * 32 + B] = sacc; }
        __syncthreads();
        if (tid < 32) { int tot = 0;
#pragma unroll
            for (int sg = 0; sg < 16; ++sg) tot += segsum[sg * 32 + tid];
            COUNTS[chunk * 32 + tid] = tot; }
    }
}
__device__ void peer_scatter_phase(const Args& a, unsigned char* lds) {
    unsigned char* ws = a.ws;
    const int* IDX = (const int*)(ws + WS_IDX); const int* COUNTS = (const int*)(ws + WS_COUNTS);
    int* BSTART = (int*)(ws + WS_BSTART); unsigned* ELIST = (unsigned*)(ws + WS_ELIST);
    int* segsum = (int*)(lds + 16384);
    int* ps = (int*)(lds + 16384 + 2048);
    int* chunkoff = (int*)(lds + 16384 + 4096);
    unsigned* off = (unsigned*)(lds + 32768);
    const int tid = threadIdx.x;
    for (int chunk = blockIdx.x; chunk < 256; chunk += gridDim.x) {
        __syncthreads();
        int e[16];
        peer_rowcount(IDX, chunk, lds, e);
        { const int B = tid & 31, part = tid >> 5; int sacc = 0;
#pragma unroll 4
          for (int c = 0; c < 16; ++c) sacc += COUNTS[(part * 16 + c) * 32 + B];
          ps[part * 32 + B] = sacc; }
        __syncthreads();
        { const int B = tid & 31, seg = tid >> 5; int sacc = 0;
#pragma unroll 8
          for (int i = 0; i < 32; ++i) sacc += lds[(seg * 32 + i) * 32 + B];
          segsum[seg * 32 + B] = sacc; }
        if (tid < 32) {
            int tot = 0, before = 0;
            const int mypart = chunk >> 4;
#pragma unroll
            for (int pt = 0; pt < 16; ++pt) { const int x = ps[pt * 32 + tid]; tot += x; if (pt < mypart) before += x; }
            for (int c = mypart * 16; c < chunk; ++c) before += COUNTS[c * 32 + tid];
            int incl = tot;
#pragma unroll
            for (int d = 1; d < 32; d <<= 1) { const int o = __shfl_up(incl, d, 64); if (tid >= d) incl += o; }
            const int bstart = incl - tot;
            chunkoff[tid] = bstart + before;
            if (chunk == 0) { BSTART[tid] = bstart; if (tid == 31) BSTART[32] = incl; }
        }
        __syncthreads();
        { const int B = tid & 31, seg = tid >> 5;
          int run = chunkoff[B];
          for (int sg = 0; sg < seg; ++sg) run += segsum[sg * 32 + B];
#pragma unroll 8
          for (int i = 0; i < 32; ++i) { const int row = seg * 32 + i; off[row * 32 + B] = (unsigned)run; run += lds[row * 32 + B]; } }
        __syncthreads();
        { const int r = tid, t = chunk * 64 + (r >> 3), p = r & 7;
#pragma unroll
          for (int k = 0; k < 16; ++k) {
              const int b = e[k] >> 9;
              const unsigned pos = off[r * 32 + b]; off[r * 32 + b] = pos + 1u;
              ELIST[pos] = (unsigned)t | ((unsigned)(e[k] & 511) << 14) | ((unsigned)(p * 16 + k) << 23);
          } }
    }
}

constexpr int PU_ROW = 272;
__device__ __forceinline__ float dot2bf(unsigned x, unsigned y, float acc) { return __builtin_amdgcn_fdot2_f32_bf16(__builtin_bit_cast(bf16v2, x), __builtin_bit_cast(bf16v2, y), acc, false); }
__device__ void peer_u_lds_phase(const Args& a, unsigned char* lds) {
    unsigned char* ws = a.ws;
    const bf16_t* H2 = (const bf16_t*)(ws + WS_B);
    const unsigned* ELIST = (const unsigned*)(ws + WS_ELIST); const int* BSTART = (const int*)(ws + WS_BSTART);
    float* P = (float*)(ws + WS_D);
    const int tid = threadIdx.x, lane = tid & 63, wave = tid >> 6, m = lane & 7;
    for (int job = blockIdx.x; job < 256; job += gridDim.x) {
        const int v = job & 7, jb = job >> 3;
        __syncthreads();
        for (int c = tid; c < 512 * 32; c += NT) {
            const int row = c >> 5, q = c & 31;
            const f32x4 x = *(const f32x4*)(a.peer_u + (size_t)(jb * 512 + row) * DM + v * 128 + q * 4);
            *(uint2*)(lds + row * PU_ROW + q * 8) = make_uint2(pack2(x[0], x[1]), pack2(x[2], x[3]));
        }
        __syncthreads();
        const int bs = BSTART[jb], be = BSTART[jb + 1];
        const bf16_t* hbase = H2 + v * 128 + m * 16;
        int base = bs + wave * 64;
        uint4 ra = *(const uint4*)(ELIST + base + (lane & ~7)), rb = *(const uint4*)(ELIST + base + (lane & ~7) + 4);
        for (; base < be; base += 8 * 64) {
            const int nb = (base + 512 < be) ? base + 512 : base;
            const uint4 na = *(const uint4*)(ELIST + nb + (lane & ~7)), nbv = *(const uint4*)(ELIST + nb + (lane & ~7) + 4);
            const unsigned recs[8] = {ra.x, ra.y, ra.z, ra.w, rb.x, rb.y, rb.z, rb.w};
            uint4 h0[8], h1[8];
#pragma unroll
            for (int it = 0; it < 8; ++it) { const bf16_t* hp = hbase + (size_t)(recs[it] & 16383u) * DM; h0[it] = *(const uint4*)hp; h1[it] = *(const uint4*)(hp + 8); }
            float val = 0.f;
#pragma unroll
            for (int it = 0; it < 8; ++it) {
                const unsigned el = (recs[it] >> 14) & 511u;
                const uint4 u0 = *(const uint4*)(lds + el * PU_ROW + m * 32), u1 = *(const uint4*)(lds + el * PU_ROW + m * 32 + 16);
                float d = 0.f;
                d = dot2bf(h0[it].x, u0.x, d); d = dot2bf(h0[it].y, u0.y, d); d = dot2bf(h0[it].z, u0.z, d); d = dot2bf(h0[it].w, u0.w, d);
                d = dot2bf(h1[it].x, u1.x, d); d = dot2bf(h1[it].y, u1.y, d); d = dot2bf(h1[it].z, u1.z, d); d = dot2bf(h1[it].w, u1.w, d);
                d += dpp_xor1(d); d += dpp_xor2(d); d += dpp_hmirror(d);
                if (it == m) val = d;
            }
            if (base + lane < be) P[(size_t)v * ((size_t)T * 128) + base + lane] = val;
            ra = na; rb = nbv;
        }
    }
}

__device__ void peer_act_phase(const Args& a) {
    unsigned char* ws = a.ws;
    const float* P = (const float*)(ws + WS_D); float* GATE = (float*)(ws + WS_GATE); const unsigned* ELIST = (const unsigned*)(ws + WS_ELIST);
    const int* IDX = (const int*)(ws + WS_IDX); const float* VS = (const float*)(ws + WS_VSCALE); _Float16* W16 = (_Float16*)(ws + WS_W16);
    const size_t n = (size_t)T * 128;
    for (size_t i = (size_t)blockIdx.x * NT + threadIdx.x; i < n; i += (size_t)gridDim.x * NT) {
        float sacc = P[i];
#pragma unroll
        for (int v = 1; v < 8; ++v) sacc += P[(size_t)v * n + i];
        const unsigned r = ELIST[i];
        const size_t o = (size_t)(r & 16383u) * 128 + (r >> 23);
        W16[o] = (_Float16)(GATE[o] * 0.5f * sacc * (1.f + erff(sacc * 0.70710678118654752f)) * VS[IDX[o]]);
    }
}


__device__ void peer_route_task(const Args& a, int p, int t0, const unsigned char* skl) {
    const bf16_t* PQ = (const bf16_t*)(a.ws + WS_D);
    const int lane = threadIdx.x & 63, r16 = lane & 15, g = lane >> 4;
    float ab0[16], ab1[16];
    peer_half_top16(PQ, skl, t0, p, 0, r16, g, ab0);
    peer_half_top16(PQ, skl, t0, p, 1, r16, g, ab1);
    peer_route_finish(a, p, t0, ab0, ab1);
}
__device__ __forceinline__ void peer_half_top16_lds(const unsigned char* __restrict__ qs, const unsigned char* __restrict__ skl, int r16, int g, float (&out)[16]) {
    f32x4 sc[8];
#pragma unroll
    for (int ni = 0; ni < 8; ++ni) sc[ni] = (f32x4){0.f, 0.f, 0.f, 0.f};
#pragma unroll
    for (int kk = 0; kk < 4; ++kk) {
        asm volatile("" ::: "memory");
        const bf16x8 af = *(const bf16x8*)(qs + r16 * RT_ROW + kk * 64 + 16 * g);
#pragma unroll
        for (int ni = 0; ni < 8; ++ni) {
            const bf16x8 bfr = *(const bf16x8*)(skl + (ni * 16 + r16) * RT_ROW + kk * 64 + 16 * g);
            sc[ni] = mfma16(bfr, af, sc[ni]);
        }
    }
    float hi[16];
#pragma unroll
    for (int ni = 0; ni < 4; ++ni)
#pragma unroll
        for (int r = 0; r < 4; ++r) {
            out[ni * 4 + r] = __uint_as_float((__float_as_uint(sc[ni][r]) & 0xffffff80u) | (unsigned)(ni * 16 + 4 * g + r));
            hi[ni * 4 + r] = __uint_as_float((__float_as_uint(sc[ni + 4][r]) & 0xffffff80u) | (unsigned)((ni + 4) * 16 + 4 * g + r));
        }
    bitonic_sort_desc<16>(out);
    bitonic_sort_desc<16>(hi);
#pragma unroll
    for (int i = 0; i < 16; ++i) out[i] = fmaxf(out[i], hi[15 - i]);
    bitonic_merge_desc<16>(out);
    xlane_merge16(out, 16);
    xlane_merge16(out, 32);
}
struct EpiRoute { const Args* ap; unsigned char* lds; int p; int brow;
    __device__ __forceinline__ void operator()(const f32x4 (&acc)[2][2][4][2], int row0, int col0) const {
        int tix = threadIdx.x; asm volatile("" : "+v"(tix));
        const int lane = tix & 63, wave = tix >> 6, r16 = lane & 15, g = lane >> 4;
        unsigned char* qs = lds;
        unsigned char* skl = lds + 256 * RT_ROW;
        const int rl0 = row0 - brow, cl0 = (col0 - p * 256);
        float* tl = (float*)(lds + 384 * RT_ROW);
#pragma unroll 1
        for (int c = 0; c < 2; ++c) {
            __syncthreads();
#pragma unroll
            for (int ai = 0; ai < 2; ++ai)
#pragma unroll
                for (int m = 0; m < 4; ++m)
#pragma unroll
                    for (int n = 0; n < 2; ++n) { const f32x4 v = c ? acc[ai][1][m][n] : acc[ai][0][m][n]; uint2 w; w.x = pack2(v[0], v[1]); w.y = pack2(v[2], v[3]);
                        *(uint2*)(qs + (rl0 + ai * 128 + m * 16) * RT_ROW + (cl0 + n * 16) * 2) = w; }
            { const bf16_t* SK = (const bf16_t*)(ap->ws + WS_SUBK) + ((size_t)p * 2 + c) * 128 * 128;
              for (int ch = tix; ch < 128 * 16; ch += NT) { const int row = ch >> 4, q = ch & 15; *(uint4*)(skl + row * RT_ROW + q * 16) = *(const uint4*)(SK + row * 128 + q * 8); } }
            __syncthreads();
#pragma unroll 1
            for (int k = 0; k < 2; ++k) {
                float lst[16];
                peer_half_top16_lds(qs + ((wave * 2 + k) * 16) * RT_ROW, skl, r16, g, lst);
                if (g == 0) { float* d = tl + (((wave * 2 + k) * 16 + r16) * 2 + c) * 16;
#pragma unroll
                    for (int q = 0; q < 4; ++q) *(f32x4*)(d + q * 4) = (f32x4){lst[q * 4], lst[q * 4 + 1], lst[q * 4 + 2], lst[q * 4 + 3]}; }
            }
        }
        __syncthreads();
#pragma unroll 1
        for (int k = 0; k < 2; ++k) {
            float ab0[16], ab1[16];
            const float* d = tl + (((wave * 2 + k) * 16 + r16) * 2) * 16;
#pragma unroll
            for (int q = 0; q < 4; ++q) { const f32x4 x0 = *(const f32x4*)(d + q * 4), x1 = *(const f32x4*)(d + 16 + q * 4);
                ab0[q * 4] = x0[0]; ab0[q * 4 + 1] = x0[1]; ab0[q * 4 + 2] = x0[2]; ab0[q * 4 + 3] = x0[3]; ab1[q * 4] = x1[0]; ab1[q * 4 + 1] = x1[1]; ab1[q * 4 + 2] = x1[2]; ab1[q * 4 + 3] = x1[3]; }
            peer_route_finish(*ap, p, brow + (wave * 2 + k) * 16, ab0, ab1);
        }
    }
};

__device__ void phase9_fused(const Args& a, unsigned char* lds) {
    unsigned char* ws = a.ws;
    for (int i = 0;; ++i) { int pm, pn; if (!g256::next_tile(i * gridDim.x + blockIdx.x, 64, 8, pm, pn)) break;
        EpiRoute e{&a, lds, pn, pm * 256};
        __syncthreads();
        g256::tile((const bf16_t*)(ws + WS_B), (const bf16_t*)(ws + WS_WPQ_T), DM, pm * 256, pn * 256, lds, e); }
    __syncthreads();
}

__device__ void peer_u_gather_phase(const Args& a) {
    unsigned char* ws = a.ws;
    const bf16_t* H2 = (const bf16_t*)(ws + WS_B); const unsigned char* U8 = ws + WS_U8;
    const unsigned* IDX = (const unsigned*)(ws + WS_IDX); float* P = (float*)(ws + WS_D);
    int tix = threadIdx.x; asm volatile("" : "+v"(tix));
    const int lane = tix & 63, m = lane & 7, j = lane >> 3;
    const int v = blockIdx.x & 7, rank = blockIdx.x >> 3, nrank = (gridDim.x - v + 7) >> 3;
    const int wg = rank * 8 + (tix >> 6), nwg = nrank * 8;
    const unsigned uoff = (unsigned)(v * 128 + 16 * m);
    for (int tp = wg; tp < T / 2; tp += nwg) {
        uint4 hq[2][2]; uint4 iq[2][4];
#pragma unroll
        for (int tt = 0; tt < 2; ++tt) {
            const size_t t = (size_t)tp * 2 + tt;
            hq[tt][0] = *(const uint4*)(H2 + t * DM + v * 128 + 16 * m); hq[tt][1] = *(const uint4*)(H2 + t * DM + v * 128 + 16 * m + 8);
#pragma unroll
            for (int q = 0; q < 4; ++q) iq[tt][q] = *(const uint4*)(IDX + t * 128 + j * 16 + q * 4);
        }
        uint4 uq[2][16];
#pragma unroll
        for (int tt = 0; tt < 2; ++tt)
#pragma unroll
            for (int q = 0; q < 4; ++q) {
                uq[tt][q * 4] = *(const uint4*)(U8 + (iq[tt][q].x * 1024u + uoff)); uq[tt][q * 4 + 1] = *(const uint4*)(U8 + (iq[tt][q].y * 1024u + uoff));
                uq[tt][q * 4 + 2] = *(const uint4*)(U8 + (iq[tt][q].z * 1024u + uoff)); uq[tt][q * 4 + 3] = *(const uint4*)(U8 + (iq[tt][q].w * 1024u + uoff));
            }
#pragma unroll
        for (int tt = 0; tt < 2; ++tt) {
            const unsigned hw[8] = {hq[tt][0].x, hq[tt][0].y, hq[tt][0].z, hq[tt][0].w, hq[tt][1].x, hq[tt][1].y, hq[tt][1].z, hq[tt][1].w};
            float val0 = 0.f, val1 = 0.f;
#pragma unroll
            for (int it = 0; it < 16; ++it) {
                unsigned wd[4] = {uq[tt][it].x, uq[tt][it].y, uq[tt][it].z, uq[tt][it].w};
                asm volatile("" : "+v"(wd[0]), "+v"(wd[1]), "+v"(wd[2]), "+v"(wd[3]), "+v"(val0), "+v"(val1));
                float d0 = 0.f, d1 = 0.f;
#pragma unroll
                for (int q = 0; q < 4; ++q) {
                    const bf16v2 lo = __builtin_amdgcn_cvt_scalef32_pk_bf16_fp8(wd[q], 1.0f, false), hi = __builtin_amdgcn_cvt_scalef32_pk_bf16_fp8(wd[q], 1.0f, true);
                    d0 = __builtin_amdgcn_fdot2_f32_bf16(__builtin_bit_cast(bf16v2, hw[2 * q]), lo, d0, false);
                    d1 = __builtin_amdgcn_fdot2_f32_bf16(__builtin_bit_cast(bf16v2, hw[2 * q + 1]), hi, d1, false);
                }
                float d = d0 + d1;
                d += dpp_xor1(d); d += dpp_xor2(d); d += dpp_hmirror(d);
                if ((it >> 1) == m) { if (it & 1) val1 = d; else val0 = d; }
            }
            *(float2*)(P + ((size_t)v * T + (size_t)tp * 2 + tt) * 128 + j * 16 + 2 * m) = make_float2(val0, val1);
        }
    }
}
__device__ void peer_u_fused_phase(const Args& a) {
    unsigned char* ws = a.ws;
    const bf16_t* H2 = (const bf16_t*)(ws + WS_B); const unsigned char* U8 = ws + WS_U8;
    const unsigned* IDX = (const unsigned*)(ws + WS_IDX); const float* GATE = (const float*)(ws + WS_GATE);
    const float* VS = (const float*)(ws + WS_VSCALE); const float* US = (const float*)(ws + WS_USCALE); unsigned* W16 = (unsigned*)(ws + WS_W16);
    int tix = threadIdx.x; asm volatile("" : "+v"(tix));
    const int lane = tix & 63, m = lane & 7, j = lane >> 3;
    const int v = blockIdx.x & 7, rank = blockIdx.x >> 3;
    const int wg = rank * 8 + (tix >> 6);
    const size_t tp0 = (size_t)v * 1024 + wg;
    float acc[4][2][2];
#pragma unroll
    for (int k = 0; k < 4; ++k) { acc[k][0][0] = 0.f; acc[k][0][1] = 0.f; acc[k][1][0] = 0.f; acc[k][1][1] = 0.f; }
#pragma unroll 1
    for (int sl = 0; sl < 8; ++sl) {
        const unsigned uoff = (unsigned)(sl * 128 + 16 * m);
#pragma unroll
        for (int k = 0; k < 4; ++k) {
            const size_t tp = tp0 + 256 * k;
            uint4 hq[2][2]; uint4 iq[2][4];
#pragma unroll
            for (int tt = 0; tt < 2; ++tt) {
                const size_t t = tp * 2 + tt;
                hq[tt][0] = *(const uint4*)(H2 + t * DM + sl * 128 + 16 * m); hq[tt][1] = *(const uint4*)(H2 + t * DM + sl * 128 + 16 * m + 8);
#pragma unroll
                for (int q = 0; q < 4; ++q) iq[tt][q] = *(const uint4*)(IDX + t * 128 + j * 16 + q * 4);
            }
            uint4 uq[2][16];
#pragma unroll
            for (int tt = 0; tt < 2; ++tt)
#pragma unroll
                for (int q = 0; q < 4; ++q) {
                    uq[tt][q * 4] = *(const uint4*)(U8 + (iq[tt][q].x * 1024u + uoff)); uq[tt][q * 4 + 1] = *(const uint4*)(U8 + (iq[tt][q].y * 1024u + uoff));
                    uq[tt][q * 4 + 2] = *(const uint4*)(U8 + (iq[tt][q].z * 1024u + uoff)); uq[tt][q * 4 + 3] = *(const uint4*)(U8 + (iq[tt][q].w * 1024u + uoff));
                }
#pragma unroll
            for (int tt = 0; tt < 2; ++tt) {
                const unsigned hw[8] = {hq[tt][0].x, hq[tt][0].y, hq[tt][0].z, hq[tt][0].w, hq[tt][1].x, hq[tt][1].y, hq[tt][1].z, hq[tt][1].w};
                float val0 = 0.f, val1 = 0.f;
#pragma unroll
                for (int it = 0; it < 16; ++it) {
                    unsigned wd[4] = {uq[tt][it].x, uq[tt][it].y, uq[tt][it].z, uq[tt][it].w};
                    asm volatile("" : "+v"(wd[0]), "+v"(wd[1]), "+v"(wd[2]), "+v"(wd[3]), "+v"(val0), "+v"(val1));
                    float d0 = 0.f, d1 = 0.f;
#pragma unroll
                    for (int q = 0; q < 4; ++q) {
                        const bf16v2 lo = __builtin_amdgcn_cvt_scalef32_pk_bf16_fp8(wd[q], 1.0f, false), hi = __builtin_amdgcn_cvt_scalef32_pk_bf16_fp8(wd[q], 1.0f, true);
                        d0 = __builtin_amdgcn_fdot2_f32_bf16(__builtin_bit_cast(bf16v2, hw[2 * q]), lo, d0, false);
                        d1 = __builtin_amdgcn_fdot2_f32_bf16(__builtin_bit_cast(bf16v2, hw[2 * q + 1]), hi, d1, false);
                    }
                    float d = d0 + d1;
                    d += dpp_xor1(d); d += dpp_xor2(d); d += dpp_hmirror(d);
                    if ((it >> 1) == m) { if (it & 1) val1 = d; else val0 = d; }
                }
                acc[k][tt][0] += val0; acc[k][tt][1] += val1;
            }
        }
    }
#pragma unroll
    for (int k = 0; k < 4; ++k)
#pragma unroll
        for (int tt = 0; tt < 2; ++tt) {
            const size_t o = ((tp0 + 256 * k) * 2 + tt) * 128 + j * 16 + 2 * m;
            const float2 gt = *(const float2*)(GATE + o); const uint2 id = *(const uint2*)(IDX + o);
            const float x0 = acc[k][tt][0] * US[id.x], x1 = acc[k][tt][1] * US[id.y];
            const float w0 = gt.x * 0.5f * x0 * (1.f + erff(x0 * 0.70710678118654752f)) * VS[id.x];
            const float w1 = gt.y * 0.5f * x1 * (1.f + erff(x1 * 0.70710678118654752f)) * VS[id.y];
            W16[o >> 1] = pack2h(w0, w1);
        }
}
__device__ void peer_uv_fused_phase(const Args& a, unsigned char* lds) {
    unsigned char* ws = a.ws;
    const bf16_t* H2 = (const bf16_t*)(ws + WS_B); const unsigned char* U8 = ws + WS_U8;
    const unsigned* IDX = (const unsigned*)(ws + WS_IDX); const float* GATE = (const float*)(ws + WS_GATE);
    const float* VS = (const float*)(ws + WS_VSCALE); const float* US = (const float*)(ws + WS_USCALE); const unsigned char* V8 = ws + WS_V8;
    unsigned char* wl = lds + (threadIdx.x >> 6) * 6528;
    unsigned char* il = wl + 8 * 272;
    int tix = threadIdx.x; asm volatile("" : "+v"(tix));
    const int lane = tix & 63, m = lane & 7, j = lane >> 3;
    const int v = blockIdx.x & 7, rank = blockIdx.x >> 3;
    const int wg = rank * 8 + (tix >> 6);
    const size_t tp0 = (size_t)v * 1024 + wg;
    float acc[4][2][2];
#pragma unroll
    for (int k = 0; k < 4; ++k) { acc[k][0][0] = 0.f; acc[k][0][1] = 0.f; acc[k][1][0] = 0.f; acc[k][1][1] = 0.f; }
#pragma unroll 1
    for (int sl = 0; sl < 8; ++sl) {
        const unsigned uoff = (unsigned)(sl * 128 + 16 * m);
#pragma unroll
        for (int k = 0; k < 4; ++k) {
            const size_t tp = tp0 + 256 * k;
            uint4 hq[2][2]; uint4 iq[2][4];
#pragma unroll
            for (int tt = 0; tt < 2; ++tt) {
                const size_t t = tp * 2 + tt;
                hq[tt][0] = *(const uint4*)(H2 + t * DM + sl * 128 + 16 * m); hq[tt][1] = *(const uint4*)(H2 + t * DM + sl * 128 + 16 * m + 8);
#pragma unroll
                for (int q = 0; q < 4; ++q) iq[tt][q] = *(const uint4*)(IDX + t * 128 + j * 16 + q * 4);
            }
            uint4 uq[2][16];
#pragma unroll
            for (int tt = 0; tt < 2; ++tt)
#pragma unroll
                for (int q = 0; q < 4; ++q) {
                    uq[tt][q * 4] = *(const uint4*)(U8 + (iq[tt][q].x * 1024u + uoff)); uq[tt][q * 4 + 1] = *(const uint4*)(U8 + (iq[tt][q].y * 1024u + uoff));
                    uq[tt][q * 4 + 2] = *(const uint4*)(U8 + (iq[tt][q].z * 1024u + uoff)); uq[tt][q * 4 + 3] = *(const uint4*)(U8 + (iq[tt][q].w * 1024u + uoff));
                }
#pragma unroll
            for (int tt = 0; tt < 2; ++tt) {
                const unsigned hw[8] = {hq[tt][0].x, hq[tt][0].y, hq[tt][0].z, hq[tt][0].w, hq[tt][1].x, hq[tt][1].y, hq[tt][1].z, hq[tt][1].w};
                float val0 = 0.f, val1 = 0.f;
#pragma unroll
                for (int it = 0; it < 16; ++it) {
                    unsigned wd[4] = {uq[tt][it].x, uq[tt][it].y, uq[tt][it].z, uq[tt][it].w};
                    asm volatile("" : "+v"(wd[0]), "+v"(wd[1]), "+v"(wd[2]), "+v"(wd[3]), "+v"(val0), "+v"(val1));
                    float d0 = 0.f, d1 = 0.f;
#pragma unroll
                    for (int q = 0; q < 4; ++q) {
                        const bf16v2 lo = __builtin_amdgcn_cvt_scalef32_pk_bf16_fp8(wd[q], 1.0f, false), hi = __builtin_amdgcn_cvt_scalef32_pk_bf16_fp8(wd[q], 1.0f, true);
                        d0 = __builtin_amdgcn_fdot2_f32_bf16(__builtin_bit_cast(bf16v2, hw[2 * q]), lo, d0, false);
                        d1 = __builtin_amdgcn_fdot2_f32_bf16(__builtin_bit_cast(bf16v2, hw[2 * q + 1]), hi, d1, false);
                    }
                    float d = d0 + d1;
                    d += dpp_xor1(d); d += dpp_xor2(d); d += dpp_hmirror(d);
                    if ((it >> 1) == m) { if (it & 1) val1 = d; else val0 = d; }
                }
                acc[k][tt][0] += val0; acc[k][tt][1] += val1;
            }
        }
    }
#pragma unroll
    for (int k = 0; k < 4; ++k)
#pragma unroll
        for (int tt = 0; tt < 2; ++tt) {
            const size_t o = ((tp0 + 256 * k) * 2 + tt) * 128 + j * 16 + 2 * m;
            const float2 gt = *(const float2*)(GATE + o); const uint2 id = *(const uint2*)(IDX + o);
            const float x0 = acc[k][tt][0] * US[id.x], x1 = acc[k][tt][1] * US[id.y];
            const float w0 = gt.x * 0.5f * x0 * (1.f + erff(x0 * 0.70710678118654752f)) * VS[id.x];
            const float w1 = gt.y * 0.5f * x1 * (1.f + erff(x1 * 0.70710678118654752f)) * VS[id.y];
            *(unsigned*)(wl + (2 * k + tt) * 272 + (j * 16 + 2 * m) * 2) = pack2h(w0, w1);
            *(uint2*)(il + (2 * k + tt) * 528 + (j * 16 + 2 * m) * 4) = id;
        }
    int tix2 = threadIdx.x; asm volatile("" : "+v"(tix2));
    const int m2 = tix2 & 7, j2 = (tix2 >> 3) & 7, wv2 = tix2 >> 6;
    const unsigned tv = (unsigned)((((blockIdx.x & 7) * 1024 + (blockIdx.x >> 3) * 8 + wv2) + 256 * (j2 >> 1)) * 2 + (j2 & 1));
    const unsigned char* wrow = lds + wv2 * 6528 + j2 * 272; const unsigned char* irow = lds + wv2 * 6528 + 8 * 272 + j2 * 528;
#pragma unroll 1
    for (int sl = 0; sl < 8; ++sl) {
        const unsigned voff = (unsigned)(sl * 128 + 16 * m2);
        float y[16];
#pragma unroll
        for (int i = 0; i < 16; ++i) y[i] = 0.f;
#pragma unroll 1
        for (int grp = 0; grp < 4; ++grp) {
            uint4 wq[4];
            uint4 vq[32];
#pragma unroll
            for (int q = 0; q < 8; ++q) {
                const uint4 i4 = *(const uint4*)(irow + grp * 128 + q * 16);
                vq[q * 4] = *(const uint4*)(V8 + (i4.x * 1024u + voff)); vq[q * 4 + 1] = *(const uint4*)(V8 + (i4.y * 1024u + voff));
                vq[q * 4 + 2] = *(const uint4*)(V8 + (i4.z * 1024u + voff)); vq[q * 4 + 3] = *(const uint4*)(V8 + (i4.w * 1024u + voff));
            }
#pragma unroll
            for (int q = 0; q < 4; ++q) wq[q] = *(const uint4*)(wrow + grp * 64 + q * 16);
#pragma unroll
            for (int it = 0; it < 32; ++it) {
                const uint4 wv4 = wq[it >> 3]; const int wc_ = (it >> 1) & 3;
                const unsigned wword = wc_ == 0 ? wv4.x : (wc_ == 1 ? wv4.y : (wc_ == 2 ? wv4.z : wv4.w));
                const f16v2 wp = __builtin_bit_cast(f16v2, wword);
                const float wt = (float)((it & 1) ? wp[1] : wp[0]);
                unsigned wd0 = vq[it].x, wd1 = vq[it].y, wd2 = vq[it].z, wd3 = vq[it].w;
                asm volatile("" : "+v"(wd0), "+v"(wd1), "+v"(wd2), "+v"(wd3), "+v"(y[0]));
                const unsigned wd[4] = {wd0, wd1, wd2, wd3};
#pragma unroll
                for (int q = 0; q < 4; ++q) {
                    const f32v2 lo = __builtin_amdgcn_cvt_pk_f32_fp8((int)wd[q], false), hi = __builtin_amdgcn_cvt_pk_f32_fp8((int)wd[q], true);
                    y[q * 4] += wt * lo[0]; y[q * 4 + 1] += wt * lo[1]; y[q * 4 + 2] += wt * hi[0]; y[q * 4 + 3] += wt * hi[1];
                }
            }
        }
        float* orow = a.out + (tv * (unsigned)DM + (unsigned)(sl * 128 + 16 * m2));
#pragma unroll
        for (int q = 0; q < 4; ++q) {
            f32x4 o = *(const f32x4*)(orow + q * 4);
            o[0] += y[q * 4]; o[1] += y[q * 4 + 1]; o[2] += y[q * 4 + 2]; o[3] += y[q * 4 + 3];
            *(f32x4*)(orow + q * 4) = o;
        }
    }
}
__device__ void peer_act_tm_phase(const Args& a) {
    unsigned char* ws = a.ws;
    const float* P = (const float*)(ws + WS_D); const float* GATE = (const float*)(ws + WS_GATE); const int* IDX = (const int*)(ws + WS_IDX);
    const float* VS = (const float*)(ws + WS_VSCALE); const float* US = (const float*)(ws + WS_USCALE); _Float16* W16 = (_Float16*)(ws + WS_W16);
    const size_t n4 = (size_t)T * 128 / 4;
    for (size_t i = (size_t)blockIdx.x * NT + threadIdx.x; i < n4; i += (size_t)gridDim.x * NT) {
        f32x4 sacc = *(const f32x4*)(P + i * 4);
#pragma unroll
        for (int v = 1; v < 8; ++v) sacc += *(const f32x4*)(P + (size_t)v * T * 128 + i * 4);
        const f32x4 gt = *(const f32x4*)(GATE + i * 4); const int4 id = *(const int4*)(IDX + i * 4);
        const int ids[4] = {id.x, id.y, id.z, id.w};
        unsigned short o[4];
#pragma unroll
        for (int r = 0; r < 4; ++r) { const float x = sacc[r] * US[ids[r]]; const _Float16 hv = (_Float16)(gt[r] * 0.5f * x * (1.f + erff(x * 0.70710678118654752f)) * VS[ids[r]]); o[r] = __builtin_bit_cast(unsigned short, hv); }
        *(uint2*)((unsigned short*)W16 + i * 4) = make_uint2((unsigned)o[0] | ((unsigned)o[1] << 16), (unsigned)o[2] | ((unsigned)o[3] << 16));
    }
}

__device__ void peer_v_phase(const Args& a) {
    unsigned char* ws = a.ws;
    const unsigned char* V8 = ws + WS_V8;
    const int* IDX = (const int*)(ws + WS_IDX); const _Float16* W16 = (const _Float16*)(ws + WS_W16);
    int tix = threadIdx.x; asm volatile("" : "+v"(tix));
    const int lane = tix & 63, m = lane & 7, j = lane >> 3;
    const int v = blockIdx.x & 7, rank = blockIdx.x >> 3, nrank = (gridDim.x - v + 7) >> 3;
    const int wg = rank * 8 + (tix >> 6), nwg = nrank * 8;
    const unsigned voff = (unsigned)(v * 128 + 16 * m);
    for (int oct = wg; oct < T / 8; oct += nwg) {
        const int t = oct * 8 + j;
        float y[16];
#pragma unroll
        for (int i = 0; i < 16; ++i) y[i] = 0.f;
        uint4 iq[8]; uint4 wq[4];
#pragma unroll
        for (int q = 0; q < 8; ++q) iq[q] = *(const uint4*)(IDX + (size_t)t * 128 + q * 4);
#pragma unroll
        for (int q = 0; q < 4; ++q) wq[q] = *(const uint4*)(W16 + (size_t)t * 128 + q * 8);
#pragma unroll 1
        for (int grp = 0; grp < 4; ++grp) {
            const int gn = (grp < 3) ? grp + 1 : grp;
            uint4 vq[32];
#pragma unroll
            for (int q = 0; q < 8; ++q) {
                vq[q * 4] = *(const uint4*)(V8 + (iq[q].x * 1024u + voff)); vq[q * 4 + 1] = *(const uint4*)(V8 + (iq[q].y * 1024u + voff));
                vq[q * 4 + 2] = *(const uint4*)(V8 + (iq[q].z * 1024u + voff)); vq[q * 4 + 3] = *(const uint4*)(V8 + (iq[q].w * 1024u + voff));
            }
            uint4 wnx[4];
#pragma unroll
            for (int q = 0; q < 8; ++q) iq[q] = *(const uint4*)(IDX + (size_t)t * 128 + gn * 32 + q * 4);
#pragma unroll
            for (int q = 0; q < 4; ++q) wnx[q] = *(const uint4*)(W16 + (size_t)t * 128 + gn * 32 + q * 8);
#pragma unroll
            for (int it = 0; it < 32; ++it) {
                const uint4 wv4 = wq[it >> 3]; const int wc_ = (it >> 1) & 3;
                const unsigned wword = wc_ == 0 ? wv4.x : (wc_ == 1 ? wv4.y : (wc_ == 2 ? wv4.z : wv4.w));
                const f16v2 wp = __builtin_bit_cast(f16v2, wword);
                const float wt = (float)((it & 1) ? wp[1] : wp[0]);
                const unsigned wd[4] = {vq[it].x, vq[it].y, vq[it].z, vq[it].w};
#pragma unroll
                for (int q = 0; q < 4; ++q) {
                    const f32v2 lo = __builtin_amdgcn_cvt_pk_f32_fp8((int)wd[q], false), hi = __builtin_amdgcn_cvt_pk_f32_fp8((int)wd[q], true);
                    y[q * 4] += wt * lo[0]; y[q * 4 + 1] += wt * lo[1]; y[q * 4 + 2] += wt * hi[0]; y[q * 4 + 3] += wt * hi[1];
                }
            }
#pragma unroll
            for (int q = 0; q < 4; ++q) wq[q] = wnx[q];
        }
        float* orow = a.out + (size_t)t * DM + v * 128 + 16 * m;
#pragma unroll
        for (int q = 0; q < 4; ++q) {
            f32x4 o = *(const f32x4*)(orow + q * 4);
            o[0] += y[q * 4]; o[1] += y[q * 4 + 1]; o[2] += y[q * 4 + 2]; o[3] += y[q * 4 + 3];
            *(f32x4*)(orow + q * 4) = o;
        }
    }
}

#define XB_TMO      128
#define XB_XCNT(j)  (256  + 64 * (j))
#define XB_XSUB(j)  (1280 + 64 * (j))
#define XB_XGEN(j)  (2304 + 64 * (j))
#define XB_TOP      3328
#define XB_TOPGEN   3392
#define XCD_BAR_WORDS 3456
#define XB_SPIN_CAP (1u << 22)
#define LAS __attribute__((address_space(3)))
__device__ __forceinline__ unsigned xb_ld(unsigned* p)              { return __hip_atomic_load(p, __ATOMIC_RELAXED, __HIP_MEMORY_SCOPE_AGENT); }
__device__ __forceinline__ unsigned xb_add(unsigned* p, unsigned v) { return __hip_atomic_fetch_add(p, v, __ATOMIC_RELAXED, __HIP_MEMORY_SCOPE_AGENT); }
__device__ __forceinline__ unsigned xb_xcc_id() { return (unsigned)__builtin_amdgcn_s_getreg((3 << 11) | 20) & 0xFu; }
#define XB_SPIN(cond, bar) do { unsigned _sp = 0; while (cond) { __builtin_amdgcn_s_sleep(1); \
    if ((++_sp & 255u) == 0u) { if (xb_ld(&(bar)[XB_TMO])) break; if (_sp > XB_SPIN_CAP) { atomicAdd(&(bar)[XB_TMO], 1u); break; } } } } while (0)
struct XcdBarrier { unsigned* bar; unsigned x; volatile LAS unsigned* st; };
__device__ __forceinline__ XcdBarrier xcd_barrier_post(unsigned* bar, volatile LAS unsigned* st) {
    XcdBarrier b; b.bar = bar; b.x = xb_xcc_id(); b.st = st;
    if (threadIdx.x == 0) (void)xb_add(&bar[XB_XCNT(b.x)], 1u);
    return b;
}
__device__ __forceinline__ void xcd_barrier_complete(unsigned* bar, unsigned x, unsigned& nloc, unsigned& nx) {
    const unsigned G = gridDim.x * gridDim.y * gridDim.z;
    unsigned sum, cnt, mine, sp = 0u;
    for (;;) {
        sum = 0u; cnt = 0u; mine = 0u;
#pragma unroll
        for (unsigned j = 0; j < 16; ++j) { const unsigned c = xb_ld(&bar[XB_XCNT(j)]); sum += c; cnt += (c > 0u) ? 1u : 0u; mine = (j == x) ? c : mine; }
        if (sum == G) break;
        __builtin_amdgcn_s_sleep(1);
        if ((++sp & 255u) == 0u) { if (xb_ld(&bar[XB_TMO])) break; if (sp > XB_SPIN_CAP) { atomicAdd(&bar[XB_TMO], 1u); break; } }
    }
    nloc = mine > 0u ? mine : 1u; nx = cnt > 0u ? cnt : 1u;
}
__device__ __forceinline__ void xcd_barrier(const XcdBarrier& b) {
    asm volatile("s_waitcnt vmcnt(0)" ::: "memory");
    __syncthreads();
    if (threadIdx.x == 0) {
        unsigned* bar = b.bar;
        __builtin_amdgcn_s_waitcnt(0);
        unsigned nloc = b.st[0], nx = b.st[1];
        if (nloc == 0u) { xcd_barrier_complete(bar, b.x, nloc, nx); b.st[0] = nloc; b.st[1] = nx; }
        const unsigned old = xb_add(&bar[XB_XSUB(b.x)], 1u);
        const unsigned gen = old / nloc;
        if (old + 1u == (gen + 1u) * nloc) {
            __builtin_amdgcn_fence(__ATOMIC_RELEASE, "agent");
            asm volatile("s_waitcnt vmcnt(0)" ::: "memory");
            const unsigned og = xb_add(&bar[XB_TOP], 1u);
            const unsigned tg = og / nx;
            if (og + 1u == (tg + 1u) * nx) xb_add(&bar[XB_TOPGEN], 1u);
            else XB_SPIN(xb_ld(&bar[XB_TOPGEN]) == tg, bar);
            __builtin_amdgcn_fence(__ATOMIC_ACQUIRE, "agent");
            xb_add(&bar[XB_XGEN(b.x)], 1u);
            asm volatile("s_waitcnt vmcnt(0)" ::: "memory");
        } else {
            XB_SPIN(xb_ld(&bar[XB_XGEN(b.x)]) == gen, bar);
            __builtin_amdgcn_fence(__ATOMIC_ACQUIRE, "agent");
            asm volatile("s_waitcnt vmcnt(0)" ::: "memory");
        }
    }
    __syncthreads();
}

constexpr int LDS_MAIN = HG_LDS;
static_assert(LDS_MAIN >= 512 * PU_ROW && LDS_MAIN >= 2 * AT_BUF && LDS_MAIN >= 131072, "LDS_MAIN");
constexpr int LDS_BYTES = LDS_MAIN + 16;
constexpr int N_PHASES = 14;

__global__ void __launch_bounds__(NT, 2) fwd_kernel(Args a) {
    extern __shared__ __attribute__((aligned(16))) unsigned char lds[];
#if N_LAUNCH_MODE == 1
#ifdef USE_CG_SYNC
    cg::grid_group grid = cg::this_grid();
#endif
    volatile LAS unsigned* xst = (volatile LAS unsigned*)(lds + LDS_MAIN);
    if (threadIdx.x < 4) xst[threadIdx.x] = 0u;
    __syncthreads();
    XcdBarrier xbar = xcd_barrier_post((unsigned*)(a.ws + WS_CTL), xst);
#ifdef USE_CG_SYNC
#define SEAM(k) do { if (a.ph_lo <= (k) && (k) + 1 < a.ph_hi) { if ((k) == 0) grid.sync(); else xcd_barrier(xbar); } } while (0)
#else
#define SEAM(k) do { if (a.ph_lo <= (k) && (k) + 1 < a.ph_hi) { xcd_barrier(xbar); } } while (0)
#endif
#else
#define SEAM(k) do { } while (0)
#endif
#define IN(k) (a.ph_lo <= (k) && (k) < a.ph_hi)
#define REPS(k) for (int rep_ = 0; rep_ < ((k) == REPEAT_PHASE ? 2 : 1); ++rep_)
    if (IN(0)) REPS(0) { phase0(a, lds); } SEAM(0);
    if (IN(1)) REPS(1) { phase1(a, lds); } SEAM(1);
    if (IN(2)) REPS(2) { phase2(a); } SEAM(2);
    if (IN(3)) REPS(3) { phase3(a, lds); } SEAM(3);
    if (IN(4)) REPS(4) {
        const int nhalf = gridDim.x >> 1;
        if ((int)blockIdx.x < nhalf) { for (int it = blockIdx.x; it < 256; it += nhalf) attn_item(a, it, lds); }
        else { for (int it = blockIdx.x - nhalf; it < 128; it += gridDim.x - nhalf) hgrn_item(a, it, lds); }
    } SEAM(5);
    if (IN(6)) REPS(6) { phase6(a); } SEAM(6);
    if (IN(7)) REPS(7) { phase7(a, lds); } SEAM(7);
    if (IN(8)) REPS(8) { rmsnorm_rows(a.out, a.ffn_norm, (bf16_t*)(a.ws + WS_B), blockIdx.x * 8 + (threadIdx.x >> 6), gridDim.x * 8); } SEAM(8);
    if (IN(9)) REPS(9) { phase9_fused(a, lds); } SEAM(10);
    if (gridDim.x == 256) { if (IN(11)) { __syncthreads(); peer_uv_fused_phase(a, lds); } }
    else {
    if (IN(11)) { peer_u_gather_phase(a); } SEAM(11);
    if (IN(12)) { peer_act_tm_phase(a); } SEAM(12); }
    if (gridDim.x != 256) { if (IN(13)) { peer_v_phase(a); } }
}

extern "C" void kernel_launch(void* const* d_in, const int* in_sizes, int n_in, void* d_out, int out_size, void* d_ws, size_t ws_size, hipStream_t stream) {
    static int grid = 0;
    if (grid == 0) {
        if (n_in != 19 || out_size != T * DM || ws_size < WS_END) { fprintf(stderr, "kernel_launch: unexpected shapes (n_in %d out %d ws %zu)\n", n_in, out_size, ws_size); grid = -1; return; }
        int dev = 0, cus = 0, per_cu = 0;
        (void)hipGetDevice(&dev); (void)hipDeviceGetAttribute(&cus, hipDeviceAttributeMultiprocessorCount, dev);
        (void)hipFuncSetAttribute((const void*)fwd_kernel, hipFuncAttributeMaxDynamicSharedMemorySize, LDS_BYTES);
        (void)hipOccupancyMaxActiveBlocksPerMultiprocessor(&per_cu, (const void*)fwd_kernel, NT, LDS_BYTES);
        if (per_cu < 1) { fprintf(stderr, "kernel_launch: occupancy query says %d blocks/CU\n", per_cu); per_cu = 1; }
        grid = cus;
        (void)hipGetLastError();
    }
    if (grid < 0) return;
    Args a{};
    a.x = (const float*)d_in[0]; a.pos = (const int*)d_in[1]; a.attn_norm = (const float*)d_in[2]; a.w_in = (const float*)d_in[3];
    a.lb_logits = (const float*)d_in[4]; a.hg_o_norm = (const float*)d_in[5]; a.q_a_norm = (const float*)d_in[6]; a.w_q_up = (const float*)d_in[7];
    a.kv_a_norm = (const float*)d_in[8]; a.w_kv_up = (const float*)d_in[9]; a.q_norm = (const float*)d_in[10]; a.k_norm = (const float*)d_in[11];
    a.mla_o_norm = (const float*)d_in[12]; a.w_out = (const float*)d_in[13]; a.ffn_norm = (const float*)d_in[14]; a.peer_wq = (const float*)d_in[15];
    a.subk = (const float*)d_in[16]; a.peer_u = (const float*)d_in[17]; a.peer_v = (const float*)d_in[18];
    a.out = (float*)d_out; a.ws = (unsigned char*)d_ws;
    const int last = (STOP_AFTER < N_PHASES - 1) ? STOP_AFTER : N_PHASES - 1;
#if N_LAUNCH_MODE == 1
    (void)hipMemsetAsync((unsigned char*)d_ws + WS_CTL, 0, 16384, stream);
    a.ph_lo = 0; a.ph_hi = last + 1;
#ifdef USE_CG_SYNC
    void* args[] = {&a};
    hipError_t e = hipLaunchCooperativeKernel((const void*)fwd_kernel, dim3(grid), dim3(NT), args, LDS_BYTES, stream);
    if (e != hipSuccess) fprintf(stderr, "cooperative launch failed: %s (grid %d)\n", hipGetErrorString(e), grid);
#else
    hipLaunchKernelGGL(fwd_kernel, dim3(grid), dim3(NT), LDS_BYTES, stream, a);
#endif
#else
    for (int ph = 0; ph <= last; ++ph) {
        a.ph_lo = ph; a.ph_hi = ph + 1;
        hipLaunchKernelGGL(fwd_kernel, dim3(grid), dim3(NT), LDS_BYTES, stream, a);
    }
#endif
}
```

```cpp
#include <hip/hip_runtime.h>
#include <hip/hip_cooperative_groups.h>
#include <cstdio>
#include <cstdint>
namespace cg = cooperative_groups;

#ifndef N_LAUNCH_MODE
#define N_LAUNCH_MODE 1
#endif
#ifndef REPEAT_PHASE
#define REPEAT_PHASE -1
#endif
#ifndef STOP_AFTER
#define STOP_AFTER 99
#endif

typedef unsigned short bf16_t;
typedef short bf16x8 __attribute__((ext_vector_type(8)));
typedef float f32x4 __attribute__((ext_vector_type(4)));

constexpr int NT = 512;
constexpr int T = 16384, SEQ = 2048, NB = 8, DM = 1024, INW = 3264;
constexpr int OFF_Q = 0, OFF_FF = 512, OFF_FB = 1024, OFF_I = 1536, OFF_G = 2048, OFF_CQ = 2560, OFF_CKV = 2944, OFF_KR = 3200;
constexpr float EPS = 1e-6f;

constexpr size_t WS_CTL = 0;
constexpr size_t WS_WIN_T = 65536;
constexpr size_t WS_WQUP_T = WS_WIN_T + (size_t)3264 * 1024 * 2;
constexpr size_t WS_WKVUP_T = WS_WQUP_T + (size_t)768 * 384 * 2;
constexpr size_t WS_WOUT_T = WS_WKVUP_T + (size_t)1024 * 256 * 2;
constexpr size_t WS_WPQ_T = WS_WOUT_T + (size_t)1024 * 1024 * 2;
constexpr size_t WS_SUBK = WS_WPQ_T + (size_t)2048 * 1024 * 2;
constexpr size_t WS_LB = WS_SUBK + (size_t)16 * 128 * 128 * 2;
constexpr size_t WS_B = 15728640;
constexpr size_t WS_CQN = WS_B;
constexpr size_t WS_CKVN = WS_B + (size_t)T * 384 * 2;
constexpr size_t WS_C = WS_B + 33554432;
constexpr size_t WS_U4 = WS_C;
constexpr size_t WS_H4 = WS_C + 16777216;
constexpr size_t WS_V4 = WS_C + 33554432;
constexpr size_t WS_VSCALE = WS_V4 + (size_t)16384 * 1024;
constexpr size_t WS_USCALE = WS_VSCALE + 65536;
constexpr size_t WS_USUM = WS_USCALE + 65536;
constexpr size_t WS_HS = WS_USUM + 65536;
constexpr size_t WS_D = WS_C + (size_t)T * INW * 2;
constexpr size_t WS_Q = WS_D + 33554432;
constexpr size_t WS_KN = WS_Q + (size_t)T * 768 * 2;
constexpr size_t WS_VT = WS_KN + (size_t)T * 512 * 2;
constexpr size_t WS_KROPE = WS_VT + (size_t)T * 512 * 2;
constexpr size_t WS_ROPECS = WS_KROPE + (size_t)T * 64 * 2;
constexpr size_t WS_END = WS_ROPECS + (size_t)T * 64 * 4;
constexpr size_t WS_W16 = WS_KROPE;
constexpr size_t WS_IDX = WS_VT;
constexpr size_t WS_GATE = WS_VT + (size_t)T * 128 * 4;
constexpr size_t WS_ELIST = WS_D + 67108864;
constexpr size_t WS_COUNTS = WS_CTL + 16384;
constexpr size_t WS_BSTART = WS_CTL + 16384 + 32768;
static_assert(WS_ELIST + (size_t)T * 128 * 4 <= WS_VT, "edge list overflow");
static_assert(WS_LB + 4096 <= WS_B, "weights overflow");
static_assert(WS_D + (size_t)T * 2048 * 2 <= WS_IDX, "PQ overlaps IDX");
static_assert(WS_GATE + (size_t)T * 128 * 4 <= WS_VT + (size_t)T * 512 * 2, "gate overflow");
static_assert(WS_HS + 65536 <= WS_D, "PEER tables overflow");
static_assert(WS_END <= 268435456, "workspace too big");

struct Args {
    const float* x; const int* pos; const float* attn_norm; const float* w_in; const float* lb_logits; const float* hg_o_norm;
    const float* q_a_norm; const float* w_q_up; const float* kv_a_norm; const float* w_kv_up; const float* q_norm; const float* k_norm;
    const float* mla_o_norm; const float* w_out; const float* ffn_norm; const float* peer_wq; const float* subk; const float* peer_u; const float* peer_v;
    float* out; unsigned char* ws; int ph_lo, ph_hi;
};

typedef __bf16 bf16v2 __attribute__((ext_vector_type(2)));
typedef float f32v2 __attribute__((ext_vector_type(2)));
__device__ __forceinline__ unsigned pack2(float lo, float hi) { const f32v2 v = {lo, hi}; return __builtin_bit_cast(unsigned, __builtin_convertvector(v, bf16v2)); }
__device__ __forceinline__ bf16_t f2bf(float f) { return (bf16_t)(pack2(f, 0.f) & 0xffffu); }
typedef _Float16 f16v2 __attribute__((ext_vector_type(2)));
__device__ __forceinline__ unsigned pack2h(float lo, float hi) { const f32v2 v = {lo, hi}; return __builtin_bit_cast(unsigned, __builtin_convertvector(v, f16v2)); }
__device__ __forceinline__ float frcp(float x) { return __builtin_amdgcn_rcpf(x); }
__device__ __forceinline__ float fexp2(float x) { return __builtin_amdgcn_exp2f(x); }
__device__ __forceinline__ float bf2f(bf16_t h) { return __uint_as_float(((unsigned)h) << 16); }
__device__ __forceinline__ float bflo(unsigned w) { return __uint_as_float(w << 16); }
__device__ __forceinline__ float bfhi(unsigned w) { return __uint_as_float(w & 0xffff0000u); }
__device__ __forceinline__ float wave_sum(float v) {
#pragma unroll
    for (int d = 32; d > 0; d >>= 1) v += __shfl_xor(v, d, 64);
    return v;
}
__device__ __forceinline__ f32x4 mfma16(bf16x8 a, bf16x8 b, f32x4 c) { return __builtin_amdgcn_mfma_f32_16x16x32_bf16(a, b, c, 0, 0, 0); }

__device__ const float ROPE_INV_FREQ[32] = {
    1.000000000e+00f, 7.498942018e-01f, 5.623413324e-01f, 4.216965139e-01f, 3.162277639e-01f, 2.371373922e-01f, 1.778279394e-01f, 1.333521456e-01f,
    1.000000015e-01f, 7.498941571e-02f, 5.623412877e-02f, 4.216964915e-02f, 3.162277862e-02f, 2.371373586e-02f, 1.778279431e-02f, 1.333521493e-02f,
    9.999999776e-03f, 7.498942316e-03f, 5.623413250e-03f, 4.216964822e-03f, 3.162277862e-03f, 2.371373819e-03f, 1.778279431e-03f, 1.333521446e-03f,
    1.000000047e-03f, 7.498941850e-04f, 5.623413017e-04f, 4.216965463e-04f, 3.162277862e-04f, 2.371373848e-04f, 1.778279402e-04f, 1.333521504e-04f};

template <int WAVES_M, int WAVES_N, int WM, int WN, class Epi>
__device__ __forceinline__ void gemm_block(const bf16_t* __restrict__ A, int lda, const bf16_t* __restrict__ Bt, int ldb, int K,
                                           int m0, int n0, int nrows_bt, unsigned char* lds, Epi& epi) {
    constexpr int BM = WAVES_M * WM * 16, BN = WAVES_N * WN * 16;
    constexpr int AI = BM / 64, BI = BN / 64;
    static_assert(WAVES_M * WAVES_N == 8, "8 waves");
    const int tid = threadIdx.x, lane = tid & 63, wave = tid >> 6;
    const int wm = wave / WAVES_N, wn = wave % WAVES_N;
    const int r16 = lane & 15, g = lane >> 4;
    unsigned char* As = lds;
    unsigned char* Bs = lds + BM * 144;
    f32x4 acc[WM][WN];
#pragma unroll
    for (int i = 0; i < WM; ++i)
#pragma unroll
        for (int j = 0; j < WN; ++j) acc[i][j] = (f32x4){0.f, 0.f, 0.f, 0.f};
    uint4 ra0, ra1, ra2, ra3, rb0, rb1, rb2, rb3;
    static_assert(AI <= 4 && BI <= 4, "stage regs");
#define GA_LOAD(i, k0) if constexpr (AI > i) { const int c = tid + i * NT, row = c >> 3, kc = c & 7; ra##i = *(const uint4*)(A + (size_t)(m0 + row) * lda + (k0) + kc * 8); }
#define GB_LOAD(i, k0) if constexpr (BI > i) { const int c = tid + i * NT, row = c >> 3, kc = c & 7; int rg = n0 + row; rg = rg < nrows_bt ? rg : nrows_bt - 1; rb##i = *(const uint4*)(Bt + (size_t)rg * ldb + (k0) + kc * 8); }
#define GA_STORE(i) if constexpr (AI > i) { const int c = tid + i * NT, row = c >> 3, kc = c & 7; *(uint4*)(As + row * 144 + kc * 16) = ra##i; }
#define GB_STORE(i) if constexpr (BI > i) { const int c = tid + i * NT, row = c >> 3, kc = c & 7; *(uint4*)(Bs + row * 144 + kc * 16) = rb##i; }
    GA_LOAD(0, 0) GA_LOAD(1, 0) GA_LOAD(2, 0) GA_LOAD(3, 0) GB_LOAD(0, 0) GB_LOAD(1, 0) GB_LOAD(2, 0) GB_LOAD(3, 0)
    const int nk = K / 64;
    for (int kt = 0; kt < nk; ++kt) {
        __syncthreads();
        GA_STORE(0) GA_STORE(1) GA_STORE(2) GA_STORE(3) GB_STORE(0) GB_STORE(1) GB_STORE(2) GB_STORE(3)
        __syncthreads();
        if (kt + 1 < nk) {
            const int k0 = (kt + 1) * 64;
            GA_LOAD(0, k0) GA_LOAD(1, k0) GA_LOAD(2, k0) GA_LOAD(3, k0) GB_LOAD(0, k0) GB_LOAD(1, k0) GB_LOAD(2, k0) GB_LOAD(3, k0)
        }
#pragma unroll
        for (int kk = 0; kk < 2; ++kk) {
            bf16x8 af[WM];
#pragma unroll
            for (int i = 0; i < WM; ++i) af[i] = *(const bf16x8*)(As + ((wm * WM + i) * 16 + r16) * 144 + kk * 64 + g * 16);
#pragma unroll
            for (int j = 0; j < WN; ++j) {
                const bf16x8 bfr = *(const bf16x8*)(Bs + ((wn * WN + j) * 16 + r16) * 144 + kk * 64 + g * 16);
#pragma unroll
                for (int i = 0; i < WM; ++i) acc[i][j] = mfma16(bfr, af[i], acc[i][j]);
            }
        }
    }
#undef GA_LOAD
#undef GB_LOAD
#undef GA_STORE
#undef GB_STORE
    epi(acc, m0 + wm * WM * 16, n0 + wn * WN * 16, lane);
}

namespace g256 {
constexpr int BM = 256, BK = 64, HALF = 128, HT = HALF * BK;
__device__ __forceinline__ int lds_byte(int r, int c) { const int st = (r >> 4) * 2 + (c >> 5), rr = r & 15, cc = c & 31, ob = rr * 64 + cc * 2; return st * 1024 + (ob ^ (((ob >> 9) & 1) << 5)); }
__device__ __forceinline__ void stage_rc(int b, int& R, int& C) { const int st = b / 1024, sb = b % 1024, swz = sb ^ (((sb >> 9) & 1) << 5); R = (st >> 1) * 16 + swz / 64; C = (st & 1) * 32 + (swz % 64) / 2; }

template <class Epi>
__device__ __forceinline__ void tile(const bf16_t* __restrict__ A, const bf16_t* __restrict__ Bt, int K, int brow, int bcol, unsigned char* lds, Epi& epi) {
    bf16_t* shm = (bf16_t*)lds;
#define G_SA(b, h) (shm + ((b) * 2 + (h)) * HT)
#define G_SB(b, h) (shm + (4 + (b) * 2 + (h)) * HT)
#define G_STAGE(P, BASE, br, kt) do { const long _g = (long)(br) * K + (long)(kt) * BK; \
    _Pragma("unroll") for (int _i = 0; _i < 2; ++_i) { const int _b = tix * 16 + _i * 8192; int _r, _c; stage_rc(_b, _r, _c); \
      __builtin_amdgcn_global_load_lds((const unsigned*)(BASE + _g + (long)_r * K + _c), (unsigned*)((char*)(P) + _b), 16, 0, 0); } } while (0)
#define G_LDA(dst, b, h) _Pragma("unroll") for (int m = 0; m < 4; ++m) _Pragma("unroll") for (int k = 0; k < 2; ++k) \
    dst[m][k] = *reinterpret_cast<const bf16x8*>((char*)G_SA(b, h) + lds_byte(wr * 64 + m * 16 + fr, k * 32 + fq * 8))
#define G_LDB(dst, b, h) _Pragma("unroll") for (int n = 0; n < 2; ++n) _Pragma("unroll") for (int k = 0; k < 2; ++k) \
    dst[n][k] = *reinterpret_cast<const bf16x8*>((char*)G_SB(b, h) + lds_byte(wc * 32 + n * 16 + fr, k * 32 + fq * 8))
#define G_MMA(ai, bj, At, Bt_) do { __builtin_amdgcn_s_setprio(1); \
    _Pragma("unroll") for (int m = 0; m < 4; ++m) _Pragma("unroll") for (int n = 0; n < 2; ++n) _Pragma("unroll") for (int k = 0; k < 2; ++k) \
      acc[ai][bj][m][n] = __builtin_amdgcn_mfma_f32_16x16x32_bf16(Bt_[n][k], At[m][k], acc[ai][bj][m][n], 0, 0, 0); \
    __builtin_amdgcn_s_setprio(0); } while (0)
#define G_WAIT_V(n) asm volatile("s_waitcnt vmcnt(" #n ")" ::: "memory")
#define G_WAIT_L(n) asm volatile("s_waitcnt lgkmcnt(" #n ")" ::: "memory")
#define G_BAR __builtin_amdgcn_s_barrier()
#define G_SCHED __builtin_amdgcn_sched_barrier(0)
    int tix = threadIdx.x; asm volatile("" : "+v"(tix));
    const int wid = tix >> 6, lane = tix & 63, wr = wid >> 2, wc = wid & 3, fr = lane & 15, fq = lane >> 4;
    f32x4 acc[2][2][4][2];
#pragma unroll
    for (int i0 = 0; i0 < 2; ++i0)
#pragma unroll
        for (int i1 = 0; i1 < 2; ++i1)
#pragma unroll
            for (int i2 = 0; i2 < 4; ++i2)
#pragma unroll
                for (int i3 = 0; i3 < 2; ++i3) acc[i0][i1][i2][i3] = (f32x4){0.f, 0.f, 0.f, 0.f};
    bf16x8 At[4][2], B0[2][2], B1[2][2];
    const int nt = K / BK;
    G_STAGE(G_SB(0, 0), Bt, bcol, 0); G_STAGE(G_SA(0, 0), A, brow, 0);
    G_STAGE(G_SB(0, 1), Bt, bcol + HALF, 0); G_STAGE(G_SA(0, 1), A, brow + HALF, 0);
    if (wr == 1) G_BAR;
    G_WAIT_V(4); G_BAR;
    G_STAGE(G_SB(1, 0), Bt, bcol, 1); G_STAGE(G_SA(1, 0), A, brow, 1); G_STAGE(G_SB(1, 1), Bt, bcol + HALF, 1);
    G_WAIT_V(6); G_BAR;
    for (int t = 0; t < nt - 2; t += 2) {
        G_LDB(B0, 0, 0); G_SCHED; G_LDA(At, 0, 0); G_STAGE(G_SA(1, 1), A, brow + HALF, t + 1);
        G_WAIT_L(8); G_BAR; G_WAIT_L(0); G_MMA(0, 0, At, B0); G_BAR; G_SCHED;
        G_LDB(B1, 0, 1); G_STAGE(G_SB(0, 0), Bt, bcol, t + 2);
        G_BAR; G_WAIT_L(0); G_MMA(0, 1, At, B1); G_BAR;
        G_LDA(At, 0, 1); G_STAGE(G_SA(0, 0), A, brow, t + 2);
        G_BAR; G_WAIT_L(0); G_MMA(1, 0, At, B0); G_BAR; G_SCHED;
        G_STAGE(G_SB(0, 1), Bt, bcol + HALF, t + 2);
        G_WAIT_V(6); G_BAR; G_MMA(1, 1, At, B1); G_BAR;
        G_LDB(B0, 1, 0); G_SCHED; G_LDA(At, 1, 0); G_STAGE(G_SA(0, 1), A, brow + HALF, t + 2);
        G_WAIT_L(8); G_BAR; G_WAIT_L(0); G_MMA(0, 0, At, B0); G_BAR; G_SCHED;
        G_LDB(B1, 1, 1); G_STAGE(G_SB(1, 0), Bt, bcol, t + 3);
        G_BAR; G_WAIT_L(0); G_MMA(0, 1, At, B1); G_BAR;
        G_LDA(At, 1, 1); G_STAGE(G_SA(1, 0), A, brow, t + 3);
        G_BAR; G_WAIT_L(0); G_MMA(1, 0, At, B0); G_BAR; G_SCHED;
        G_STAGE(G_SB(1, 1), Bt, bcol + HALF, t + 3);
        G_WAIT_V(6); G_BAR; G_MMA(1, 1, At, B1); G_BAR;
    }
    { G_LDB(B0, 0, 0); G_LDA(At, 0, 0); G_STAGE(G_SA(1, 1), A, brow + HALF, nt - 1);
      G_BAR; G_WAIT_L(0); G_MMA(0, 0, At, B0); G_BAR;
      G_LDB(B1, 0, 1); G_BAR; G_WAIT_L(0); G_MMA(0, 1, At, B1); G_BAR;
      G_LDA(At, 0, 1); G_WAIT_V(4); G_BAR; G_WAIT_L(0); G_MMA(1, 0, At, B0); G_MMA(1, 1, At, B1); G_BAR; }
    { G_LDB(B0, 1, 0); G_LDA(At, 1, 0); G_WAIT_V(2); G_BAR; G_WAIT_L(0); G_MMA(0, 0, At, B0); G_BAR;
      G_LDB(B1, 1, 1); G_WAIT_V(0); G_BAR; G_WAIT_L(0); G_MMA(0, 1, At, B1); G_BAR;
      G_LDA(At, 1, 1); G_BAR; G_WAIT_L(0); G_MMA(1, 0, At, B0); G_MMA(1, 1, At, B1); G_BAR; }
    if (wr == 0) G_BAR;
    epi(acc, brow + wr * 64 + fr, bcol + wc * 32 + 4 * fq);
#undef G_SA
#undef G_SB
#undef G_STAGE
#undef G_LDA
#undef G_LDB
#undef G_MMA
#undef G_WAIT_V
#undef G_WAIT_L
#undef G_BAR
#undef G_SCHED
}
__device__ __forceinline__ bool next_tile(int L, int nM, int nN, int& pm, int& pn) {
    const int nwg = nM * nN; if (L >= nwg) return false;
    int wgid = L; { const int q = nwg / 8, r = nwg % 8, xcd = wgid % 8, off = wgid / 8; wgid = (xcd < r ? xcd * (q + 1) : r * (q + 1) + (xcd - r) * q) + off; }
    const int WGM = 8, nig = WGM * nN, gid = wgid / nig, fm = gid * WGM, gsz = (nM - fm) < WGM ? (nM - fm) : WGM;
    pm = fm + ((wgid % nig) % gsz); pn = (wgid % nig) / gsz; return true;
}
struct EpiBf16 { bf16_t* O; int ldc;
    __device__ __forceinline__ void operator()(const f32x4 (&acc)[2][2][4][2], int row0, int col0) const {
#pragma unroll
        for (int ai = 0; ai < 2; ++ai)
#pragma unroll
            for (int m = 0; m < 4; ++m) { bf16_t* rp = O + (size_t)(row0 + ai * 128 + m * 16) * ldc + col0;
#pragma unroll
                for (int bj = 0; bj < 2; ++bj)
#pragma unroll
                    for (int n = 0; n < 2; ++n) { const f32x4 v = acc[ai][bj][m][n]; uint2 w; w.x = pack2(v[0], v[1]); w.y = pack2(v[2], v[3]); *(uint2*)(rp + bj * 128 + n * 16) = w; } }
    }
};
struct EpiResid { const float* X; float* O;
    __device__ __forceinline__ void operator()(const f32x4 (&acc)[2][2][4][2], int row0, int col0) const {
#pragma unroll
        for (int ai = 0; ai < 2; ++ai)
#pragma unroll
            for (int m = 0; m < 4; ++m) { const size_t ro = (size_t)(row0 + ai * 128 + m * 16) * DM + col0;
#pragma unroll
                for (int bj = 0; bj < 2; ++bj)
#pragma unroll
                    for (int n = 0; n < 2; ++n) { const size_t off = ro + bj * 128 + n * 16; const f32x4 xv = *(const f32x4*)(X + off); *(f32x4*)(O + off) = xv + acc[ai][bj][m][n]; } }
    }
};
struct EpiBf16Silu { bf16_t* O; int ldc; int nsilu;
    __device__ __forceinline__ void operator()(const f32x4 (&acc)[2][2][4][2], int row0, int col0) const {
        const bool sl = col0 < nsilu;
#pragma unroll
        for (int ai = 0; ai < 2; ++ai)
#pragma unroll
            for (int m = 0; m < 4; ++m) { bf16_t* rp = O + (size_t)(row0 + ai * 128 + m * 16) * ldc + col0;
#pragma unroll
                for (int bj = 0; bj < 2; ++bj)
#pragma unroll
                    for (int n = 0; n < 2; ++n) { f32x4 v = acc[ai][bj][m][n];
                        if (sl) {
#pragma unroll
                            for (int r = 0; r < 4; ++r) v[r] = v[r] * frcp(1.f + __expf(-v[r])); }
                        uint2 w; w.x = pack2(v[0], v[1]); w.y = pack2(v[2], v[3]); *(uint2*)(rp + bj * 128 + n * 16) = w; } }
    }
};
}

template <int WM_, int WN_> struct EpiBf16 {
    bf16_t* O; int ldc; int ncols;
    __device__ __forceinline__ void operator()(const f32x4 (&acc)[WM_][WN_], int mb, int nb, int lane) const {
        const int r16 = lane & 15, g = lane >> 4;
#pragma unroll
        for (int i = 0; i < WM_; ++i)
#pragma unroll
            for (int j = 0; j < WN_; ++j) {
                const int row = mb + i * 16 + r16, col = nb + j * 16 + 4 * g;
                if (col < ncols) { uint2 w; w.x = pack2(acc[i][j][0], acc[i][j][1]); w.y = pack2(acc[i][j][2], acc[i][j][3]); *(uint2*)(O + (size_t)row * ldc + col) = w; }
            }
    }
};
struct EpiResid {
    const float* X; float* O;
    __device__ __forceinline__ void operator()(const f32x4 (&acc)[4][2], int mb, int nb, int lane) const {
        const int r16 = lane & 15, g = lane >> 4;
#pragma unroll
        for (int i = 0; i < 4; ++i)
#pragma unroll
            for (int j = 0; j < 2; ++j) {
                const size_t off = (size_t)(mb + i * 16 + r16) * DM + nb + j * 16 + 4 * g;
                const f32x4 xv = *(const f32x4*)(X + off);
                *(f32x4*)(O + off) = xv + acc[i][j];
            }
    }
};
struct EpiQ {
    bf16_t* Q; const float* q_norm; const float* ropecs;
    __device__ __forceinline__ void operator()(const f32x4 (&accs)[2][12], int mb, int nb, int lane) const {
      const int r16 = lane & 15, g = lane >> 4;
#pragma unroll
      for (int mi = 0; mi < 2; ++mi) {
        const f32x4 (&accm)[12] = accs[mi];
        const int row = mb + mi * 16 + r16, h = nb / 192;
        float ssn = 0.f, ssr = 0.f;
#pragma unroll
        for (int j = 0; j < 8; ++j)
#pragma unroll
            for (int r = 0; r < 4; ++r) ssn += accm[j][r] * accm[j][r];
#pragma unroll
        for (int j = 8; j < 12; ++j)
#pragma unroll
            for (int r = 0; r < 4; ++r) ssr += accm[j][r] * accm[j][r];
        ssn += __shfl_xor(ssn, 16, 64); ssn += __shfl_xor(ssn, 32, 64);
        ssr += __shfl_xor(ssr, 16, 64); ssr += __shfl_xor(ssr, 32, 64);
        const float SC = 0.07216878364870322f * 1.4426950408889634f;
        const float rn = rsqrtf(ssn * (1.f / 128.f) + EPS) * SC, rr = rsqrtf(ssr * (1.f / 64.f) + EPS) * SC;
        bf16_t* qrow = Q + ((size_t)row * 4 + h) * 192;
#pragma unroll
        for (int j = 0; j < 8; ++j) {
            const int c = j * 16 + 4 * g;
            const f32x4 gn = *(const f32x4*)(q_norm + c);
            uint2 w; w.x = pack2(accm[j][0] * rn * gn[0], accm[j][1] * rn * gn[1]); w.y = pack2(accm[j][2] * rn * gn[2], accm[j][3] * rn * gn[3]);
            *(uint2*)(qrow + c) = w;
        }
#pragma unroll
        for (int j = 0; j < 2; ++j) {
            const int jj = j * 16 + 4 * g;
            const f32x4 g1 = *(const f32x4*)(q_norm + 128 + jj), g2 = *(const f32x4*)(q_norm + 160 + jj);
            float o1[4], o2[4];
#pragma unroll
            for (int r = 0; r < 4; ++r) {
                const float2 cs = *(const float2*)(ropecs + ((size_t)row * 32 + jj + r) * 2);
                const float a1 = accm[8 + j][r] * rr * g1[r], a2 = accm[10 + j][r] * rr * g2[r];
                o1[r] = a1 * cs.x - a2 * cs.y; o2[r] = a2 * cs.x + a1 * cs.y;
            }
            uint2 w; w.x = pack2(o1[0], o1[1]); w.y = pack2(o1[2], o1[3]); *(uint2*)(qrow + 128 + jj) = w;
            w.x = pack2(o2[0], o2[1]); w.y = pack2(o2[2], o2[3]); *(uint2*)(qrow + 160 + jj) = w;
        }
      }
    }
};
template <int WMK> struct EpiKV {
    bf16_t* KN; bf16_t* VT; const float* k_norm;
    __device__ __forceinline__ void operator()(const f32x4 (&accs)[WMK][16], int mb, int nb, int lane) const {
      const int r16 = lane & 15, g = lane >> 4;
#pragma unroll
      for (int mi = 0; mi < WMK; ++mi) {
        const f32x4 (&accm)[16] = accs[mi];
        const int row = mb + mi * 16 + r16, h = nb / 256;
        float ssn = 0.f;
#pragma unroll
        for (int j = 0; j < 8; ++j)
#pragma unroll
            for (int r = 0; r < 4; ++r) ssn += accm[j][r] * accm[j][r];
        ssn += __shfl_xor(ssn, 16, 64); ssn += __shfl_xor(ssn, 32, 64);
        const float rn = rsqrtf(ssn * (1.f / 128.f) + EPS);
        bf16_t* krow = KN + ((size_t)row * 4 + h) * 128;
#pragma unroll
        for (int j = 0; j < 8; ++j) {
            const int c = j * 16 + 4 * g;
            const f32x4 gn = *(const f32x4*)(k_norm + c);
            uint2 w; w.x = pack2(accm[j][0] * rn * gn[0], accm[j][1] * rn * gn[1]); w.y = pack2(accm[j][2] * rn * gn[2], accm[j][3] * rn * gn[3]);
            *(uint2*)(krow + c) = w;
        }
        const int b = row >> 11, s = row & 2047;
        bf16_t* vp = VT + ((size_t)(b * 4 + h) * 128 + 4 * g) * SEQ + s;
#pragma unroll
        for (int j = 0; j < 8; ++j) {
            asm volatile("" : "+v"(vp));
            vp[0] = f2bf(accm[8 + j][0]); vp[SEQ] = f2bf(accm[8 + j][1]); vp[2 * SEQ] = f2bf(accm[8 + j][2]); vp[3 * SEQ] = f2bf(accm[8 + j][3]);
            vp += 16 * SEQ;
        }
      }
    }
};

__device__ void transpose_convert(const float* __restrict__ W, bf16_t* __restrict__ Wt, int K, int N, unsigned char* lds, int bid, int nblk) {
    bf16_t* tile = (bf16_t*)lds;
    const int tid = threadIdx.x;
    const int tk = K / 64, tn = N / 64;
    for (int t = bid; t < tk * tn; t += nblk) {
        const int k0 = (t / tn) * 64, n0 = (t % tn) * 64;
        __syncthreads();
#pragma unroll
        for (int p = 0; p < 2; ++p) {
            const int kk = (tid >> 4) + p * 32, n4 = (tid & 15) * 4;
            const f32x4 v = *(const f32x4*)(W + (size_t)(k0 + kk) * N + n0 + n4);
#pragma unroll
            for (int r = 0; r < 4; ++r) tile[(n4 + r) * 66 + kk] = f2bf(v[r]);
        }
        __syncthreads();
        {
            const int nn = tid >> 3, k8 = (tid & 7) * 8;
            unsigned w[4];
#pragma unroll
            for (int r = 0; r < 4; ++r) w[r] = (unsigned)tile[nn * 66 + k8 + 2 * r] | ((unsigned)tile[nn * 66 + k8 + 2 * r + 1] << 16);
            *(uint4*)(Wt + (size_t)(n0 + nn) * K + k0 + k8) = make_uint4(w[0], w[1], w[2], w[3]);
        }
    }
    __syncthreads();
}

template <bool Q4>
__device__ void rmsnorm_rows(const float* __restrict__ X, const float* __restrict__ gain, bf16_t* __restrict__ O, int gw, int nw, unsigned char* __restrict__ H4 = nullptr, float* __restrict__ HS = nullptr) {
    const int lane = threadIdx.x & 63;
    for (int row = gw; row < T; row += nw) {
        const float* xr = X + (size_t)row * DM;
        f32x4 v[4]; float ss = 0.f;
#pragma unroll
        for (int i = 0; i < 4; ++i) { v[i] = *(const f32x4*)(xr + i * 256 + lane * 4); ss += v[i][0] * v[i][0] + v[i][1] * v[i][1] + v[i][2] * v[i][2] + v[i][3] * v[i][3]; }
        ss = wave_sum(ss);
        const float rs = rsqrtf(ss * (1.f / 1024.f) + EPS);
        float amax = 0.f;
#pragma unroll
        for (int i = 0; i < 4; ++i) {
            const f32x4 gn = *(const f32x4*)(gain + i * 256 + lane * 4);
#pragma unroll
            for (int e = 0; e < 4; ++e) { v[i][e] = v[i][e] * rs * gn[e]; amax = fmaxf(amax, fabsf(v[i][e])); }
            uint2 w; w.x = pack2(v[i][0], v[i][1]); w.y = pack2(v[i][2], v[i][3]);
            *(uint2*)(O + (size_t)row * DM + i * 256 + lane * 4) = w;
        }
        if constexpr (Q4) {
#pragma unroll
            for (int d = 32; d > 0; d >>= 1) amax = fmaxf(amax, __shfl_xor(amax, d, 64));
            const float inv = amax > 0.f ? 127.f / amax : 0.f;
            unsigned char* hr = H4 + (size_t)row * 1024 + (lane >> 3) * 32 + ((lane >> 1) & 3) * 4 + (lane & 1) * 2;
#pragma unroll
            for (int i = 0; i < 4; ++i) {
                unsigned ha = 0, hb = 0;
#pragma unroll
                for (int e = 0; e < 4; ++e) { const unsigned tb = (unsigned)((int)rintf(v[i][e] * inv) + 128); ha |= ((tb >> 4) ^ 8u) << (4 * e); hb |= ((tb & 15u) ^ 8u) << (4 * e); }
                *(unsigned short*)(hr + i * 256) = (unsigned short)ha; *(unsigned short*)(hr + i * 256 + 16) = (unsigned short)hb;
            }
            if (lane == 0) HS[row] = amax * (1.f / 127.f);
        }
    }
}

__device__ void phase0(const Args& a, unsigned char* lds) {
    unsigned char* ws = a.ws;
    const int bid = blockIdx.x, nblk = gridDim.x, tid = threadIdx.x;
    transpose_convert(a.w_in, (bf16_t*)(ws + WS_WIN_T), 1024, 3264, lds, bid, nblk);
    transpose_convert(a.w_q_up, (bf16_t*)(ws + WS_WQUP_T), 384, 768, lds, bid, nblk);
    transpose_convert(a.w_kv_up, (bf16_t*)(ws + WS_WKVUP_T), 256, 1024, lds, bid, nblk);
    transpose_convert(a.w_out, (bf16_t*)(ws + WS_WOUT_T), 1024, 1024, lds, bid, nblk);
    transpose_convert(a.peer_wq, (bf16_t*)(ws + WS_WPQ_T), 1024, 2048, lds, bid, nblk);
    const int gt = bid * NT + tid, ngt = nblk * NT;
    bf16_t* sk = (bf16_t*)(ws + WS_SUBK);
    for (int i = gt; i < 16 * 128 * 128; i += ngt) sk[i] = f2bf(a.subk[i]);
    float* lb = (float*)(ws + WS_LB);
    for (int i = gt; i < 1024; i += ngt) { const float l0 = a.lb_logits[i], l1 = a.lb_logits[1024 + i]; lb[i] = 1.f / (1.f + expf(l1 - l0)); }
    rmsnorm_rows<false>(a.x, a.attn_norm, (bf16_t*)(ws + WS_B), bid * 8 + (tid >> 6), nblk * 8);
}

__device__ void phase1(const Args& a, unsigned char* lds) {
    unsigned char* ws = a.ws;
    const bf16_t* H = (const bf16_t*)(ws + WS_B); const bf16_t* W = (const bf16_t*)(ws + WS_WIN_T);
    g256::EpiBf16Silu e{(bf16_t*)(ws + WS_C), INW, 512};
    for (int i = 0;; ++i) { int pm, pn; if (!g256::next_tile(i * gridDim.x + blockIdx.x, 64, 12, pm, pn)) break;
        __syncthreads();
        g256::tile(H, W, DM, pm * 256, pn * 256, lds, e); }
    __syncthreads();
    EpiBf16<1, 6> e2{(bf16_t*)(ws + WS_C), INW, INW};
    for (int t = blockIdx.x; t < 256; t += gridDim.x)
        gemm_block<4, 2, 1, 6>(H, DM, W, DM, DM, t * 64, 3072, INW, lds, e2);
}

__device__ void phase2(const Args& a) {
    unsigned char* ws = a.ws;
    const bf16_t* PROJ = (const bf16_t*)(ws + WS_C);
    bf16_t* CQN = (bf16_t*)(ws + WS_CQN); bf16_t* CKVN = (bf16_t*)(ws + WS_CKVN); bf16_t* KROPE = (bf16_t*)(ws + WS_KROPE);
    float* ROPECS = (float*)(ws + WS_ROPECS);
    const int lane = threadIdx.x & 63;
    const float2 gq0 = *(const float2*)(a.q_a_norm + lane * 2), gq1 = *(const float2*)(a.q_a_norm + 128 + lane * 2), gq2 = *(const float2*)(a.q_a_norm + 256 + lane * 2);
    const float2 gk0 = *(const float2*)(a.kv_a_norm + lane * 2), gk1 = *(const float2*)(a.kv_a_norm + 128 + lane * 2);
    const float gr = a.k_norm[128 + lane];
    const float invf = ROPE_INV_FREQ[lane & 31];
    const int nw = gridDim.x * 8;
    for (int t0 = blockIdx.x * 8 + (threadIdx.x >> 6); t0 < T; t0 += nw * 4) {
        unsigned wq[4][3], wk[4][2]; float vr[4], ps[4];
#pragma unroll
        for (int u = 0; u < 4; ++u) {
            const int t = min(t0 + u * nw, T - 1);
            const bf16_t* pr = PROJ + (size_t)t * INW;
#pragma unroll
            for (int i = 0; i < 3; ++i) wq[u][i] = *(const unsigned*)(pr + OFF_CQ + i * 128 + lane * 2);
#pragma unroll
            for (int i = 0; i < 2; ++i) wk[u][i] = *(const unsigned*)(pr + OFF_CKV + i * 128 + lane * 2);
            vr[u] = bf2f(pr[OFF_KR + lane]);
            ps[u] = (float)a.pos[t];
        }
        float sq[4], sk[4], sr[4];
#pragma unroll
        for (int u = 0; u < 4; ++u) {
            sq[u] = 0.f; sk[u] = 0.f;
#pragma unroll
            for (int i = 0; i < 3; ++i) { const float x0 = bflo(wq[u][i]), x1 = bfhi(wq[u][i]); sq[u] += x0 * x0 + x1 * x1; }
#pragma unroll
            for (int i = 0; i < 2; ++i) { const float x0 = bflo(wk[u][i]), x1 = bfhi(wk[u][i]); sk[u] += x0 * x0 + x1 * x1; }
            sr[u] = vr[u] * vr[u];
        }
#pragma unroll
        for (int d = 32; d > 0; d >>= 1)
#pragma unroll
            for (int u = 0; u < 4; ++u) { sq[u] += __shfl_xor(sq[u], d, 64); sk[u] += __shfl_xor(sk[u], d, 64); sr[u] += __shfl_xor(sr[u], d, 64); }
#pragma unroll
        for (int u = 0; u < 4; ++u) {
            const int t = t0 + u * nw;
            if (t < T) {
                const float rq = rsqrtf(sq[u] * (1.f / 384.f) + EPS), rk = rsqrtf(sk[u] * (1.f / 256.f) + EPS), rr = rsqrtf(sr[u] * (1.f / 64.f) + EPS);
                bf16_t* cq = CQN + (size_t)t * 384 + lane * 2; bf16_t* ck = CKVN + (size_t)t * 256 + lane * 2;
                *(unsigned*)(cq) = pack2(bflo(wq[u][0]) * rq * gq0.x, bfhi(wq[u][0]) * rq * gq0.y);
                *(unsigned*)(cq + 128) = pack2(bflo(wq[u][1]) * rq * gq1.x, bfhi(wq[u][1]) * rq * gq1.y);
                *(unsigned*)(cq + 256) = pack2(bflo(wq[u][2]) * rq * gq2.x, bfhi(wq[u][2]) * rq * gq2.y);
                *(unsigned*)(ck) = pack2(bflo(wk[u][0]) * rk * gk0.x, bfhi(wk[u][0]) * rk * gk0.y);
                *(unsigned*)(ck + 128) = pack2(bflo(wk[u][1]) * rk * gk1.x, bfhi(wk[u][1]) * rk * gk1.y);
                const float xn = vr[u] * rr * gr;
                const float other = __shfl_xor(xn, 32, 64);
                float sn, cs; sincosf(ps[u] * invf, &sn, &cs);
                const float o = (lane < 32) ? (xn * cs - other * sn) : (xn * cs + other * sn);
                KROPE[(size_t)t * 64 + lane] = f2bf(o);
                if (lane < 32) { *(float2*)(ROPECS + ((size_t)t * 32 + lane) * 2) = make_float2(cs, sn); }
            }
        }
    }
}

__device__ void phase3(const Args& a, unsigned char* lds) {
    unsigned char* ws = a.ws;
    EpiQ eq{(bf16_t*)(ws + WS_Q), a.q_norm, (const float*)(ws + WS_ROPECS)};
    EpiKV<1> ekv{(bf16_t*)(ws + WS_KN), (bf16_t*)(ws + WS_VT), a.k_norm};
    for (int t = blockIdx.x; t < 768; t += gridDim.x) {
        if (t < 256) { const int mt = t >> 2, h = t & 3;
            gemm_block<8, 1, 2, 12>((const bf16_t*)(ws + WS_CQN), 384, (const bf16_t*)(ws + WS_WQUP_T), 384, 384, mt * 256, h * 192, 768, lds, eq);
        } else { const int u = t - 256, mt = u >> 2, h = u & 3;
            gemm_block<8, 1, 1, 16>((const bf16_t*)(ws + WS_CKVN), 256, (const bf16_t*)(ws + WS_WKVUP_T), 256, 256, mt * 128, h * 256, 1024, lds, ekv);
        }
    }
}

constexpr int AT_KROW = 400, AT_VROW = 144, AT_KBYTES = 64 * AT_KROW, AT_VBYTES = 128 * AT_VROW, AT_BUF = AT_KBYTES + AT_VBYTES;
__device__ void attn_item(const Args& a, int item, unsigned char* lds) {
    unsigned char* ws = a.ws;
    const bf16_t* Q = (const bf16_t*)(ws + WS_Q); const bf16_t* KN = (const bf16_t*)(ws + WS_KN);
    const bf16_t* KR = (const bf16_t*)(ws + WS_KROPE); const bf16_t* VT = (const bf16_t*)(ws + WS_VT);
    bf16_t* YCAT = (bf16_t*)(ws + WS_B);
    const int qb = item & 7, h = (item >> 3) & 3, b = item >> 5;
    const int tid = threadIdx.x, lane = tid & 63, wave = tid >> 6, r16 = lane & 15, g = lane >> 4;
    const unsigned kn_off = (unsigned)((((size_t)b * SEQ + (tid >> 4)) * 4 + h) * 128 + (tid & 15) * 8);
    const unsigned kr_off = (unsigned)(((size_t)b * SEQ + (tid >> 3)) * 64 + (tid & 7) * 8);
    const unsigned vt_off = (unsigned)(((size_t)(b * 4 + h) * 128 + (tid >> 3)) * SEQ + (tid & 7) * 8);
    const int kn_dst = (tid >> 4) * AT_KROW + (tid & 15) * 16, kr_dst = (tid >> 3) * AT_KROW + 256 + (tid & 7) * 16;
    const int v_dst = AT_KBYTES + (tid >> 3) * AT_VROW + (tid & 7) * 16;
    bf16x8 qf[2][6];
#pragma unroll
    for (int qs = 0; qs < 2; ++qs) {
        const size_t tq = (size_t)b * SEQ + qb * 256 + wave * 32 + qs * 16 + r16;
#pragma unroll
        for (int kk = 0; kk < 6; ++kk) qf[qs][kk] = *(const bf16x8*)(Q + (tq * 4 + h) * 192 + kk * 32 + 8 * g);
    }
    f32x4 O[2][8];
#pragma unroll
    for (int qs = 0; qs < 2; ++qs)
#pragma unroll
        for (int d = 0; d < 8; ++d) O[qs][d] = (f32x4){0.f, 0.f, 0.f, 0.f};
    float m_run[2] = {0.f, 0.f}, l_part[2] = {0.f, 0.f};
    uint4 sk0, sk1, sk2, sv0, sv1;
#define AT_GLOADK(tile) do { \
        sk0 = *(const uint4*)(KN + kn_off + (size_t)(tile) * (64 * 512)); sk1 = *(const uint4*)(KN + kn_off + 32 * 512 + (size_t)(tile) * (64 * 512)); \
        sk2 = *(const uint4*)(KR + kr_off + (size_t)(tile) * (64 * 64)); } while (0)
#define AT_GLOADV(tile) do { \
        sv0 = *(const uint4*)(VT + vt_off + (size_t)(tile) * 64); sv1 = *(const uint4*)(VT + vt_off + (size_t)64 * SEQ + (size_t)(tile) * 64); } while (0)
#define AT_LSTOREK(buf) do { unsigned char* bb = lds + (buf) * AT_BUF; \
        *(uint4*)(bb + kn_dst) = sk0; *(uint4*)(bb + kn_dst + 32 * AT_KROW) = sk1; *(uint4*)(bb + kr_dst) = sk2; } while (0)
#define AT_LSTOREV(buf) do { unsigned char* bb = lds + (buf) * AT_BUF; \
        *(uint4*)(bb + v_dst) = sv0; *(uint4*)(bb + v_dst + 64 * AT_VROW) = sv1; } while (0)
    __syncthreads();
    AT_GLOADK(0); AT_GLOADV(0);
    AT_LSTOREK(0); AT_LSTOREV(0);
    __syncthreads();
    constexpr int NTILE = SEQ / 64;
    for (int t = 0; t < NTILE; ++t) {
        if (t + 1 < NTILE) AT_GLOADK(t + 1);
        const unsigned char* kb = lds + (t & 1) * AT_BUF;
        const unsigned char* vb = kb + AT_KBYTES;
        f32x4 S[2][4];
#pragma unroll
        for (int qs = 0; qs < 2; ++qs)
#pragma unroll
            for (int j = 0; j < 4; ++j) { const float nm = -m_run[qs]; S[qs][j] = (f32x4){nm, nm, nm, nm}; }
#pragma unroll
        for (int j = 0; j < 4; ++j) {
            const int krow = (j >> 1) * 32 + 8 * (r16 >> 2) + 4 * (j & 1) + (r16 & 3);
#pragma unroll
            for (int kk = 0; kk < 6; ++kk) {
                const bf16x8 kf = *(const bf16x8*)(kb + krow * AT_KROW + kk * 64 + g * 16);
                S[0][j] = mfma16(kf, qf[0][kk], S[0][j]);
                S[1][j] = mfma16(kf, qf[1][kk], S[1][j]);
            }
        }
        if (t + 1 < NTILE) { AT_LSTOREK((t + 1) & 1); AT_GLOADV(t + 1); }
        bf16x8 pf[2][2];
#pragma unroll
        for (int qs = 0; qs < 2; ++qs) {
            float mx = -1e30f;
#pragma unroll
            for (int j = 0; j < 4; ++j) mx = fmaxf(mx, fmaxf(fmaxf(S[qs][j][0], S[qs][j][1]), fmaxf(S[qs][j][2], S[qs][j][3])));
            mx = fmaxf(mx, __shfl_xor(mx, 16, 64)); mx = fmaxf(mx, __shfl_xor(mx, 32, 64));
            if (t == 0 || !__all(mx <= 8.f)) {
                const float delta = (t == 0) ? mx : fmaxf(mx, 0.f);
                m_run[qs] += delta;
#pragma unroll
                for (int j = 0; j < 4; ++j) { S[qs][j][0] -= delta; S[qs][j][1] -= delta; S[qs][j][2] -= delta; S[qs][j][3] -= delta; }
                if (t != 0) {
                    const float alpha = fexp2(-delta);
                    l_part[qs] *= alpha;
#pragma unroll
                    for (int d = 0; d < 8; ++d) O[qs][d] *= alpha;
                }
            }
            float ps = 0.f;
#pragma unroll
            for (int grp = 0; grp < 2; ++grp) {
                float pv[8];
#pragma unroll
                for (int jj = 0; jj < 8; ++jj) { pv[jj] = fexp2(S[qs][grp * 2 + (jj >> 2)][jj & 3]); ps += pv[jj]; }
                union { uint4 u; bf16x8 v; } cv; cv.u = make_uint4(pack2(pv[0], pv[1]), pack2(pv[2], pv[3]), pack2(pv[4], pv[5]), pack2(pv[6], pv[7]));
                pf[qs][grp] = cv.v;
            }
            l_part[qs] += ps;
        }
        __builtin_amdgcn_s_setprio(1);
#pragma unroll
        for (int grp = 0; grp < 2; ++grp)
#pragma unroll
            for (int d = 0; d < 8; ++d) {
                const bf16x8 vf = *(const bf16x8*)(vb + (d * 16 + r16) * AT_VROW + grp * 64 + g * 16);
                O[0][d] = mfma16(vf, pf[0][grp], O[0][d]);
                O[1][d] = mfma16(vf, pf[1][grp], O[1][d]);
            }
        __builtin_amdgcn_s_setprio(0);
        if (t + 1 < NTILE) AT_LSTOREV((t + 1) & 1);
        __syncthreads();
    }
#undef AT_GLOADK
#undef AT_GLOADV
#undef AT_LSTOREK
#undef AT_LSTOREV
#pragma unroll
    for (int qs = 0; qs < 2; ++qs) {
        float l = l_part[qs]; l += __shfl_xor(l, 16, 64); l += __shfl_xor(l, 32, 64);
        const float inv = frcp(l);
        float ss = 0.f;
#pragma unroll
        for (int d = 0; d < 8; ++d) { O[qs][d] *= inv; ss += O[qs][d][0] * O[qs][d][0] + O[qs][d][1] * O[qs][d][1] + O[qs][d][2] * O[qs][d][2] + O[qs][d][3] * O[qs][d][3]; }
        ss += __shfl_xor(ss, 16, 64); ss += __shfl_xor(ss, 32, 64);
        const float rs = rsqrtf(ss * (1.f / 128.f) + EPS);
        const size_t tq = (size_t)b * SEQ + qb * 256 + wave * 32 + qs * 16 + r16;
#pragma unroll
        for (int d = 0; d < 8; ++d) {
            const int dv = d * 16 + 4 * g;
            const f32x4 gn = *(const f32x4*)(a.mla_o_norm + h * 128 + dv);
            uint2 w; w.x = pack2(O[qs][d][0] * rs * gn[0], O[qs][d][1] * rs * gn[1]); w.y = pack2(O[qs][d][2] * rs * gn[2], O[qs][d][3] * rs * gn[3]);
            *(uint2*)(YCAT + tq * DM + 512 + h * 128 + dv) = w;
        }
    }
}

constexpr int HG_E = 0;
constexpr int HG_EL = HG_E + 64 * 132 * 4;
constexpr int HG_QT = HG_EL + 1024;
constexpr int HG_QH = HG_QT + 17408;
constexpr int HG_KD = HG_QH + 17408;
constexpr int HG_K10 = HG_KD + 17408;
constexpr int HG_VT = HG_K10 + 8704;
constexpr int HG_SM = HG_VT + 2 * 9216;
constexpr int HG_STB = HG_SM + 9216;
constexpr int HG_LDS = HG_STB + 2 * 17408;
__device__ void hgrn_item(const Args& a, int item, unsigned char* lds) {
    unsigned char* ws = a.ws;
    const bf16_t* PROJ = (const bf16_t*)(ws + WS_C);
    const float* LB = (const float*)(ws + WS_LB);
    bf16_t* OHG = (bf16_t*)(ws + WS_D);
    const int vs = item & 1, dir = (item >> 1) & 1, h = (item >> 2) & 3, b = item >> 4;
    const int tid = threadIdx.x, lane = tid & 63, wave = tid >> 6, r16 = lane & 15, g = lane >> 4;
    float* E = (float*)(lds + HG_E); float* EL = (float*)(lds + HG_EL);
    bf16_t* Qt = (bf16_t*)(lds + HG_QT); bf16_t* Qh = (bf16_t*)(lds + HG_QH); bf16_t* Kd = (bf16_t*)(lds + HG_KD); bf16_t* K10 = (bf16_t*)(lds + HG_K10);
    bf16_t* vT = (bf16_t*)(lds + HG_VT); bf16_t* Sm = (bf16_t*)(lds + HG_SM); bf16_t* STb = (bf16_t*)(lds + HG_STB);
    const int kB = wave * 16 + r16;
    const float lbk = LB[dir * 512 + h * 128 + kB];
    const int offf = dir ? OFF_FB : OFF_FF;
    const int rowA = tid >> 4, k8A = (tid & 15) * 8;
    const int vrow = tid >> 3, vc8 = (tid & 7) * 8;
    const size_t tokbase = (size_t)b * SEQ;
    __syncthreads();
    for (int i = tid; i < 2 * 64 * 136; i += NT) STb[i] = 0;
    f32x4 accS[4]; accS[0] = (f32x4){0.f, 0.f, 0.f, 0.f}; accS[1] = accS[0]; accS[2] = accS[0]; accS[3] = accS[0];
    unsigned short fB[16]; uint4 qA0, qA1, vA;
#define HG_PREFETCH(n) do { \
        _Pragma("unroll") for (int sc = 0; sc < 2; ++sc) _Pragma("unroll") for (int jj = 0; jj < 8; ++jj) { \
            const int tau = (n) * 64 + sc * 32 + g * 8 + jj, tt = dir ? (SEQ - 1 - tau) : tau; \
            fB[sc * 8 + jj] = PROJ[(tokbase + tt) * INW + offf + h * 128 + kB]; } \
        { const int tau = (n) * 64 + rowA, tt = dir ? (SEQ - 1 - tau) : tau; qA0 = *(const uint4*)(PROJ + (tokbase + tt) * INW + OFF_Q + h * 128 + k8A); } \
        { const int tau = (n) * 64 + rowA + 32, tt = dir ? (SEQ - 1 - tau) : tau; qA1 = *(const uint4*)(PROJ + (tokbase + tt) * INW + OFF_Q + h * 128 + k8A); } \
        { const int tau = (n) * 64 + vrow, tt = dir ? (SEQ - 1 - tau) : tau; vA = *(const uint4*)(PROJ + (tokbase + tt) * INW + OFF_I + h * 128 + vs * 64 + vc8); } \
    } while (0)
    HG_PREFETCH(0);
    for (int n = 0; n < 32; ++n) {
        bf16_t* vTn = vT + (n & 1) * (64 * 72);
        bf16x8 kbf[2];
        {
            float kd[16], ev[16], elast[2];
#pragma unroll
            for (int sc = 0; sc < 2; ++sc) {
                float run = 1.f, runi = 1.f, bb[8], bi[8];
#pragma unroll
                for (int jj = 0; jj < 8; ++jj) {
                    const float u = __expf(-bf2f(fB[sc * 8 + jj]));
                    const float a1 = 1.f + u, a2 = 1.f + lbk * u, r = frcp(a1 * a2);
                    const float f = a2 * a2 * r, fi = a1 * a1 * r;
                    kd[sc * 8 + jj] = 1.f - f;
                    run *= f; bb[jj] = run; runi *= fi; bi[jj] = runi;
                }
                float incl = run, inci = runi;
                { const float t1 = __shfl_up(incl, 16, 64), s1 = __shfl_up(inci, 16, 64); if (g >= 1) { incl *= t1; inci *= s1; } }
                { const float t2 = __shfl_up(incl, 32, 64), s2 = __shfl_up(inci, 32, 64); if (g >= 2) { incl *= t2; inci *= s2; } }
                float excl = __shfl_up(incl, 16, 64), exci = __shfl_up(inci, 16, 64); if (g == 0) { excl = 1.f; exci = 1.f; }
                elast[sc] = __shfl(incl, 48 + r16, 64);
#pragma unroll
                for (int jj = 0; jj < 8; ++jj) {
                    ev[sc * 8 + jj] = bb[jj] * excl;
                    kd[sc * 8 + jj] = kd[sc * 8 + jj] * (bi[jj] * exci);
                }
            }
#pragma unroll
            for (int sc = 0; sc < 2; ++sc)
#pragma unroll
                for (int jj = 0; jj < 8; ++jj) {
                    const int row = sc * 32 + g * 8 + jj;
                    E[row * 132 + kB] = ev[sc * 8 + jj];
                    Kd[row * 136 + kB] = f2bf(kd[sc * 8 + jj]);
                    if (sc == 0) K10[row * 136 + kB] = f2bf(kd[jj] * elast[0]);
                }
            if (g == 3) { EL[kB] = elast[0]; EL[128 + kB] = elast[1]; }
#pragma unroll
            for (int jj = 0; jj < 8; ++jj) { kbf[0][jj] = (short)f2bf(kd[jj] * elast[0] * elast[1]); kbf[1][jj] = (short)f2bf(kd[8 + jj] * elast[1]); }
        }
        {
            const unsigned w4[4] = {vA.x, vA.y, vA.z, vA.w};
#pragma unroll
            for (int q = 0; q < 4; ++q) { vTn[(vc8 + 2 * q) * 72 + vrow] = (bf16_t)(w4[q] & 0xffffu); vTn[(vc8 + 2 * q + 1) * 72 + vrow] = (bf16_t)(w4[q] >> 16); }
        }
        const uint4 qc0 = qA0, qc1 = qA1;
        if (n + 1 < 32) HG_PREFETCH(n + 1);
        __syncthreads();
        {
            const f32x4 d31 = *(const f32x4*)(EL + wave * 16 + 4 * g), d63 = *(const f32x4*)(EL + 128 + wave * 16 + 4 * g);
            const f32x4 dk = d31 * d63;
            bf16_t* stw = STb + (n & 1) * (64 * 136);
#pragma unroll
            for (int vt = 0; vt < 4; ++vt) {
                f32x4 c = accS[vt] * dk;
#pragma unroll
                for (int sc = 0; sc < 2; ++sc) {
                    const bf16x8 vf = *(const bf16x8*)(vTn + (vt * 16 + r16) * 72 + sc * 32 + 8 * g);
                    c = mfma16(kbf[sc], vf, c);
                }
                accS[vt] = c;
                uint2 w; w.x = pack2(c[0], c[1]); w.y = pack2(c[2], c[3]);
                *(uint2*)(stw + (vt * 16 + r16) * 136 + wave * 16 + 4 * g) = w;
            }
        }
        {
            const f32x4 e31a = *(const f32x4*)(EL + k8A), e31b = *(const f32x4*)(EL + k8A + 4);
#pragma unroll
            for (int u = 0; u < 2; ++u) {
                const int row = rowA + u * 32;
                const uint4 qq = u ? qc1 : qc0;
                const f32x4 ea = *(const f32x4*)(E + row * 132 + k8A), eb = *(const f32x4*)(E + row * 132 + k8A + 4);
                const float qr[8] = {bflo(qq.x), bfhi(qq.x), bflo(qq.y), bfhi(qq.y), bflo(qq.z), bfhi(qq.z), bflo(qq.w), bfhi(qq.w)};
                float qt[8], qh[8];
#pragma unroll
                for (int i = 0; i < 8; ++i) {
                    const float qs = qr[i];
                    qt[i] = qs * (i < 4 ? ea[i] : eb[i - 4]);
                    qh[i] = u ? qt[i] * (i < 4 ? e31a[i] : e31b[i - 4]) : qt[i];
                }
                *(uint4*)(Qt + row * 136 + k8A) = make_uint4(pack2(qt[0], qt[1]), pack2(qt[2], qt[3]), pack2(qt[4], qt[5]), pack2(qt[6], qt[7]));
                *(uint4*)(Qh + row * 136 + k8A) = make_uint4(pack2(qh[0], qh[1]), pack2(qh[2], qh[3]), pack2(qh[4], qh[5]), pack2(qh[6], qh[7]));
            }
        }
        __syncthreads();
#pragma unroll
        for (int q2 = 0; q2 < 2; ++q2) {
            const int tix = wave * 2 + q2, ti = tix >> 2, si = tix & 3;
            f32x4 sc = (f32x4){0.f, 0.f, 0.f, 0.f};
            if (si <= ti) {
                const bf16_t* kb = (ti >= 2 && si < 2) ? K10 : Kd;
#pragma unroll
                for (int kk = 0; kk < 4; ++kk) {
                    const bf16x8 af = *(const bf16x8*)(Qt + (ti * 16 + r16) * 136 + kk * 32 + 8 * g);
                    const bf16x8 bfr = *(const bf16x8*)(kb + (si * 16 + r16) * 136 + kk * 32 + 8 * g);
                    sc = mfma16(bfr, af, sc);
                }
                if (si == ti) {
#pragma unroll
                    for (int r = 0; r < 4; ++r) if (4 * g + r > r16) sc[r] = 0.f;
                }
            }
            uint2 w; w.x = pack2(sc[0], sc[1]); w.y = pack2(sc[2], sc[3]);
            *(uint2*)(Sm + (ti * 16 + r16) * 72 + si * 16 + 4 * g) = w;
        }
        __syncthreads();
#pragma unroll
        for (int q2 = 0; q2 < 2; ++q2) {
            const int ti = wave >> 1, vi = (wave & 1) * 2 + q2;
            const bf16_t* stp = STb + ((n + 1) & 1) * (64 * 136);
            f32x4 o = (f32x4){0.f, 0.f, 0.f, 0.f};
#pragma unroll
            for (int kk = 0; kk < 2; ++kk) {
                const bf16x8 af = *(const bf16x8*)(Sm + (ti * 16 + r16) * 72 + kk * 32 + 8 * g);
                const bf16x8 bfr = *(const bf16x8*)(vTn + (vi * 16 + r16) * 72 + kk * 32 + 8 * g);
                o = mfma16(bfr, af, o);
            }
#pragma unroll
            for (int kk = 0; kk < 4; ++kk) {
                const bf16x8 af = *(const bf16x8*)(Qh + (ti * 16 + r16) * 136 + kk * 32 + 8 * g);
                const bf16x8 bfr = *(const bf16x8*)(stp + (vi * 16 + r16) * 136 + kk * 32 + 8 * g);
                o = mfma16(bfr, af, o);
            }
            const int tau = n * 64 + ti * 16 + r16, tt = dir ? (SEQ - 1 - tau) : tau;
            uint2 w; w.x = pack2(o[0], o[1]); w.y = pack2(o[2], o[3]);
            *(uint2*)(OHG + ((size_t)dir * T + tokbase + tt) * 512 + h * 128 + vs * 64 + vi * 16 + 4 * g) = w;
        }
    }
#undef HG_PREFETCH
    __syncthreads();
}

__device__ void phase6(const Args& a) {
    unsigned char* ws = a.ws;
    const bf16_t* OHG = (const bf16_t*)(ws + WS_D); const bf16_t* PROJ = (const bf16_t*)(ws + WS_C);
    bf16_t* YCAT = (bf16_t*)(ws + WS_B);
    const int lane = threadIdx.x & 63;
    for (int t = blockIdx.x * 8 + (threadIdx.x >> 6); t < T; t += gridDim.x * 8) {
        const int c0 = lane * 8;
        const uint4 f = *(const uint4*)(OHG + (size_t)t * 512 + c0), bw = *(const uint4*)(OHG + ((size_t)T + t) * 512 + c0);
        const uint4 gg = *(const uint4*)(PROJ + (size_t)t * INW + OFF_G + c0);
        float o[8];
        o[0] = bflo(f.x) + bflo(bw.x); o[1] = bfhi(f.x) + bfhi(bw.x); o[2] = bflo(f.y) + bflo(bw.y); o[3] = bfhi(f.y) + bfhi(bw.y);
        o[4] = bflo(f.z) + bflo(bw.z); o[5] = bfhi(f.z) + bfhi(bw.z); o[6] = bflo(f.w) + bflo(bw.w); o[7] = bfhi(f.w) + bfhi(bw.w);
        float gr[8] = {bflo(gg.x), bfhi(gg.x), bflo(gg.y), bfhi(gg.y), bflo(gg.z), bfhi(gg.z), bflo(gg.w), bfhi(gg.w)};
        float ss = 0.f;
#pragma unroll
        for (int i = 0; i < 8; ++i) ss += o[i] * o[i];
        ss += __shfl_xor(ss, 1, 64); ss += __shfl_xor(ss, 2, 64); ss += __shfl_xor(ss, 4, 64); ss += __shfl_xor(ss, 8, 64);
        const float rs = rsqrtf(ss * (1.f / 128.f) + EPS);
        float y[8];
#pragma unroll
        for (int i = 0; i < 8; ++i) { const float gt = gr[i] * frcp(1.f + __expf(-gr[i])); y[i] = o[i] * rs * a.hg_o_norm[c0 + i] * gt; }
        *(uint4*)(YCAT + (size_t)t * DM + c0) = make_uint4(pack2(y[0], y[1]), pack2(y[2], y[3]), pack2(y[4], y[5]), pack2(y[6], y[7]));
    }
}

__device__ void phase7(const Args& a, unsigned char* lds) {
    unsigned char* ws = a.ws;
    g256::EpiResid e{a.x, a.out};
    for (int i = 0;; ++i) { int pm, pn; if (!g256::next_tile(i * gridDim.x + blockIdx.x, 64, 4, pm, pn)) break;
        __syncthreads();
        g256::tile((const bf16_t*)(ws + WS_B), (const bf16_t*)(ws + WS_WOUT_T), DM, pm * 256, pn * 256, lds, e); }
    __syncthreads();
    {
        const int lane = threadIdx.x & 63;
        for (int rr = blockIdx.x * 8 + (threadIdx.x >> 6); rr < 32768; rr += gridDim.x * 8) {
            const bool isv = rr >= 16384; const int row = rr & 16383;
            const float* src = (isv ? a.peer_v : a.peer_u) + (size_t)row * DM + lane * 4;
            f32x4 x[4]; float ss = 0.f;
#pragma unroll
            for (int q = 0; q < 4; ++q) { x[q] = *(const f32x4*)(src + q * 256); ss += x[q][0] * x[q][0] + x[q][1] * x[q][1] + x[q][2] * x[q][2] + x[q][3] * x[q][3]; }
            ss = wave_sum(ss);
            const float rms = sqrtf(ss * (1.f / 1024.f));
            if (isv) {
                const float sc = 0.47f * rms, inv = sc > 0.f ? 1.f / sc : 0.f;
                unsigned char* dst = ws + WS_V4 + (size_t)row * 512 + lane * 2;
#pragma unroll
                for (int q = 0; q < 4; ++q) {
                    unsigned pk = 0;
                    pk = __builtin_amdgcn_cvt_scalef32_pk_fp4_f32(pk, fminf(fmaxf(x[q][0] * inv, -6.f), 6.f), fminf(fmaxf(x[q][1] * inv, -6.f), 6.f), 1.0f, 0);
                    pk = __builtin_amdgcn_cvt_scalef32_pk_fp4_f32(pk, fminf(fmaxf(x[q][2] * inv, -6.f), 6.f), fminf(fmaxf(x[q][3] * inv, -6.f), 6.f), 1.0f, 1);
                    *(unsigned short*)(dst + q * 128) = (unsigned short)pk;
                }
                if (lane == 0) ((float*)(ws + WS_VSCALE))[row] = sc;
            } else {
                const float st = 0.36f * rms, inv = st > 0.f ? 1.f / st : 0.f;
                unsigned char* dst = ws + WS_U4 + (size_t)row * 512 + lane * 2;
                int qs = 0;
#pragma unroll
                for (int q = 0; q < 4; ++q) {
                    unsigned hw = 0;
#pragma unroll
                    for (int e = 0; e < 4; ++e) { const int qi = (int)rintf(fminf(fmaxf(x[q][e] * inv, -8.f), 7.f)); qs += qi; hw |= (unsigned)(qi & 15) << (4 * e); }
                    *(unsigned short*)(dst + q * 128) = (unsigned short)hw;
                }
#pragma unroll
                for (int d = 32; d > 0; d >>= 1) qs += __shfl_xor(qs, d, 64);
                if (lane == 0) { ((float*)(ws + WS_USCALE))[row] = st; ((int*)(ws + WS_USUM))[row] = qs; }
            }
        }
    }
}


__device__ __forceinline__ void ce_desc(float& x, float& y) { const float hi = fmaxf(x, y), lo = fminf(x, y); x = hi; y = lo; }
template <int N> __device__ __forceinline__ void bitonic_sort_desc(float (&v)[N]) {
#pragma unroll
    for (int k = 2; k <= N; k <<= 1)
#pragma unroll
        for (int j = k >> 1; j > 0; j >>= 1)
#pragma unroll
            for (int i = 0; i < N; ++i) { const int l = i ^ j; if (l > i) { if ((i & k) == 0) ce_desc(v[i], v[l]); else ce_desc(v[l], v[i]); } }
}
template <int N> __device__ __forceinline__ void bitonic_merge_desc(float (&v)[N]) {
#pragma unroll
    for (int j = N >> 1; j > 0; j >>= 1)
#pragma unroll
        for (int i = 0; i < N; ++i) { const int l = i ^ j; if (l > i) ce_desc(v[i], v[l]); }
}
__device__ __forceinline__ void xlane_merge16(float (&v)[16], int mask) {
    float o[16];
#pragma unroll
    for (int i = 0; i < 16; ++i) o[i] = __shfl_xor(v[15 - i], mask, 64);
#pragma unroll
    for (int i = 0; i < 16; ++i) v[i] = fmaxf(v[i], o[i]);
    bitonic_merge_desc<16>(v);
}
__device__ __forceinline__ unsigned bsel(unsigned m, unsigned x1, unsigned x0) { return x0 ^ ((x1 ^ x0) & m); }
__device__ __forceinline__ float sel16(const float (&v)[16], unsigned i) {
    const unsigned m0 = 0u - (i & 1u), m1 = 0u - ((i >> 1) & 1u), m2 = 0u - ((i >> 2) & 1u), m3 = 0u - ((i >> 3) & 1u);
    unsigned t8[8], t4[4], t2[2];
#pragma unroll
    for (int q = 0; q < 8; ++q) t8[q] = bsel(m0, __float_as_uint(v[2 * q + 1]), __float_as_uint(v[2 * q]));
#pragma unroll
    for (int q = 0; q < 4; ++q) t4[q] = bsel(m1, t8[2 * q + 1], t8[2 * q]);
#pragma unroll
    for (int q = 0; q < 2; ++q) t2[q] = bsel(m2, t4[2 * q + 1], t4[2 * q]);
    return __uint_as_float(bsel(m3, t2[1], t2[0]));
}
__device__ __forceinline__ float sel4(int g, float x0, float x1, float x2, float x3) {
    const unsigned m0 = 0u - ((unsigned)g & 1u), m1 = 0u - (((unsigned)g >> 1) & 1u);
    const unsigned lo = bsel(m0, __float_as_uint(x1), __float_as_uint(x0)), hi = bsel(m0, __float_as_uint(x3), __float_as_uint(x2));
    return __uint_as_float(bsel(m1, hi, lo));
}

static constexpr int PI[52] = {0,0,0,0,0,0,0,0,0,0,0,0,0,0,0,0,1,1,1,1,1,1,1,1,2,2,2,2,2,3,3,3,3,4,4,4,5,5,6,6,7,7,8,9,10,11,12,13,14,15,0,0};
static constexpr int PJ[52] = {0,1,2,3,4,5,6,7,8,9,10,11,12,13,14,15,0,1,2,3,4,5,6,7,0,1,2,3,4,0,1,2,3,0,1,2,0,1,0,1,0,1,0,0,0,0,0,0,0,0,0,0};
constexpr int RT_ROW = 272;
__device__ __forceinline__ void peer_half_top16(const bf16_t* __restrict__ PQ, const unsigned char* __restrict__ skl, int t0, int p, int c, int r16, int g, float (&out)[16]) {
    f32x4 sc[8];
#pragma unroll
    for (int ni = 0; ni < 8; ++ni) sc[ni] = (f32x4){0.f, 0.f, 0.f, 0.f};
    bf16x8 af[4];
#pragma unroll
    for (int kk = 0; kk < 4; ++kk) af[kk] = *(const bf16x8*)(PQ + (size_t)(t0 + r16) * 2048 + p * 256 + c * 128 + kk * 32 + 8 * g);
#pragma unroll
    for (int kk = 0; kk < 4; ++kk) {
        asm volatile("" ::: "memory");
#pragma unroll
        for (int ni = 0; ni < 8; ++ni) {
            const bf16x8 bfr = *(const bf16x8*)(skl + (c * 128 + ni * 16 + r16) * RT_ROW + kk * 64 + 16 * g);
            sc[ni] = mfma16(bfr, af[kk], sc[ni]);
        }
    }
    float hi[16];
#pragma unroll
    for (int ni = 0; ni < 4; ++ni)
#pragma unroll
        for (int r = 0; r < 4; ++r) {
            out[ni * 4 + r] = __uint_as_float((__float_as_uint(sc[ni][r]) & 0xffffff80u) | (unsigned)(ni * 16 + 4 * g + r));
            hi[ni * 4 + r] = __uint_as_float((__float_as_uint(sc[ni + 4][r]) & 0xffffff80u) | (unsigned)((ni + 4) * 16 + 4 * g + r));
        }
    bitonic_sort_desc<16>(out);
    bitonic_sort_desc<16>(hi);
#pragma unroll
    for (int i = 0; i < 16; ++i) out[i] = fmaxf(out[i], hi[15 - i]);
    bitonic_merge_desc<16>(out);
    xlane_merge16(out, 16);
    xlane_merge16(out, 32);
}
__device__ __forceinline__ void peer_route_finish(const Args& a, int p, int t0, const float (&ab0)[16], const float (&ab1)[16]) {
    unsigned char* ws = a.ws;
    int* IDX = (int*)(ws + WS_IDX); float* GATE = (float*)(ws + WS_GATE);
    int tix_ = threadIdx.x; asm volatile("" : "+v"(tix_));
    const int lane = tix_ & 63, r16 = lane & 15, g = lane >> 4;
    float va[16], vb[16];
#pragma unroll
    for (int i = 0; i < 16; ++i) { va[i] = __uint_as_float(__float_as_uint(ab0[i]) & 0xffffff80u); vb[i] = __uint_as_float(__float_as_uint(ab1[i]) & 0xffffff80u); }
    float v[16];
#pragma unroll
    for (int s = 0; s < 13; ++s) {
        const float x0 = __uint_as_float((__float_as_uint(va[PI[4 * s]] + vb[PJ[4 * s]]) & 0xffffff00u) | (unsigned)(PI[4 * s] * 16 + PJ[4 * s]));
        const float x1 = __uint_as_float((__float_as_uint(va[PI[4 * s + 1]] + vb[PJ[4 * s + 1]]) & 0xffffff00u) | (unsigned)(PI[4 * s + 1] * 16 + PJ[4 * s + 1]));
        const float x2 = (4 * s + 2 < 50) ? __uint_as_float((__float_as_uint(va[PI[4 * s + 2]] + vb[PJ[4 * s + 2]]) & 0xffffff00u) | (unsigned)(PI[4 * s + 2] * 16 + PJ[4 * s + 2])) : -3.0e38f;
        const float x3 = (4 * s + 3 < 50) ? __uint_as_float((__float_as_uint(va[PI[4 * s + 3]] + vb[PJ[4 * s + 3]]) & 0xffffff00u) | (unsigned)(PI[4 * s + 3] * 16 + PJ[4 * s + 3])) : -3.0e38f;
        v[s] = sel4(g, x0, x1, x2, x3);
    }
    v[13] = -3.0e38f; v[14] = -3.0e38f; v[15] = -3.0e38f;
    bitonic_sort_desc<16>(v);
    xlane_merge16(v, 16);
    xlane_merge16(v, 32);
    float e[16], sum = 0.f;
    const float mtop = __uint_as_float(__float_as_uint(v[0]) & 0xffffff00u);
#pragma unroll
    for (int q = 0; q < 16; ++q) { e[q] = __expf(__uint_as_float(__float_as_uint(v[q]) & 0xffffff00u) - mtop); sum += e[q]; }
    const float inv = 1.f / sum;
    int oi[4]; float og[4];
#pragma unroll
    for (int r = 0; r < 4; ++r) {
        const unsigned key = __float_as_uint(sel4(g, v[r], v[4 + r], v[8 + r], v[12 + r]));
        const unsigned pos = key & 255u;
        const unsigned ia = __float_as_uint(sel16(ab0, pos >> 4)) & 127u, ib = __float_as_uint(sel16(ab1, pos & 15u)) & 127u;
        oi[r] = (int)(ia * 128u + ib);
        og[r] = sel4(g, e[r], e[4 + r], e[8 + r], e[12 + r]) * inv;
    }
    const size_t o = (size_t)(t0 + r16) * 128 + p * 16 + 4 * g;
    *(int4*)(IDX + o) = make_int4(oi[0], oi[1], oi[2], oi[3]);
    *(f32x4*)(GATE + o) = (f32x4){og[0], og[1], og[2], og[3]};
}

__device__ __forceinline__ float dpp_xor1(float v) { return __builtin_bit_cast(float, __builtin_amdgcn_mov_dpp(__builtin_bit_cast(int, v), 0xB1, 0xF, 0xF, true)); }
__device__ __forceinline__ float dpp_xor2(float v) { return __builtin_bit_cast(float, __builtin_amdgcn_mov_dpp(__builtin_bit_cast(int, v), 0x4E, 0xF, 0xF, true)); }
__device__ __forceinline__ float dpp_hmirror(float v) { return __builtin_bit_cast(float, __builtin_amdgcn_mov_dpp(__builtin_bit_cast(int, v), 0x141, 0xF, 0xF, true)); }


constexpr int PU_ROW = 272;
__device__ __forceinline__ float dot2bf(unsigned x, unsigned y, float acc) { return __builtin_amdgcn_fdot2_f32_bf16(__builtin_bit_cast(bf16v2, x), __builtin_bit_cast(bf16v2, y), acc, false); }


__device__ __forceinline__ void peer_half_top16_lds(const unsigned char* __restrict__ qs, const unsigned char* __restrict__ skl, int r16, int g, float (&out)[16]) {
    f32x4 sc[8];
#pragma unroll
    for (int ni = 0; ni < 8; ++ni) sc[ni] = (f32x4){0.f, 0.f, 0.f, 0.f};
#pragma unroll
    for (int kk = 0; kk < 4; ++kk) {
        asm volatile("" ::: "memory");
        const bf16x8 af = *(const bf16x8*)(qs + r16 * RT_ROW + kk * 64 + 16 * g);
#pragma unroll
        for (int ni = 0; ni < 8; ++ni) {
            const bf16x8 bfr = *(const bf16x8*)(skl + (ni * 16 + r16) * RT_ROW + kk * 64 + 16 * g);
            sc[ni] = mfma16(bfr, af, sc[ni]);
        }
    }
    float hi[16];
#pragma unroll
    for (int ni = 0; ni < 4; ++ni)
#pragma unroll
        for (int r = 0; r < 4; ++r) {
            out[ni * 4 + r] = __uint_as_float((__float_as_uint(sc[ni][r]) & 0xffffff80u) | (unsigned)(ni * 16 + 4 * g + r));
            hi[ni * 4 + r] = __uint_as_float((__float_as_uint(sc[ni + 4][r]) & 0xffffff80u) | (unsigned)((ni + 4) * 16 + 4 * g + r));
        }
    bitonic_sort_desc<16>(out);
    bitonic_sort_desc<16>(hi);
#pragma unroll
    for (int i = 0; i < 16; ++i) out[i] = fmaxf(out[i], hi[15 - i]);
    bitonic_merge_desc<16>(out);
    xlane_merge16(out, 16);
    xlane_merge16(out, 32);
}
struct EpiRoute { const Args* ap; unsigned char* lds; int p; int brow;
    __device__ __forceinline__ void operator()(const f32x4 (&acc)[2][2][4][2], int row0, int col0) const {
        int tix = threadIdx.x; asm volatile("" : "+v"(tix));
        const int lane = tix & 63, wave = tix >> 6, r16 = lane & 15, g = lane >> 4;
        unsigned char* qs = lds;
        unsigned char* skl = lds + 256 * RT_ROW;
        const int rl0 = row0 - brow, cl0 = (col0 - p * 256);
        float* tl = (float*)(lds + 384 * RT_ROW);
#pragma unroll 1
        for (int c = 0; c < 2; ++c) {
            __syncthreads();
#pragma unroll
            for (int ai = 0; ai < 2; ++ai)
#pragma unroll
                for (int m = 0; m < 4; ++m)
#pragma unroll
                    for (int n = 0; n < 2; ++n) { const f32x4 v = c ? acc[ai][1][m][n] : acc[ai][0][m][n]; uint2 w; w.x = pack2(v[0], v[1]); w.y = pack2(v[2], v[3]);
                        *(uint2*)(qs + (rl0 + ai * 128 + m * 16) * RT_ROW + (cl0 + n * 16) * 2) = w; }
            { const bf16_t* SK = (const bf16_t*)(ap->ws + WS_SUBK) + ((size_t)p * 2 + c) * 128 * 128;
              for (int ch = tix; ch < 128 * 16; ch += NT) { const int row = ch >> 4, q = ch & 15; *(uint4*)(skl + row * RT_ROW + q * 16) = *(const uint4*)(SK + row * 128 + q * 8); } }
            __syncthreads();
#pragma unroll 1
            for (int k = 0; k < 2; ++k) {
                float lst[16];
                peer_half_top16_lds(qs + ((wave * 2 + k) * 16) * RT_ROW, skl, r16, g, lst);
                if (g == 0) { float* d = tl + (((wave * 2 + k) * 16 + r16) * 2 + c) * 16;
#pragma unroll
                    for (int q = 0; q < 4; ++q) *(f32x4*)(d + q * 4) = (f32x4){lst[q * 4], lst[q * 4 + 1], lst[q * 4 + 2], lst[q * 4 + 3]}; }
            }
        }
        __syncthreads();
#pragma unroll 1
        for (int k = 0; k < 2; ++k) {
            float ab0[16], ab1[16];
            const float* d = tl + (((wave * 2 + k) * 16 + r16) * 2) * 16;
#pragma unroll
            for (int q = 0; q < 4; ++q) { const f32x4 x0 = *(const f32x4*)(d + q * 4), x1 = *(const f32x4*)(d + 16 + q * 4);
                ab0[q * 4] = x0[0]; ab0[q * 4 + 1] = x0[1]; ab0[q * 4 + 2] = x0[2]; ab0[q * 4 + 3] = x0[3]; ab1[q * 4] = x1[0]; ab1[q * 4 + 1] = x1[1]; ab1[q * 4 + 2] = x1[2]; ab1[q * 4 + 3] = x1[3]; }
            peer_route_finish(*ap, p, brow + (wave * 2 + k) * 16, ab0, ab1);
        }
    }
};

__device__ void phase9_fused(const Args& a, unsigned char* lds) {
    unsigned char* ws = a.ws;
    for (int i = 0;; ++i) { int pm, pn; if (!g256::next_tile(i * gridDim.x + blockIdx.x, 64, 8, pm, pn)) break;
        EpiRoute e{&a, lds, pn, pm * 256};
        __syncthreads();
        g256::tile((const bf16_t*)(ws + WS_B), (const bf16_t*)(ws + WS_WPQ_T), DM, pm * 256, pn * 256, lds, e); }
    __syncthreads();
}

__device__ __forceinline__ int idpp_xor1(int v) { return __builtin_amdgcn_mov_dpp(v, 0xB1, 0xF, 0xF, true); }
__device__ __forceinline__ int idpp_xor2(int v) { return __builtin_amdgcn_mov_dpp(v, 0x4E, 0xF, 0xF, true); }
__device__ __forceinline__ int idpp_hmirror(int v) { return __builtin_amdgcn_mov_dpp(v, 0x141, 0xF, 0xF, true); }

__device__ void peer_uv_phase(const Args& a, unsigned char* lds) {
    unsigned char* ws = a.ws;
    const unsigned char* H4 = ws + WS_H4; const unsigned char* U4 = ws + WS_U4; const unsigned char* V4 = ws + WS_V4;
    const unsigned* IDX = (const unsigned*)(ws + WS_IDX); const float* GATE = (const float*)(ws + WS_GATE);
    const float* VS = (const float*)(ws + WS_VSCALE); const float* US = (const float*)(ws + WS_USCALE);
    const int* USUM = (const int*)(ws + WS_USUM); const float* HS = (const float*)(ws + WS_HS);
    const int wv = __builtin_amdgcn_readfirstlane((int)(threadIdx.x >> 6));
    unsigned char* wl = lds + wv * 6528;
    unsigned char* il = wl + 8 * 272;
    for (int item = blockIdx.x * 8 + wv; item < 2048; item += gridDim.x * 8) {
    const int tpbase = ((item >> 3) & 7) * 1024 + (item >> 6) * 8 + (item & 7);
    {
    int tix = threadIdx.x; asm volatile("" : "+v"(tix));
    const int lane = tix & 63, m = lane & 7, j = lane >> 3;
    const size_t tp0 = (size_t)tpbase;
    int acc[4][2][2];
#pragma unroll
    for (int k = 0; k < 4; ++k) { acc[k][0][0] = 0; acc[k][0][1] = 0; acc[k][1][0] = 0; acc[k][1][1] = 0; }
#pragma unroll 1
    for (int sl = 0; sl < 4; ++sl) {
        const unsigned uoff = (unsigned)(sl * 128 + 16 * m);
#pragma unroll
        for (int k = 0; k < 4; ++k) {
            const size_t tp = tp0 + 256 * k;
            uint4 ha[2], hb[2]; uint4 iq[2][4];
#pragma unroll
            for (int tt = 0; tt < 2; ++tt) {
                const size_t t = tp * 2 + tt;
                ha[tt] = *(const uint4*)(H4 + t * 1024 + sl * 256 + m * 32); hb[tt] = *(const uint4*)(H4 + t * 1024 + sl * 256 + m * 32 + 16);
#pragma unroll
                for (int q = 0; q < 4; ++q) iq[tt][q] = *(const uint4*)(IDX + t * 128 + j * 16 + q * 4);
            }
            uint4 uq[2][16];
#pragma unroll
            for (int tt = 0; tt < 2; ++tt)
#pragma unroll
                for (int q = 0; q < 4; ++q) {
                    uq[tt][q * 4] = *(const uint4*)(U4 + (iq[tt][q].x * 512u + uoff)); uq[tt][q * 4 + 1] = *(const uint4*)(U4 + (iq[tt][q].y * 512u + uoff));
                    uq[tt][q * 4 + 2] = *(const uint4*)(U4 + (iq[tt][q].z * 512u + uoff)); uq[tt][q * 4 + 3] = *(const uint4*)(U4 + (iq[tt][q].w * 512u + uoff));
                }
#pragma unroll
            for (int tt = 0; tt < 2; ++tt) {
                const int haw[4] = {(int)ha[tt].x, (int)ha[tt].y, (int)ha[tt].z, (int)ha[tt].w};
                const int hbw[4] = {(int)hb[tt].x, (int)hb[tt].y, (int)hb[tt].z, (int)hb[tt].w};
                int val0 = 0, val1 = 0;
#pragma unroll
                for (int it = 0; it < 16; ++it) {
                    int wd[4] = {(int)uq[tt][it].x, (int)uq[tt][it].y, (int)uq[tt][it].z, (int)uq[tt][it].w};
                    asm volatile("" : "+v"(wd[0]), "+v"(wd[1]), "+v"(wd[2]), "+v"(wd[3]), "+v"(val0), "+v"(val1));
                    int dh = 0, dl = 0;
#pragma unroll
                    for (int q = 0; q < 4; ++q) { dh = __builtin_amdgcn_sdot8(haw[q], wd[q], dh, false); dl = __builtin_amdgcn_sdot8(hbw[q], wd[q], dl, false); }
                    int d = (dh << 4) + dl;
                    d += idpp_xor1(d); d += idpp_xor2(d); d += idpp_hmirror(d);
                    if ((it >> 1) == m) { if (it & 1) val1 = d; else val0 = d; }
                }
                acc[k][tt][0] += val0; acc[k][tt][1] += val1;
            }
        }
    }
#pragma unroll
    for (int k = 0; k < 4; ++k)
#pragma unroll
        for (int tt = 0; tt < 2; ++tt) {
            const size_t t = (tp0 + 256 * k) * 2 + tt; const size_t o = t * 128 + j * 16 + 2 * m;
            const float2 gt = *(const float2*)(GATE + o); const uint2 id = *(const uint2*)(IDX + o);
            const float hs = HS[t];
            const float x0 = (float)(acc[k][tt][0] + 8 * USUM[id.x]) * (hs * US[id.x]), x1 = (float)(acc[k][tt][1] + 8 * USUM[id.y]) * (hs * US[id.y]);
            const float w0 = gt.x * 0.5f * x0 * (1.f + erff(x0 * 0.70710678118654752f)) * VS[id.x];
            const float w1 = gt.y * 0.5f * x1 * (1.f + erff(x1 * 0.70710678118654752f)) * VS[id.y];
            *(unsigned*)(wl + (2 * k + tt) * 272 + (j * 16 + 2 * m) * 2) = pack2h(w0, w1);
            *(uint2*)(il + (2 * k + tt) * 528 + (j * 16 + 2 * m) * 4) = id;
        }
    }
    int tix2 = threadIdx.x; asm volatile("" : "+v"(tix2));
    const int m2 = tix2 & 7, j2 = (tix2 >> 3) & 7;
    const unsigned tv = (unsigned)((tpbase + 256 * (j2 >> 1)) * 2 + (j2 & 1));
    const unsigned char* wrow = wl + j2 * 272; const unsigned char* irow = il + j2 * 528;
#pragma unroll 1
    for (int sl = 0; sl < 4; ++sl) {
        const unsigned voff = (unsigned)(sl * 128 + 16 * m2);
        float y[32];
#pragma unroll
        for (int i = 0; i < 32; ++i) y[i] = 0.f;
#pragma unroll 1
        for (int grp = 0; grp < 4; ++grp) {
            uint4 wq[4];
            uint4 vq[32];
#pragma unroll
            for (int q = 0; q < 8; ++q) {
                const uint4 i4 = *(const uint4*)(irow + grp * 128 + q * 16);
                vq[q * 4] = *(const uint4*)(V4 + (i4.x * 512u + voff)); vq[q * 4 + 1] = *(const uint4*)(V4 + (i4.y * 512u + voff));
                vq[q * 4 + 2] = *(const uint4*)(V4 + (i4.z * 512u + voff)); vq[q * 4 + 3] = *(const uint4*)(V4 + (i4.w * 512u + voff));
            }
#pragma unroll
            for (int q = 0; q < 4; ++q) wq[q] = *(const uint4*)(wrow + grp * 64 + q * 16);
#pragma unroll
            for (int it = 0; it < 32; ++it) {
                const uint4 wv4 = wq[it >> 3]; const int wc_ = (it >> 1) & 3;
                const unsigned wword = wc_ == 0 ? wv4.x : (wc_ == 1 ? wv4.y : (wc_ == 2 ? wv4.z : wv4.w));
                const f16v2 wp = __builtin_bit_cast(f16v2, wword);
                const float wt = (float)((it & 1) ? wp[1] : wp[0]);
                unsigned wd0 = vq[it].x, wd1 = vq[it].y, wd2 = vq[it].z, wd3 = vq[it].w;
                asm volatile("" : "+v"(wd0), "+v"(wd1), "+v"(wd2), "+v"(wd3), "+v"(y[0]));
                const unsigned wd[4] = {wd0, wd1, wd2, wd3};
#pragma unroll
                for (int q = 0; q < 4; ++q) {
                    const f32v2 p0 = __builtin_amdgcn_cvt_scalef32_pk_f32_fp4(wd[q], 1.0f, 0), p1 = __builtin_amdgcn_cvt_scalef32_pk_f32_fp4(wd[q], 1.0f, 1);
                    const f32v2 p2 = __builtin_amdgcn_cvt_scalef32_pk_f32_fp4(wd[q], 1.0f, 2), p3 = __builtin_amdgcn_cvt_scalef32_pk_f32_fp4(wd[q], 1.0f, 3);
                    y[q * 8] += wt * p0[0]; y[q * 8 + 1] += wt * p0[1]; y[q * 8 + 2] += wt * p1[0]; y[q * 8 + 3] += wt * p1[1];
                    y[q * 8 + 4] += wt * p2[0]; y[q * 8 + 5] += wt * p2[1]; y[q * 8 + 6] += wt * p3[0]; y[q * 8 + 7] += wt * p3[1];
                }
            }
        }
        float* orow = a.out + (tv * (unsigned)DM + (unsigned)(sl * 256 + 32 * m2));
#pragma unroll
        for (int q = 0; q < 8; ++q) {
            f32x4 o = *(const f32x4*)(orow + q * 4);
            o[0] += y[q * 4]; o[1] += y[q * 4 + 1]; o[2] += y[q * 4 + 2]; o[3] += y[q * 4 + 3];
            *(f32x4*)(orow + q * 4) = o;
        }
    }
    }
}

#define XB_TMO      128
#define XB_XCNT(j)  (256  + 64 * (j))
#define XB_XSUB(j)  (1280 + 64 * (j))
#define XB_XGEN(j)  (2304 + 64 * (j))
#define XB_TOP      3328
#define XB_TOPGEN   3392
#define XCD_BAR_WORDS 3456
#define XB_SPIN_CAP (1u << 22)
#define LAS __attribute__((address_space(3)))
__device__ __forceinline__ unsigned xb_ld(unsigned* p)              { return __hip_atomic_load(p, __ATOMIC_RELAXED, __HIP_MEMORY_SCOPE_AGENT); }
__device__ __forceinline__ unsigned xb_add(unsigned* p, unsigned v) { return __hip_atomic_fetch_add(p, v, __ATOMIC_RELAXED, __HIP_MEMORY_SCOPE_AGENT); }
__device__ __forceinline__ unsigned xb_xcc_id() { return (unsigned)__builtin_amdgcn_s_getreg((3 << 11) | 20) & 0xFu; }
#define XB_SPIN(cond, bar) do { unsigned _sp = 0; while (cond) { __builtin_amdgcn_s_sleep(1); \
    if ((++_sp & 255u) == 0u) { if (xb_ld(&(bar)[XB_TMO])) break; if (_sp > XB_SPIN_CAP) { atomicAdd(&(bar)[XB_TMO], 1u); break; } } } } while (0)
struct XcdBarrier { unsigned* bar; unsigned x; volatile LAS unsigned* st; };
__device__ __forceinline__ XcdBarrier xcd_barrier_post(unsigned* bar, volatile LAS unsigned* st) {
    XcdBarrier b; b.bar = bar; b.x = xb_xcc_id(); b.st = st;
    if (threadIdx.x == 0) (void)xb_add(&bar[XB_XCNT(b.x)], 1u);
    return b;
}
__device__ __forceinline__ void xcd_barrier_complete(unsigned* bar, unsigned x, unsigned& nloc, unsigned& nx) {
    const unsigned G = gridDim.x * gridDim.y * gridDim.z;
    unsigned sum, cnt, mine, sp = 0u;
    for (;;) {
        sum = 0u; cnt = 0u; mine = 0u;
#pragma unroll
        for (unsigned j = 0; j < 16; ++j) { const unsigned c = xb_ld(&bar[XB_XCNT(j)]); sum += c; cnt += (c > 0u) ? 1u : 0u; mine = (j == x) ? c : mine; }
        if (sum == G) break;
        __builtin_amdgcn_s_sleep(1);
        if ((++sp & 255u) == 0u) { if (xb_ld(&bar[XB_TMO])) break; if (sp > XB_SPIN_CAP) { atomicAdd(&bar[XB_TMO], 1u); break; } }
    }
    nloc = mine > 0u ? mine : 1u; nx = cnt > 0u ? cnt : 1u;
}
__device__ __forceinline__ void xcd_barrier(const XcdBarrier& b) {
    asm volatile("s_waitcnt vmcnt(0)" ::: "memory");
    __syncthreads();
    if (threadIdx.x == 0) {
        unsigned* bar = b.bar;
        __builtin_amdgcn_s_waitcnt(0);
        unsigned nloc = b.st[0], nx = b.st[1];
        if (nloc == 0u) { xcd_barrier_complete(bar, b.x, nloc, nx); b.st[0] = nloc; b.st[1] = nx; }
        const unsigned old = xb_add(&bar[XB_XSUB(b.x)], 1u);
        const unsigned gen = old / nloc;
        if (old + 1u == (gen + 1u) * nloc) {
            __builtin_amdgcn_fence(__ATOMIC_RELEASE, "agent");
            asm volatile("s_waitcnt vmcnt(0)" ::: "memory");
            const unsigned og = xb_add(&bar[XB_TOP], 1u);
            const unsigned tg = og / nx;
            if (og + 1u == (tg + 1u) * nx) xb_add(&bar[XB_TOPGEN], 1u);
            else XB_SPIN(xb_ld(&bar[XB_TOPGEN]) == tg, bar);
            __builtin_amdgcn_fence(__ATOMIC_ACQUIRE, "agent");
            xb_add(&bar[XB_XGEN(b.x)], 1u);
            asm volatile("s_waitcnt vmcnt(0)" ::: "memory");
        } else {
            XB_SPIN(xb_ld(&bar[XB_XGEN(b.x)]) == gen, bar);
            __builtin_amdgcn_fence(__ATOMIC_ACQUIRE, "agent");
            asm volatile("s_waitcnt vmcnt(0)" ::: "memory");
        }
    }
    __syncthreads();
}

constexpr int LDS_MAIN = HG_LDS;
static_assert(LDS_MAIN >= 512 * PU_ROW && LDS_MAIN >= 2 * AT_BUF && LDS_MAIN >= 131072, "LDS_MAIN");
constexpr int LDS_BYTES = LDS_MAIN + 16;
constexpr int N_PHASES = 14;

__global__ void __launch_bounds__(NT, 2) fwd_kernel(Args a) {
    extern __shared__ __attribute__((aligned(16))) unsigned char lds[];
#if N_LAUNCH_MODE == 1
#ifdef USE_CG_SYNC
    cg::grid_group grid = cg::this_grid();
#endif
    volatile LAS unsigned* xst = (volatile LAS unsigned*)(lds + LDS_MAIN);
    if (threadIdx.x < 4) xst[threadIdx.x] = 0u;
    __syncthreads();
    XcdBarrier xbar = xcd_barrier_post((unsigned*)(a.ws + WS_CTL), xst);
#ifdef USE_CG_SYNC
#define SEAM(k) do { if (a.ph_lo <= (k) && (k) + 1 < a.ph_hi) { if ((k) == 0) grid.sync(); else xcd_barrier(xbar); } } while (0)
#else
#define SEAM(k) do { if (a.ph_lo <= (k) && (k) + 1 < a.ph_hi) { xcd_barrier(xbar); } } while (0)
#endif
#else
#define SEAM(k) do { } while (0)
#endif
#define IN(k) (a.ph_lo <= (k) && (k) < a.ph_hi)
#define REPS(k) for (int rep_ = 0; rep_ < ((k) == REPEAT_PHASE ? 2 : 1); ++rep_)
    if (IN(0)) REPS(0) { phase0(a, lds); } SEAM(0);
    if (IN(1)) REPS(1) { phase1(a, lds); } SEAM(1);
    if (IN(2)) REPS(2) { phase2(a); } SEAM(2);
    if (IN(3)) REPS(3) { phase3(a, lds); } SEAM(3);
    if (IN(4)) REPS(4) {
        const int nhalf = gridDim.x >> 1;
        if ((int)blockIdx.x < nhalf) { for (int it = blockIdx.x; it < 256; it += nhalf) attn_item(a, it, lds); }
        else { for (int it = blockIdx.x - nhalf; it < 128; it += gridDim.x - nhalf) hgrn_item(a, it, lds); }
    } SEAM(5);
    if (IN(6)) REPS(6) { phase6(a); } SEAM(6);
    if (IN(7)) REPS(7) { phase7(a, lds); } SEAM(7);
    if (IN(8)) REPS(8) { rmsnorm_rows<true>(a.out, a.ffn_norm, (bf16_t*)(a.ws + WS_B), blockIdx.x * 8 + (threadIdx.x >> 6), gridDim.x * 8, a.ws + WS_H4, (float*)(a.ws + WS_HS)); } SEAM(8);
    if (IN(9)) REPS(9) { phase9_fused(a, lds); } SEAM(10);
    if (IN(11)) { __syncthreads(); peer_uv_phase(a, lds); }
}

extern "C" void kernel_launch(void* const* d_in, const int* in_sizes, int n_in, void* d_out, int out_size, void* d_ws, size_t ws_size, hipStream_t stream) {
    static int grid = 0;
    if (grid == 0) {
        if (n_in != 19 || out_size != T * DM || ws_size < WS_END) { fprintf(stderr, "kernel_launch: unexpected shapes (n_in %d out %d ws %zu)\n", n_in, out_size, ws_size); grid = -1; return; }
        int dev = 0, cus = 0, per_cu = 0;
        (void)hipGetDevice(&dev); (void)hipDeviceGetAttribute(&cus, hipDeviceAttributeMultiprocessorCount, dev);
        (void)hipFuncSetAttribute((const void*)fwd_kernel, hipFuncAttributeMaxDynamicSharedMemorySize, LDS_BYTES);
        (void)hipOccupancyMaxActiveBlocksPerMultiprocessor(&per_cu, (const void*)fwd_kernel, NT, LDS_BYTES);
        if (per_cu < 1) { fprintf(stderr, "kernel_launch: occupancy query says %d blocks/CU\n", per_cu); per_cu = 1; }
        grid = cus;
        (void)hipGetLastError();
    }
    if (grid < 0) return;
    Args a{};
    a.x = (const float*)d_in[0]; a.pos = (const int*)d_in[1]; a.attn_norm = (const float*)d_in[2]; a.w_in = (const float*)d_in[3];
    a.lb_logits = (const float*)d_in[4]; a.hg_o_norm = (const float*)d_in[5]; a.q_a_norm = (const float*)d_in[6]; a.w_q_up = (const float*)d_in[7];
    a.kv_a_norm = (const float*)d_in[8]; a.w_kv_up = (const float*)d_in[9]; a.q_norm = (const float*)d_in[10]; a.k_norm = (const float*)d_in[11];
    a.mla_o_norm = (const float*)d_in[12]; a.w_out = (const float*)d_in[13]; a.ffn_norm = (const float*)d_in[14]; a.peer_wq = (const float*)d_in[15];
    a.subk = (const float*)d_in[16]; a.peer_u = (const float*)d_in[17]; a.peer_v = (const float*)d_in[18];
    a.out = (float*)d_out; a.ws = (unsigned char*)d_ws;
    const int last = (STOP_AFTER < N_PHASES - 1) ? STOP_AFTER : N_PHASES - 1;
#if N_LAUNCH_MODE == 1
    (void)hipMemsetAsync((unsigned char*)d_ws + WS_CTL, 0, 16384, stream);
    a.ph_lo = 0; a.ph_hi = last + 1;
#ifdef USE_CG_SYNC
    void* args[] = {&a};
    hipError_t e = hipLaunchCooperativeKernel((const void*)fwd_kernel, dim3(grid), dim3(NT), args, LDS_BYTES, stream);
    if (e != hipSuccess) fprintf(stderr, "cooperative launch failed: %s (grid %d)\n", hipGetErrorString(e), grid);
#else
    hipLaunchKernelGGL(fwd_kernel, dim3(grid), dim3(NT), LDS_BYTES, stream, a);
#endif
#else
    for (int ph = 0; ph <= last; ++ph) {
        a.ph_lo = ph; a.ph_hi = ph + 1;
        hipLaunchKernelGGL(fwd_kernel, dim3(grid), dim3(NT), LDS_BYTES, stream, a);
    }
#endif
}
```

```cpp
#include <hip/hip_runtime.h>
#include <hip/hip_cooperative_groups.h>
#include <cstdio>
#include <cstdint>
namespace cg = cooperative_groups;

#ifndef N_LAUNCH_MODE
#define N_LAUNCH_MODE 1
#endif
#ifndef REPEAT_PHASE
#define REPEAT_PHASE -1
#endif
#ifndef ATT_REP
#define ATT_REP 1
#endif
#ifndef HG_REP
#define HG_REP 1
#endif
#ifndef STOP_AFTER
#define STOP_AFTER 99
#endif

typedef unsigned short bf16_t;
typedef short bf16x8 __attribute__((ext_vector_type(8)));
typedef float f32x4 __attribute__((ext_vector_type(4)));

constexpr int NT = 512;
constexpr int T = 16384, SEQ = 2048, NB = 8, DM = 1024, INW = 3264;
constexpr int OFF_Q = 0, OFF_FF = 512, OFF_FB = 1024, OFF_I = 1536, OFF_G = 2048, OFF_CQ = 2560, OFF_CKV = 2944, OFF_KR = 3200;
constexpr float EPS = 1e-6f;

constexpr size_t WS_CTL = 0;
constexpr size_t WS_WIN_T = 65536;
constexpr size_t WS_WQUP_T = WS_WIN_T + (size_t)3264 * 1024 * 2;
constexpr size_t WS_WKVUP_T = WS_WQUP_T + (size_t)768 * 384 * 2;
constexpr size_t WS_WOUT_T = WS_WKVUP_T + (size_t)1024 * 256 * 2;
constexpr size_t WS_WPQ_T = WS_WOUT_T + (size_t)1024 * 1024 * 2;
constexpr size_t WS_SUBK = WS_WPQ_T + (size_t)2048 * 1024 * 2;
constexpr size_t WS_LB = WS_SUBK + (size_t)16 * 128 * 128 * 2;
constexpr size_t WS_B = 15728640;
constexpr size_t WS_CQN = WS_B;
constexpr size_t WS_CKVN = WS_B + (size_t)T * 384 * 2;
constexpr size_t WS_C = WS_B + 33554432;
constexpr size_t WS_H4 = WS_C;
constexpr size_t WS_R = WS_C + 33554432;
constexpr size_t WS_HS = WS_C + 16777216;
constexpr size_t WS_D = WS_C + (size_t)T * INW * 2;
constexpr size_t WS_Q = WS_D + 33554432;
constexpr size_t WS_KN = WS_Q + (size_t)T * 768 * 2;
constexpr size_t WS_VT = WS_KN + (size_t)T * 512 * 2;
constexpr size_t WS_KROPE = WS_VT + (size_t)T * 512 * 2;
constexpr size_t WS_ROPECS = WS_KROPE + (size_t)T * 64 * 2;
constexpr size_t WS_U4 = WS_ROPECS;
constexpr size_t WS_V4 = WS_U4 + (size_t)16384 * 512;
constexpr size_t WS_VSCALE = WS_V4 + (size_t)16384 * 512;
constexpr size_t WS_USCALE = WS_VSCALE + 65536;
constexpr size_t WS_USUM = WS_USCALE + 65536;
constexpr size_t WS_END = WS_USUM + 65536;
static_assert(WS_U4 >= WS_ROPECS && WS_ROPECS + (size_t)T * 64 * 4 <= WS_END, "rope table inside the tail region");
constexpr size_t WS_W16 = WS_KROPE;
constexpr size_t WS_IDX = WS_VT;
constexpr size_t WS_GATE = WS_VT + (size_t)T * 128 * 4;
constexpr size_t WS_ELIST = WS_D + 67108864;
constexpr size_t WS_COUNTS = WS_CTL + 16384;
constexpr size_t WS_BSTART = WS_CTL + 16384 + 32768;
static_assert(WS_ELIST + (size_t)T * 128 * 4 <= WS_VT, "edge list overflow");
static_assert(WS_LB + 4096 <= WS_B, "weights overflow");
static_assert(WS_D + (size_t)T * 2048 * 2 <= WS_IDX, "PQ overlaps IDX");
static_assert(WS_GATE + (size_t)T * 128 * 4 <= WS_VT + (size_t)T * 512 * 2, "gate overflow");
static_assert(WS_HS + 65536 <= WS_D, "H4 overflow");
static_assert(WS_END <= 268435456, "workspace too big");

struct Args {
    const float* x; const int* pos; const float* attn_norm; const float* w_in; const float* lb_logits; const float* hg_o_norm;
    const float* q_a_norm; const float* w_q_up; const float* kv_a_norm; const float* w_kv_up; const float* q_norm; const float* k_norm;
    const float* mla_o_norm; const float* w_out; const float* ffn_norm; const float* peer_wq; const float* subk; const float* peer_u; const float* peer_v;
    float* out; unsigned char* ws; int ph_lo, ph_hi;
};

typedef __bf16 bf16v2 __attribute__((ext_vector_type(2)));
typedef float f32v2 __attribute__((ext_vector_type(2)));
__device__ __forceinline__ unsigned pack2(float lo, float hi) { const f32v2 v = {lo, hi}; return __builtin_bit_cast(unsigned, __builtin_convertvector(v, bf16v2)); }
__device__ __forceinline__ bf16_t f2bf(float f) { return (bf16_t)(pack2(f, 0.f) & 0xffffu); }
typedef _Float16 f16v2 __attribute__((ext_vector_type(2)));
__device__ __forceinline__ unsigned pack2h(float lo, float hi) { const f32v2 v = {lo, hi}; return __builtin_bit_cast(unsigned, __builtin_convertvector(v, f16v2)); }
__device__ __forceinline__ float frcp(float x) { return __builtin_amdgcn_rcpf(x); }
__device__ __forceinline__ float fexp2(float x) { return __builtin_amdgcn_exp2f(x); }
__device__ __forceinline__ float bf2f(bf16_t h) { return __uint_as_float(((unsigned)h) << 16); }
__device__ __forceinline__ float bflo(unsigned w) { return __uint_as_float(w << 16); }
__device__ __forceinline__ float bfhi(unsigned w) { return __uint_as_float(w & 0xffff0000u); }
__device__ __forceinline__ float wave_sum(float v) {
#pragma unroll
    for (int d = 32; d > 0; d >>= 1) v += __shfl_xor(v, d, 64);
    return v;
}
__device__ __forceinline__ f32x4 mfma16(bf16x8 a, bf16x8 b, f32x4 c) { return __builtin_amdgcn_mfma_f32_16x16x32_bf16(a, b, c, 0, 0, 0); }

__device__ const float ROPE_INV_FREQ[32] = {
    1.000000000e+00f, 7.498942018e-01f, 5.623413324e-01f, 4.216965139e-01f, 3.162277639e-01f, 2.371373922e-01f, 1.778279394e-01f, 1.333521456e-01f,
    1.000000015e-01f, 7.498941571e-02f, 5.623412877e-02f, 4.216964915e-02f, 3.162277862e-02f, 2.371373586e-02f, 1.778279431e-02f, 1.333521493e-02f,
    9.999999776e-03f, 7.498942316e-03f, 5.623413250e-03f, 4.216964822e-03f, 3.162277862e-03f, 2.371373819e-03f, 1.778279431e-03f, 1.333521446e-03f,
    1.000000047e-03f, 7.498941850e-04f, 5.623413017e-04f, 4.216965463e-04f, 3.162277862e-04f, 2.371373848e-04f, 1.778279402e-04f, 1.333521504e-04f};

template <int WAVES_M, int WAVES_N, int WM, int WN, class Epi>
__device__ __forceinline__ void gemm_block(const bf16_t* __restrict__ A, int lda, const bf16_t* __restrict__ Bt, int ldb, int K,
                                           int m0, int n0, int nrows_bt, unsigned char* lds, Epi& epi) {
    constexpr int BM = WAVES_M * WM * 16, BN = WAVES_N * WN * 16;
    constexpr int AI = BM / 64, BI = BN / 64;
    static_assert(WAVES_M * WAVES_N == 8, "8 waves");
    const int tid = threadIdx.x, lane = tid & 63, wave = tid >> 6;
    const int wm = wave / WAVES_N, wn = wave % WAVES_N;
    const int r16 = lane & 15, g = lane >> 4;
    unsigned char* As = lds;
    unsigned char* Bs = lds + BM * 144;
    f32x4 acc[WM][WN];
#pragma unroll
    for (int i = 0; i < WM; ++i)
#pragma unroll
        for (int j = 0; j < WN; ++j) acc[i][j] = (f32x4){0.f, 0.f, 0.f, 0.f};
    uint4 ra0, ra1, ra2, ra3, rb0, rb1, rb2, rb3;
    static_assert(AI <= 4 && BI <= 4, "stage regs");
#define GA_LOAD(i, k0) if constexpr (AI > i) { const int c = tid + i * NT, row = c >> 3, kc = c & 7; ra##i = *(const uint4*)(A + (size_t)(m0 + row) * lda + (k0) + kc * 8); }
#define GB_LOAD(i, k0) if constexpr (BI > i) { const int c = tid + i * NT, row = c >> 3, kc = c & 7; int rg = n0 + row; rg = rg < nrows_bt ? rg : nrows_bt - 1; rb##i = *(const uint4*)(Bt + (size_t)rg * ldb + (k0) + kc * 8); }
#define GA_STORE(i) if constexpr (AI > i) { const int c = tid + i * NT, row = c >> 3, kc = c & 7; *(uint4*)(As + row * 144 + kc * 16) = ra##i; }
#define GB_STORE(i) if constexpr (BI > i) { const int c = tid + i * NT, row = c >> 3, kc = c & 7; *(uint4*)(Bs + row * 144 + kc * 16) = rb##i; }
    GA_LOAD(0, 0) GA_LOAD(1, 0) GA_LOAD(2, 0) GA_LOAD(3, 0) GB_LOAD(0, 0) GB_LOAD(1, 0) GB_LOAD(2, 0) GB_LOAD(3, 0)
    const int nk = K / 64;
    for (int kt = 0; kt < nk; ++kt) {
        __syncthreads();
        GA_STORE(0) GA_STORE(1) GA_STORE(2) GA_STORE(3) GB_STORE(0) GB_STORE(1) GB_STORE(2) GB_STORE(3)
        __syncthreads();
        if (kt + 1 < nk) {
            const int k0 = (kt + 1) * 64;
            GA_LOAD(0, k0) GA_LOAD(1, k0) GA_LOAD(2, k0) GA_LOAD(3, k0) GB_LOAD(0, k0) GB_LOAD(1, k0) GB_LOAD(2, k0) GB_LOAD(3, k0)
        }
#pragma unroll
        for (int kk = 0; kk < 2; ++kk) {
            bf16x8 af[WM];
#pragma unroll
            for (int i = 0; i < WM; ++i) af[i] = *(const bf16x8*)(As + ((wm * WM + i) * 16 + r16) * 144 + kk * 64 + g * 16);
#pragma unroll
            for (int j = 0; j < WN; ++j) {
                const bf16x8 bfr = *(const bf16x8*)(Bs + ((wn * WN + j) * 16 + r16) * 144 + kk * 64 + g * 16);
#pragma unroll
                for (int i = 0; i < WM; ++i) acc[i][j] = mfma16(bfr, af[i], acc[i][j]);
            }
        }
    }
#undef GA_LOAD
#undef GB_LOAD
#undef GA_STORE
#undef GB_STORE
    epi(acc, m0 + wm * WM * 16, n0 + wn * WN * 16, lane);
}

namespace g256 {
constexpr int BM = 256, BK = 64, HALF = 128, HT = HALF * BK;
__device__ __forceinline__ int lds_byte(int r, int c) { const int st = (r >> 4) * 2 + (c >> 5), rr = r & 15, cc = c & 31, ob = rr * 64 + cc * 2; return st * 1024 + (ob ^ (((ob >> 9) & 1) << 5)); }
__device__ __forceinline__ void stage_rc(int b, int& R, int& C) { const int st = b / 1024, sb = b % 1024, swz = sb ^ (((sb >> 9) & 1) << 5); R = (st >> 1) * 16 + swz / 64; C = (st & 1) * 32 + (swz % 64) / 2; }

template <class Epi>
__device__ __forceinline__ void tile(const bf16_t* __restrict__ A, const bf16_t* __restrict__ Bt, int K, int brow, int bcol, unsigned char* lds, Epi& epi) {
    bf16_t* shm = (bf16_t*)lds;
#define G_SA(b, h) (shm + ((b) * 2 + (h)) * HT)
#define G_SB(b, h) (shm + (4 + (b) * 2 + (h)) * HT)
#define G_STAGE(P, BASE, br, kt) do { const long _g = (long)(br) * K + (long)(kt) * BK; \
    _Pragma("unroll") for (int _i = 0; _i < 2; ++_i) { const int _b = tix * 16 + _i * 8192; int _r, _c; stage_rc(_b, _r, _c); \
      __builtin_amdgcn_global_load_lds((const unsigned*)(BASE + _g + (long)_r * K + _c), (unsigned*)((char*)(P) + _b), 16, 0, 0); } } while (0)
#define G_LDA(dst, b, h) _Pragma("unroll") for (int m = 0; m < 4; ++m) _Pragma("unroll") for (int k = 0; k < 2; ++k) \
    dst[m][k] = *reinterpret_cast<const bf16x8*>((char*)G_SA(b, h) + lds_byte(wr * 64 + m * 16 + fr, k * 32 + fq * 8))
#define G_LDB(dst, b, h) _Pragma("unroll") for (int n = 0; n < 2; ++n) _Pragma("unroll") for (int k = 0; k < 2; ++k) \
    dst[n][k] = *reinterpret_cast<const bf16x8*>((char*)G_SB(b, h) + lds_byte(wc * 32 + n * 16 + fr, k * 32 + fq * 8))
#define G_MMA(ai, bj, At, Bt_) do { __builtin_amdgcn_s_setprio(1); \
    _Pragma("unroll") for (int m = 0; m < 4; ++m) _Pragma("unroll") for (int n = 0; n < 2; ++n) _Pragma("unroll") for (int k = 0; k < 2; ++k) \
      acc[ai][bj][m][n] = __builtin_amdgcn_mfma_f32_16x16x32_bf16(Bt_[n][k], At[m][k], acc[ai][bj][m][n], 0, 0, 0); \
    __builtin_amdgcn_s_setprio(0); } while (0)
#define G_WAIT_V(n) asm volatile("s_waitcnt vmcnt(" #n ")" ::: "memory")
#define G_WAIT_L(n) asm volatile("s_waitcnt lgkmcnt(" #n ")" ::: "memory")
#define G_BAR __builtin_amdgcn_s_barrier()
#define G_SCHED __builtin_amdgcn_sched_barrier(0)
    int tix = threadIdx.x; asm volatile("" : "+v"(tix));
    const int wid = tix >> 6, lane = tix & 63, wr = wid >> 2, wc = wid & 3, fr = lane & 15, fq = lane >> 4;
    f32x4 acc[2][2][4][2];
#pragma unroll
    for (int i0 = 0; i0 < 2; ++i0)
#pragma unroll
        for (int i1 = 0; i1 < 2; ++i1)
#pragma unroll
            for (int i2 = 0; i2 < 4; ++i2)
#pragma unroll
                for (int i3 = 0; i3 < 2; ++i3) acc[i0][i1][i2][i3] = (f32x4){0.f, 0.f, 0.f, 0.f};
    bf16x8 At[4][2], B0[2][2], B1[2][2];
    const int nt = K / BK;
    G_STAGE(G_SB(0, 0), Bt, bcol, 0); G_STAGE(G_SA(0, 0), A, brow, 0);
    G_STAGE(G_SB(0, 1), Bt, bcol + HALF, 0); G_STAGE(G_SA(0, 1), A, brow + HALF, 0);
    if (wr == 1) G_BAR;
    G_WAIT_V(4); G_BAR;
    G_STAGE(G_SB(1, 0), Bt, bcol, 1); G_STAGE(G_SA(1, 0), A, brow, 1); G_STAGE(G_SB(1, 1), Bt, bcol + HALF, 1);
    G_WAIT_V(6); G_BAR;
    for (int t = 0; t < nt - 2; t += 2) {
        G_LDB(B0, 0, 0); G_SCHED; G_LDA(At, 0, 0); G_STAGE(G_SA(1, 1), A, brow + HALF, t + 1);
        G_WAIT_L(8); G_BAR; G_WAIT_L(0); G_MMA(0, 0, At, B0); G_BAR; G_SCHED;
        G_LDB(B1, 0, 1); G_STAGE(G_SB(0, 0), Bt, bcol, t + 2);
        G_BAR; G_WAIT_L(0); G_MMA(0, 1, At, B1); G_BAR;
        G_LDA(At, 0, 1); G_STAGE(G_SA(0, 0), A, brow, t + 2);
        G_BAR; G_WAIT_L(0); G_MMA(1, 0, At, B0); G_BAR; G_SCHED;
        G_STAGE(G_SB(0, 1), Bt, bcol + HALF, t + 2);
        G_WAIT_V(6); G_BAR; G_MMA(1, 1, At, B1); G_BAR;
        G_LDB(B0, 1, 0); G_SCHED; G_LDA(At, 1, 0); G_STAGE(G_SA(0, 1), A, brow + HALF, t + 2);
        G_WAIT_L(8); G_BAR; G_WAIT_L(0); G_MMA(0, 0, At, B0); G_BAR; G_SCHED;
        G_LDB(B1, 1, 1); G_STAGE(G_SB(1, 0), Bt, bcol, t + 3);
        G_BAR; G_WAIT_L(0); G_MMA(0, 1, At, B1); G_BAR;
        G_LDA(At, 1, 1); G_STAGE(G_SA(1, 0), A, brow, t + 3);
        G_BAR; G_WAIT_L(0); G_MMA(1, 0, At, B0); G_BAR; G_SCHED;
        G_STAGE(G_SB(1, 1), Bt, bcol + HALF, t + 3);
        G_WAIT_V(6); G_BAR; G_MMA(1, 1, At, B1); G_BAR;
    }
    { G_LDB(B0, 0, 0); G_LDA(At, 0, 0); G_STAGE(G_SA(1, 1), A, brow + HALF, nt - 1);
      G_BAR; G_WAIT_L(0); G_MMA(0, 0, At, B0); G_BAR;
      G_LDB(B1, 0, 1); G_BAR; G_WAIT_L(0); G_MMA(0, 1, At, B1); G_BAR;
      G_LDA(At, 0, 1); G_WAIT_V(4); G_BAR; G_WAIT_L(0); G_MMA(1, 0, At, B0); G_MMA(1, 1, At, B1); G_BAR; }
    { G_LDB(B0, 1, 0); G_LDA(At, 1, 0); G_WAIT_V(2); G_BAR; G_WAIT_L(0); G_MMA(0, 0, At, B0); G_BAR;
      G_LDB(B1, 1, 1); G_WAIT_V(0); G_BAR; G_WAIT_L(0); G_MMA(0, 1, At, B1); G_BAR;
      G_LDA(At, 1, 1); G_BAR; G_WAIT_L(0); G_MMA(1, 0, At, B0); G_MMA(1, 1, At, B1); G_BAR; }
    if (wr == 0) G_BAR;
    epi(acc, brow + wr * 64 + fr, bcol + wc * 32 + 4 * fq);
#undef G_SA
#undef G_SB
#undef G_STAGE
#undef G_LDA
#undef G_LDB
#undef G_MMA
#undef G_WAIT_V
#undef G_WAIT_L
#undef G_BAR
#undef G_SCHED
}
__device__ __forceinline__ bool next_tile(int L, int nM, int nN, int& pm, int& pn) {
    const int nwg = nM * nN; if (L >= nwg) return false;
    int wgid = L; { const int q = nwg / 8, r = nwg % 8, xcd = wgid % 8, off = wgid / 8; wgid = (xcd < r ? xcd * (q + 1) : r * (q + 1) + (xcd - r) * q) + off; }
    const int WGM = 8, nig = WGM * nN, gid = wgid / nig, fm = gid * WGM, gsz = (nM - fm) < WGM ? (nM - fm) : WGM;
    pm = fm + ((wgid % nig) % gsz); pn = (wgid % nig) / gsz; return true;
}
struct EpiBf16 { bf16_t* O; int ldc;
    __device__ __forceinline__ void operator()(const f32x4 (&acc)[2][2][4][2], int row0, int col0) const {
#pragma unroll
        for (int ai = 0; ai < 2; ++ai)
#pragma unroll
            for (int m = 0; m < 4; ++m) { bf16_t* rp = O + (size_t)(row0 + ai * 128 + m * 16) * ldc + col0;
#pragma unroll
                for (int bj = 0; bj < 2; ++bj)
#pragma unroll
                    for (int n = 0; n < 2; ++n) { const f32x4 v = acc[ai][bj][m][n]; uint2 w; w.x = pack2(v[0], v[1]); w.y = pack2(v[2], v[3]); *(uint2*)(rp + bj * 128 + n * 16) = w; } }
    }
};
struct EpiResid { const float* X; bf16_t* O;
    __device__ __forceinline__ void operator()(const f32x4 (&acc)[2][2][4][2], int row0, int col0) const {
#pragma unroll
        for (int ai = 0; ai < 2; ++ai)
#pragma unroll
            for (int m = 0; m < 4; ++m) { const size_t ro = (size_t)(row0 + ai * 128 + m * 16) * DM + col0;
#pragma unroll
                for (int bj = 0; bj < 2; ++bj)
#pragma unroll
                    for (int n = 0; n < 2; ++n) { const size_t off = ro + bj * 128 + n * 16; const f32x4 v = *(const f32x4*)(X + off) + acc[ai][bj][m][n];
                        uint2 w; w.x = pack2(v[0], v[1]); w.y = pack2(v[2], v[3]); *(uint2*)(O + off) = w; } }
    }
};
struct EpiBf16Silu { bf16_t* O; int ldc; int nsilu;
    __device__ __forceinline__ void operator()(const f32x4 (&acc)[2][2][4][2], int row0, int col0) const {
        const bool sl = col0 < nsilu;
#pragma unroll
        for (int ai = 0; ai < 2; ++ai)
#pragma unroll
            for (int m = 0; m < 4; ++m) { bf16_t* rp = O + (size_t)(row0 + ai * 128 + m * 16) * ldc + col0;
#pragma unroll
                for (int bj = 0; bj < 2; ++bj)
#pragma unroll
                    for (int n = 0; n < 2; ++n) { f32x4 v = acc[ai][bj][m][n];
                        if (sl) {
#pragma unroll
                            for (int r = 0; r < 4; ++r) v[r] = v[r] * frcp(1.f + __expf(-v[r])); }
                        uint2 w; w.x = pack2(v[0], v[1]); w.y = pack2(v[2], v[3]); *(uint2*)(rp + bj * 128 + n * 16) = w; } }
    }
};
}

template <int WM_, int WN_> struct EpiBf16 {
    bf16_t* O; int ldc; int ncols;
    __device__ __forceinline__ void operator()(const f32x4 (&acc)[WM_][WN_], int mb, int nb, int lane) const {
        const int r16 = lane & 15, g = lane >> 4;
#pragma unroll
        for (int i = 0; i < WM_; ++i)
#pragma unroll
            for (int j = 0; j < WN_; ++j) {
                const int row = mb + i * 16 + r16, col = nb + j * 16 + 4 * g;
                if (col < ncols) { uint2 w; w.x = pack2(acc[i][j][0], acc[i][j][1]); w.y = pack2(acc[i][j][2], acc[i][j][3]); *(uint2*)(O + (size_t)row * ldc + col) = w; }
            }
    }
};
struct EpiQ {
    bf16_t* Q; const float* q_norm; const float* ropecs;
    __device__ __forceinline__ void operator()(const f32x4 (&accs)[2][12], int mb, int nb, int lane) const {
      const int r16 = lane & 15, g = lane >> 4;
#pragma unroll
      for (int mi = 0; mi < 2; ++mi) {
        const f32x4 (&accm)[12] = accs[mi];
        const int row = mb + mi * 16 + r16, h = nb / 192;
        float ssn = 0.f, ssr = 0.f;
#pragma unroll
        for (int j = 0; j < 8; ++j)
#pragma unroll
            for (int r = 0; r < 4; ++r) ssn += accm[j][r] * accm[j][r];
#pragma unroll
        for (int j = 8; j < 12; ++j)
#pragma unroll
            for (int r = 0; r < 4; ++r) ssr += accm[j][r] * accm[j][r];
        ssn += __shfl_xor(ssn, 16, 64); ssn += __shfl_xor(ssn, 32, 64);
        ssr += __shfl_xor(ssr, 16, 64); ssr += __shfl_xor(ssr, 32, 64);
        const float SC = 0.07216878364870322f * 1.4426950408889634f;
        const float rn = rsqrtf(ssn * (1.f / 128.f) + EPS) * SC, rr = rsqrtf(ssr * (1.f / 64.f) + EPS) * SC;
        bf16_t* qrow = Q + ((size_t)row * 4 + h) * 192;
#pragma unroll
        for (int j = 0; j < 8; ++j) {
            const int c = j * 16 + 4 * g;
            const f32x4 gn = *(const f32x4*)(q_norm + c);
            uint2 w; w.x = pack2(accm[j][0] * rn * gn[0], accm[j][1] * rn * gn[1]); w.y = pack2(accm[j][2] * rn * gn[2], accm[j][3] * rn * gn[3]);
            *(uint2*)(qrow + c) = w;
        }
#pragma unroll
        for (int j = 0; j < 2; ++j) {
            const int jj = j * 16 + 4 * g;
            const f32x4 g1 = *(const f32x4*)(q_norm + 128 + jj), g2 = *(const f32x4*)(q_norm + 160 + jj);
            float o1[4], o2[4];
#pragma unroll
            for (int r = 0; r < 4; ++r) {
                const float2 cs = *(const float2*)(ropecs + ((size_t)row * 32 + jj + r) * 2);
                const float a1 = accm[8 + j][r] * rr * g1[r], a2 = accm[10 + j][r] * rr * g2[r];
                o1[r] = a1 * cs.x - a2 * cs.y; o2[r] = a2 * cs.x + a1 * cs.y;
            }
            uint2 w; w.x = pack2(o1[0], o1[1]); w.y = pack2(o1[2], o1[3]); *(uint2*)(qrow + 128 + jj) = w;
            w.x = pack2(o2[0], o2[1]); w.y = pack2(o2[2], o2[3]); *(uint2*)(qrow + 160 + jj) = w;
        }
      }
    }
};
template <int WMK> struct EpiKV {
    bf16_t* KN; bf16_t* VT; const float* k_norm;
    __device__ __forceinline__ void operator()(const f32x4 (&accs)[WMK][16], int mb, int nb, int lane) const {
      const int r16 = lane & 15, g = lane >> 4;
#pragma unroll
      for (int mi = 0; mi < WMK; ++mi) {
        const f32x4 (&accm)[16] = accs[mi];
        const int row = mb + mi * 16 + r16, h = nb / 256;
        float ssn = 0.f;
#pragma unroll
        for (int j = 0; j < 8; ++j)
#pragma unroll
            for (int r = 0; r < 4; ++r) ssn += accm[j][r] * accm[j][r];
        ssn += __shfl_xor(ssn, 16, 64); ssn += __shfl_xor(ssn, 32, 64);
        const float rn = rsqrtf(ssn * (1.f / 128.f) + EPS);
        bf16_t* krow = KN + ((size_t)row * 4 + h) * 128;
#pragma unroll
        for (int j = 0; j < 8; ++j) {
            const int c = j * 16 + 4 * g;
            const f32x4 gn = *(const f32x4*)(k_norm + c);
            uint2 w; w.x = pack2(accm[j][0] * rn * gn[0], accm[j][1] * rn * gn[1]); w.y = pack2(accm[j][2] * rn * gn[2], accm[j][3] * rn * gn[3]);
            *(uint2*)(krow + c) = w;
        }
        const int b = row >> 11, s = row & 2047;
        bf16_t* vp = VT + ((size_t)(b * 4 + h) * 128 + 4 * g) * SEQ + s;
#pragma unroll
        for (int j = 0; j < 8; ++j) {
            asm volatile("" : "+v"(vp));
            vp[0] = f2bf(accm[8 + j][0]); vp[SEQ] = f2bf(accm[8 + j][1]); vp[2 * SEQ] = f2bf(accm[8 + j][2]); vp[3 * SEQ] = f2bf(accm[8 + j][3]);
            vp += 16 * SEQ;
        }
      }
    }
};

__device__ void transpose_convert(const float* __restrict__ W, bf16_t* __restrict__ Wt, int K, int N, unsigned char* lds, int bid, int nblk) {
    bf16_t* tile = (bf16_t*)lds;
    const int tid = threadIdx.x;
    const int tk = K / 64, tn = N / 64;
    for (int t = bid; t < tk * tn; t += nblk) {
        const int k0 = (t / tn) * 64, n0 = (t % tn) * 64;
        __syncthreads();
#pragma unroll
        for (int p = 0; p < 2; ++p) {
            const int kk = (tid >> 4) + p * 32, n4 = (tid & 15) * 4;
            const f32x4 v = *(const f32x4*)(W + (size_t)(k0 + kk) * N + n0 + n4);
#pragma unroll
            for (int r = 0; r < 4; ++r) tile[(n4 + r) * 66 + kk] = f2bf(v[r]);
        }
        __syncthreads();
        {
            const int nn = tid >> 3, k8 = (tid & 7) * 8;
            unsigned w[4];
#pragma unroll
            for (int r = 0; r < 4; ++r) w[r] = (unsigned)tile[nn * 66 + k8 + 2 * r] | ((unsigned)tile[nn * 66 + k8 + 2 * r + 1] << 16);
            *(uint4*)(Wt + (size_t)(n0 + nn) * K + k0 + k8) = make_uint4(w[0], w[1], w[2], w[3]);
        }
    }
    __syncthreads();
}

template <bool Q4, class TIN>
__device__ void rmsnorm_rows(const TIN* __restrict__ X, const float* __restrict__ gain, bf16_t* __restrict__ O, int gw, int nw, unsigned char* __restrict__ H4 = nullptr, float* __restrict__ HS = nullptr) {
    const int lane = threadIdx.x & 63;
    for (int row = gw; row < T; row += nw) {
        const TIN* xr = X + (size_t)row * DM;
        f32x4 v[4]; float ss = 0.f;
#pragma unroll
        for (int i = 0; i < 4; ++i) {
            if constexpr (sizeof(TIN) == 4) v[i] = *(const f32x4*)(xr + i * 256 + lane * 4);
            else { const uint2 w = *(const uint2*)(xr + i * 256 + lane * 4); v[i] = (f32x4){bflo(w.x), bfhi(w.x), bflo(w.y), bfhi(w.y)}; }
            ss += v[i][0] * v[i][0] + v[i][1] * v[i][1] + v[i][2] * v[i][2] + v[i][3] * v[i][3]; }
        ss = wave_sum(ss);
        const float rs = rsqrtf(ss * (1.f / 1024.f) + EPS);
        float amax = 0.f;
#pragma unroll
        for (int i = 0; i < 4; ++i) {
            const f32x4 gn = *(const f32x4*)(gain + i * 256 + lane * 4);
#pragma unroll
            for (int e = 0; e < 4; ++e) { v[i][e] = v[i][e] * rs * gn[e]; amax = fmaxf(amax, fabsf(v[i][e])); }
            uint2 w; w.x = pack2(v[i][0], v[i][1]); w.y = pack2(v[i][2], v[i][3]);
            *(uint2*)(O + (size_t)row * DM + i * 256 + lane * 4) = w;
        }
        if constexpr (Q4) {
#pragma unroll
            for (int d = 32; d > 0; d >>= 1) amax = fmaxf(amax, __shfl_xor(amax, d, 64));
            const float inv = amax > 0.f ? 127.f / amax : 0.f;
            unsigned char* hr = H4 + (size_t)row * 1024 + (lane >> 3) * 32 + ((lane >> 1) & 3) * 4 + (lane & 1) * 2;
#pragma unroll
            for (int i = 0; i < 4; ++i) {
                unsigned ha = 0, hb = 0;
#pragma unroll
                for (int e = 0; e < 4; ++e) { const unsigned tb = (unsigned)((int)rintf(v[i][e] * inv) + 128); ha |= ((tb >> 4) ^ 8u) << (4 * e); hb |= ((tb & 15u) ^ 8u) << (4 * e); }
                *(unsigned short*)(hr + i * 256) = (unsigned short)ha; *(unsigned short*)(hr + i * 256 + 16) = (unsigned short)hb;
            }
            if (lane == 0) HS[row] = amax * (1.f / 127.f);
        }
    }
}

__device__ void phase0(const Args& a, unsigned char* lds) {
    unsigned char* ws = a.ws;
    const int bid = blockIdx.x, nblk = gridDim.x, tid = threadIdx.x;
    transpose_convert(a.w_in, (bf16_t*)(ws + WS_WIN_T), 1024, 3264, lds, bid, nblk);
    transpose_convert(a.w_q_up, (bf16_t*)(ws + WS_WQUP_T), 384, 768, lds, bid, nblk);
    transpose_convert(a.w_kv_up, (bf16_t*)(ws + WS_WKVUP_T), 256, 1024, lds, bid, nblk);
    transpose_convert(a.w_out, (bf16_t*)(ws + WS_WOUT_T), 1024, 1024, lds, bid, nblk);
    transpose_convert(a.peer_wq, (bf16_t*)(ws + WS_WPQ_T), 1024, 2048, lds, bid, nblk);
    const int gt = bid * NT + tid, ngt = nblk * NT;
    bf16_t* sk = (bf16_t*)(ws + WS_SUBK);
    for (int i = gt; i < 16 * 128 * 128; i += ngt) sk[i] = f2bf(a.subk[i]);
    float* lb = (float*)(ws + WS_LB);
    for (int i = gt; i < 1024; i += ngt) { const float l0 = a.lb_logits[i], l1 = a.lb_logits[1024 + i]; lb[i] = 1.f / (1.f + expf(l1 - l0)); }
    rmsnorm_rows<false, float>(a.x, a.attn_norm, (bf16_t*)(ws + WS_B), bid * 8 + (tid >> 6), nblk * 8);
}

__device__ void phase1(const Args& a, unsigned char* lds) {
    unsigned char* ws = a.ws;
    const bf16_t* H = (const bf16_t*)(ws + WS_B); const bf16_t* W = (const bf16_t*)(ws + WS_WIN_T);
    g256::EpiBf16Silu e{(bf16_t*)(ws + WS_C), INW, 512};
    for (int i = 0;; ++i) { int pm, pn; if (!g256::next_tile(i * gridDim.x + blockIdx.x, 64, 12, pm, pn)) break;
        __syncthreads();
        g256::tile(H, W, DM, pm * 256, pn * 256, lds, e); }
    __syncthreads();
    EpiBf16<1, 6> e2{(bf16_t*)(ws + WS_C), INW, INW};
    for (int t = blockIdx.x; t < 256; t += gridDim.x)
        gemm_block<4, 2, 1, 6>(H, DM, W, DM, DM, t * 64, 3072, INW, lds, e2);
}

__device__ void phase2(const Args& a) {
    unsigned char* ws = a.ws;
    const bf16_t* PROJ = (const bf16_t*)(ws + WS_C);
    bf16_t* CQN = (bf16_t*)(ws + WS_CQN); bf16_t* CKVN = (bf16_t*)(ws + WS_CKVN); bf16_t* KROPE = (bf16_t*)(ws + WS_KROPE);
    float* ROPECS = (float*)(ws + WS_ROPECS);
    const int lane = threadIdx.x & 63;
    const float2 gq0 = *(const float2*)(a.q_a_norm + lane * 2), gq1 = *(const float2*)(a.q_a_norm + 128 + lane * 2), gq2 = *(const float2*)(a.q_a_norm + 256 + lane * 2);
    const float2 gk0 = *(const float2*)(a.kv_a_norm + lane * 2), gk1 = *(const float2*)(a.kv_a_norm + 128 + lane * 2);
    const float gr = a.k_norm[128 + lane];
    const float invf = ROPE_INV_FREQ[lane & 31];
    const int nw = gridDim.x * 8;
    for (int t0 = blockIdx.x * 8 + (threadIdx.x >> 6); t0 < T; t0 += nw * 4) {
        unsigned wq[4][3], wk[4][2]; float vr[4], ps[4];
#pragma unroll
        for (int u = 0; u < 4; ++u) {
            const int t = min(t0 + u * nw, T - 1);
            const bf16_t* pr = PROJ + (size_t)t * INW;
#pragma unroll
            for (int i = 0; i < 3; ++i) wq[u][i] = *(const unsigned*)(pr + OFF_CQ + i * 128 + lane * 2);
#pragma unroll
            for (int i = 0; i < 2; ++i) wk[u][i] = *(const unsigned*)(pr + OFF_CKV + i * 128 + lane * 2);
            vr[u] = bf2f(pr[OFF_KR + lane]);
            ps[u] = (float)a.pos[t];
        }
        float sq[4], sk[4], sr[4];
#pragma unroll
        for (int u = 0; u < 4; ++u) {
            sq[u] = 0.f; sk[u] = 0.f;
#pragma unroll
            for (int i = 0; i < 3; ++i) { const float x0 = bflo(wq[u][i]), x1 = bfhi(wq[u][i]); sq[u] += x0 * x0 + x1 * x1; }
#pragma unroll
            for (int i = 0; i < 2; ++i) { const float x0 = bflo(wk[u][i]), x1 = bfhi(wk[u][i]); sk[u] += x0 * x0 + x1 * x1; }
            sr[u] = vr[u] * vr[u];
        }
#pragma unroll
        for (int d = 32; d > 0; d >>= 1)
#pragma unroll
            for (int u = 0; u < 4; ++u) { sq[u] += __shfl_xor(sq[u], d, 64); sk[u] += __shfl_xor(sk[u], d, 64); sr[u] += __shfl_xor(sr[u], d, 64); }
#pragma unroll
        for (int u = 0; u < 4; ++u) {
            const int t = t0 + u * nw;
            if (t < T) {
                const float rq = rsqrtf(sq[u] * (1.f / 384.f) + EPS), rk = rsqrtf(sk[u] * (1.f / 256.f) + EPS), rr = rsqrtf(sr[u] * (1.f / 64.f) + EPS);
                bf16_t* cq = CQN + (size_t)t * 384 + lane * 2; bf16_t* ck = CKVN + (size_t)t * 256 + lane * 2;
                *(unsigned*)(cq) = pack2(bflo(wq[u][0]) * rq * gq0.x, bfhi(wq[u][0]) * rq * gq0.y);
                *(unsigned*)(cq + 128) = pack2(bflo(wq[u][1]) * rq * gq1.x, bfhi(wq[u][1]) * rq * gq1.y);
                *(unsigned*)(cq + 256) = pack2(bflo(wq[u][2]) * rq * gq2.x, bfhi(wq[u][2]) * rq * gq2.y);
                *(unsigned*)(ck) = pack2(bflo(wk[u][0]) * rk * gk0.x, bfhi(wk[u][0]) * rk * gk0.y);
                *(unsigned*)(ck + 128) = pack2(bflo(wk[u][1]) * rk * gk1.x, bfhi(wk[u][1]) * rk * gk1.y);
                const float xn = vr[u] * rr * gr;
                const float other = __shfl_xor(xn, 32, 64);
                float sn, cs; sincosf(ps[u] * invf, &sn, &cs);
                const float o = (lane < 32) ? (xn * cs - other * sn) : (xn * cs + other * sn);
                KROPE[(size_t)t * 64 + lane] = f2bf(o);
                if (lane < 32) { *(float2*)(ROPECS + ((size_t)t * 32 + lane) * 2) = make_float2(cs, sn); }
            }
        }
    }
}

__device__ void phase3(const Args& a, unsigned char* lds) {
    unsigned char* ws = a.ws;
    EpiQ eq{(bf16_t*)(ws + WS_Q), a.q_norm, (const float*)(ws + WS_ROPECS)};
    EpiKV<1> ekv{(bf16_t*)(ws + WS_KN), (bf16_t*)(ws + WS_VT), a.k_norm};
    for (int t = blockIdx.x; t < 768; t += gridDim.x) {
        if (t < 256) { const int mt = t >> 2, h = t & 3;
            gemm_block<8, 1, 2, 12>((const bf16_t*)(ws + WS_CQN), 384, (const bf16_t*)(ws + WS_WQUP_T), 384, 384, mt * 256, h * 192, 768, lds, eq);
        } else { const int u = t - 256, mt = u >> 2, h = u & 3;
            gemm_block<8, 1, 1, 16>((const bf16_t*)(ws + WS_CKVN), 256, (const bf16_t*)(ws + WS_WKVUP_T), 256, 256, mt * 128, h * 256, 1024, lds, ekv);
        }
    }
}

constexpr int AT_KROW = 400, AT_VROW = 144, AT_KBYTES = 64 * AT_KROW, AT_VBYTES = 128 * AT_VROW, AT_BUF = AT_KBYTES + AT_VBYTES;
__device__ void attn_item(const Args& a, int item, unsigned char* lds) {
    unsigned char* ws = a.ws;
    const bf16_t* Q = (const bf16_t*)(ws + WS_Q); const bf16_t* KN = (const bf16_t*)(ws + WS_KN);
    const bf16_t* KR = (const bf16_t*)(ws + WS_KROPE); const bf16_t* VT = (const bf16_t*)(ws + WS_VT);
    bf16_t* YCAT = (bf16_t*)(ws + WS_B);
    const int qb = item & 7, h = (item >> 3) & 3, b = item >> 5;
    const int tid = threadIdx.x, lane = tid & 63, wave = tid >> 6, r16 = lane & 15, g = lane >> 4;
    const unsigned kn_off = (unsigned)((((size_t)b * SEQ + (tid >> 4)) * 4 + h) * 128 + (tid & 15) * 8);
    const unsigned kr_off = (unsigned)(((size_t)b * SEQ + (tid >> 3)) * 64 + (tid & 7) * 8);
    const unsigned vt_off = (unsigned)(((size_t)(b * 4 + h) * 128 + (tid >> 3)) * SEQ + (tid & 7) * 8);
    const int kn_dst = (tid >> 4) * AT_KROW + (tid & 15) * 16, kr_dst = (tid >> 3) * AT_KROW + 256 + (tid & 7) * 16;
    const int v_dst = AT_KBYTES + (tid >> 3) * AT_VROW + (tid & 7) * 16;
    bf16x8 qf[2][6];
#pragma unroll
    for (int qs = 0; qs < 2; ++qs) {
        const size_t tq = (size_t)b * SEQ + qb * 256 + wave * 32 + qs * 16 + r16;
#pragma unroll
        for (int kk = 0; kk < 6; ++kk) qf[qs][kk] = *(const bf16x8*)(Q + (tq * 4 + h) * 192 + kk * 32 + 8 * g);
    }
    f32x4 O[2][8];
#pragma unroll
    for (int qs = 0; qs < 2; ++qs)
#pragma unroll
        for (int d = 0; d < 8; ++d) O[qs][d] = (f32x4){0.f, 0.f, 0.f, 0.f};
    float m_run[2] = {0.f, 0.f}, l_part[2] = {0.f, 0.f};
    uint4 sk0, sk1, sk2, sv0, sv1;
#define AT_GLOADK(tile) do { \
        sk0 = *(const uint4*)(KN + kn_off + (size_t)(tile) * (64 * 512)); sk1 = *(const uint4*)(KN + kn_off + 32 * 512 + (size_t)(tile) * (64 * 512)); \
        sk2 = *(const uint4*)(KR + kr_off + (size_t)(tile) * (64 * 64)); } while (0)
#define AT_GLOADV(tile) do { \
        sv0 = *(const uint4*)(VT + vt_off + (size_t)(tile) * 64); sv1 = *(const uint4*)(VT + vt_off + (size_t)64 * SEQ + (size_t)(tile) * 64); } while (0)
#define AT_LSTOREK(buf) do { unsigned char* bb = lds + (buf) * AT_BUF; \
        *(uint4*)(bb + kn_dst) = sk0; *(uint4*)(bb + kn_dst + 32 * AT_KROW) = sk1; *(uint4*)(bb + kr_dst) = sk2; } while (0)
#define AT_LSTOREV(buf) do { unsigned char* bb = lds + (buf) * AT_BUF; \
        *(uint4*)(bb + v_dst) = sv0; *(uint4*)(bb + v_dst + 64 * AT_VROW) = sv1; } while (0)
    __syncthreads();
    AT_GLOADK(0); AT_GLOADV(0);
    AT_LSTOREK(0); AT_LSTOREV(0);
    __syncthreads();
    constexpr int NTILE = SEQ / 64;
    for (int t = 0; t < NTILE; ++t) {
        if (t + 1 < NTILE) AT_GLOADK(t + 1);
        const unsigned char* kb = lds + (t & 1) * AT_BUF;
        const unsigned char* vb = kb + AT_KBYTES;
        f32x4 S[2][4];
#pragma unroll
        for (int qs = 0; qs < 2; ++qs)
#pragma unroll
            for (int j = 0; j < 4; ++j) { const float nm = -m_run[qs]; S[qs][j] = (f32x4){nm, nm, nm, nm}; }
#pragma unroll
        for (int j = 0; j < 4; ++j) {
            const int krow = (j >> 1) * 32 + 8 * (r16 >> 2) + 4 * (j & 1) + (r16 & 3);
#pragma unroll
            for (int kk = 0; kk < 6; ++kk) {
                const bf16x8 kf = *(const bf16x8*)(kb + krow * AT_KROW + kk * 64 + g * 16);
                S[0][j] = mfma16(kf, qf[0][kk], S[0][j]);
                S[1][j] = mfma16(kf, qf[1][kk], S[1][j]);
            }
        }
        if (t + 1 < NTILE) { AT_LSTOREK((t + 1) & 1); AT_GLOADV(t + 1); }
        bf16x8 pf[2][2];
#pragma unroll
        for (int qs = 0; qs < 2; ++qs) {
            float mx = -1e30f;
#pragma unroll
            for (int j = 0; j < 4; ++j) mx = fmaxf(mx, fmaxf(fmaxf(S[qs][j][0], S[qs][j][1]), fmaxf(S[qs][j][2], S[qs][j][3])));
            mx = fmaxf(mx, __shfl_xor(mx, 16, 64)); mx = fmaxf(mx, __shfl_xor(mx, 32, 64));
            if (t == 0 || !__all(mx <= 8.f)) {
                const float delta = (t == 0) ? mx : fmaxf(mx, 0.f);
                m_run[qs] += delta;
#pragma unroll
                for (int j = 0; j < 4; ++j) { S[qs][j][0] -= delta; S[qs][j][1] -= delta; S[qs][j][2] -= delta; S[qs][j][3] -= delta; }
                if (t != 0) {
                    const float alpha = fexp2(-delta);
                    l_part[qs] *= alpha;
#pragma unroll
                    for (int d = 0; d < 8; ++d) O[qs][d] *= alpha;
                }
            }
            float ps = 0.f;
#pragma unroll
            for (int grp = 0; grp < 2; ++grp) {
                float pv[8];
#pragma unroll
                for (int jj = 0; jj < 8; ++jj) { pv[jj] = fexp2(S[qs][grp * 2 + (jj >> 2)][jj & 3]); ps += pv[jj]; }
                union { uint4 u; bf16x8 v; } cv; cv.u = make_uint4(pack2(pv[0], pv[1]), pack2(pv[2], pv[3]), pack2(pv[4], pv[5]), pack2(pv[6], pv[7]));
                pf[qs][grp] = cv.v;
            }
            l_part[qs] += ps;
        }
        __builtin_amdgcn_s_setprio(1);
#pragma unroll
        for (int grp = 0; grp < 2; ++grp)
#pragma unroll
            for (int d = 0; d < 8; ++d) {
                const bf16x8 vf = *(const bf16x8*)(vb + (d * 16 + r16) * AT_VROW + grp * 64 + g * 16);
                O[0][d] = mfma16(vf, pf[0][grp], O[0][d]);
                O[1][d] = mfma16(vf, pf[1][grp], O[1][d]);
            }
        __builtin_amdgcn_s_setprio(0);
        if (t + 1 < NTILE) AT_LSTOREV((t + 1) & 1);
        __syncthreads();
    }
#undef AT_GLOADK
#undef AT_GLOADV
#undef AT_LSTOREK
#undef AT_LSTOREV
#pragma unroll
    for (int qs = 0; qs < 2; ++qs) {
        float l = l_part[qs]; l += __shfl_xor(l, 16, 64); l += __shfl_xor(l, 32, 64);
        const float inv = frcp(l);
        float ss = 0.f;
#pragma unroll
        for (int d = 0; d < 8; ++d) { O[qs][d] *= inv; ss += O[qs][d][0] * O[qs][d][0] + O[qs][d][1] * O[qs][d][1] + O[qs][d][2] * O[qs][d][2] + O[qs][d][3] * O[qs][d][3]; }
        ss += __shfl_xor(ss, 16, 64); ss += __shfl_xor(ss, 32, 64);
        const float rs = rsqrtf(ss * (1.f / 128.f) + EPS);
        const size_t tq = (size_t)b * SEQ + qb * 256 + wave * 32 + qs * 16 + r16;
#pragma unroll
        for (int d = 0; d < 8; ++d) {
            const int dv = d * 16 + 4 * g;
            const f32x4 gn = *(const f32x4*)(a.mla_o_norm + h * 128 + dv);
            uint2 w; w.x = pack2(O[qs][d][0] * rs * gn[0], O[qs][d][1] * rs * gn[1]); w.y = pack2(O[qs][d][2] * rs * gn[2], O[qs][d][3] * rs * gn[3]);
            *(uint2*)(YCAT + tq * DM + 512 + h * 128 + dv) = w;
        }
    }
}

constexpr int HG_E = 0;
constexpr int HG_EL = HG_E + 64 * 132 * 4;
constexpr int HG_QT = HG_EL + 1024;
constexpr int HG_QH = HG_QT + 17408;
constexpr int HG_KD = HG_QH + 17408;
constexpr int HG_K10 = HG_KD + 17408;
constexpr int HG_VT = HG_K10 + 8704;
constexpr int HG_SM = HG_VT + 2 * 9216;
constexpr int HG_STB = HG_SM + 9216;
constexpr int HG_LDS = HG_STB + 2 * 17408;
__device__ void hgrn_item(const Args& a, int item, unsigned char* lds) {
    unsigned char* ws = a.ws;
    const bf16_t* PROJ = (const bf16_t*)(ws + WS_C);
    const float* LB = (const float*)(ws + WS_LB);
    bf16_t* OHG = (bf16_t*)(ws + WS_D);
    const int vs = item & 1, dir = (item >> 1) & 1, h = (item >> 2) & 3, b = item >> 4;
    const int tid = threadIdx.x, lane = tid & 63, wave = tid >> 6, r16 = lane & 15, g = lane >> 4;
    float* E = (float*)(lds + HG_E); float* EL = (float*)(lds + HG_EL);
    bf16_t* Qt = (bf16_t*)(lds + HG_QT); bf16_t* Qh = (bf16_t*)(lds + HG_QH); bf16_t* Kd = (bf16_t*)(lds + HG_KD); bf16_t* K10 = (bf16_t*)(lds + HG_K10);
    bf16_t* vT = (bf16_t*)(lds + HG_VT); bf16_t* Sm = (bf16_t*)(lds + HG_SM); bf16_t* STb = (bf16_t*)(lds + HG_STB);
    const int kB = wave * 16 + r16;
    const float lbk = LB[dir * 512 + h * 128 + kB];
    const int offf = dir ? OFF_FB : OFF_FF;
    const int rowA = tid >> 4, k8A = (tid & 15) * 8;
    const int vrow = tid >> 3, vc8 = (tid & 7) * 8;
    const size_t tokbase = (size_t)b * SEQ;
    __syncthreads();
    for (int i = tid; i < 2 * 64 * 136; i += NT) STb[i] = 0;
    f32x4 accS[4]; accS[0] = (f32x4){0.f, 0.f, 0.f, 0.f}; accS[1] = accS[0]; accS[2] = accS[0]; accS[3] = accS[0];
    unsigned short fB[16]; uint4 qA0, qA1, vA;
#define HG_PREFETCH(n) do { \
        _Pragma("unroll") for (int sc = 0; sc < 2; ++sc) _Pragma("unroll") for (int jj = 0; jj < 8; ++jj) { \
            const int tau = (n) * 64 + sc * 32 + g * 8 + jj, tt = dir ? (SEQ - 1 - tau) : tau; \
            fB[sc * 8 + jj] = PROJ[(tokbase + tt) * INW + offf + h * 128 + kB]; } \
        { const int tau = (n) * 64 + rowA, tt = dir ? (SEQ - 1 - tau) : tau; qA0 = *(const uint4*)(PROJ + (tokbase + tt) * INW + OFF_Q + h * 128 + k8A); } \
        { const int tau = (n) * 64 + rowA + 32, tt = dir ? (SEQ - 1 - tau) : tau; qA1 = *(const uint4*)(PROJ + (tokbase + tt) * INW + OFF_Q + h * 128 + k8A); } \
        { const int tau = (n) * 64 + vrow, tt = dir ? (SEQ - 1 - tau) : tau; vA = *(const uint4*)(PROJ + (tokbase + tt) * INW + OFF_I + h * 128 + vs * 64 + vc8); } \
    } while (0)
    HG_PREFETCH(0);
    for (int n = 0; n < 32; ++n) {
        bf16_t* vTn = vT + (n & 1) * (64 * 72);
        bf16x8 kbf[2];
        {
            float kd[16], ev[16], elast[2];
#pragma unroll
            for (int sc = 0; sc < 2; ++sc) {
                float run = 1.f, runi = 1.f, bb[8], bi[8];
#pragma unroll
                for (int jj = 0; jj < 8; ++jj) {
                    const float u = __expf(-bf2f(fB[sc * 8 + jj]));
                    const float a1 = 1.f + u, a2 = 1.f + lbk * u, r = frcp(a1 * a2);
                    const float f = a2 * a2 * r, fi = a1 * a1 * r;
                    kd[sc * 8 + jj] = 1.f - f;
                    run *= f; bb[jj] = run; runi *= fi; bi[jj] = runi;
                }
                float incl = run, inci = runi;
                { const float t1 = __shfl_up(incl, 16, 64), s1 = __shfl_up(inci, 16, 64); if (g >= 1) { incl *= t1; inci *= s1; } }
                { const float t2 = __shfl_up(incl, 32, 64), s2 = __shfl_up(inci, 32, 64); if (g >= 2) { incl *= t2; inci *= s2; } }
                float excl = __shfl_up(incl, 16, 64), exci = __shfl_up(inci, 16, 64); if (g == 0) { excl = 1.f; exci = 1.f; }
                elast[sc] = __shfl(incl, 48 + r16, 64);
#pragma unroll
                for (int jj = 0; jj < 8; ++jj) {
                    ev[sc * 8 + jj] = bb[jj] * excl;
                    kd[sc * 8 + jj] = kd[sc * 8 + jj] * (bi[jj] * exci);
                }
            }
#pragma unroll
            for (int sc = 0; sc < 2; ++sc)
#pragma unroll
                for (int jj = 0; jj < 8; ++jj) {
                    const int row = sc * 32 + g * 8 + jj;
                    E[row * 132 + kB] = ev[sc * 8 + jj];
                    Kd[row * 136 + kB] = f2bf(kd[sc * 8 + jj]);
                    if (sc == 0) K10[row * 136 + kB] = f2bf(kd[jj] * elast[0]);
                }
            if (g == 3) { EL[kB] = elast[0]; EL[128 + kB] = elast[1]; }
#pragma unroll
            for (int jj = 0; jj < 8; ++jj) { kbf[0][jj] = (short)f2bf(kd[jj] * elast[0] * elast[1]); kbf[1][jj] = (short)f2bf(kd[8 + jj] * elast[1]); }
        }
        {
            const unsigned w4[4] = {vA.x, vA.y, vA.z, vA.w};
#pragma unroll
            for (int q = 0; q < 4; ++q) { vTn[(vc8 + 2 * q) * 72 + vrow] = (bf16_t)(w4[q] & 0xffffu); vTn[(vc8 + 2 * q + 1) * 72 + vrow] = (bf16_t)(w4[q] >> 16); }
        }
        const uint4 qc0 = qA0, qc1 = qA1;
        if (n + 1 < 32) HG_PREFETCH(n + 1);
        __syncthreads();
        {
            const f32x4 d31 = *(const f32x4*)(EL + wave * 16 + 4 * g), d63 = *(const f32x4*)(EL + 128 + wave * 16 + 4 * g);
            const f32x4 dk = d31 * d63;
            bf16_t* stw = STb + (n & 1) * (64 * 136);
#pragma unroll
            for (int vt = 0; vt < 4; ++vt) {
                f32x4 c = accS[vt] * dk;
#pragma unroll
                for (int sc = 0; sc < 2; ++sc) {
                    const bf16x8 vf = *(const bf16x8*)(vTn + (vt * 16 + r16) * 72 + sc * 32 + 8 * g);
                    c = mfma16(kbf[sc], vf, c);
                }
                accS[vt] = c;
                uint2 w; w.x = pack2(c[0], c[1]); w.y = pack2(c[2], c[3]);
                *(uint2*)(stw + (vt * 16 + r16) * 136 + wave * 16 + 4 * g) = w;
            }
        }
        {
            const f32x4 e31a = *(const f32x4*)(EL + k8A), e31b = *(const f32x4*)(EL + k8A + 4);
#pragma unroll
            for (int u = 0; u < 2; ++u) {
                const int row = rowA + u * 32;
                const uint4 qq = u ? qc1 : qc0;
                const f32x4 ea = *(const f32x4*)(E + row * 132 + k8A), eb = *(const f32x4*)(E + row * 132 + k8A + 4);
                const float qr[8] = {bflo(qq.x), bfhi(qq.x), bflo(qq.y), bfhi(qq.y), bflo(qq.z), bfhi(qq.z), bflo(qq.w), bfhi(qq.w)};
                float qt[8], qh[8];
#pragma unroll
                for (int i = 0; i < 8; ++i) {
                    const float qs = qr[i];
                    qt[i] = qs * (i < 4 ? ea[i] : eb[i - 4]);
                    qh[i] = u ? qt[i] * (i < 4 ? e31a[i] : e31b[i - 4]) : qt[i];
                }
                *(uint4*)(Qt + row * 136 + k8A) = make_uint4(pack2(qt[0], qt[1]), pack2(qt[2], qt[3]), pack2(qt[4], qt[5]), pack2(qt[6], qt[7]));
                *(uint4*)(Qh + row * 136 + k8A) = make_uint4(pack2(qh[0], qh[1]), pack2(qh[2], qh[3]), pack2(qh[4], qh[5]), pack2(qh[6], qh[7]));
            }
        }
        __syncthreads();
#pragma unroll
        for (int q2 = 0; q2 < 2; ++q2) {
            const int tix = wave * 2 + q2, ti = tix >> 2, si = tix & 3;
            f32x4 sc = (f32x4){0.f, 0.f, 0.f, 0.f};
            if (si <= ti) {
                const bf16_t* kb = (ti >= 2 && si < 2) ? K10 : Kd;
#pragma unroll
                for (int kk = 0; kk < 4; ++kk) {
                    const bf16x8 af = *(const bf16x8*)(Qt + (ti * 16 + r16) * 136 + kk * 32 + 8 * g);
                    const bf16x8 bfr = *(const bf16x8*)(kb + (si * 16 + r16) * 136 + kk * 32 + 8 * g);
                    sc = mfma16(bfr, af, sc);
                }
                if (si == ti) {
#pragma unroll
                    for (int r = 0; r < 4; ++r) if (4 * g + r > r16) sc[r] = 0.f;
                }
            }
            uint2 w; w.x = pack2(sc[0], sc[1]); w.y = pack2(sc[2], sc[3]);
            *(uint2*)(Sm + (ti * 16 + r16) * 72 + si * 16 + 4 * g) = w;
        }
        __syncthreads();
#pragma unroll
        for (int q2 = 0; q2 < 2; ++q2) {
            const int ti = wave >> 1, vi = (wave & 1) * 2 + q2;
            const bf16_t* stp = STb + ((n + 1) & 1) * (64 * 136);
            f32x4 o = (f32x4){0.f, 0.f, 0.f, 0.f};
#pragma unroll
            for (int kk = 0; kk < 2; ++kk) {
                const bf16x8 af = *(const bf16x8*)(Sm + (ti * 16 + r16) * 72 + kk * 32 + 8 * g);
                const bf16x8 bfr = *(const bf16x8*)(vTn + (vi * 16 + r16) * 72 + kk * 32 + 8 * g);
                o = mfma16(bfr, af, o);
            }
#pragma unroll
            for (int kk = 0; kk < 4; ++kk) {
                const bf16x8 af = *(const bf16x8*)(Qh + (ti * 16 + r16) * 136 + kk * 32 + 8 * g);
                const bf16x8 bfr = *(const bf16x8*)(stp + (vi * 16 + r16) * 136 + kk * 32 + 8 * g);
                o = mfma16(bfr, af, o);
            }
            const int tau = n * 64 + ti * 16 + r16, tt = dir ? (SEQ - 1 - tau) : tau;
            uint2 w; w.x = pack2(o[0], o[1]); w.y = pack2(o[2], o[3]);
            *(uint2*)(OHG + ((size_t)dir * T + tokbase + tt) * 512 + h * 128 + vs * 64 + vi * 16 + 4 * g) = w;
        }
    }
#undef HG_PREFETCH
    __syncthreads();
}

__device__ void phase6(const Args& a) {
    unsigned char* ws = a.ws;
    const bf16_t* OHG = (const bf16_t*)(ws + WS_D); const bf16_t* PROJ = (const bf16_t*)(ws + WS_C);
    bf16_t* YCAT = (bf16_t*)(ws + WS_B);
    const int lane = threadIdx.x & 63;
    for (int t = blockIdx.x * 8 + (threadIdx.x >> 6); t < T; t += gridDim.x * 8) {
        const int c0 = lane * 8;
        const uint4 f = *(const uint4*)(OHG + (size_t)t * 512 + c0), bw = *(const uint4*)(OHG + ((size_t)T + t) * 512 + c0);
        const uint4 gg = *(const uint4*)(PROJ + (size_t)t * INW + OFF_G + c0);
        float o[8];
        o[0] = bflo(f.x) + bflo(bw.x); o[1] = bfhi(f.x) + bfhi(bw.x); o[2] = bflo(f.y) + bflo(bw.y); o[3] = bfhi(f.y) + bfhi(bw.y);
        o[4] = bflo(f.z) + bflo(bw.z); o[5] = bfhi(f.z) + bfhi(bw.z); o[6] = bflo(f.w) + bflo(bw.w); o[7] = bfhi(f.w) + bfhi(bw.w);
        float gr[8] = {bflo(gg.x), bfhi(gg.x), bflo(gg.y), bfhi(gg.y), bflo(gg.z), bfhi(gg.z), bflo(gg.w), bfhi(gg.w)};
        float ss = 0.f;
#pragma unroll
        for (int i = 0; i < 8; ++i) ss += o[i] * o[i];
        ss += __shfl_xor(ss, 1, 64); ss += __shfl_xor(ss, 2, 64); ss += __shfl_xor(ss, 4, 64); ss += __shfl_xor(ss, 8, 64);
        const float rs = rsqrtf(ss * (1.f / 128.f) + EPS);
        float y[8];
#pragma unroll
        for (int i = 0; i < 8; ++i) { const float gt = gr[i] * frcp(1.f + __expf(-gr[i])); y[i] = o[i] * rs * a.hg_o_norm[c0 + i] * gt; }
        *(uint4*)(YCAT + (size_t)t * DM + c0) = make_uint4(pack2(y[0], y[1]), pack2(y[2], y[3]), pack2(y[4], y[5]), pack2(y[6], y[7]));
    }
}

template <int NB>
__device__ void convert_tables(const Args& a, int gw, int nw) {
    unsigned char* ws = a.ws;
    const int lane = threadIdx.x & 63;
    for (int rr0 = gw; rr0 < 32768; rr0 += nw * NB) {
        f32x4 x[NB][4];
#pragma unroll
        for (int b = 0; b < NB; ++b) {
            int rr = rr0 + b * nw; rr = rr < 32768 ? rr : 32767;
            const float* src = (rr >= 16384 ? a.peer_v : a.peer_u) + (size_t)(rr & 16383) * DM + lane * 4;
#pragma unroll
            for (int q = 0; q < 4; ++q) x[b][q] = *(const f32x4*)(src + q * 256);
        }
#pragma unroll
        for (int b = 0; b < NB; ++b) {
            const int rr = rr0 + b * nw;
            if (rr >= 32768) break;
            const bool isv = rr >= 16384; const int row = rr & 16383;
            float ss = 0.f;
#pragma unroll
            for (int q = 0; q < 4; ++q) ss += x[b][q][0] * x[b][q][0] + x[b][q][1] * x[b][q][1] + x[b][q][2] * x[b][q][2] + x[b][q][3] * x[b][q][3];
            ss = wave_sum(ss);
            const float rms = sqrtf(ss * (1.f / 1024.f));
            if (isv) {
                const float sc = 0.47f * rms, inv = sc > 0.f ? 1.f / sc : 0.f;
                unsigned char* dst = ws + WS_V4 + (size_t)row * 512 + lane * 2;
#pragma unroll
                for (int q = 0; q < 4; ++q) {
                    unsigned pk = 0;
                    pk = __builtin_amdgcn_cvt_scalef32_pk_fp4_f32(pk, fminf(fmaxf(x[b][q][0] * inv, -6.f), 6.f), fminf(fmaxf(x[b][q][1] * inv, -6.f), 6.f), 1.0f, 0);
                    pk = __builtin_amdgcn_cvt_scalef32_pk_fp4_f32(pk, fminf(fmaxf(x[b][q][2] * inv, -6.f), 6.f), fminf(fmaxf(x[b][q][3] * inv, -6.f), 6.f), 1.0f, 1);
                    *(unsigned short*)(dst + q * 128) = (unsigned short)pk;
                }
                if (lane == 0) ((float*)(ws + WS_VSCALE))[row] = sc;
            } else {
                const float st = 0.36f * rms, inv = st > 0.f ? 1.f / st : 0.f;
                unsigned char* dst = ws + WS_U4 + (size_t)row * 512 + lane * 2;
                int qs = 0;
#pragma unroll
                for (int q = 0; q < 4; ++q) {
                    unsigned hw = 0;
#pragma unroll
                    for (int e = 0; e < 4; ++e) { const int qi = (int)rintf(fminf(fmaxf(x[b][q][e] * inv, -8.f), 7.f)); qs += qi; hw |= (unsigned)(qi & 15) << (4 * e); }
                    *(unsigned short*)(dst + q * 128) = (unsigned short)hw;
                }
#pragma unroll
                for (int d = 32; d > 0; d >>= 1) qs += __shfl_xor(qs, d, 64);
                if (lane == 0) { ((float*)(ws + WS_USCALE))[row] = st; ((int*)(ws + WS_USUM))[row] = qs; }
            }
        }
    }
}

__device__ void phase7(const Args& a, unsigned char* lds) {
    unsigned char* ws = a.ws;
    g256::EpiResid e{a.x, (bf16_t*)(ws + WS_R)};
    for (int i = 0;; ++i) { int pm, pn; if (!g256::next_tile(i * gridDim.x + blockIdx.x, 64, 4, pm, pn)) break;
        __syncthreads();
        g256::tile((const bf16_t*)(ws + WS_B), (const bf16_t*)(ws + WS_WOUT_T), DM, pm * 256, pn * 256, lds, e); }
    __syncthreads();
    convert_tables<4>(a, blockIdx.x * 8 + (threadIdx.x >> 6), gridDim.x * 8);
}


__device__ __forceinline__ void ce_desc(float& x, float& y) { const float hi = fmaxf(x, y), lo = fminf(x, y); x = hi; y = lo; }
template <int N> __device__ __forceinline__ void bitonic_sort_desc(float (&v)[N]) {
#pragma unroll
    for (int k = 2; k <= N; k <<= 1)
#pragma unroll
        for (int j = k >> 1; j > 0; j >>= 1)
#pragma unroll
            for (int i = 0; i < N; ++i) { const int l = i ^ j; if (l > i) { if ((i & k) == 0) ce_desc(v[i], v[l]); else ce_desc(v[l], v[i]); } }
}
template <int N> __device__ __forceinline__ void bitonic_merge_desc(float (&v)[N]) {
#pragma unroll
    for (int j = N >> 1; j > 0; j >>= 1)
#pragma unroll
        for (int i = 0; i < N; ++i) { const int l = i ^ j; if (l > i) ce_desc(v[i], v[l]); }
}
__device__ __forceinline__ void xlane_merge16(float (&v)[16], int mask) {
    float o[16];
#pragma unroll
    for (int i = 0; i < 16; ++i) o[i] = __shfl_xor(v[15 - i], mask, 64);
#pragma unroll
    for (int i = 0; i < 16; ++i) v[i] = fmaxf(v[i], o[i]);
    bitonic_merge_desc<16>(v);
}
__device__ __forceinline__ unsigned bsel(unsigned m, unsigned x1, unsigned x0) { return x0 ^ ((x1 ^ x0) & m); }
__device__ __forceinline__ float sel16(const float (&v)[16], unsigned i) {
    const unsigned m0 = 0u - (i & 1u), m1 = 0u - ((i >> 1) & 1u), m2 = 0u - ((i >> 2) & 1u), m3 = 0u - ((i >> 3) & 1u);
    unsigned t8[8], t4[4], t2[2];
#pragma unroll
    for (int q = 0; q < 8; ++q) t8[q] = bsel(m0, __float_as_uint(v[2 * q + 1]), __float_as_uint(v[2 * q]));
#pragma unroll
    for (int q = 0; q < 4; ++q) t4[q] = bsel(m1, t8[2 * q + 1], t8[2 * q]);
#pragma unroll
    for (int q = 0; q < 2; ++q) t2[q] = bsel(m2, t4[2 * q + 1], t4[2 * q]);
    return __uint_as_float(bsel(m3, t2[1], t2[0]));
}
__device__ __forceinline__ float sel4(int g, float x0, float x1, float x2, float x3) {
    const unsigned m0 = 0u - ((unsigned)g & 1u), m1 = 0u - (((unsigned)g >> 1) & 1u);
    const unsigned lo = bsel(m0, __float_as_uint(x1), __float_as_uint(x0)), hi = bsel(m0, __float_as_uint(x3), __float_as_uint(x2));
    return __uint_as_float(bsel(m1, hi, lo));
}

static constexpr int PI[52] = {0,0,0,0,0,0,0,0,0,0,0,0,0,0,0,0,1,1,1,1,1,1,1,1,2,2,2,2,2,3,3,3,3,4,4,4,5,5,6,6,7,7,8,9,10,11,12,13,14,15,0,0};
static constexpr int PJ[52] = {0,1,2,3,4,5,6,7,8,9,10,11,12,13,14,15,0,1,2,3,4,5,6,7,0,1,2,3,4,0,1,2,3,0,1,2,0,1,0,1,0,1,0,0,0,0,0,0,0,0,0,0};
constexpr int RT_ROW = 272;
__device__ __forceinline__ void peer_half_top16(const bf16_t* __restrict__ PQ, const unsigned char* __restrict__ skl, int t0, int p, int c, int r16, int g, float (&out)[16]) {
    f32x4 sc[8];
#pragma unroll
    for (int ni = 0; ni < 8; ++ni) sc[ni] = (f32x4){0.f, 0.f, 0.f, 0.f};
    bf16x8 af[4];
#pragma unroll
    for (int kk = 0; kk < 4; ++kk) af[kk] = *(const bf16x8*)(PQ + (size_t)(t0 + r16) * 2048 + p * 256 + c * 128 + kk * 32 + 8 * g);
#pragma unroll
    for (int kk = 0; kk < 4; ++kk) {
        asm volatile("" ::: "memory");
#pragma unroll
        for (int ni = 0; ni < 8; ++ni) {
            const bf16x8 bfr = *(const bf16x8*)(skl + (c * 128 + ni * 16 + r16) * RT_ROW + kk * 64 + 16 * g);
            sc[ni] = mfma16(bfr, af[kk], sc[ni]);
        }
    }
    float hi[16];
#pragma unroll
    for (int ni = 0; ni < 4; ++ni)
#pragma unroll
        for (int r = 0; r < 4; ++r) {
            out[ni * 4 + r] = __uint_as_float((__float_as_uint(sc[ni][r]) & 0xffffff80u) | (unsigned)(ni * 16 + 4 * g + r));
            hi[ni * 4 + r] = __uint_as_float((__float_as_uint(sc[ni + 4][r]) & 0xffffff80u) | (unsigned)((ni + 4) * 16 + 4 * g + r));
        }
    bitonic_sort_desc<16>(out);
    bitonic_sort_desc<16>(hi);
#pragma unroll
    for (int i = 0; i < 16; ++i) out[i] = fmaxf(out[i], hi[15 - i]);
    bitonic_merge_desc<16>(out);
    xlane_merge16(out, 16);
    xlane_merge16(out, 32);
}
__device__ __forceinline__ void peer_route_finish(const Args& a, int p, int t0, const float (&ab0)[16], const float (&ab1)[16]) {
    unsigned char* ws = a.ws;
    int* IDX = (int*)(ws + WS_IDX); float* GATE = (float*)(ws + WS_GATE);
    int tix_ = threadIdx.x; asm volatile("" : "+v"(tix_));
    const int lane = tix_ & 63, r16 = lane & 15, g = lane >> 4;
    float va[16], vb[16];
#pragma unroll
    for (int i = 0; i < 16; ++i) { va[i] = __uint_as_float(__float_as_uint(ab0[i]) & 0xffffff80u); vb[i] = __uint_as_float(__float_as_uint(ab1[i]) & 0xffffff80u); }
    float v[16];
#pragma unroll
    for (int s = 0; s < 13; ++s) {
        const float x0 = __uint_as_float((__float_as_uint(va[PI[4 * s]] + vb[PJ[4 * s]]) & 0xffffff00u) | (unsigned)(PI[4 * s] * 16 + PJ[4 * s]));
        const float x1 = __uint_as_float((__float_as_uint(va[PI[4 * s + 1]] + vb[PJ[4 * s + 1]]) & 0xffffff00u) | (unsigned)(PI[4 * s + 1] * 16 + PJ[4 * s + 1]));
        const float x2 = (4 * s + 2 < 50) ? __uint_as_float((__float_as_uint(va[PI[4 * s + 2]] + vb[PJ[4 * s + 2]]) & 0xffffff00u) | (unsigned)(PI[4 * s + 2] * 16 + PJ[4 * s + 2])) : -3.0e38f;
        const float x3 = (4 * s + 3 < 50) ? __uint_as_float((__float_as_uint(va[PI[4 * s + 3]] + vb[PJ[4 * s + 3]]) & 0xffffff00u) | (unsigned)(PI[4 * s + 3] * 16 + PJ[4 * s + 3])) : -3.0e38f;
        v[s] = sel4(g, x0, x1, x2, x3);
    }
    v[13] = -3.0e38f; v[14] = -3.0e38f; v[15] = -3.0e38f;
    bitonic_sort_desc<16>(v);
    xlane_merge16(v, 16);
    xlane_merge16(v, 32);
    float e[16], sum = 0.f;
    const float mtop = __uint_as_float(__float_as_uint(v[0]) & 0xffffff00u);
#pragma unroll
    for (int q = 0; q < 16; ++q) { e[q] = __expf(__uint_as_float(__float_as_uint(v[q]) & 0xffffff00u) - mtop); sum += e[q]; }
    const float inv = 1.f / sum;
    int oi[4]; float og[4];
#pragma unroll
    for (int r = 0; r < 4; ++r) {
        const unsigned key = __float_as_uint(sel4(g, v[r], v[4 + r], v[8 + r], v[12 + r]));
        const unsigned pos = key & 255u;
        const unsigned ia = __float_as_uint(sel16(ab0, pos >> 4)) & 127u, ib = __float_as_uint(sel16(ab1, pos & 15u)) & 127u;
        oi[r] = (int)(ia * 128u + ib);
        og[r] = sel4(g, e[r], e[4 + r], e[8 + r], e[12 + r]) * inv;
    }
    const size_t o = (size_t)(t0 + r16) * 128 + p * 16 + 4 * g;
    *(int4*)(IDX + o) = make_int4(oi[0], oi[1], oi[2], oi[3]);
    *(f32x4*)(GATE + o) = (f32x4){og[0], og[1], og[2], og[3]};
}

__device__ __forceinline__ float dpp_xor1(float v) { return __builtin_bit_cast(float, __builtin_amdgcn_mov_dpp(__builtin_bit_cast(int, v), 0xB1, 0xF, 0xF, true)); }
__device__ __forceinline__ float dpp_xor2(float v) { return __builtin_bit_cast(float, __builtin_amdgcn_mov_dpp(__builtin_bit_cast(int, v), 0x4E, 0xF, 0xF, true)); }
__device__ __forceinline__ float dpp_hmirror(float v) { return __builtin_bit_cast(float, __builtin_amdgcn_mov_dpp(__builtin_bit_cast(int, v), 0x141, 0xF, 0xF, true)); }


constexpr int PU_ROW = 272;
__device__ __forceinline__ float dot2bf(unsigned x, unsigned y, float acc) { return __builtin_amdgcn_fdot2_f32_bf16(__builtin_bit_cast(bf16v2, x), __builtin_bit_cast(bf16v2, y), acc, false); }


__device__ __forceinline__ void peer_half_top16_lds(const unsigned char* __restrict__ qs, const unsigned char* __restrict__ skl, int r16, int g, float (&out)[16]) {
    f32x4 sc[8];
#pragma unroll
    for (int ni = 0; ni < 8; ++ni) sc[ni] = (f32x4){0.f, 0.f, 0.f, 0.f};
#pragma unroll
    for (int kk = 0; kk < 4; ++kk) {
        asm volatile("" ::: "memory");
        const bf16x8 af = *(const bf16x8*)(qs + r16 * RT_ROW + kk * 64 + 16 * g);
#pragma unroll
        for (int ni = 0; ni < 8; ++ni) {
            const bf16x8 bfr = *(const bf16x8*)(skl + (ni * 16 + r16) * RT_ROW + kk * 64 + 16 * g);
            sc[ni] = mfma16(bfr, af, sc[ni]);
        }
    }
    float hi[16];
#pragma unroll
    for (int ni = 0; ni < 4; ++ni)
#pragma unroll
        for (int r = 0; r < 4; ++r) {
            out[ni * 4 + r] = __uint_as_float((__float_as_uint(sc[ni][r]) & 0xffffff80u) | (unsigned)(ni * 16 + 4 * g + r));
            hi[ni * 4 + r] = __uint_as_float((__float_as_uint(sc[ni + 4][r]) & 0xffffff80u) | (unsigned)((ni + 4) * 16 + 4 * g + r));
        }
    bitonic_sort_desc<16>(out);
    bitonic_sort_desc<16>(hi);
#pragma unroll
    for (int i = 0; i < 16; ++i) out[i] = fmaxf(out[i], hi[15 - i]);
    bitonic_merge_desc<16>(out);
    xlane_merge16(out, 16);
    xlane_merge16(out, 32);
}
struct EpiRoute { const Args* ap; unsigned char* lds; int p; int brow;
    __device__ __forceinline__ void operator()(const f32x4 (&acc)[2][2][4][2], int row0, int col0) const {
        int tix = threadIdx.x; asm volatile("" : "+v"(tix));
        const int lane = tix & 63, wave = tix >> 6, r16 = lane & 15, g = lane >> 4;
        unsigned char* qs = lds;
        unsigned char* skl = lds + 256 * RT_ROW;
        const int rl0 = row0 - brow, cl0 = (col0 - p * 256);
        float* tl = (float*)(lds + 384 * RT_ROW);
#pragma unroll 1
        for (int c = 0; c < 2; ++c) {
            __syncthreads();
#pragma unroll
            for (int ai = 0; ai < 2; ++ai)
#pragma unroll
                for (int m = 0; m < 4; ++m)
#pragma unroll
                    for (int n = 0; n < 2; ++n) { const f32x4 v = c ? acc[ai][1][m][n] : acc[ai][0][m][n]; uint2 w; w.x = pack2(v[0], v[1]); w.y = pack2(v[2], v[3]);
                        *(uint2*)(qs + (rl0 + ai * 128 + m * 16) * RT_ROW + (cl0 + n * 16) * 2) = w; }
            { const bf16_t* SK = (const bf16_t*)(ap->ws + WS_SUBK) + ((size_t)p * 2 + c) * 128 * 128;
              for (int ch = tix; ch < 128 * 16; ch += NT) { const int row = ch >> 4, q = ch & 15; *(uint4*)(skl + row * RT_ROW + q * 16) = *(const uint4*)(SK + row * 128 + q * 8); } }
            __syncthreads();
#pragma unroll 1
            for (int k = 0; k < 2; ++k) {
                float lst[16];
                peer_half_top16_lds(qs + ((wave * 2 + k) * 16) * RT_ROW, skl, r16, g, lst);
                if (g == 0) { float* d = tl + (((wave * 2 + k) * 16 + r16) * 2 + c) * 16;
#pragma unroll
                    for (int q = 0; q < 4; ++q) *(f32x4*)(d + q * 4) = (f32x4){lst[q * 4], lst[q * 4 + 1], lst[q * 4 + 2], lst[q * 4 + 3]}; }
            }
        }
        __syncthreads();
#pragma unroll 1
        for (int k = 0; k < 2; ++k) {
            float ab0[16], ab1[16];
            const float* d = tl + (((wave * 2 + k) * 16 + r16) * 2) * 16;
#pragma unroll
            for (int q = 0; q < 4; ++q) { const f32x4 x0 = *(const f32x4*)(d + q * 4), x1 = *(const f32x4*)(d + 16 + q * 4);
                ab0[q * 4] = x0[0]; ab0[q * 4 + 1] = x0[1]; ab0[q * 4 + 2] = x0[2]; ab0[q * 4 + 3] = x0[3]; ab1[q * 4] = x1[0]; ab1[q * 4 + 1] = x1[1]; ab1[q * 4 + 2] = x1[2]; ab1[q * 4 + 3] = x1[3]; }
            peer_route_finish(*ap, p, brow + (wave * 2 + k) * 16, ab0, ab1);
        }
    }
};

__device__ void phase9_fused(const Args& a, unsigned char* lds) {
    unsigned char* ws = a.ws;
    for (int i = 0;; ++i) { int pm, pn; if (!g256::next_tile(i * gridDim.x + blockIdx.x, 64, 8, pm, pn)) break;
        EpiRoute e{&a, lds, pn, pm * 256};
        __syncthreads();
        g256::tile((const bf16_t*)(ws + WS_B), (const bf16_t*)(ws + WS_WPQ_T), DM, pm * 256, pn * 256, lds, e); }
    __syncthreads();
}

__device__ __forceinline__ int idpp_xor1(int v) { return __builtin_amdgcn_mov_dpp(v, 0xB1, 0xF, 0xF, true); }
__device__ __forceinline__ int idpp_xor2(int v) { return __builtin_amdgcn_mov_dpp(v, 0x4E, 0xF, 0xF, true); }
__device__ __forceinline__ int idpp_hmirror(int v) { return __builtin_amdgcn_mov_dpp(v, 0x141, 0xF, 0xF, true); }

__device__ void peer_uv_phase(const Args& a, unsigned char* lds) {
    unsigned char* ws = a.ws;
    const unsigned char* H4 = ws + WS_H4; const unsigned char* U4 = ws + WS_U4; const unsigned char* V4 = ws + WS_V4;
    const unsigned* IDX = (const unsigned*)(ws + WS_IDX); const float* GATE = (const float*)(ws + WS_GATE);
    const float* VS = (const float*)(ws + WS_VSCALE); const float* US = (const float*)(ws + WS_USCALE);
    const int* USUM = (const int*)(ws + WS_USUM); const float* HS = (const float*)(ws + WS_HS);
    const int wv = __builtin_amdgcn_readfirstlane((int)(threadIdx.x >> 6));
    unsigned char* wl = lds + wv * 6528;
    unsigned char* il = wl + 8 * 272;
    for (int item = blockIdx.x * 8 + wv; item < 2048; item += gridDim.x * 8) {
    const int tpbase = ((item >> 3) & 7) * 1024 + (item >> 6) * 8 + (item & 7);
    {
    int tix = threadIdx.x; asm volatile("" : "+v"(tix));
    const int lane = tix & 63, m = lane & 7, j = lane >> 3;
    const size_t tp0 = (size_t)tpbase;
    int acc[4][2][2];
#pragma unroll
    for (int k = 0; k < 4; ++k) { acc[k][0][0] = 0; acc[k][0][1] = 0; acc[k][1][0] = 0; acc[k][1][1] = 0; }
#pragma unroll 1
    for (int sl = 0; sl < 4; ++sl) {
        const unsigned uoff = (unsigned)(sl * 128 + 16 * m);
#pragma unroll
        for (int k = 0; k < 4; ++k) {
            const size_t tp = tp0 + 256 * k;
            uint4 ha[2], hb[2]; uint4 iq[2][4];
#pragma unroll
            for (int tt = 0; tt < 2; ++tt) {
                const size_t t = tp * 2 + tt;
                ha[tt] = *(const uint4*)(H4 + t * 1024 + sl * 256 + m * 32); hb[tt] = *(const uint4*)(H4 + t * 1024 + sl * 256 + m * 32 + 16);
#pragma unroll
                for (int q = 0; q < 4; ++q) iq[tt][q] = *(const uint4*)(IDX + t * 128 + j * 16 + q * 4);
            }
            uint4 uq[2][16];
#pragma unroll
            for (int tt = 0; tt < 2; ++tt)
#pragma unroll
                for (int q = 0; q < 4; ++q) {
                    uq[tt][q * 4] = *(const uint4*)(U4 + (iq[tt][q].x * 512u + uoff)); uq[tt][q * 4 + 1] = *(const uint4*)(U4 + (iq[tt][q].y * 512u + uoff));
                    uq[tt][q * 4 + 2] = *(const uint4*)(U4 + (iq[tt][q].z * 512u + uoff)); uq[tt][q * 4 + 3] = *(const uint4*)(U4 + (iq[tt][q].w * 512u + uoff));
                }
#pragma unroll
            for (int tt = 0; tt < 2; ++tt) {
                const int haw[4] = {(int)ha[tt].x, (int)ha[tt].y, (int)ha[tt].z, (int)ha[tt].w};
                const int hbw[4] = {(int)hb[tt].x, (int)hb[tt].y, (int)hb[tt].z, (int)hb[tt].w};
                int val0 = 0, val1 = 0;
#pragma unroll
                for (int it = 0; it < 16; ++it) {
                    int wd[4] = {(int)uq[tt][it].x, (int)uq[tt][it].y, (int)uq[tt][it].z, (int)uq[tt][it].w};
                    asm volatile("" : "+v"(wd[0]), "+v"(wd[1]), "+v"(wd[2]), "+v"(wd[3]), "+v"(val0), "+v"(val1));
                    int dh = 0, dl = 0;
#pragma unroll
                    for (int q = 0; q < 4; ++q) { dh = __builtin_amdgcn_sdot8(haw[q], wd[q], dh, false); dl = __builtin_amdgcn_sdot8(hbw[q], wd[q], dl, false); }
                    int d = (dh << 4) + dl;
                    d += idpp_xor1(d); d += idpp_xor2(d); d += idpp_hmirror(d);
                    if ((it >> 1) == m) { if (it & 1) val1 = d; else val0 = d; }
                }
                acc[k][tt][0] += val0; acc[k][tt][1] += val1;
            }
        }
    }
#pragma unroll
    for (int k = 0; k < 4; ++k)
#pragma unroll
        for (int tt = 0; tt < 2; ++tt) {
            const size_t t = (tp0 + 256 * k) * 2 + tt; const size_t o = t * 128 + j * 16 + 2 * m;
            const float2 gt = *(const float2*)(GATE + o); const uint2 id = *(const uint2*)(IDX + o);
            const float hs = HS[t];
            const float x0 = (float)(acc[k][tt][0] + 8 * USUM[id.x]) * (hs * US[id.x]), x1 = (float)(acc[k][tt][1] + 8 * USUM[id.y]) * (hs * US[id.y]);
            const float w0 = gt.x * 0.5f * x0 * (1.f + erff(x0 * 0.70710678118654752f)) * VS[id.x];
            const float w1 = gt.y * 0.5f * x1 * (1.f + erff(x1 * 0.70710678118654752f)) * VS[id.y];
            *(unsigned*)(wl + (2 * k + tt) * 272 + (j * 16 + 2 * m) * 2) = pack2h(w0, w1);
            *(uint2*)(il + (2 * k + tt) * 528 + (j * 16 + 2 * m) * 4) = id;
        }
    }
    int tix2 = threadIdx.x; asm volatile("" : "+v"(tix2));
    const int m2 = tix2 & 7, j2 = (tix2 >> 3) & 7;
    const unsigned tv = (unsigned)((tpbase + 256 * (j2 >> 1)) * 2 + (j2 & 1));
    const unsigned char* wrow = wl + j2 * 272; const unsigned char* irow = il + j2 * 528;
#pragma unroll 1
    for (int sl = 0; sl < 4; ++sl) {
        const unsigned voff = (unsigned)(sl * 128 + 16 * m2);
        float y[32];
#pragma unroll
        for (int i = 0; i < 32; ++i) y[i] = 0.f;
#pragma unroll 1
        for (int grp = 0; grp < 4; ++grp) {
            uint4 wq[4];
            uint4 vq[32];
#pragma unroll
            for (int q = 0; q < 8; ++q) {
                const uint4 i4 = *(const uint4*)(irow + grp * 128 + q * 16);
                vq[q * 4] = *(const uint4*)(V4 + (i4.x * 512u + voff)); vq[q * 4 + 1] = *(const uint4*)(V4 + (i4.y * 512u + voff));
                vq[q * 4 + 2] = *(const uint4*)(V4 + (i4.z * 512u + voff)); vq[q * 4 + 3] = *(const uint4*)(V4 + (i4.w * 512u + voff));
            }
#pragma unroll
            for (int q = 0; q < 4; ++q) wq[q] = *(const uint4*)(wrow + grp * 64 + q * 16);
#pragma unroll
            for (int it = 0; it < 32; ++it) {
                const uint4 wv4 = wq[it >> 3]; const int wc_ = (it >> 1) & 3;
                const unsigned wword = wc_ == 0 ? wv4.x : (wc_ == 1 ? wv4.y : (wc_ == 2 ? wv4.z : wv4.w));
                const f16v2 wp = __builtin_bit_cast(f16v2, wword);
                const float wt = (float)((it & 1) ? wp[1] : wp[0]);
                unsigned wd0 = vq[it].x, wd1 = vq[it].y, wd2 = vq[it].z, wd3 = vq[it].w;
                asm volatile("" : "+v"(wd0), "+v"(wd1), "+v"(wd2), "+v"(wd3), "+v"(y[0]));
                const unsigned wd[4] = {wd0, wd1, wd2, wd3};
#pragma unroll
                for (int q = 0; q < 4; ++q) {
                    const f32v2 p0 = __builtin_amdgcn_cvt_scalef32_pk_f32_fp4(wd[q], 1.0f, 0), p1 = __builtin_amdgcn_cvt_scalef32_pk_f32_fp4(wd[q], 1.0f, 1);
                    const f32v2 p2 = __builtin_amdgcn_cvt_scalef32_pk_f32_fp4(wd[q], 1.0f, 2), p3 = __builtin_amdgcn_cvt_scalef32_pk_f32_fp4(wd[q], 1.0f, 3);
                    y[q * 8] += wt * p0[0]; y[q * 8 + 1] += wt * p0[1]; y[q * 8 + 2] += wt * p1[0]; y[q * 8 + 3] += wt * p1[1];
                    y[q * 8 + 4] += wt * p2[0]; y[q * 8 + 5] += wt * p2[1]; y[q * 8 + 6] += wt * p3[0]; y[q * 8 + 7] += wt * p3[1];
                }
            }
        }
        const unsigned ooff = tv * (unsigned)DM + (unsigned)(sl * 256 + 32 * m2);
        const bf16_t* rrow = (const bf16_t*)(ws + WS_R) + ooff; float* orow = a.out + ooff;
#pragma unroll
        for (int q = 0; q < 4; ++q) {
            const uint4 r = *(const uint4*)(rrow + q * 8);
            *(f32x4*)(orow + q * 8) = (f32x4){bflo(r.x) + y[q * 8], bfhi(r.x) + y[q * 8 + 1], bflo(r.y) + y[q * 8 + 2], bfhi(r.y) + y[q * 8 + 3]};
            *(f32x4*)(orow + q * 8 + 4) = (f32x4){bflo(r.z) + y[q * 8 + 4], bfhi(r.z) + y[q * 8 + 5], bflo(r.w) + y[q * 8 + 6], bfhi(r.w) + y[q * 8 + 7]};
        }
    }
    }
}

#define XB_TMO      128
#define XB_XCNT(j)  (256  + 64 * (j))
#define XB_XSUB(j)  (1280 + 64 * (j))
#define XB_XGEN(j)  (2304 + 64 * (j))
#define XB_TOP      3328
#define XB_TOPGEN   3392
#define XCD_BAR_WORDS 3456
#define XB_SPIN_CAP (1u << 22)
#define LAS __attribute__((address_space(3)))
__device__ __forceinline__ unsigned xb_ld(unsigned* p)              { return __hip_atomic_load(p, __ATOMIC_RELAXED, __HIP_MEMORY_SCOPE_AGENT); }
__device__ __forceinline__ unsigned xb_add(unsigned* p, unsigned v) { return __hip_atomic_fetch_add(p, v, __ATOMIC_RELAXED, __HIP_MEMORY_SCOPE_AGENT); }
__device__ __forceinline__ unsigned xb_xcc_id() { return (unsigned)__builtin_amdgcn_s_getreg((3 << 11) | 20) & 0xFu; }
#define XB_SPIN(cond, bar) do { unsigned _sp = 0; while (cond) { __builtin_amdgcn_s_sleep(1); \
    if ((++_sp & 255u) == 0u) { if (xb_ld(&(bar)[XB_TMO])) break; if (_sp > XB_SPIN_CAP) { atomicAdd(&(bar)[XB_TMO], 1u); break; } } } } while (0)
struct XcdBarrier { unsigned* bar; unsigned x; volatile LAS unsigned* st; };
__device__ __forceinline__ XcdBarrier xcd_barrier_post(unsigned* bar, volatile LAS unsigned* st) {
    XcdBarrier b; b.bar = bar; b.x = xb_xcc_id(); b.st = st;
    if (threadIdx.x == 0) (void)xb_add(&bar[XB_XCNT(b.x)], 1u);
    return b;
}
__device__ __forceinline__ void xcd_barrier_complete(unsigned* bar, unsigned x, unsigned& nloc, unsigned& nx) {
    const unsigned G = gridDim.x * gridDim.y * gridDim.z;
    unsigned sum, cnt, mine, sp = 0u;
    for (;;) {
        sum = 0u; cnt = 0u; mine = 0u;
#pragma unroll
        for (unsigned j = 0; j < 16; ++j) { const unsigned c = xb_ld(&bar[XB_XCNT(j)]); sum += c; cnt += (c > 0u) ? 1u : 0u; mine = (j == x) ? c : mine; }
        if (sum == G) break;
        __builtin_amdgcn_s_sleep(1);
        if ((++sp & 255u) == 0u) { if (xb_ld(&bar[XB_TMO])) break; if (sp > XB_SPIN_CAP) { atomicAdd(&bar[XB_TMO], 1u); break; } }
    }
    nloc = mine > 0u ? mine : 1u; nx = cnt > 0u ? cnt : 1u;
}
__device__ __forceinline__ void xcd_barrier(const XcdBarrier& b) {
    asm volatile("s_waitcnt vmcnt(0)" ::: "memory");
    __syncthreads();
    if (threadIdx.x == 0) {
        unsigned* bar = b.bar;
        __builtin_amdgcn_s_waitcnt(0);
        unsigned nloc = b.st[0], nx = b.st[1];
        if (nloc == 0u) { xcd_barrier_complete(bar, b.x, nloc, nx); b.st[0] = nloc; b.st[1] = nx; }
        const unsigned old = xb_add(&bar[XB_XSUB(b.x)], 1u);
        const unsigned gen = old / nloc;
        if (old + 1u == (gen + 1u) * nloc) {
            __builtin_amdgcn_fence(__ATOMIC_RELEASE, "agent");
            asm volatile("s_waitcnt vmcnt(0)" ::: "memory");
            const unsigned og = xb_add(&bar[XB_TOP], 1u);
            const unsigned tg = og / nx;
            if (og + 1u == (tg + 1u) * nx) xb_add(&bar[XB_TOPGEN], 1u);
            else XB_SPIN(xb_ld(&bar[XB_TOPGEN]) == tg, bar);
            __builtin_amdgcn_fence(__ATOMIC_ACQUIRE, "agent");
            xb_add(&bar[XB_XGEN(b.x)], 1u);
            asm volatile("s_waitcnt vmcnt(0)" ::: "memory");
        } else {
            XB_SPIN(xb_ld(&bar[XB_XGEN(b.x)]) == gen, bar);
            __builtin_amdgcn_fence(__ATOMIC_ACQUIRE, "agent");
            asm volatile("s_waitcnt vmcnt(0)" ::: "memory");
        }
    }
    __syncthreads();
}

constexpr int LDS_MAIN = HG_LDS;
static_assert(LDS_MAIN >= 512 * PU_ROW && LDS_MAIN >= 2 * AT_BUF && LDS_MAIN >= 131072, "LDS_MAIN");
constexpr int LDS_BYTES = LDS_MAIN + 16;
constexpr int N_PHASES = 14;

__global__ void __launch_bounds__(NT, 2) fwd_kernel(Args a) {
    extern __shared__ __attribute__((aligned(16))) unsigned char lds[];
#if N_LAUNCH_MODE == 1
#ifdef USE_CG_SYNC
    cg::grid_group grid = cg::this_grid();
#endif
    volatile LAS unsigned* xst = (volatile LAS unsigned*)(lds + LDS_MAIN);
    if (threadIdx.x < 4) xst[threadIdx.x] = 0u;
    __syncthreads();
    XcdBarrier xbar = xcd_barrier_post((unsigned*)(a.ws + WS_CTL), xst);
#ifdef USE_CG_SYNC
#define SEAM(k) do { if (a.ph_lo <= (k) && (k) + 1 < a.ph_hi) { if ((k) == 0) grid.sync(); else xcd_barrier(xbar); } } while (0)
#else
#define SEAM(k) do { if (a.ph_lo <= (k) && (k) + 1 < a.ph_hi) { xcd_barrier(xbar); } } while (0)
#endif
#else
#define SEAM(k) do { } while (0)
#endif
#define IN(k) (a.ph_lo <= (k) && (k) < a.ph_hi)
#define REPS(k) for (int rep_ = 0; rep_ < ((k) == REPEAT_PHASE ? 2 : 1); ++rep_)
    if (IN(0)) REPS(0) { phase0(a, lds); } SEAM(0);
    if (IN(1)) REPS(1) { phase1(a, lds); } SEAM(1);
    if (IN(2)) REPS(2) { phase2(a); } SEAM(2);
    if (IN(3)) REPS(3) { phase3(a, lds); } SEAM(3);
    if (IN(4)) REPS(4) {
        const int nhalf = gridDim.x >> 1;
        if ((int)blockIdx.x < nhalf) { for (int r_ = 0; r_ < ATT_REP; ++r_) for (int it = blockIdx.x; it < 256; it += nhalf) attn_item(a, it, lds); }
        else { for (int r_ = 0; r_ < HG_REP; ++r_) for (int it = blockIdx.x - nhalf; it < 128; it += gridDim.x - nhalf) hgrn_item(a, it, lds); }
    } SEAM(5);
    if (IN(6)) REPS(6) { phase6(a); } SEAM(6);
    if (IN(7)) REPS(7) { phase7(a, lds); } SEAM(7);
    if (IN(8)) REPS(8) { rmsnorm_rows<true, bf16_t>((const bf16_t*)(a.ws + WS_R), a.ffn_norm, (bf16_t*)(a.ws + WS_B), blockIdx.x * 8 + (threadIdx.x >> 6), gridDim.x * 8, a.ws + WS_H4, (float*)(a.ws + WS_HS)); } SEAM(8);
    if (IN(9)) REPS(9) { phase9_fused(a, lds); } SEAM(10);
    if (IN(11)) { __syncthreads(); peer_uv_phase(a, lds); }
}

extern "C" void kernel_launch(void* const* d_in, const int* in_sizes, int n_in, void* d_out, int out_size, void* d_ws, size_t ws_size, hipStream_t stream) {
    static int grid = 0;
    if (grid == 0) {
        if (n_in != 19 || out_size != T * DM || ws_size < WS_END) { fprintf(stderr, "kernel_launch: unexpected shapes (n_in %d out %d ws %zu)\n", n_in, out_size, ws_size); grid = -1; return; }
        int dev = 0, cus = 0, per_cu = 0;
        (void)hipGetDevice(&dev); (void)hipDeviceGetAttribute(&cus, hipDeviceAttributeMultiprocessorCount, dev);
        (void)hipFuncSetAttribute((const void*)fwd_kernel, hipFuncAttributeMaxDynamicSharedMemorySize, LDS_BYTES);
        (void)hipOccupancyMaxActiveBlocksPerMultiprocessor(&per_cu, (const void*)fwd_kernel, NT, LDS_BYTES);
        if (per_cu < 1) { fprintf(stderr, "kernel_launch: occupancy query says %d blocks/CU\n", per_cu); per_cu = 1; }
        grid = cus;
        (void)hipGetLastError();
    }
    if (grid < 0) return;
    Args a{};
    a.x = (const float*)d_in[0]; a.pos = (const int*)d_in[1]; a.attn_norm = (const float*)d_in[2]; a.w_in = (const float*)d_in[3];
    a.lb_logits = (const float*)d_in[4]; a.hg_o_norm = (const float*)d_in[5]; a.q_a_norm = (const float*)d_in[6]; a.w_q_up = (const float*)d_in[7];
    a.kv_a_norm = (const float*)d_in[8]; a.w_kv_up = (const float*)d_in[9]; a.q_norm = (const float*)d_in[10]; a.k_norm = (const float*)d_in[11];
    a.mla_o_norm = (const float*)d_in[12]; a.w_out = (const float*)d_in[13]; a.ffn_norm = (const float*)d_in[14]; a.peer_wq = (const float*)d_in[15];
    a.subk = (const float*)d_in[16]; a.peer_u = (const float*)d_in[17]; a.peer_v = (const float*)d_in[18];
    a.out = (float*)d_out; a.ws = (unsigned char*)d_ws;
    const int last = (STOP_AFTER < N_PHASES - 1) ? STOP_AFTER : N_PHASES - 1;
#if N_LAUNCH_MODE == 1
    (void)hipMemsetAsync((unsigned char*)d_ws + WS_CTL, 0, 16384, stream);
    a.ph_lo = 0; a.ph_hi = last + 1;
#ifdef USE_CG_SYNC
    void* args[] = {&a};
    hipError_t e = hipLaunchCooperativeKernel((const void*)fwd_kernel, dim3(grid), dim3(NT), args, LDS_BYTES, stream);
    if (e != hipSuccess) fprintf(stderr, "cooperative launch failed: %s (grid %d)\n", hipGetErrorString(e), grid);
#else
    hipLaunchKernelGGL(fwd_kernel, dim3(grid), dim3(NT), LDS_BYTES, stream, a);
#endif
#else
    for (int ph = 0; ph <= last; ++ph) {
        a.ph_lo = ph; a.ph_hi = ph + 1;
        hipLaunchKernelGGL(fwd_kernel, dim3(grid), dim3(NT), LDS_BYTES, stream, a);
    }
#endif
}
```

```cpp
#include <hip/hip_runtime.h>
#include <hip/hip_cooperative_groups.h>
#include <cstdio>
#include <cstdint>
namespace cg = cooperative_groups;

#ifndef N_LAUNCH_MODE
#define N_LAUNCH_MODE 1
#endif
#ifndef REPEAT_PHASE
#define REPEAT_PHASE -1
#endif
#ifndef ATT_REP
#define ATT_REP 1
#endif
#ifndef HG_REP
#define HG_REP 1
#endif
#ifndef STOP_AFTER
#define STOP_AFTER 99
#endif

typedef unsigned short bf16_t;
typedef short bf16x8 __attribute__((ext_vector_type(8)));
typedef float f32x4 __attribute__((ext_vector_type(4)));

constexpr int NT = 512;
constexpr int T = 16384, SEQ = 2048, NB = 8, DM = 1024, INW = 3264;
constexpr int OFF_Q = 0, OFF_FF = 512, OFF_FB = 1024, OFF_I = 1536, OFF_G = 2048, OFF_CQ = 2560, OFF_CKV = 2944, OFF_KR = 3200;
constexpr float EPS = 1e-6f;

constexpr size_t WS_CTL = 0;
constexpr size_t WS_WIN_T = 65536;
constexpr size_t WS_WQUP_T = WS_WIN_T + (size_t)3264 * 1024 * 2;
constexpr size_t WS_WKVUP_T = WS_WQUP_T + (size_t)768 * 384 * 2;
constexpr size_t WS_WOUT_T = WS_WKVUP_T + (size_t)1024 * 256 * 2;
constexpr size_t WS_WPQ_T = WS_WOUT_T + (size_t)1024 * 1024 * 2;
constexpr size_t WS_SUBK = WS_WPQ_T + (size_t)2048 * 1024 * 2;
constexpr size_t WS_LB = WS_SUBK + (size_t)16 * 128 * 128 * 2;
constexpr size_t WS_B = 15728640;
constexpr size_t WS_CQN = WS_B;
constexpr size_t WS_CKVN = WS_B + (size_t)T * 384 * 2;
constexpr size_t WS_C = WS_B + 33554432;
constexpr size_t WS_R = WS_C + 33554432;
constexpr size_t WS_PART = WS_C;
constexpr size_t WS_D = WS_C + (size_t)T * INW * 2;
constexpr size_t WS_Q = WS_D + 33554432;
constexpr size_t WS_KN = WS_Q + (size_t)T * 768 * 2;
constexpr size_t WS_VT = WS_KN + (size_t)T * 512 * 2;
constexpr size_t WS_KROPE = WS_VT + (size_t)T * 512 * 2;
constexpr size_t WS_ROPECS = WS_KROPE + (size_t)T * 64 * 2;
constexpr size_t WS_U4 = WS_ROPECS;
constexpr size_t WS_V4 = WS_U4 + (size_t)16384 * 512;
constexpr size_t WS_VSCALE = WS_V4 + (size_t)16384 * 512;
constexpr size_t WS_USCALE = WS_VSCALE + 65536;
constexpr size_t WS_USUM = WS_USCALE + 65536;
constexpr size_t WS_END = WS_USUM + 65536;
static_assert(WS_U4 >= WS_ROPECS && WS_ROPECS + (size_t)T * 64 * 4 <= WS_END, "rope table inside the tail region");
constexpr size_t WS_W16 = WS_KROPE;
constexpr size_t WS_IDX = WS_VT;
constexpr size_t WS_GATE = WS_VT + (size_t)T * 128 * 4;
constexpr size_t WS_ELIST = WS_D + 67108864;
constexpr size_t WS_COUNTS = WS_CTL + 16384;
constexpr size_t WS_BSTART = WS_CTL + 16384 + 32768;
static_assert(WS_ELIST + (size_t)T * 128 * 4 <= WS_VT, "edge list overflow");
static_assert(WS_LB + 4096 <= WS_B, "weights overflow");
static_assert(WS_D + (size_t)T * 2048 * 2 <= WS_IDX, "PQ overlaps IDX");
static_assert(WS_GATE + (size_t)T * 128 * 4 <= WS_VT + (size_t)T * 512 * 2, "gate overflow");
static_assert(WS_END <= 268435456, "workspace too big");

struct Args {
    const float* x; const int* pos; const float* attn_norm; const float* w_in; const float* lb_logits; const float* hg_o_norm;
    const float* q_a_norm; const float* w_q_up; const float* kv_a_norm; const float* w_kv_up; const float* q_norm; const float* k_norm;
    const float* mla_o_norm; const float* w_out; const float* ffn_norm; const float* peer_wq; const float* subk; const float* peer_u; const float* peer_v;
    float* out; unsigned char* ws; int ph_lo, ph_hi;
};

typedef __bf16 bf16v2 __attribute__((ext_vector_type(2)));
typedef float f32v2 __attribute__((ext_vector_type(2)));
__device__ __forceinline__ unsigned pack2(float lo, float hi) { const f32v2 v = {lo, hi}; return __builtin_bit_cast(unsigned, __builtin_convertvector(v, bf16v2)); }
__device__ __forceinline__ bf16_t f2bf(float f) { return (bf16_t)(pack2(f, 0.f) & 0xffffu); }
typedef _Float16 f16v2 __attribute__((ext_vector_type(2)));
__device__ __forceinline__ unsigned pack2h(float lo, float hi) { const f32v2 v = {lo, hi}; return __builtin_bit_cast(unsigned, __builtin_convertvector(v, f16v2)); }
__device__ __forceinline__ float frcp(float x) { return __builtin_amdgcn_rcpf(x); }
__device__ __forceinline__ float fexp2(float x) { return __builtin_amdgcn_exp2f(x); }
__device__ __forceinline__ float bf2f(bf16_t h) { return __uint_as_float(((unsigned)h) << 16); }
__device__ __forceinline__ float bflo(unsigned w) { return __uint_as_float(w << 16); }
__device__ __forceinline__ float bfhi(unsigned w) { return __uint_as_float(w & 0xffff0000u); }
__device__ __forceinline__ float wave_sum(float v) {
#pragma unroll
    for (int d = 32; d > 0; d >>= 1) v += __shfl_xor(v, d, 64);
    return v;
}
__device__ __forceinline__ f32x4 mfma16(bf16x8 a, bf16x8 b, f32x4 c) { return __builtin_amdgcn_mfma_f32_16x16x32_bf16(a, b, c, 0, 0, 0); }

__device__ const float ROPE_INV_FREQ[32] = {
    1.000000000e+00f, 7.498942018e-01f, 5.623413324e-01f, 4.216965139e-01f, 3.162277639e-01f, 2.371373922e-01f, 1.778279394e-01f, 1.333521456e-01f,
    1.000000015e-01f, 7.498941571e-02f, 5.623412877e-02f, 4.216964915e-02f, 3.162277862e-02f, 2.371373586e-02f, 1.778279431e-02f, 1.333521493e-02f,
    9.999999776e-03f, 7.498942316e-03f, 5.623413250e-03f, 4.216964822e-03f, 3.162277862e-03f, 2.371373819e-03f, 1.778279431e-03f, 1.333521446e-03f,
    1.000000047e-03f, 7.498941850e-04f, 5.623413017e-04f, 4.216965463e-04f, 3.162277862e-04f, 2.371373848e-04f, 1.778279402e-04f, 1.333521504e-04f};

template <int WAVES_M, int WAVES_N, int WM, int WN, class Epi>
__device__ __forceinline__ void gemm_block(const bf16_t* __restrict__ A, int lda, const bf16_t* __restrict__ Bt, int ldb, int K,
                                           int m0, int n0, int nrows_bt, unsigned char* lds, Epi& epi) {
    constexpr int BM = WAVES_M * WM * 16, BN = WAVES_N * WN * 16;
    constexpr int AI = BM / 64, BI = BN / 64;
    static_assert(WAVES_M * WAVES_N == 8, "8 waves");
    const int tid = threadIdx.x, lane = tid & 63, wave = tid >> 6;
    const int wm = wave / WAVES_N, wn = wave % WAVES_N;
    const int r16 = lane & 15, g = lane >> 4;
    unsigned char* As = lds;
    unsigned char* Bs = lds + BM * 144;
    f32x4 acc[WM][WN];
#pragma unroll
    for (int i = 0; i < WM; ++i)
#pragma unroll
        for (int j = 0; j < WN; ++j) acc[i][j] = (f32x4){0.f, 0.f, 0.f, 0.f};
    uint4 ra0, ra1, ra2, ra3, rb0, rb1, rb2, rb3;
    static_assert(AI <= 4 && BI <= 4, "stage regs");
#define GA_LOAD(i, k0) if constexpr (AI > i) { const int c = tid + i * NT, row = c >> 3, kc = c & 7; ra##i = *(const uint4*)(A + (size_t)(m0 + row) * lda + (k0) + kc * 8); }
#define GB_LOAD(i, k0) if constexpr (BI > i) { const int c = tid + i * NT, row = c >> 3, kc = c & 7; int rg = n0 + row; rg = rg < nrows_bt ? rg : nrows_bt - 1; rb##i = *(const uint4*)(Bt + (size_t)rg * ldb + (k0) + kc * 8); }
#define GA_STORE(i) if constexpr (AI > i) { const int c = tid + i * NT, row = c >> 3, kc = c & 7; *(uint4*)(As + row * 144 + kc * 16) = ra##i; }
#define GB_STORE(i) if constexpr (BI > i) { const int c = tid + i * NT, row = c >> 3, kc = c & 7; *(uint4*)(Bs + row * 144 + kc * 16) = rb##i; }
    GA_LOAD(0, 0) GA_LOAD(1, 0) GA_LOAD(2, 0) GA_LOAD(3, 0) GB_LOAD(0, 0) GB_LOAD(1, 0) GB_LOAD(2, 0) GB_LOAD(3, 0)
    const int nk = K / 64;
    for (int kt = 0; kt < nk; ++kt) {
        __syncthreads();
        GA_STORE(0) GA_STORE(1) GA_STORE(2) GA_STORE(3) GB_STORE(0) GB_STORE(1) GB_STORE(2) GB_STORE(3)
        __syncthreads();
        if (kt + 1 < nk) {
            const int k0 = (kt + 1) * 64;
            GA_LOAD(0, k0) GA_LOAD(1, k0) GA_LOAD(2, k0) GA_LOAD(3, k0) GB_LOAD(0, k0) GB_LOAD(1, k0) GB_LOAD(2, k0) GB_LOAD(3, k0)
        }
#pragma unroll
        for (int kk = 0; kk < 2; ++kk) {
            bf16x8 af[WM];
#pragma unroll
            for (int i = 0; i < WM; ++i) af[i] = *(const bf16x8*)(As + ((wm * WM + i) * 16 + r16) * 144 + kk * 64 + g * 16);
#pragma unroll
            for (int j = 0; j < WN; ++j) {
                const bf16x8 bfr = *(const bf16x8*)(Bs + ((wn * WN + j) * 16 + r16) * 144 + kk * 64 + g * 16);
#pragma unroll
                for (int i = 0; i < WM; ++i) acc[i][j] = mfma16(bfr, af[i], acc[i][j]);
            }
        }
    }
#undef GA_LOAD
#undef GB_LOAD
#undef GA_STORE
#undef GB_STORE
    epi(acc, m0 + wm * WM * 16, n0 + wn * WN * 16, lane);
}

namespace g256 {
constexpr int BM = 256, BK = 64, HALF = 128, HT = HALF * BK;
__device__ __forceinline__ int lds_byte(int r, int c) { const int st = (r >> 4) * 2 + (c >> 5), rr = r & 15, cc = c & 31, ob = rr * 64 + cc * 2; return st * 1024 + (ob ^ (((ob >> 9) & 1) << 5)); }
__device__ __forceinline__ void stage_rc(int b, int& R, int& C) { const int st = b / 1024, sb = b % 1024, swz = sb ^ (((sb >> 9) & 1) << 5); R = (st >> 1) * 16 + swz / 64; C = (st & 1) * 32 + (swz % 64) / 2; }

template <class Epi>
__device__ __forceinline__ void tile(const bf16_t* __restrict__ A, const bf16_t* __restrict__ Bt, int K, int brow, int bcol, unsigned char* lds, Epi& epi) {
    bf16_t* shm = (bf16_t*)lds;
#define G_SA(b, h) (shm + ((b) * 2 + (h)) * HT)
#define G_SB(b, h) (shm + (4 + (b) * 2 + (h)) * HT)
#define G_STAGE(P, BASE, br, kt) do { const long _g = (long)(br) * K + (long)(kt) * BK; \
    _Pragma("unroll") for (int _i = 0; _i < 2; ++_i) { const int _b = tix * 16 + _i * 8192; int _r, _c; stage_rc(_b, _r, _c); \
      __builtin_amdgcn_global_load_lds((const unsigned*)(BASE + _g + (long)_r * K + _c), (unsigned*)((char*)(P) + _b), 16, 0, 0); } } while (0)
#define G_LDA(dst, b, h) _Pragma("unroll") for (int m = 0; m < 4; ++m) _Pragma("unroll") for (int k = 0; k < 2; ++k) \
    dst[m][k] = *reinterpret_cast<const bf16x8*>((char*)G_SA(b, h) + lds_byte(wr * 64 + m * 16 + fr, k * 32 + fq * 8))
#define G_LDB(dst, b, h) _Pragma("unroll") for (int n = 0; n < 2; ++n) _Pragma("unroll") for (int k = 0; k < 2; ++k) \
    dst[n][k] = *reinterpret_cast<const bf16x8*>((char*)G_SB(b, h) + lds_byte(wc * 32 + n * 16 + fr, k * 32 + fq * 8))
#define G_MMA(ai, bj, At, Bt_) do { __builtin_amdgcn_s_setprio(1); \
    _Pragma("unroll") for (int m = 0; m < 4; ++m) _Pragma("unroll") for (int n = 0; n < 2; ++n) _Pragma("unroll") for (int k = 0; k < 2; ++k) \
      acc[ai][bj][m][n] = __builtin_amdgcn_mfma_f32_16x16x32_bf16(Bt_[n][k], At[m][k], acc[ai][bj][m][n], 0, 0, 0); \
    __builtin_amdgcn_s_setprio(0); } while (0)
#define G_WAIT_V(n) asm volatile("s_waitcnt vmcnt(" #n ")" ::: "memory")
#define G_WAIT_L(n) asm volatile("s_waitcnt lgkmcnt(" #n ")" ::: "memory")
#define G_BAR __builtin_amdgcn_s_barrier()
#define G_SCHED __builtin_amdgcn_sched_barrier(0)
    int tix = threadIdx.x; asm volatile("" : "+v"(tix));
    const int wid = tix >> 6, lane = tix & 63, wr = wid >> 2, wc = wid & 3, fr = lane & 15, fq = lane >> 4;
    f32x4 acc[2][2][4][2];
#pragma unroll
    for (int i0 = 0; i0 < 2; ++i0)
#pragma unroll
        for (int i1 = 0; i1 < 2; ++i1)
#pragma unroll
            for (int i2 = 0; i2 < 4; ++i2)
#pragma unroll
                for (int i3 = 0; i3 < 2; ++i3) acc[i0][i1][i2][i3] = (f32x4){0.f, 0.f, 0.f, 0.f};
    bf16x8 At[4][2], B0[2][2], B1[2][2];
    const int nt = K / BK;
    G_STAGE(G_SB(0, 0), Bt, bcol, 0); G_STAGE(G_SA(0, 0), A, brow, 0);
    G_STAGE(G_SB(0, 1), Bt, bcol + HALF, 0); G_STAGE(G_SA(0, 1), A, brow + HALF, 0);
    if (wr == 1) G_BAR;
    G_WAIT_V(4); G_BAR;
    G_STAGE(G_SB(1, 0), Bt, bcol, 1); G_STAGE(G_SA(1, 0), A, brow, 1); G_STAGE(G_SB(1, 1), Bt, bcol + HALF, 1);
    G_WAIT_V(6); G_BAR;
    for (int t = 0; t < nt - 2; t += 2) {
        G_LDB(B0, 0, 0); G_SCHED; G_LDA(At, 0, 0); G_STAGE(G_SA(1, 1), A, brow + HALF, t + 1);
        G_WAIT_L(8); G_BAR; G_WAIT_L(0); G_MMA(0, 0, At, B0); G_BAR; G_SCHED;
        G_LDB(B1, 0, 1); G_STAGE(G_SB(0, 0), Bt, bcol, t + 2);
        G_BAR; G_WAIT_L(0); G_MMA(0, 1, At, B1); G_BAR;
        G_LDA(At, 0, 1); G_STAGE(G_SA(0, 0), A, brow, t + 2);
        G_BAR; G_WAIT_L(0); G_MMA(1, 0, At, B0); G_BAR; G_SCHED;
        G_STAGE(G_SB(0, 1), Bt, bcol + HALF, t + 2);
        G_WAIT_V(6); G_BAR; G_MMA(1, 1, At, B1); G_BAR;
        G_LDB(B0, 1, 0); G_SCHED; G_LDA(At, 1, 0); G_STAGE(G_SA(0, 1), A, brow + HALF, t + 2);
        G_WAIT_L(8); G_BAR; G_WAIT_L(0); G_MMA(0, 0, At, B0); G_BAR; G_SCHED;
        G_LDB(B1, 1, 1); G_STAGE(G_SB(1, 0), Bt, bcol, t + 3);
        G_BAR; G_WAIT_L(0); G_MMA(0, 1, At, B1); G_BAR;
        G_LDA(At, 1, 1); G_STAGE(G_SA(1, 0), A, brow, t + 3);
        G_BAR; G_WAIT_L(0); G_MMA(1, 0, At, B0); G_BAR; G_SCHED;
        G_STAGE(G_SB(1, 1), Bt, bcol + HALF, t + 3);
        G_WAIT_V(6); G_BAR; G_MMA(1, 1, At, B1); G_BAR;
    }
    { G_LDB(B0, 0, 0); G_LDA(At, 0, 0); G_STAGE(G_SA(1, 1), A, brow + HALF, nt - 1);
      G_BAR; G_WAIT_L(0); G_MMA(0, 0, At, B0); G_BAR;
      G_LDB(B1, 0, 1); G_BAR; G_WAIT_L(0); G_MMA(0, 1, At, B1); G_BAR;
      G_LDA(At, 0, 1); G_WAIT_V(4); G_BAR; G_WAIT_L(0); G_MMA(1, 0, At, B0); G_MMA(1, 1, At, B1); G_BAR; }
    { G_LDB(B0, 1, 0); G_LDA(At, 1, 0); G_WAIT_V(2); G_BAR; G_WAIT_L(0); G_MMA(0, 0, At, B0); G_BAR;
      G_LDB(B1, 1, 1); G_WAIT_V(0); G_BAR; G_WAIT_L(0); G_MMA(0, 1, At, B1); G_BAR;
      G_LDA(At, 1, 1); G_BAR; G_WAIT_L(0); G_MMA(1, 0, At, B0); G_MMA(1, 1, At, B1); G_BAR; }
    if (wr == 0) G_BAR;
    epi(acc, brow + wr * 64 + fr, bcol + wc * 32 + 4 * fq);
#undef G_SA
#undef G_SB
#undef G_STAGE
#undef G_LDA
#undef G_LDB
#undef G_MMA
#undef G_WAIT_V
#undef G_WAIT_L
#undef G_BAR
#undef G_SCHED
}
__device__ __forceinline__ bool next_tile(int L, int nM, int nN, int& pm, int& pn) {
    const int nwg = nM * nN; if (L >= nwg) return false;
    int wgid = L; { const int q = nwg / 8, r = nwg % 8, xcd = wgid % 8, off = wgid / 8; wgid = (xcd < r ? xcd * (q + 1) : r * (q + 1) + (xcd - r) * q) + off; }
    const int WGM = 8, nig = WGM * nN, gid = wgid / nig, fm = gid * WGM, gsz = (nM - fm) < WGM ? (nM - fm) : WGM;
    pm = fm + ((wgid % nig) % gsz); pn = (wgid % nig) / gsz; return true;
}
struct EpiBf16 { bf16_t* O; int ldc;
    __device__ __forceinline__ void operator()(const f32x4 (&acc)[2][2][4][2], int row0, int col0) const {
#pragma unroll
        for (int ai = 0; ai < 2; ++ai)
#pragma unroll
            for (int m = 0; m < 4; ++m) { bf16_t* rp = O + (size_t)(row0 + ai * 128 + m * 16) * ldc + col0;
#pragma unroll
                for (int bj = 0; bj < 2; ++bj)
#pragma unroll
                    for (int n = 0; n < 2; ++n) { const f32x4 v = acc[ai][bj][m][n]; uint2 w; w.x = pack2(v[0], v[1]); w.y = pack2(v[2], v[3]); *(uint2*)(rp + bj * 128 + n * 16) = w; } }
    }
};
struct EpiResid { const float* X; bf16_t* O; float* PART; unsigned char* lds;
    __device__ __forceinline__ void operator()(const f32x4 (&acc)[2][2][4][2], int row0, int col0) const {
        float* red = (float*)lds;
        const int wc = (col0 & 255) >> 5, fq = (col0 & 31) >> 2, rl0 = row0 & 255;
        __syncthreads();
#pragma unroll
        for (int ai = 0; ai < 2; ++ai)
#pragma unroll
            for (int m = 0; m < 4; ++m) { const size_t ro = (size_t)(row0 + ai * 128 + m * 16) * DM + col0; float ss = 0.f;
#pragma unroll
                for (int bj = 0; bj < 2; ++bj)
#pragma unroll
                    for (int n = 0; n < 2; ++n) { const size_t off = ro + bj * 128 + n * 16; const f32x4 v = *(const f32x4*)(X + off) + acc[ai][bj][m][n];
                        ss += v[0] * v[0] + v[1] * v[1] + v[2] * v[2] + v[3] * v[3];
                        uint2 w; w.x = pack2(v[0], v[1]); w.y = pack2(v[2], v[3]); *(uint2*)(O + off) = w; }
                ss += __shfl_xor(ss, 16, 64); ss += __shfl_xor(ss, 32, 64);
                if (fq == 0) red[wc * 256 + rl0 + ai * 128 + m * 16] = ss; }
        __syncthreads();
        if (threadIdx.x < 256) { const int r = threadIdx.x; PART[(size_t)(col0 >> 8) * T + (row0 & ~255) + r] = (red[r] + red[256 + r]) + (red[512 + r] + red[768 + r]); }
    }
};
struct EpiBf16Silu { bf16_t* O; int ldc; int nsilu;
    __device__ __forceinline__ void operator()(const f32x4 (&acc)[2][2][4][2], int row0, int col0) const {
        const bool sl = col0 < nsilu;
#pragma unroll
        for (int ai = 0; ai < 2; ++ai)
#pragma unroll
            for (int m = 0; m < 4; ++m) { bf16_t* rp = O + (size_t)(row0 + ai * 128 + m * 16) * ldc + col0;
#pragma unroll
                for (int bj = 0; bj < 2; ++bj)
#pragma unroll
                    for (int n = 0; n < 2; ++n) { f32x4 v = acc[ai][bj][m][n];
                        if (sl) {
#pragma unroll
                            for (int r = 0; r < 4; ++r) v[r] = v[r] * frcp(1.f + __expf(-v[r])); }
                        uint2 w; w.x = pack2(v[0], v[1]); w.y = pack2(v[2], v[3]); *(uint2*)(rp + bj * 128 + n * 16) = w; } }
    }
};
}

template <int WM_, int WN_> struct EpiBf16 {
    bf16_t* O; int ldc; int ncols;
    __device__ __forceinline__ void operator()(const f32x4 (&acc)[WM_][WN_], int mb, int nb, int lane) const {
        const int r16 = lane & 15, g = lane >> 4;
#pragma unroll
        for (int i = 0; i < WM_; ++i)
#pragma unroll
            for (int j = 0; j < WN_; ++j) {
                const int row = mb + i * 16 + r16, col = nb + j * 16 + 4 * g;
                if (col < ncols) { uint2 w; w.x = pack2(acc[i][j][0], acc[i][j][1]); w.y = pack2(acc[i][j][2], acc[i][j][3]); *(uint2*)(O + (size_t)row * ldc + col) = w; }
            }
    }
};
struct EpiQ {
    bf16_t* Q; const float* q_norm; const float* ropecs;
    __device__ __forceinline__ void operator()(const f32x4 (&accs)[2][12], int mb, int nb, int lane) const {
      const int r16 = lane & 15, g = lane >> 4;
#pragma unroll
      for (int mi = 0; mi < 2; ++mi) {
        const f32x4 (&accm)[12] = accs[mi];
        const int row = mb + mi * 16 + r16, h = nb / 192;
        float ssn = 0.f, ssr = 0.f;
#pragma unroll
        for (int j = 0; j < 8; ++j)
#pragma unroll
            for (int r = 0; r < 4; ++r) ssn += accm[j][r] * accm[j][r];
#pragma unroll
        for (int j = 8; j < 12; ++j)
#pragma unroll
            for (int r = 0; r < 4; ++r) ssr += accm[j][r] * accm[j][r];
        ssn += __shfl_xor(ssn, 16, 64); ssn += __shfl_xor(ssn, 32, 64);
        ssr += __shfl_xor(ssr, 16, 64); ssr += __shfl_xor(ssr, 32, 64);
        const float SC = 0.07216878364870322f * 1.4426950408889634f;
        const float rn = rsqrtf(ssn * (1.f / 128.f) + EPS) * SC, rr = rsqrtf(ssr * (1.f / 64.f) + EPS) * SC;
        bf16_t* qrow = Q + ((size_t)row * 4 + h) * 192;
#pragma unroll
        for (int j = 0; j < 8; ++j) {
            const int c = j * 16 + 4 * g;
            const f32x4 gn = *(const f32x4*)(q_norm + c);
            uint2 w; w.x = pack2(accm[j][0] * rn * gn[0], accm[j][1] * rn * gn[1]); w.y = pack2(accm[j][2] * rn * gn[2], accm[j][3] * rn * gn[3]);
            *(uint2*)(qrow + c) = w;
        }
#pragma unroll
        for (int j = 0; j < 2; ++j) {
            const int jj = j * 16 + 4 * g;
            const f32x4 g1 = *(const f32x4*)(q_norm + 128 + jj), g2 = *(const f32x4*)(q_norm + 160 + jj);
            float o1[4], o2[4];
#pragma unroll
            for (int r = 0; r < 4; ++r) {
                const float2 cs = *(const float2*)(ropecs + ((size_t)row * 32 + jj + r) * 2);
                const float a1 = accm[8 + j][r] * rr * g1[r], a2 = accm[10 + j][r] * rr * g2[r];
                o1[r] = a1 * cs.x - a2 * cs.y; o2[r] = a2 * cs.x + a1 * cs.y;
            }
            uint2 w; w.x = pack2(o1[0], o1[1]); w.y = pack2(o1[2], o1[3]); *(uint2*)(qrow + 128 + jj) = w;
            w.x = pack2(o2[0], o2[1]); w.y = pack2(o2[2], o2[3]); *(uint2*)(qrow + 160 + jj) = w;
        }
      }
    }
};
template <int WMK> struct EpiKV {
    bf16_t* KN; bf16_t* VT; const float* k_norm;
    __device__ __forceinline__ void operator()(const f32x4 (&accs)[WMK][16], int mb, int nb, int lane) const {
      const int r16 = lane & 15, g = lane >> 4;
#pragma unroll
      for (int mi = 0; mi < WMK; ++mi) {
        const f32x4 (&accm)[16] = accs[mi];
        const int row = mb + mi * 16 + r16, h = nb / 256;
        float ssn = 0.f;
#pragma unroll
        for (int j = 0; j < 8; ++j)
#pragma unroll
            for (int r = 0; r < 4; ++r) ssn += accm[j][r] * accm[j][r];
        ssn += __shfl_xor(ssn, 16, 64); ssn += __shfl_xor(ssn, 32, 64);
        const float rn = rsqrtf(ssn * (1.f / 128.f) + EPS);
        bf16_t* krow = KN + ((size_t)row * 4 + h) * 128;
#pragma unroll
        for (int j = 0; j < 8; ++j) {
            const int c = j * 16 + 4 * g;
            const f32x4 gn = *(const f32x4*)(k_norm + c);
            uint2 w; w.x = pack2(accm[j][0] * rn * gn[0], accm[j][1] * rn * gn[1]); w.y = pack2(accm[j][2] * rn * gn[2], accm[j][3] * rn * gn[3]);
            *(uint2*)(krow + c) = w;
        }
        const int b = row >> 11, s = row & 2047;
        bf16_t* vp = VT + ((size_t)(b * 4 + h) * 128 + 4 * g) * SEQ + s;
#pragma unroll
        for (int j = 0; j < 8; ++j) {
            asm volatile("" : "+v"(vp));
            vp[0] = f2bf(accm[8 + j][0]); vp[SEQ] = f2bf(accm[8 + j][1]); vp[2 * SEQ] = f2bf(accm[8 + j][2]); vp[3 * SEQ] = f2bf(accm[8 + j][3]);
            vp += 16 * SEQ;
        }
      }
    }
};

__device__ void transpose_convert(const float* __restrict__ W, bf16_t* __restrict__ Wt, int K, int N, unsigned char* lds, int bid, int nblk, const float* __restrict__ kscale = nullptr) {
    bf16_t* tile = (bf16_t*)lds;
    const int tid = threadIdx.x;
    const int tk = K / 64, tn = N / 64;
    for (int t = bid; t < tk * tn; t += nblk) {
        const int k0 = (t / tn) * 64, n0 = (t % tn) * 64;
        __syncthreads();
#pragma unroll
        for (int p = 0; p < 2; ++p) {
            const int kk = (tid >> 4) + p * 32, n4 = (tid & 15) * 4;
            f32x4 v = *(const f32x4*)(W + (size_t)(k0 + kk) * N + n0 + n4);
            if (kscale) v *= kscale[k0 + kk];
#pragma unroll
            for (int r = 0; r < 4; ++r) tile[(n4 + r) * 66 + kk] = f2bf(v[r]);
        }
        __syncthreads();
        {
            const int nn = tid >> 3, k8 = (tid & 7) * 8;
            unsigned w[4];
#pragma unroll
            for (int r = 0; r < 4; ++r) w[r] = (unsigned)tile[nn * 66 + k8 + 2 * r] | ((unsigned)tile[nn * 66 + k8 + 2 * r + 1] << 16);
            *(uint4*)(Wt + (size_t)(n0 + nn) * K + k0 + k8) = make_uint4(w[0], w[1], w[2], w[3]);
        }
    }
    __syncthreads();
}

__device__ void rmsnorm_rows(const float* __restrict__ X, const float* __restrict__ gain, bf16_t* __restrict__ O, int gw, int nw) {
    const int lane = threadIdx.x & 63;
    for (int row = gw; row < T; row += nw) {
        const float* xr = X + (size_t)row * DM;
        f32x4 v[4]; float ss = 0.f;
#pragma unroll
        for (int i = 0; i < 4; ++i) { v[i] = *(const f32x4*)(xr + i * 256 + lane * 4); ss += v[i][0] * v[i][0] + v[i][1] * v[i][1] + v[i][2] * v[i][2] + v[i][3] * v[i][3]; }
        ss = wave_sum(ss);
        const float rs = rsqrtf(ss * (1.f / 1024.f) + EPS);
#pragma unroll
        for (int i = 0; i < 4; ++i) {
            const f32x4 gn = *(const f32x4*)(gain + i * 256 + lane * 4);
            uint2 w; w.x = pack2(v[i][0] * rs * gn[0], v[i][1] * rs * gn[1]); w.y = pack2(v[i][2] * rs * gn[2], v[i][3] * rs * gn[3]);
            *(uint2*)(O + (size_t)row * DM + i * 256 + lane * 4) = w;
        }
    }
}

__device__ void phase0(const Args& a, unsigned char* lds) {
    unsigned char* ws = a.ws;
    const int bid = blockIdx.x, nblk = gridDim.x, tid = threadIdx.x;
    transpose_convert(a.w_in, (bf16_t*)(ws + WS_WIN_T), 1024, 3264, lds, bid, nblk);
    transpose_convert(a.w_q_up, (bf16_t*)(ws + WS_WQUP_T), 384, 768, lds, bid, nblk);
    transpose_convert(a.w_kv_up, (bf16_t*)(ws + WS_WKVUP_T), 256, 1024, lds, bid, nblk);
    transpose_convert(a.w_out, (bf16_t*)(ws + WS_WOUT_T), 1024, 1024, lds, bid, nblk);
    transpose_convert(a.peer_wq, (bf16_t*)(ws + WS_WPQ_T), 1024, 2048, lds, bid, nblk, a.ffn_norm);
    const int gt = bid * NT + tid, ngt = nblk * NT;
    bf16_t* sk = (bf16_t*)(ws + WS_SUBK);
    for (int i = gt; i < 16 * 128 * 128; i += ngt) sk[i] = f2bf(a.subk[i]);
    float* lb = (float*)(ws + WS_LB);
    for (int i = gt; i < 1024; i += ngt) { const float l0 = a.lb_logits[i], l1 = a.lb_logits[1024 + i]; lb[i] = 1.f / (1.f + expf(l1 - l0)); }
    rmsnorm_rows(a.x, a.attn_norm, (bf16_t*)(ws + WS_B), bid * 8 + (tid >> 6), nblk * 8);
}

__device__ void phase1(const Args& a, unsigned char* lds) {
    unsigned char* ws = a.ws;
    const bf16_t* H = (const bf16_t*)(ws + WS_B); const bf16_t* W = (const bf16_t*)(ws + WS_WIN_T);
    g256::EpiBf16Silu e{(bf16_t*)(ws + WS_C), INW, 512};
    for (int i = 0;; ++i) { int pm, pn; if (!g256::next_tile(i * gridDim.x + blockIdx.x, 64, 12, pm, pn)) break;
        __syncthreads();
        g256::tile(H, W, DM, pm * 256, pn * 256, lds, e); }
    __syncthreads();
    EpiBf16<1, 6> e2{(bf16_t*)(ws + WS_C), INW, INW};
    for (int t = blockIdx.x; t < 256; t += gridDim.x)
        gemm_block<4, 2, 1, 6>(H, DM, W, DM, DM, t * 64, 3072, INW, lds, e2);
}

__device__ void phase2(const Args& a) {
    unsigned char* ws = a.ws;
    const bf16_t* PROJ = (const bf16_t*)(ws + WS_C);
    bf16_t* CQN = (bf16_t*)(ws + WS_CQN); bf16_t* CKVN = (bf16_t*)(ws + WS_CKVN); bf16_t* KROPE = (bf16_t*)(ws + WS_KROPE);
    float* ROPECS = (float*)(ws + WS_ROPECS);
    const int lane = threadIdx.x & 63;
    const float2 gq0 = *(const float2*)(a.q_a_norm + lane * 2), gq1 = *(const float2*)(a.q_a_norm + 128 + lane * 2), gq2 = *(const float2*)(a.q_a_norm + 256 + lane * 2);
    const float2 gk0 = *(const float2*)(a.kv_a_norm + lane * 2), gk1 = *(const float2*)(a.kv_a_norm + 128 + lane * 2);
    const float gr = a.k_norm[128 + lane];
    const float invf = ROPE_INV_FREQ[lane & 31];
    const int nw = gridDim.x * 8;
    for (int t0 = blockIdx.x * 8 + (threadIdx.x >> 6); t0 < T; t0 += nw * 4) {
        unsigned wq[4][3], wk[4][2]; float vr[4], ps[4];
#pragma unroll
        for (int u = 0; u < 4; ++u) {
            const int t = min(t0 + u * nw, T - 1);
            const bf16_t* pr = PROJ + (size_t)t * INW;
#pragma unroll
            for (int i = 0; i < 3; ++i) wq[u][i] = *(const unsigned*)(pr + OFF_CQ + i * 128 + lane * 2);
#pragma unroll
            for (int i = 0; i < 2; ++i) wk[u][i] = *(const unsigned*)(pr + OFF_CKV + i * 128 + lane * 2);
            vr[u] = bf2f(pr[OFF_KR + lane]);
            ps[u] = (float)a.pos[t];
        }
        float sq[4], sk[4], sr[4];
#pragma unroll
        for (int u = 0; u < 4; ++u) {
            sq[u] = 0.f; sk[u] = 0.f;
#pragma unroll
            for (int i = 0; i < 3; ++i) { const float x0 = bflo(wq[u][i]), x1 = bfhi(wq[u][i]); sq[u] += x0 * x0 + x1 * x1; }
#pragma unroll
            for (int i = 0; i < 2; ++i) { const float x0 = bflo(wk[u][i]), x1 = bfhi(wk[u][i]); sk[u] += x0 * x0 + x1 * x1; }
            sr[u] = vr[u] * vr[u];
        }
#pragma unroll
        for (int d = 32; d > 0; d >>= 1)
#pragma unroll
            for (int u = 0; u < 4; ++u) { sq[u] += __shfl_xor(sq[u], d, 64); sk[u] += __shfl_xor(sk[u], d, 64); sr[u] += __shfl_xor(sr[u], d, 64); }
#pragma unroll
        for (int u = 0; u < 4; ++u) {
            const int t = t0 + u * nw;
            if (t < T) {
                const float rq = rsqrtf(sq[u] * (1.f / 384.f) + EPS), rk = rsqrtf(sk[u] * (1.f / 256.f) + EPS), rr = rsqrtf(sr[u] * (1.f / 64.f) + EPS);
                bf16_t* cq = CQN + (size_t)t * 384 + lane * 2; bf16_t* ck = CKVN + (size_t)t * 256 + lane * 2;
                *(unsigned*)(cq) = pack2(bflo(wq[u][0]) * rq * gq0.x, bfhi(wq[u][0]) * rq * gq0.y);
                *(unsigned*)(cq + 128) = pack2(bflo(wq[u][1]) * rq * gq1.x, bfhi(wq[u][1]) * rq * gq1.y);
                *(unsigned*)(cq + 256) = pack2(bflo(wq[u][2]) * rq * gq2.x, bfhi(wq[u][2]) * rq * gq2.y);
                *(unsigned*)(ck) = pack2(bflo(wk[u][0]) * rk * gk0.x, bfhi(wk[u][0]) * rk * gk0.y);
                *(unsigned*)(ck + 128) = pack2(bflo(wk[u][1]) * rk * gk1.x, bfhi(wk[u][1]) * rk * gk1.y);
                const float xn = vr[u] * rr * gr;
                const float other = __shfl_xor(xn, 32, 64);
                float sn, cs; sincosf(ps[u] * invf, &sn, &cs);
                const float o = (lane < 32) ? (xn * cs - other * sn) : (xn * cs + other * sn);
                KROPE[(size_t)t * 64 + lane] = f2bf(o);
                if (lane < 32) { *(float2*)(ROPECS + ((size_t)t * 32 + lane) * 2) = make_float2(cs, sn); }
            }
        }
    }
}

__device__ void phase3(const Args& a, unsigned char* lds) {
    unsigned char* ws = a.ws;
    EpiQ eq{(bf16_t*)(ws + WS_Q), a.q_norm, (const float*)(ws + WS_ROPECS)};
    EpiKV<1> ekv{(bf16_t*)(ws + WS_KN), (bf16_t*)(ws + WS_VT), a.k_norm};
    for (int t = blockIdx.x; t < 768; t += gridDim.x) {
        if (t < 256) { const int mt = t >> 2, h = t & 3;
            gemm_block<8, 1, 2, 12>((const bf16_t*)(ws + WS_CQN), 384, (const bf16_t*)(ws + WS_WQUP_T), 384, 384, mt * 256, h * 192, 768, lds, eq);
        } else { const int u = t - 256, mt = u >> 2, h = u & 3;
            gemm_block<8, 1, 1, 16>((const bf16_t*)(ws + WS_CKVN), 256, (const bf16_t*)(ws + WS_WKVUP_T), 256, 256, mt * 128, h * 256, 1024, lds, ekv);
        }
    }
}

constexpr int AT_KROW = 400, AT_VROW = 144, AT_KBYTES = 64 * AT_KROW, AT_VBYTES = 128 * AT_VROW, AT_BUF = AT_KBYTES + AT_VBYTES;
__device__ void attn_item(const Args& a, int item, unsigned char* lds) {
    unsigned char* ws = a.ws;
    const bf16_t* Q = (const bf16_t*)(ws + WS_Q); const bf16_t* KN = (const bf16_t*)(ws + WS_KN);
    const bf16_t* KR = (const bf16_t*)(ws + WS_KROPE); const bf16_t* VT = (const bf16_t*)(ws + WS_VT);
    bf16_t* YCAT = (bf16_t*)(ws + WS_B);
    const int qb = item & 7, h = (item >> 3) & 3, b = item >> 5;
    const int tid = threadIdx.x, lane = tid & 63, wave = tid >> 6, r16 = lane & 15, g = lane >> 4;
    const unsigned kn_off = (unsigned)((((size_t)b * SEQ + (tid >> 4)) * 4 + h) * 128 + (tid & 15) * 8);
    const unsigned kr_off = (unsigned)(((size_t)b * SEQ + (tid >> 3)) * 64 + (tid & 7) * 8);
    const unsigned vt_off = (unsigned)(((size_t)(b * 4 + h) * 128 + (tid >> 3)) * SEQ + (tid & 7) * 8);
    const int kn_dst = (tid >> 4) * AT_KROW + (tid & 15) * 16, kr_dst = (tid >> 3) * AT_KROW + 256 + (tid & 7) * 16;
    const int v_dst = AT_KBYTES + (tid >> 3) * AT_VROW + (tid & 7) * 16;
    bf16x8 qf[2][6];
#pragma unroll
    for (int qs = 0; qs < 2; ++qs) {
        const size_t tq = (size_t)b * SEQ + qb * 256 + wave * 32 + qs * 16 + r16;
#pragma unroll
        for (int kk = 0; kk < 6; ++kk) qf[qs][kk] = *(const bf16x8*)(Q + (tq * 4 + h) * 192 + kk * 32 + 8 * g);
    }
    f32x4 O[2][8];
#pragma unroll
    for (int qs = 0; qs < 2; ++qs)
#pragma unroll
        for (int d = 0; d < 8; ++d) O[qs][d] = (f32x4){0.f, 0.f, 0.f, 0.f};
    float m_run[2] = {0.f, 0.f}, l_part[2] = {0.f, 0.f};
    uint4 sk0, sk1, sk2, sv0, sv1;
#define AT_GLOADK(tile) do { \
        sk0 = *(const uint4*)(KN + kn_off + (size_t)(tile) * (64 * 512)); sk1 = *(const uint4*)(KN + kn_off + 32 * 512 + (size_t)(tile) * (64 * 512)); \
        sk2 = *(const uint4*)(KR + kr_off + (size_t)(tile) * (64 * 64)); } while (0)
#define AT_GLOADV(tile) do { \
        sv0 = *(const uint4*)(VT + vt_off + (size_t)(tile) * 64); sv1 = *(const uint4*)(VT + vt_off + (size_t)64 * SEQ + (size_t)(tile) * 64); } while (0)
#define AT_LSTOREK(buf) do { unsigned char* bb = lds + (buf) * AT_BUF; \
        *(uint4*)(bb + kn_dst) = sk0; *(uint4*)(bb + kn_dst + 32 * AT_KROW) = sk1; *(uint4*)(bb + kr_dst) = sk2; } while (0)
#define AT_LSTOREV(buf) do { unsigned char* bb = lds + (buf) * AT_BUF; \
        *(uint4*)(bb + v_dst) = sv0; *(uint4*)(bb + v_dst + 64 * AT_VROW) = sv1; } while (0)
    __syncthreads();
    AT_GLOADK(0); AT_GLOADV(0);
    AT_LSTOREK(0); AT_LSTOREV(0);
    __syncthreads();
    constexpr int NTILE = SEQ / 64;
    for (int t = 0; t < NTILE; ++t) {
        if (t + 1 < NTILE) AT_GLOADK(t + 1);
        const unsigned char* kb = lds + (t & 1) * AT_BUF;
        const unsigned char* vb = kb + AT_KBYTES;
        f32x4 S[2][4];
#pragma unroll
        for (int qs = 0; qs < 2; ++qs)
#pragma unroll
            for (int j = 0; j < 4; ++j) { const float nm = -m_run[qs]; S[qs][j] = (f32x4){nm, nm, nm, nm}; }
#pragma unroll
        for (int j = 0; j < 4; ++j) {
            const int krow = (j >> 1) * 32 + 8 * (r16 >> 2) + 4 * (j & 1) + (r16 & 3);
#pragma unroll
            for (int kk = 0; kk < 6; ++kk) {
                const bf16x8 kf = *(const bf16x8*)(kb + krow * AT_KROW + kk * 64 + g * 16);
                S[0][j] = mfma16(kf, qf[0][kk], S[0][j]);
                S[1][j] = mfma16(kf, qf[1][kk], S[1][j]);
            }
        }
        if (t + 1 < NTILE) { AT_LSTOREK((t + 1) & 1); AT_GLOADV(t + 1); }
        bf16x8 pf[2][2];
#pragma unroll
        for (int qs = 0; qs < 2; ++qs) {
            float mx = -1e30f;
#pragma unroll
            for (int j = 0; j < 4; ++j) mx = fmaxf(mx, fmaxf(fmaxf(S[qs][j][0], S[qs][j][1]), fmaxf(S[qs][j][2], S[qs][j][3])));
            mx = fmaxf(mx, __shfl_xor(mx, 16, 64)); mx = fmaxf(mx, __shfl_xor(mx, 32, 64));
            if (t == 0 || !__all(mx <= 8.f)) {
                const float delta = (t == 0) ? mx : fmaxf(mx, 0.f);
                m_run[qs] += delta;
#pragma unroll
                for (int j = 0; j < 4; ++j) { S[qs][j][0] -= delta; S[qs][j][1] -= delta; S[qs][j][2] -= delta; S[qs][j][3] -= delta; }
                if (t != 0) {
                    const float alpha = fexp2(-delta);
                    l_part[qs] *= alpha;
#pragma unroll
                    for (int d = 0; d < 8; ++d) O[qs][d] *= alpha;
                }
            }
            float ps = 0.f;
#pragma unroll
            for (int grp = 0; grp < 2; ++grp) {
                float pv[8];
#pragma unroll
                for (int jj = 0; jj < 8; ++jj) { pv[jj] = fexp2(S[qs][grp * 2 + (jj >> 2)][jj & 3]); ps += pv[jj]; }
                union { uint4 u; bf16x8 v; } cv; cv.u = make_uint4(pack2(pv[0], pv[1]), pack2(pv[2], pv[3]), pack2(pv[4], pv[5]), pack2(pv[6], pv[7]));
                pf[qs][grp] = cv.v;
            }
            l_part[qs] += ps;
        }
        __builtin_amdgcn_s_setprio(1);
#pragma unroll
        for (int grp = 0; grp < 2; ++grp)
#pragma unroll
            for (int d = 0; d < 8; ++d) {
                const bf16x8 vf = *(const bf16x8*)(vb + (d * 16 + r16) * AT_VROW + grp * 64 + g * 16);
                O[0][d] = mfma16(vf, pf[0][grp], O[0][d]);
                O[1][d] = mfma16(vf, pf[1][grp], O[1][d]);
            }
        __builtin_amdgcn_s_setprio(0);
        if (t + 1 < NTILE) AT_LSTOREV((t + 1) & 1);
        __syncthreads();
    }
#undef AT_GLOADK
#undef AT_GLOADV
#undef AT_LSTOREK
#undef AT_LSTOREV
#pragma unroll
    for (int qs = 0; qs < 2; ++qs) {
        float l = l_part[qs]; l += __shfl_xor(l, 16, 64); l += __shfl_xor(l, 32, 64);
        const float inv = frcp(l);
        float ss = 0.f;
#pragma unroll
        for (int d = 0; d < 8; ++d) { O[qs][d] *= inv; ss += O[qs][d][0] * O[qs][d][0] + O[qs][d][1] * O[qs][d][1] + O[qs][d][2] * O[qs][d][2] + O[qs][d][3] * O[qs][d][3]; }
        ss += __shfl_xor(ss, 16, 64); ss += __shfl_xor(ss, 32, 64);
        const float rs = rsqrtf(ss * (1.f / 128.f) + EPS);
        const size_t tq = (size_t)b * SEQ + qb * 256 + wave * 32 + qs * 16 + r16;
#pragma unroll
        for (int d = 0; d < 8; ++d) {
            const int dv = d * 16 + 4 * g;
            const f32x4 gn = *(const f32x4*)(a.mla_o_norm + h * 128 + dv);
            uint2 w; w.x = pack2(O[qs][d][0] * rs * gn[0], O[qs][d][1] * rs * gn[1]); w.y = pack2(O[qs][d][2] * rs * gn[2], O[qs][d][3] * rs * gn[3]);
            *(uint2*)(YCAT + tq * DM + 512 + h * 128 + dv) = w;
        }
    }
}

constexpr int HG_E = 0;
constexpr int HG_EL = HG_E + 64 * 132 * 4;
constexpr int HG_QT = HG_EL + 1024;
constexpr int HG_QH = HG_QT + 17408;
constexpr int HG_KD = HG_QH + 17408;
constexpr int HG_K10 = HG_KD + 17408;
constexpr int HG_VT = HG_K10 + 8704;
constexpr int HG_SM = HG_VT + 2 * 9216;
constexpr int HG_STB = HG_SM + 9216;
constexpr int HG_LDS = HG_STB + 2 * 17408;
__device__ void hgrn_item(const Args& a, int item, unsigned char* lds) {
    unsigned char* ws = a.ws;
    const bf16_t* PROJ = (const bf16_t*)(ws + WS_C);
    const float* LB = (const float*)(ws + WS_LB);
    bf16_t* OHG = (bf16_t*)(ws + WS_D);
    const int vs = item & 1, dir = (item >> 1) & 1, h = (item >> 2) & 3, b = item >> 4;
    const int tid = threadIdx.x, lane = tid & 63, wave = tid >> 6, r16 = lane & 15, g = lane >> 4;
    float* E = (float*)(lds + HG_E); float* EL = (float*)(lds + HG_EL);
    bf16_t* Qt = (bf16_t*)(lds + HG_QT); bf16_t* Qh = (bf16_t*)(lds + HG_QH); bf16_t* Kd = (bf16_t*)(lds + HG_KD); bf16_t* K10 = (bf16_t*)(lds + HG_K10);
    bf16_t* vT = (bf16_t*)(lds + HG_VT); bf16_t* Sm = (bf16_t*)(lds + HG_SM); bf16_t* STb = (bf16_t*)(lds + HG_STB);
    const int kB = wave * 16 + r16;
    const float lbk = LB[dir * 512 + h * 128 + kB];
    const int offf = dir ? OFF_FB : OFF_FF;
    const int rowA = tid >> 4, k8A = (tid & 15) * 8;
    const int vrow = tid >> 3, vc8 = (tid & 7) * 8;
    const size_t tokbase = (size_t)b * SEQ;
    __syncthreads();
    for (int i = tid; i < 2 * 64 * 136; i += NT) STb[i] = 0;
    f32x4 accS[4]; accS[0] = (f32x4){0.f, 0.f, 0.f, 0.f}; accS[1] = accS[0]; accS[2] = accS[0]; accS[3] = accS[0];
    unsigned short fB[16]; uint4 qA0, qA1, vA;
#define HG_PREFETCH(n) do { \
        _Pragma("unroll") for (int sc = 0; sc < 2; ++sc) _Pragma("unroll") for (int jj = 0; jj < 8; ++jj) { \
            const int tau = (n) * 64 + sc * 32 + g * 8 + jj, tt = dir ? (SEQ - 1 - tau) : tau; \
            fB[sc * 8 + jj] = PROJ[(tokbase + tt) * INW + offf + h * 128 + kB]; } \
        { const int tau = (n) * 64 + rowA, tt = dir ? (SEQ - 1 - tau) : tau; qA0 = *(const uint4*)(PROJ + (tokbase + tt) * INW + OFF_Q + h * 128 + k8A); } \
        { const int tau = (n) * 64 + rowA + 32, tt = dir ? (SEQ - 1 - tau) : tau; qA1 = *(const uint4*)(PROJ + (tokbase + tt) * INW + OFF_Q + h * 128 + k8A); } \
        { const int tau = (n) * 64 + vrow, tt = dir ? (SEQ - 1 - tau) : tau; vA = *(const uint4*)(PROJ + (tokbase + tt) * INW + OFF_I + h * 128 + vs * 64 + vc8); } \
    } while (0)
    HG_PREFETCH(0);
    for (int n = 0; n < 32; ++n) {
        bf16_t* vTn = vT + (n & 1) * (64 * 72);
        bf16x8 kbf[2];
        {
            float kd[16], ev[16], elast[2];
#pragma unroll
            for (int sc = 0; sc < 2; ++sc) {
                float run = 1.f, runi = 1.f, bb[8], bi[8];
#pragma unroll
                for (int jj = 0; jj < 8; ++jj) {
                    const float u = __expf(-bf2f(fB[sc * 8 + jj]));
                    const float a1 = 1.f + u, a2 = 1.f + lbk * u, r = frcp(a1 * a2);
                    const float f = a2 * a2 * r, fi = a1 * a1 * r;
                    kd[sc * 8 + jj] = 1.f - f;
                    run *= f; bb[jj] = run; runi *= fi; bi[jj] = runi;
                }
                float incl = run, inci = runi;
                { const float t1 = __shfl_up(incl, 16, 64), s1 = __shfl_up(inci, 16, 64); if (g >= 1) { incl *= t1; inci *= s1; } }
                { const float t2 = __shfl_up(incl, 32, 64), s2 = __shfl_up(inci, 32, 64); if (g >= 2) { incl *= t2; inci *= s2; } }
                float excl = __shfl_up(incl, 16, 64), exci = __shfl_up(inci, 16, 64); if (g == 0) { excl = 1.f; exci = 1.f; }
                elast[sc] = __shfl(incl, 48 + r16, 64);
#pragma unroll
                for (int jj = 0; jj < 8; ++jj) {
                    ev[sc * 8 + jj] = bb[jj] * excl;
                    kd[sc * 8 + jj] = kd[sc * 8 + jj] * (bi[jj] * exci);
                }
            }
#pragma unroll
            for (int sc = 0; sc < 2; ++sc)
#pragma unroll
                for (int jj = 0; jj < 8; ++jj) {
                    const int row = sc * 32 + g * 8 + jj;
                    E[row * 132 + kB] = ev[sc * 8 + jj];
                    Kd[row * 136 + kB] = f2bf(kd[sc * 8 + jj]);
                    if (sc == 0) K10[row * 136 + kB] = f2bf(kd[jj] * elast[0]);
                }
            if (g == 3) { EL[kB] = elast[0]; EL[128 + kB] = elast[1]; }
#pragma unroll
            for (int jj = 0; jj < 8; ++jj) { kbf[0][jj] = (short)f2bf(kd[jj] * elast[0] * elast[1]); kbf[1][jj] = (short)f2bf(kd[8 + jj] * elast[1]); }
        }
        {
            const unsigned w4[4] = {vA.x, vA.y, vA.z, vA.w};
#pragma unroll
            for (int q = 0; q < 4; ++q) { vTn[(vc8 + 2 * q) * 72 + vrow] = (bf16_t)(w4[q] & 0xffffu); vTn[(vc8 + 2 * q + 1) * 72 + vrow] = (bf16_t)(w4[q] >> 16); }
        }
        const uint4 qc0 = qA0, qc1 = qA1;
        if (n + 1 < 32) HG_PREFETCH(n + 1);
        __syncthreads();
        {
            const f32x4 d31 = *(const f32x4*)(EL + wave * 16 + 4 * g), d63 = *(const f32x4*)(EL + 128 + wave * 16 + 4 * g);
            const f32x4 dk = d31 * d63;
            bf16_t* stw = STb + (n & 1) * (64 * 136);
#pragma unroll
            for (int vt = 0; vt < 4; ++vt) {
                f32x4 c = accS[vt] * dk;
#pragma unroll
                for (int sc = 0; sc < 2; ++sc) {
                    const bf16x8 vf = *(const bf16x8*)(vTn + (vt * 16 + r16) * 72 + sc * 32 + 8 * g);
                    c = mfma16(kbf[sc], vf, c);
                }
                accS[vt] = c;
                uint2 w; w.x = pack2(c[0], c[1]); w.y = pack2(c[2], c[3]);
                *(uint2*)(stw + (vt * 16 + r16) * 136 + wave * 16 + 4 * g) = w;
            }
        }
        {
            const f32x4 e31a = *(const f32x4*)(EL + k8A), e31b = *(const f32x4*)(EL + k8A + 4);
#pragma unroll
            for (int u = 0; u < 2; ++u) {
                const int row = rowA + u * 32;
                const uint4 qq = u ? qc1 : qc0;
                const f32x4 ea = *(const f32x4*)(E + row * 132 + k8A), eb = *(const f32x4*)(E + row * 132 + k8A + 4);
                const float qr[8] = {bflo(qq.x), bfhi(qq.x), bflo(qq.y), bfhi(qq.y), bflo(qq.z), bfhi(qq.z), bflo(qq.w), bfhi(qq.w)};
                float qt[8], qh[8];
#pragma unroll
                for (int i = 0; i < 8; ++i) {
                    const float qs = qr[i];
                    qt[i] = qs * (i < 4 ? ea[i] : eb[i - 4]);
                    qh[i] = u ? qt[i] * (i < 4 ? e31a[i] : e31b[i - 4]) : qt[i];
                }
                *(uint4*)(Qt + row * 136 + k8A) = make_uint4(pack2(qt[0], qt[1]), pack2(qt[2], qt[3]), pack2(qt[4], qt[5]), pack2(qt[6], qt[7]));
                *(uint4*)(Qh + row * 136 + k8A) = make_uint4(pack2(qh[0], qh[1]), pack2(qh[2], qh[3]), pack2(qh[4], qh[5]), pack2(qh[6], qh[7]));
            }
        }
        __syncthreads();
#pragma unroll
        for (int q2 = 0; q2 < 2; ++q2) {
            const int tix = wave * 2 + q2, ti = tix >> 2, si = tix & 3;
            f32x4 sc = (f32x4){0.f, 0.f, 0.f, 0.f};
            if (si <= ti) {
                const bf16_t* kb = (ti >= 2 && si < 2) ? K10 : Kd;
#pragma unroll
                for (int kk = 0; kk < 4; ++kk) {
                    const bf16x8 af = *(const bf16x8*)(Qt + (ti * 16 + r16) * 136 + kk * 32 + 8 * g);
                    const bf16x8 bfr = *(const bf16x8*)(kb + (si * 16 + r16) * 136 + kk * 32 + 8 * g);
                    sc = mfma16(bfr, af, sc);
                }
                if (si == ti) {
#pragma unroll
                    for (int r = 0; r < 4; ++r) if (4 * g + r > r16) sc[r] = 0.f;
                }
            }
            uint2 w; w.x = pack2(sc[0], sc[1]); w.y = pack2(sc[2], sc[3]);
            *(uint2*)(Sm + (ti * 16 + r16) * 72 + si * 16 + 4 * g) = w;
        }
        __syncthreads();
#pragma unroll
        for (int q2 = 0; q2 < 2; ++q2) {
            const int ti = wave >> 1, vi = (wave & 1) * 2 + q2;
            const bf16_t* stp = STb + ((n + 1) & 1) * (64 * 136);
            f32x4 o = (f32x4){0.f, 0.f, 0.f, 0.f};
#pragma unroll
            for (int kk = 0; kk < 2; ++kk) {
                const bf16x8 af = *(const bf16x8*)(Sm + (ti * 16 + r16) * 72 + kk * 32 + 8 * g);
                const bf16x8 bfr = *(const bf16x8*)(vTn + (vi * 16 + r16) * 72 + kk * 32 + 8 * g);
                o = mfma16(bfr, af, o);
            }
#pragma unroll
            for (int kk = 0; kk < 4; ++kk) {
                const bf16x8 af = *(const bf16x8*)(Qh + (ti * 16 + r16) * 136 + kk * 32 + 8 * g);
                const bf16x8 bfr = *(const bf16x8*)(stp + (vi * 16 + r16) * 136 + kk * 32 + 8 * g);
                o = mfma16(bfr, af, o);
            }
            const int tau = n * 64 + ti * 16 + r16, tt = dir ? (SEQ - 1 - tau) : tau;
            uint2 w; w.x = pack2(o[0], o[1]); w.y = pack2(o[2], o[3]);
            *(uint2*)(OHG + ((size_t)dir * T + tokbase + tt) * 512 + h * 128 + vs * 64 + vi * 16 + 4 * g) = w;
        }
    }
#undef HG_PREFETCH
    __syncthreads();
}

__device__ void phase6(const Args& a) {
    unsigned char* ws = a.ws;
    const bf16_t* OHG = (const bf16_t*)(ws + WS_D); const bf16_t* PROJ = (const bf16_t*)(ws + WS_C);
    bf16_t* YCAT = (bf16_t*)(ws + WS_B);
    const int lane = threadIdx.x & 63;
    for (int t = blockIdx.x * 8 + (threadIdx.x >> 6); t < T; t += gridDim.x * 8) {
        const int c0 = lane * 8;
        const uint4 f = *(const uint4*)(OHG + (size_t)t * 512 + c0), bw = *(const uint4*)(OHG + ((size_t)T + t) * 512 + c0);
        const uint4 gg = *(const uint4*)(PROJ + (size_t)t * INW + OFF_G + c0);
        float o[8];
        o[0] = bflo(f.x) + bflo(bw.x); o[1] = bfhi(f.x) + bfhi(bw.x); o[2] = bflo(f.y) + bflo(bw.y); o[3] = bfhi(f.y) + bfhi(bw.y);
        o[4] = bflo(f.z) + bflo(bw.z); o[5] = bfhi(f.z) + bfhi(bw.z); o[6] = bflo(f.w) + bflo(bw.w); o[7] = bfhi(f.w) + bfhi(bw.w);
        float gr[8] = {bflo(gg.x), bfhi(gg.x), bflo(gg.y), bfhi(gg.y), bflo(gg.z), bfhi(gg.z), bflo(gg.w), bfhi(gg.w)};
        float ss = 0.f;
#pragma unroll
        for (int i = 0; i < 8; ++i) ss += o[i] * o[i];
        ss += __shfl_xor(ss, 1, 64); ss += __shfl_xor(ss, 2, 64); ss += __shfl_xor(ss, 4, 64); ss += __shfl_xor(ss, 8, 64);
        const float rs = rsqrtf(ss * (1.f / 128.f) + EPS);
        float y[8];
#pragma unroll
        for (int i = 0; i < 8; ++i) { const float gt = gr[i] * frcp(1.f + __expf(-gr[i])); y[i] = o[i] * rs * a.hg_o_norm[c0 + i] * gt; }
        *(uint4*)(YCAT + (size_t)t * DM + c0) = make_uint4(pack2(y[0], y[1]), pack2(y[2], y[3]), pack2(y[4], y[5]), pack2(y[6], y[7]));
    }
}

template <int NB>
__device__ void convert_tables(const Args& a, int gw, int nw) {
    unsigned char* ws = a.ws;
    const int lane = threadIdx.x & 63;
    for (int rr0 = gw; rr0 < 32768; rr0 += nw * NB) {
        f32x4 x[NB][4];
#pragma unroll
        for (int b = 0; b < NB; ++b) {
            int rr = rr0 + b * nw; rr = rr < 32768 ? rr : 32767;
            const float* src = (rr >= 16384 ? a.peer_v : a.peer_u) + (size_t)(rr & 16383) * DM + lane * 4;
#pragma unroll
            for (int q = 0; q < 4; ++q) x[b][q] = *(const f32x4*)(src + q * 256);
        }
#pragma unroll
        for (int b = 0; b < NB; ++b) {
            const int rr = rr0 + b * nw;
            if (rr >= 32768) break;
            const bool isv = rr >= 16384; const int row = rr & 16383;
            float ss = 0.f;
#pragma unroll
            for (int q = 0; q < 4; ++q) ss += x[b][q][0] * x[b][q][0] + x[b][q][1] * x[b][q][1] + x[b][q][2] * x[b][q][2] + x[b][q][3] * x[b][q][3];
            ss = wave_sum(ss);
            const float rms = sqrtf(ss * (1.f / 1024.f));
            if (isv) {
                const float sc = 0.47f * rms, inv = sc > 0.f ? 1.f / sc : 0.f;
                unsigned char* dst = ws + WS_V4 + (size_t)row * 512 + lane * 2;
#pragma unroll
                for (int q = 0; q < 4; ++q) {
                    unsigned pk = 0;
                    pk = __builtin_amdgcn_cvt_scalef32_pk_fp4_f32(pk, fminf(fmaxf(x[b][q][0] * inv, -6.f), 6.f), fminf(fmaxf(x[b][q][1] * inv, -6.f), 6.f), 1.0f, 0);
                    pk = __builtin_amdgcn_cvt_scalef32_pk_fp4_f32(pk, fminf(fmaxf(x[b][q][2] * inv, -6.f), 6.f), fminf(fmaxf(x[b][q][3] * inv, -6.f), 6.f), 1.0f, 1);
                    *(unsigned short*)(dst + q * 128) = (unsigned short)pk;
                }
                if (lane == 0) ((float*)(ws + WS_VSCALE))[row] = sc;
            } else {
                const float st = 0.36f * rms, inv = st > 0.f ? 1.f / st : 0.f;
                unsigned char* dst = ws + WS_U4 + (size_t)row * 512 + lane * 2;
                int qs = 0;
#pragma unroll
                for (int q = 0; q < 4; ++q) {
                    unsigned hw = 0;
#pragma unroll
                    for (int e = 0; e < 4; ++e) { const int qi = (int)rintf(fminf(fmaxf(x[b][q][e] * inv, -8.f), 7.f)); qs += qi; hw |= (unsigned)(qi & 15) << (4 * e); }
                    *(unsigned short*)(dst + q * 128) = (unsigned short)hw;
                }
#pragma unroll
                for (int d = 32; d > 0; d >>= 1) qs += __shfl_xor(qs, d, 64);
                if (lane == 0) { ((float*)(ws + WS_USCALE))[row] = st; ((int*)(ws + WS_USUM))[row] = qs; }
            }
        }
    }
}

__device__ void phase7(const Args& a, unsigned char* lds) {
    unsigned char* ws = a.ws;
    g256::EpiResid e{a.x, (bf16_t*)(ws + WS_R), (float*)(ws + WS_PART), lds};
    for (int i = 0;; ++i) { int pm, pn; if (!g256::next_tile(i * gridDim.x + blockIdx.x, 64, 4, pm, pn)) break;
        __syncthreads();
        g256::tile((const bf16_t*)(ws + WS_B), (const bf16_t*)(ws + WS_WOUT_T), DM, pm * 256, pn * 256, lds, e); }
    __syncthreads();
    convert_tables<4>(a, blockIdx.x * 8 + (threadIdx.x >> 6), gridDim.x * 8);
}


__device__ __forceinline__ void ce_desc(float& x, float& y) { const float hi = fmaxf(x, y), lo = fminf(x, y); x = hi; y = lo; }
template <int N> __device__ __forceinline__ void bitonic_sort_desc(float (&v)[N]) {
#pragma unroll
    for (int k = 2; k <= N; k <<= 1)
#pragma unroll
        for (int j = k >> 1; j > 0; j >>= 1)
#pragma unroll
            for (int i = 0; i < N; ++i) { const int l = i ^ j; if (l > i) { if ((i & k) == 0) ce_desc(v[i], v[l]); else ce_desc(v[l], v[i]); } }
}
template <int N> __device__ __forceinline__ void bitonic_merge_desc(float (&v)[N]) {
#pragma unroll
    for (int j = N >> 1; j > 0; j >>= 1)
#pragma unroll
        for (int i = 0; i < N; ++i) { const int l = i ^ j; if (l > i) ce_desc(v[i], v[l]); }
}
__device__ __forceinline__ void xlane_merge16(float (&v)[16], int mask) {
    float o[16];
#pragma unroll
    for (int i = 0; i < 16; ++i) o[i] = __shfl_xor(v[15 - i], mask, 64);
#pragma unroll
    for (int i = 0; i < 16; ++i) v[i] = fmaxf(v[i], o[i]);
    bitonic_merge_desc<16>(v);
}
__device__ __forceinline__ unsigned bsel(unsigned m, unsigned x1, unsigned x0) { return x0 ^ ((x1 ^ x0) & m); }
__device__ __forceinline__ float sel16(const float (&v)[16], unsigned i) {
    const unsigned m0 = 0u - (i & 1u), m1 = 0u - ((i >> 1) & 1u), m2 = 0u - ((i >> 2) & 1u), m3 = 0u - ((i >> 3) & 1u);
    unsigned t8[8], t4[4], t2[2];
#pragma unroll
    for (int q = 0; q < 8; ++q) t8[q] = bsel(m0, __float_as_uint(v[2 * q + 1]), __float_as_uint(v[2 * q]));
#pragma unroll
    for (int q = 0; q < 4; ++q) t4[q] = bsel(m1, t8[2 * q + 1], t8[2 * q]);
#pragma unroll
    for (int q = 0; q < 2; ++q) t2[q] = bsel(m2, t4[2 * q + 1], t4[2 * q]);
    return __uint_as_float(bsel(m3, t2[1], t2[0]));
}
__device__ __forceinline__ float sel4(int g, float x0, float x1, float x2, float x3) {
    const unsigned m0 = 0u - ((unsigned)g & 1u), m1 = 0u - (((unsigned)g >> 1) & 1u);
    const unsigned lo = bsel(m0, __float_as_uint(x1), __float_as_uint(x0)), hi = bsel(m0, __float_as_uint(x3), __float_as_uint(x2));
    return __uint_as_float(bsel(m1, hi, lo));
}

static constexpr int PI[52] = {0,0,0,0,0,0,0,0,0,0,0,0,0,0,0,0,1,1,1,1,1,1,1,1,2,2,2,2,2,3,3,3,3,4,4,4,5,5,6,6,7,7,8,9,10,11,12,13,14,15,0,0};
static constexpr int PJ[52] = {0,1,2,3,4,5,6,7,8,9,10,11,12,13,14,15,0,1,2,3,4,5,6,7,0,1,2,3,4,0,1,2,3,0,1,2,0,1,0,1,0,1,0,0,0,0,0,0,0,0,0,0};
constexpr int RT_ROW = 272;
__device__ __forceinline__ void peer_half_top16(const bf16_t* __restrict__ PQ, const unsigned char* __restrict__ skl, int t0, int p, int c, int r16, int g, float (&out)[16]) {
    f32x4 sc[8];
#pragma unroll
    for (int ni = 0; ni < 8; ++ni) sc[ni] = (f32x4){0.f, 0.f, 0.f, 0.f};
    bf16x8 af[4];
#pragma unroll
    for (int kk = 0; kk < 4; ++kk) af[kk] = *(const bf16x8*)(PQ + (size_t)(t0 + r16) * 2048 + p * 256 + c * 128 + kk * 32 + 8 * g);
#pragma unroll
    for (int kk = 0; kk < 4; ++kk) {
        asm volatile("" ::: "memory");
#pragma unroll
        for (int ni = 0; ni < 8; ++ni) {
            const bf16x8 bfr = *(const bf16x8*)(skl + (c * 128 + ni * 16 + r16) * RT_ROW + kk * 64 + 16 * g);
            sc[ni] = mfma16(bfr, af[kk], sc[ni]);
        }
    }
    float hi[16];
#pragma unroll
    for (int ni = 0; ni < 4; ++ni)
#pragma unroll
        for (int r = 0; r < 4; ++r) {
            out[ni * 4 + r] = __uint_as_float((__float_as_uint(sc[ni][r]) & 0xffffff80u) | (unsigned)(ni * 16 + 4 * g + r));
            hi[ni * 4 + r] = __uint_as_float((__float_as_uint(sc[ni + 4][r]) & 0xffffff80u) | (unsigned)((ni + 4) * 16 + 4 * g + r));
        }
    bitonic_sort_desc<16>(out);
    bitonic_sort_desc<16>(hi);
#pragma unroll
    for (int i = 0; i < 16; ++i) out[i] = fmaxf(out[i], hi[15 - i]);
    bitonic_merge_desc<16>(out);
    xlane_merge16(out, 16);
    xlane_merge16(out, 32);
}
__device__ __forceinline__ void peer_route_finish(const Args& a, int p, int t0, const float (&ab0)[16], const float (&ab1)[16]) {
    unsigned char* ws = a.ws;
    int* IDX = (int*)(ws + WS_IDX); float* GATE = (float*)(ws + WS_GATE);
    int tix_ = threadIdx.x; asm volatile("" : "+v"(tix_));
    const int lane = tix_ & 63, r16 = lane & 15, g = lane >> 4;
    float va[16], vb[16];
#pragma unroll
    for (int i = 0; i < 16; ++i) { va[i] = __uint_as_float(__float_as_uint(ab0[i]) & 0xffffff80u); vb[i] = __uint_as_float(__float_as_uint(ab1[i]) & 0xffffff80u); }
    float v[16];
#pragma unroll
    for (int s = 0; s < 13; ++s) {
        const float x0 = __uint_as_float((__float_as_uint(va[PI[4 * s]] + vb[PJ[4 * s]]) & 0xffffff00u) | (unsigned)(PI[4 * s] * 16 + PJ[4 * s]));
        const float x1 = __uint_as_float((__float_as_uint(va[PI[4 * s + 1]] + vb[PJ[4 * s + 1]]) & 0xffffff00u) | (unsigned)(PI[4 * s + 1] * 16 + PJ[4 * s + 1]));
        const float x2 = (4 * s + 2 < 50) ? __uint_as_float((__float_as_uint(va[PI[4 * s + 2]] + vb[PJ[4 * s + 2]]) & 0xffffff00u) | (unsigned)(PI[4 * s + 2] * 16 + PJ[4 * s + 2])) : -3.0e38f;
        const float x3 = (4 * s + 3 < 50) ? __uint_as_float((__float_as_uint(va[PI[4 * s + 3]] + vb[PJ[4 * s + 3]]) & 0xffffff00u) | (unsigned)(PI[4 * s + 3] * 16 + PJ[4 * s + 3])) : -3.0e38f;
        v[s] = sel4(g, x0, x1, x2, x3);
    }
    v[13] = -3.0e38f; v[14] = -3.0e38f; v[15] = -3.0e38f;
    bitonic_sort_desc<16>(v);
    xlane_merge16(v, 16);
    xlane_merge16(v, 32);
    float e[16], sum = 0.f;
    const float mtop = __uint_as_float(__float_as_uint(v[0]) & 0xffffff00u);
#pragma unroll
    for (int q = 0; q < 16; ++q) { e[q] = __expf(__uint_as_float(__float_as_uint(v[q]) & 0xffffff00u) - mtop); sum += e[q]; }
    const float inv = 1.f / sum;
    int oi[4]; float og[4];
#pragma unroll
    for (int r = 0; r < 4; ++r) {
        const unsigned key = __float_as_uint(sel4(g, v[r], v[4 + r], v[8 + r], v[12 + r]));
        const unsigned pos = key & 255u;
        const unsigned ia = __float_as_uint(sel16(ab0, pos >> 4)) & 127u, ib = __float_as_uint(sel16(ab1, pos & 15u)) & 127u;
        oi[r] = (int)(ia * 128u + ib);
        og[r] = sel4(g, e[r], e[4 + r], e[8 + r], e[12 + r]) * inv;
    }
    const size_t o = (size_t)(t0 + r16) * 128 + p * 16 + 4 * g;
    *(int4*)(IDX + o) = make_int4(oi[0], oi[1], oi[2], oi[3]);
    *(f32x4*)(GATE + o) = (f32x4){og[0], og[1], og[2], og[3]};
}

__device__ __forceinline__ float dpp_xor1(float v) { return __builtin_bit_cast(float, __builtin_amdgcn_mov_dpp(__builtin_bit_cast(int, v), 0xB1, 0xF, 0xF, true)); }
__device__ __forceinline__ float dpp_xor2(float v) { return __builtin_bit_cast(float, __builtin_amdgcn_mov_dpp(__builtin_bit_cast(int, v), 0x4E, 0xF, 0xF, true)); }
__device__ __forceinline__ float dpp_hmirror(float v) { return __builtin_bit_cast(float, __builtin_amdgcn_mov_dpp(__builtin_bit_cast(int, v), 0x141, 0xF, 0xF, true)); }


constexpr int PU_ROW = 272;
__device__ __forceinline__ float dot2bf(unsigned x, unsigned y, float acc) { return __builtin_amdgcn_fdot2_f32_bf16(__builtin_bit_cast(bf16v2, x), __builtin_bit_cast(bf16v2, y), acc, false); }


__device__ __forceinline__ void peer_half_top16_lds(const unsigned char* __restrict__ qs, const unsigned char* __restrict__ skl, int r16, int g, float (&out)[16]) {
    f32x4 sc[8];
#pragma unroll
    for (int ni = 0; ni < 8; ++ni) sc[ni] = (f32x4){0.f, 0.f, 0.f, 0.f};
#pragma unroll
    for (int kk = 0; kk < 4; ++kk) {
        asm volatile("" ::: "memory");
        const bf16x8 af = *(const bf16x8*)(qs + r16 * RT_ROW + kk * 64 + 16 * g);
#pragma unroll
        for (int ni = 0; ni < 8; ++ni) {
            const bf16x8 bfr = *(const bf16x8*)(skl + (ni * 16 + r16) * RT_ROW + kk * 64 + 16 * g);
            sc[ni] = mfma16(bfr, af, sc[ni]);
        }
    }
    float hi[16];
#pragma unroll
    for (int ni = 0; ni < 4; ++ni)
#pragma unroll
        for (int r = 0; r < 4; ++r) {
            out[ni * 4 + r] = __uint_as_float((__float_as_uint(sc[ni][r]) & 0xffffff80u) | (unsigned)(ni * 16 + 4 * g + r));
            hi[ni * 4 + r] = __uint_as_float((__float_as_uint(sc[ni + 4][r]) & 0xffffff80u) | (unsigned)((ni + 4) * 16 + 4 * g + r));
        }
    bitonic_sort_desc<16>(out);
    bitonic_sort_desc<16>(hi);
#pragma unroll
    for (int i = 0; i < 16; ++i) out[i] = fmaxf(out[i], hi[15 - i]);
    bitonic_merge_desc<16>(out);
    xlane_merge16(out, 16);
    xlane_merge16(out, 32);
}
struct EpiRoute { const Args* ap; unsigned char* lds; int p; int brow;
    __device__ __forceinline__ void operator()(const f32x4 (&acc)[2][2][4][2], int row0, int col0) const {
        int tix = threadIdx.x; asm volatile("" : "+v"(tix));
        const int lane = tix & 63, wave = tix >> 6, r16 = lane & 15, g = lane >> 4;
        unsigned char* qs = lds;
        unsigned char* skl = lds + 256 * RT_ROW;
        const int rl0 = row0 - brow, cl0 = (col0 - p * 256);
        float* tl = (float*)(lds + 384 * RT_ROW);
        float rs[2][4];
        { const float* PART = (const float*)(ap->ws + WS_PART);
#pragma unroll
          for (int ai = 0; ai < 2; ++ai)
#pragma unroll
            for (int m = 0; m < 4; ++m) { const int row = row0 + ai * 128 + m * 16;
                rs[ai][m] = rsqrtf(((PART[row] + PART[T + row]) + (PART[2 * T + row] + PART[3 * T + row])) * (1.f / 1024.f) + EPS); } }
#pragma unroll 1
        for (int c = 0; c < 2; ++c) {
            __syncthreads();
#pragma unroll
            for (int ai = 0; ai < 2; ++ai)
#pragma unroll
                for (int m = 0; m < 4; ++m)
#pragma unroll
                    for (int n = 0; n < 2; ++n) { const f32x4 v = (c ? acc[ai][1][m][n] : acc[ai][0][m][n]) * rs[ai][m]; uint2 w; w.x = pack2(v[0], v[1]); w.y = pack2(v[2], v[3]);
                        *(uint2*)(qs + (rl0 + ai * 128 + m * 16) * RT_ROW + (cl0 + n * 16) * 2) = w; }
            { const bf16_t* SK = (const bf16_t*)(ap->ws + WS_SUBK) + ((size_t)p * 2 + c) * 128 * 128;
              for (int ch = tix; ch < 128 * 16; ch += NT) { const int row = ch >> 4, q = ch & 15; *(uint4*)(skl + row * RT_ROW + q * 16) = *(const uint4*)(SK + row * 128 + q * 8); } }
            __syncthreads();
#pragma unroll 1
            for (int k = 0; k < 2; ++k) {
                float lst[16];
                peer_half_top16_lds(qs + ((wave * 2 + k) * 16) * RT_ROW, skl, r16, g, lst);
                if (g == 0) { float* d = tl + (((wave * 2 + k) * 16 + r16) * 2 + c) * 16;
#pragma unroll
                    for (int q = 0; q < 4; ++q) *(f32x4*)(d + q * 4) = (f32x4){lst[q * 4], lst[q * 4 + 1], lst[q * 4 + 2], lst[q * 4 + 3]}; }
            }
        }
        __syncthreads();
#pragma unroll 1
        for (int k = 0; k < 2; ++k) {
            float ab0[16], ab1[16];
            const float* d = tl + (((wave * 2 + k) * 16 + r16) * 2) * 16;
#pragma unroll
            for (int q = 0; q < 4; ++q) { const f32x4 x0 = *(const f32x4*)(d + q * 4), x1 = *(const f32x4*)(d + 16 + q * 4);
                ab0[q * 4] = x0[0]; ab0[q * 4 + 1] = x0[1]; ab0[q * 4 + 2] = x0[2]; ab0[q * 4 + 3] = x0[3]; ab1[q * 4] = x1[0]; ab1[q * 4 + 1] = x1[1]; ab1[q * 4 + 2] = x1[2]; ab1[q * 4 + 3] = x1[3]; }
            peer_route_finish(*ap, p, brow + (wave * 2 + k) * 16, ab0, ab1);
        }
    }
};

__device__ void phase9_fused(const Args& a, unsigned char* lds) {
    unsigned char* ws = a.ws;
    for (int i = 0;; ++i) { int pm, pn; if (!g256::next_tile(i * gridDim.x + blockIdx.x, 64, 8, pm, pn)) break;
        EpiRoute e{&a, lds, pn, pm * 256};
        __syncthreads();
        g256::tile((const bf16_t*)(ws + WS_R), (const bf16_t*)(ws + WS_WPQ_T), DM, pm * 256, pn * 256, lds, e); }
    __syncthreads();
}

__device__ __forceinline__ int idpp_xor1(int v) { return __builtin_amdgcn_mov_dpp(v, 0xB1, 0xF, 0xF, true); }
__device__ __forceinline__ int idpp_xor2(int v) { return __builtin_amdgcn_mov_dpp(v, 0x4E, 0xF, 0xF, true); }
__device__ __forceinline__ int idpp_hmirror(int v) { return __builtin_amdgcn_mov_dpp(v, 0x141, 0xF, 0xF, true); }

__device__ void peer_uv_phase(const Args& a, unsigned char* lds) {
    unsigned char* ws = a.ws;
    const unsigned char* U4 = ws + WS_U4; const unsigned char* V4 = ws + WS_V4;
    const unsigned* IDX = (const unsigned*)(ws + WS_IDX); const float* GATE = (const float*)(ws + WS_GATE);
    const float* VS = (const float*)(ws + WS_VSCALE); const float* US = (const float*)(ws + WS_USCALE);
    const int* USUM = (const int*)(ws + WS_USUM);
    const int wv = __builtin_amdgcn_readfirstlane((int)(threadIdx.x >> 6));
    unsigned char* wl = lds + wv * 6528;
    unsigned char* il = wl + 8 * 272;
    unsigned char* hl = lds + 8 * 6528 + wv * 8192;
    float* hsl = (float*)(lds + 8 * 6528 + 8 * 8192) + wv * 8;
    for (int item = blockIdx.x * 8 + wv; item < 2048; item += gridDim.x * 8) {
    const int tpbase = ((item >> 3) & 7) * 1024 + (item >> 6) * 8 + (item & 7);
    {
        int tix0 = threadIdx.x; asm volatile("" : "+v"(tix0));
        const int lane = tix0 & 63;
        const bf16_t* R = (const bf16_t*)(ws + WS_R);
        uint2 rw[8][4];
#pragma unroll
        for (int tau = 0; tau < 8; ++tau) { const size_t t = (size_t)(tpbase + 256 * (tau >> 1)) * 2 + (tau & 1);
#pragma unroll
            for (int i = 0; i < 4; ++i) rw[tau][i] = *(const uint2*)(R + t * DM + i * 256 + lane * 4); }
        f32x4 gn[4];
#pragma unroll
        for (int i = 0; i < 4; ++i) gn[i] = *(const f32x4*)(a.ffn_norm + i * 256 + lane * 4);
        unsigned char* hr = hl + (lane >> 3) * 32 + ((lane >> 1) & 3) * 4 + (lane & 1) * 2;
#pragma unroll
        for (int tau = 0; tau < 8; ++tau) {
            f32x4 v[4]; float ss = 0.f;
#pragma unroll
            for (int i = 0; i < 4; ++i) { v[i] = (f32x4){bflo(rw[tau][i].x), bfhi(rw[tau][i].x), bflo(rw[tau][i].y), bfhi(rw[tau][i].y)};
                ss += v[i][0] * v[i][0] + v[i][1] * v[i][1] + v[i][2] * v[i][2] + v[i][3] * v[i][3]; }
            ss = wave_sum(ss);
            const float rs = rsqrtf(ss * (1.f / 1024.f) + EPS);
            float amax = 0.f;
#pragma unroll
            for (int i = 0; i < 4; ++i)
#pragma unroll
                for (int e = 0; e < 4; ++e) { v[i][e] = v[i][e] * rs * gn[i][e]; amax = fmaxf(amax, fabsf(v[i][e])); }
#pragma unroll
            for (int d = 32; d > 0; d >>= 1) amax = fmaxf(amax, __shfl_xor(amax, d, 64));
            const float inv = amax > 0.f ? 127.f / amax : 0.f;
#pragma unroll
            for (int i = 0; i < 4; ++i) {
                unsigned ha = 0, hb = 0;
#pragma unroll
                for (int e = 0; e < 4; ++e) { const unsigned tb = (unsigned)((int)rintf(v[i][e] * inv) + 128); ha |= ((tb >> 4) ^ 8u) << (4 * e); hb |= ((tb & 15u) ^ 8u) << (4 * e); }
                *(unsigned short*)(hr + tau * 1024 + i * 256) = (unsigned short)ha; *(unsigned short*)(hr + tau * 1024 + i * 256 + 16) = (unsigned short)hb;
            }
            if (lane == 0) hsl[tau] = amax * (1.f / 127.f);
        }
    }
    {
    int tix = threadIdx.x; asm volatile("" : "+v"(tix));
    const int lane = tix & 63, m = lane & 7, j = lane >> 3;
    const size_t tp0 = (size_t)tpbase;
    int acc[4][2][2];
#pragma unroll
    for (int k = 0; k < 4; ++k) { acc[k][0][0] = 0; acc[k][0][1] = 0; acc[k][1][0] = 0; acc[k][1][1] = 0; }
#pragma unroll 1
    for (int sl = 0; sl < 4; ++sl) {
        const unsigned uoff = (unsigned)(sl * 128 + 16 * m);
#pragma unroll
        for (int k = 0; k < 4; ++k) {
            const size_t tp = tp0 + 256 * k;
            uint4 ha[2], hb[2]; uint4 iq[2][4];
#pragma unroll
            for (int tt = 0; tt < 2; ++tt) {
                const size_t t = tp * 2 + tt;
                ha[tt] = *(const uint4*)(hl + (2 * k + tt) * 1024 + sl * 256 + m * 32); hb[tt] = *(const uint4*)(hl + (2 * k + tt) * 1024 + sl * 256 + m * 32 + 16);
#pragma unroll
                for (int q = 0; q < 4; ++q) iq[tt][q] = *(const uint4*)(IDX + t * 128 + j * 16 + q * 4);
            }
            uint4 uq[2][16];
#pragma unroll
            for (int tt = 0; tt < 2; ++tt)
#pragma unroll
                for (int q = 0; q < 4; ++q) {
                    uq[tt][q * 4] = *(const uint4*)(U4 + (iq[tt][q].x * 512u + uoff)); uq[tt][q * 4 + 1] = *(const uint4*)(U4 + (iq[tt][q].y * 512u + uoff));
                    uq[tt][q * 4 + 2] = *(const uint4*)(U4 + (iq[tt][q].z * 512u + uoff)); uq[tt][q * 4 + 3] = *(const uint4*)(U4 + (iq[tt][q].w * 512u + uoff));
                }
#pragma unroll
            for (int tt = 0; tt < 2; ++tt) {
                const int haw[4] = {(int)ha[tt].x, (int)ha[tt].y, (int)ha[tt].z, (int)ha[tt].w};
                const int hbw[4] = {(int)hb[tt].x, (int)hb[tt].y, (int)hb[tt].z, (int)hb[tt].w};
                int val0 = 0, val1 = 0;
#pragma unroll
                for (int it = 0; it < 16; ++it) {
                    int wd[4] = {(int)uq[tt][it].x, (int)uq[tt][it].y, (int)uq[tt][it].z, (int)uq[tt][it].w};
                    asm volatile("" : "+v"(wd[0]), "+v"(wd[1]), "+v"(wd[2]), "+v"(wd[3]), "+v"(val0), "+v"(val1));
                    int dh = 0, dl = 0;
#pragma unroll
                    for (int q = 0; q < 4; ++q) { dh = __builtin_amdgcn_sdot8(haw[q], wd[q], dh, false); dl = __builtin_amdgcn_sdot8(hbw[q], wd[q], dl, false); }
                    int d = (dh << 4) + dl;
                    d += idpp_xor1(d); d += idpp_xor2(d); d += idpp_hmirror(d);
                    if ((it >> 1) == m) { if (it & 1) val1 = d; else val0 = d; }
                }
                acc[k][tt][0] += val0; acc[k][tt][1] += val1;
            }
        }
    }
#pragma unroll
    for (int k = 0; k < 4; ++k)
#pragma unroll
        for (int tt = 0; tt < 2; ++tt) {
            const size_t t = (tp0 + 256 * k) * 2 + tt; const size_t o = t * 128 + j * 16 + 2 * m;
            const float2 gt = *(const float2*)(GATE + o); const uint2 id = *(const uint2*)(IDX + o);
            const float hs = hsl[2 * k + tt];
            const float x0 = (float)(acc[k][tt][0] + 8 * USUM[id.x]) * (hs * US[id.x]), x1 = (float)(acc[k][tt][1] + 8 * USUM[id.y]) * (hs * US[id.y]);
            const float w0 = gt.x * 0.5f * x0 * (1.f + erff(x0 * 0.70710678118654752f)) * VS[id.x];
            const float w1 = gt.y * 0.5f * x1 * (1.f + erff(x1 * 0.70710678118654752f)) * VS[id.y];
            *(unsigned*)(wl + (2 * k + tt) * 272 + (j * 16 + 2 * m) * 2) = pack2h(w0, w1);
            *(uint2*)(il + (2 * k + tt) * 528 + (j * 16 + 2 * m) * 4) = id;
        }
    }
    int tix2 = threadIdx.x; asm volatile("" : "+v"(tix2));
    const int m2 = tix2 & 7, j2 = (tix2 >> 3) & 7;
    const unsigned tv = (unsigned)((tpbase + 256 * (j2 >> 1)) * 2 + (j2 & 1));
    const unsigned char* wrow = wl + j2 * 272; const unsigned char* irow = il + j2 * 528;
#pragma unroll 1
    for (int sl = 0; sl < 4; ++sl) {
        const unsigned voff = (unsigned)(sl * 128 + 16 * m2);
        float y[32];
#pragma unroll
        for (int i = 0; i < 32; ++i) y[i] = 0.f;
#pragma unroll 1
        for (int grp = 0; grp < 4; ++grp) {
            uint4 wq[4];
            uint4 vq[32];
#pragma unroll
            for (int q = 0; q < 8; ++q) {
                const uint4 i4 = *(const uint4*)(irow + grp * 128 + q * 16);
                vq[q * 4] = *(const uint4*)(V4 + (i4.x * 512u + voff)); vq[q * 4 + 1] = *(const uint4*)(V4 + (i4.y * 512u + voff));
                vq[q * 4 + 2] = *(const uint4*)(V4 + (i4.z * 512u + voff)); vq[q * 4 + 3] = *(const uint4*)(V4 + (i4.w * 512u + voff));
            }
#pragma unroll
            for (int q = 0; q < 4; ++q) wq[q] = *(const uint4*)(wrow + grp * 64 + q * 16);
#pragma unroll
            for (int it = 0; it < 32; ++it) {
                const uint4 wv4 = wq[it >> 3]; const int wc_ = (it >> 1) & 3;
                const unsigned wword = wc_ == 0 ? wv4.x : (wc_ == 1 ? wv4.y : (wc_ == 2 ? wv4.z : wv4.w));
                const f16v2 wp = __builtin_bit_cast(f16v2, wword);
                const float wt = (float)((it & 1) ? wp[1] : wp[0]);
                unsigned wd0 = vq[it].x, wd1 = vq[it].y, wd2 = vq[it].z, wd3 = vq[it].w;
                asm volatile("" : "+v"(wd0), "+v"(wd1), "+v"(wd2), "+v"(wd3), "+v"(y[0]));
                const unsigned wd[4] = {wd0, wd1, wd2, wd3};
#pragma unroll
                for (int q = 0; q < 4; ++q) {
                    const f32v2 p0 = __builtin_amdgcn_cvt_scalef32_pk_f32_fp4(wd[q], 1.0f, 0), p1 = __builtin_amdgcn_cvt_scalef32_pk_f32_fp4(wd[q], 1.0f, 1);
                    const f32v2 p2 = __builtin_amdgcn_cvt_scalef32_pk_f32_fp4(wd[q], 1.0f, 2), p3 = __builtin_amdgcn_cvt_scalef32_pk_f32_fp4(wd[q], 1.0f, 3);
                    y[q * 8] += wt * p0[0]; y[q * 8 + 1] += wt * p0[1]; y[q * 8 + 2] += wt * p1[0]; y[q * 8 + 3] += wt * p1[1];
                    y[q * 8 + 4] += wt * p2[0]; y[q * 8 + 5] += wt * p2[1]; y[q * 8 + 6] += wt * p3[0]; y[q * 8 + 7] += wt * p3[1];
                }
            }
        }
        const unsigned ooff = tv * (unsigned)DM + (unsigned)(sl * 256 + 32 * m2);
        const bf16_t* rrow = (const bf16_t*)(ws + WS_R) + ooff; float* orow = a.out + ooff;
#pragma unroll
        for (int q = 0; q < 4; ++q) {
            const uint4 r = *(const uint4*)(rrow + q * 8);
            *(f32x4*)(orow + q * 8) = (f32x4){bflo(r.x) + y[q * 8], bfhi(r.x) + y[q * 8 + 1], bflo(r.y) + y[q * 8 + 2], bfhi(r.y) + y[q * 8 + 3]};
            *(f32x4*)(orow + q * 8 + 4) = (f32x4){bflo(r.z) + y[q * 8 + 4], bfhi(r.z) + y[q * 8 + 5], bflo(r.w) + y[q * 8 + 6], bfhi(r.w) + y[q * 8 + 7]};
        }
    }
    }
}

#define XB_TMO      128
#define XB_XCNT(j)  (256  + 64 * (j))
#define XB_XSUB(j)  (1280 + 64 * (j))
#define XB_XGEN(j)  (2304 + 64 * (j))
#define XB_TOP      3328
#define XB_TOPGEN   3392
#define XCD_BAR_WORDS 3456
#define XB_SPIN_CAP (1u << 22)
#define LAS __attribute__((address_space(3)))
__device__ __forceinline__ unsigned xb_ld(unsigned* p)              { return __hip_atomic_load(p, __ATOMIC_RELAXED, __HIP_MEMORY_SCOPE_AGENT); }
__device__ __forceinline__ unsigned xb_add(unsigned* p, unsigned v) { return __hip_atomic_fetch_add(p, v, __ATOMIC_RELAXED, __HIP_MEMORY_SCOPE_AGENT); }
__device__ __forceinline__ unsigned xb_xcc_id() { return (unsigned)__builtin_amdgcn_s_getreg((3 << 11) | 20) & 0xFu; }
#define XB_SPIN(cond, bar) do { unsigned _sp = 0; while (cond) { __builtin_amdgcn_s_sleep(1); \
    if ((++_sp & 255u) == 0u) { if (xb_ld(&(bar)[XB_TMO])) break; if (_sp > XB_SPIN_CAP) { atomicAdd(&(bar)[XB_TMO], 1u); break; } } } } while (0)
struct XcdBarrier { unsigned* bar; unsigned x; volatile LAS unsigned* st; };
__device__ __forceinline__ XcdBarrier xcd_barrier_post(unsigned* bar, volatile LAS unsigned* st) {
    XcdBarrier b; b.bar = bar; b.x = xb_xcc_id(); b.st = st;
    if (threadIdx.x == 0) (void)xb_add(&bar[XB_XCNT(b.x)], 1u);
    return b;
}
__device__ __forceinline__ void xcd_barrier_complete(unsigned* bar, unsigned x, unsigned& nloc, unsigned& nx) {
    const unsigned G = gridDim.x * gridDim.y * gridDim.z;
    unsigned sum, cnt, mine, sp = 0u;
    for (;;) {
        sum = 0u; cnt = 0u; mine = 0u;
#pragma unroll
        for (unsigned j = 0; j < 16; ++j) { const unsigned c = xb_ld(&bar[XB_XCNT(j)]); sum += c; cnt += (c > 0u) ? 1u : 0u; mine = (j == x) ? c : mine; }
        if (sum == G) break;
        __builtin_amdgcn_s_sleep(1);
        if ((++sp & 255u) == 0u) { if (xb_ld(&bar[XB_TMO])) break; if (sp > XB_SPIN_CAP) { atomicAdd(&bar[XB_TMO], 1u); break; } }
    }
    nloc = mine > 0u ? mine : 1u; nx = cnt > 0u ? cnt : 1u;
}
__device__ __forceinline__ void xcd_barrier(const XcdBarrier& b) {
    asm volatile("s_waitcnt vmcnt(0)" ::: "memory");
    __syncthreads();
    if (threadIdx.x == 0) {
        unsigned* bar = b.bar;
        __builtin_amdgcn_s_waitcnt(0);
        unsigned nloc = b.st[0], nx = b.st[1];
        if (nloc == 0u) { xcd_barrier_complete(bar, b.x, nloc, nx); b.st[0] = nloc; b.st[1] = nx; }
        const unsigned old = xb_add(&bar[XB_XSUB(b.x)], 1u);
        const unsigned gen = old / nloc;
        if (old + 1u == (gen + 1u) * nloc) {
            __builtin_amdgcn_fence(__ATOMIC_RELEASE, "agent");
            asm volatile("s_waitcnt vmcnt(0)" ::: "memory");
            const unsigned og = xb_add(&bar[XB_TOP], 1u);
            const unsigned tg = og / nx;
            if (og + 1u == (tg + 1u) * nx) xb_add(&bar[XB_TOPGEN], 1u);
            else XB_SPIN(xb_ld(&bar[XB_TOPGEN]) == tg, bar);
            __builtin_amdgcn_fence(__ATOMIC_ACQUIRE, "agent");
            xb_add(&bar[XB_XGEN(b.x)], 1u);
            asm volatile("s_waitcnt vmcnt(0)" ::: "memory");
        } else {
            XB_SPIN(xb_ld(&bar[XB_XGEN(b.x)]) == gen, bar);
            __builtin_amdgcn_fence(__ATOMIC_ACQUIRE, "agent");
            asm volatile("s_waitcnt vmcnt(0)" ::: "memory");
        }
    }
    __syncthreads();
}

constexpr int LDS_MAIN = HG_LDS;
static_assert(LDS_MAIN >= 512 * PU_ROW && LDS_MAIN >= 2 * AT_BUF && LDS_MAIN >= 131072, "LDS_MAIN");
constexpr int LDS_BYTES = LDS_MAIN + 16;
constexpr int N_PHASES = 14;

__global__ void __launch_bounds__(NT, 2) fwd_kernel(Args a) {
    extern __shared__ __attribute__((aligned(16))) unsigned char lds[];
#if N_LAUNCH_MODE == 1
#ifdef USE_CG_SYNC
    cg::grid_group grid = cg::this_grid();
#endif
    volatile LAS unsigned* xst = (volatile LAS unsigned*)(lds + LDS_MAIN);
    if (threadIdx.x < 4) xst[threadIdx.x] = 0u;
    __syncthreads();
    XcdBarrier xbar = xcd_barrier_post((unsigned*)(a.ws + WS_CTL), xst);
#ifdef USE_CG_SYNC
#define SEAM(k) do { if (a.ph_lo <= (k) && (k) + 1 < a.ph_hi) { if ((k) == 0) grid.sync(); else xcd_barrier(xbar); } } while (0)
#else
#define SEAM(k) do { if (a.ph_lo <= (k) && (k) + 1 < a.ph_hi) { xcd_barrier(xbar); } } while (0)
#endif
#else
#define SEAM(k) do { } while (0)
#endif
#define IN(k) (a.ph_lo <= (k) && (k) < a.ph_hi)
#define REPS(k) for (int rep_ = 0; rep_ < ((k) == REPEAT_PHASE ? 2 : 1); ++rep_)
    if (IN(0)) REPS(0) { phase0(a, lds); } SEAM(0);
    if (IN(1)) REPS(1) { phase1(a, lds); } SEAM(1);
    if (IN(2)) REPS(2) { phase2(a); } SEAM(2);
    if (IN(3)) REPS(3) { phase3(a, lds); } SEAM(3);
    if (IN(4)) REPS(4) {
        const int nhalf = gridDim.x >> 1;
        if ((int)blockIdx.x < nhalf) { for (int r_ = 0; r_ < ATT_REP; ++r_) for (int it = blockIdx.x; it < 256; it += nhalf) attn_item(a, it, lds); }
        else { for (int r_ = 0; r_ < HG_REP; ++r_) for (int it = blockIdx.x - nhalf; it < 128; it += gridDim.x - nhalf) hgrn_item(a, it, lds); }
    } SEAM(5);
    if (IN(6)) REPS(6) { phase6(a); } SEAM(6);
    if (IN(7)) REPS(7) { phase7(a, lds); } SEAM(7);
    if (IN(9)) REPS(9) { phase9_fused(a, lds); } SEAM(10);
    if (IN(11)) { __syncthreads(); peer_uv_phase(a, lds); }
}

extern "C" void kernel_launch(void* const* d_in, const int* in_sizes, int n_in, void* d_out, int out_size, void* d_ws, size_t ws_size, hipStream_t stream) {
    static int grid = 0;
    if (grid == 0) {
        if (n_in != 19 || out_size != T * DM || ws_size < WS_END) { fprintf(stderr, "kernel_launch: unexpected shapes (n_in %d out %d ws %zu)\n", n_in, out_size, ws_size); grid = -1; return; }
        int dev = 0, cus = 0, per_cu = 0;
        (void)hipGetDevice(&dev); (void)hipDeviceGetAttribute(&cus, hipDeviceAttributeMultiprocessorCount, dev);
        (void)hipFuncSetAttribute((const void*)fwd_kernel, hipFuncAttributeMaxDynamicSharedMemorySize, LDS_BYTES);
        (void)hipOccupancyMaxActiveBlocksPerMultiprocessor(&per_cu, (const void*)fwd_kernel, NT, LDS_BYTES);
        if (per_cu < 1) { fprintf(stderr, "kernel_launch: occupancy query says %d blocks/CU\n", per_cu); per_cu = 1; }
        grid = cus;
        (void)hipGetLastError();
    }
    if (grid < 0) return;
    Args a{};
    a.x = (const float*)d_in[0]; a.pos = (const int*)d_in[1]; a.attn_norm = (const float*)d_in[2]; a.w_in = (const float*)d_in[3];
    a.lb_logits = (const float*)d_in[4]; a.hg_o_norm = (const float*)d_in[5]; a.q_a_norm = (const float*)d_in[6]; a.w_q_up = (const float*)d_in[7];
    a.kv_a_norm = (const float*)d_in[8]; a.w_kv_up = (const float*)d_in[9]; a.q_norm = (const float*)d_in[10]; a.k_norm = (const float*)d_in[11];
    a.mla_o_norm = (const float*)d_in[12]; a.w_out = (const float*)d_in[13]; a.ffn_norm = (const float*)d_in[14]; a.peer_wq = (const float*)d_in[15];
    a.subk = (const float*)d_in[16]; a.peer_u = (const float*)d_in[17]; a.peer_v = (const float*)d_in[18];
    a.out = (float*)d_out; a.ws = (unsigned char*)d_ws;
    const int last = (STOP_AFTER < N_PHASES - 1) ? STOP_AFTER : N_PHASES - 1;
#if N_LAUNCH_MODE == 1
    (void)hipMemsetAsync((unsigned char*)d_ws + WS_CTL, 0, 16384, stream);
    a.ph_lo = 0; a.ph_hi = last + 1;
#ifdef USE_CG_SYNC
    void* args[] = {&a};
    hipError_t e = hipLaunchCooperativeKernel((const void*)fwd_kernel, dim3(grid), dim3(NT), args, LDS_BYTES, stream);
    if (e != hipSuccess) fprintf(stderr, "cooperative launch failed: %s (grid %d)\n", hipGetErrorString(e), grid);
#else
    hipLaunchKernelGGL(fwd_kernel, dim3(grid), dim3(NT), LDS_BYTES, stream, a);
#endif
#else
    for (int ph = 0; ph <= last; ++ph) {
        a.ph_lo = ph; a.ph_hi = ph + 1;
        hipLaunchKernelGGL(fwd_kernel, dim3(grid), dim3(NT), LDS_BYTES, stream, a);
    }
#endif
}
```

```cpp
#include <hip/hip_runtime.h>
#include <hip/hip_cooperative_groups.h>
#include <cstdio>
#include <cstdint>
namespace cg = cooperative_groups;

#ifndef N_LAUNCH_MODE
#define N_LAUNCH_MODE 1
#endif
#ifndef REPEAT_PHASE
#define REPEAT_PHASE -1
#endif
#ifndef ATT_REP
#define ATT_REP 1
#endif
#ifndef HG_REP
#define HG_REP 1
#endif
#ifndef STOP_AFTER
#define STOP_AFTER 99
#endif

typedef unsigned short bf16_t;
typedef short bf16x8 __attribute__((ext_vector_type(8)));
typedef float f32x4 __attribute__((ext_vector_type(4)));

constexpr int NT = 512;
constexpr int T = 16384, SEQ = 2048, NB = 8, DM = 1024, INW = 3264;
constexpr int OFF_Q = 0, OFF_FF = 512, OFF_FB = 1024, OFF_I = 1536, OFF_G = 2048, OFF_CQ = 2560, OFF_CKV = 2944, OFF_KR = 3200;
constexpr float EPS = 1e-6f;

constexpr size_t WS_CTL = 0;
constexpr size_t WS_WIN_T = 65536;
constexpr size_t WS_WQUP_T = WS_WIN_T + (size_t)3264 * 1024 * 2;
constexpr size_t WS_WKVUP_T = WS_WQUP_T + (size_t)768 * 384 * 2;
constexpr size_t WS_WOUT_T = WS_WKVUP_T + (size_t)1024 * 256 * 2;
constexpr size_t WS_WPQ_T = WS_WOUT_T + (size_t)1024 * 1024 * 2;
constexpr size_t WS_SUBK = WS_WPQ_T + (size_t)2048 * 1024 * 2;
constexpr size_t WS_LB = WS_SUBK + (size_t)16 * 128 * 128 * 2;
constexpr size_t WS_B = 15728640;
constexpr size_t WS_CQN = WS_B;
constexpr size_t WS_CKVN = WS_B + (size_t)T * 384 * 2;
constexpr size_t WS_C = WS_B + 33554432;
constexpr size_t WS_R = WS_C + 33554432;
constexpr size_t WS_PART = WS_C;
constexpr size_t WS_D = WS_C + (size_t)T * INW * 2;
constexpr size_t WS_Q = WS_D + 33554432;
constexpr size_t WS_KN = WS_Q + (size_t)T * 768 * 2;
constexpr size_t WS_VT = WS_KN + (size_t)T * 512 * 2;
constexpr size_t WS_KROPE = WS_VT + (size_t)T * 512 * 2;
constexpr size_t WS_ROPECS = WS_KROPE + (size_t)T * 64 * 2;
constexpr size_t WS_U4 = WS_ROPECS;
constexpr size_t WS_V4 = WS_U4 + (size_t)16384 * 512;
constexpr size_t WS_VSCALE = WS_V4 + (size_t)16384 * 512;
constexpr size_t WS_USCALE = WS_VSCALE + 65536;
constexpr size_t WS_USUM = WS_USCALE + 65536;
constexpr size_t WS_END = WS_USUM + 65536;
static_assert(WS_U4 >= WS_ROPECS && WS_ROPECS + (size_t)T * 64 * 4 <= WS_END, "rope table inside the tail region");
constexpr size_t WS_W16 = WS_KROPE;
constexpr size_t WS_IDX = WS_VT;
constexpr size_t WS_GATE = WS_VT + (size_t)T * 128 * 4;
constexpr size_t WS_ELIST = WS_D + 67108864;
constexpr size_t WS_COUNTS = WS_CTL + 16384;
constexpr size_t WS_BSTART = WS_CTL + 16384 + 32768;
static_assert(WS_ELIST + (size_t)T * 128 * 4 <= WS_VT, "edge list overflow");
static_assert(WS_LB + 4096 <= WS_B, "weights overflow");
static_assert(WS_D + (size_t)T * 2048 * 2 <= WS_IDX, "PQ overlaps IDX");
static_assert(WS_GATE + (size_t)T * 128 * 4 <= WS_VT + (size_t)T * 512 * 2, "gate overflow");
static_assert(WS_END <= 268435456, "workspace too big");

struct Args {
    const float* x; const int* pos; const float* attn_norm; const float* w_in; const float* lb_logits; const float* hg_o_norm;
    const float* q_a_norm; const float* w_q_up; const float* kv_a_norm; const float* w_kv_up; const float* q_norm; const float* k_norm;
    const float* mla_o_norm; const float* w_out; const float* ffn_norm; const float* peer_wq; const float* subk; const float* peer_u; const float* peer_v;
    float* out; unsigned char* ws; int ph_lo, ph_hi;
};

typedef __bf16 bf16v2 __attribute__((ext_vector_type(2)));
typedef float f32v2 __attribute__((ext_vector_type(2)));
__device__ __forceinline__ unsigned pack2(float lo, float hi) { const f32v2 v = {lo, hi}; return __builtin_bit_cast(unsigned, __builtin_convertvector(v, bf16v2)); }
__device__ __forceinline__ bf16_t f2bf(float f) { return (bf16_t)(pack2(f, 0.f) & 0xffffu); }
typedef _Float16 f16v2 __attribute__((ext_vector_type(2)));
__device__ __forceinline__ unsigned pack2h(float lo, float hi) { const f32v2 v = {lo, hi}; return __builtin_bit_cast(unsigned, __builtin_convertvector(v, f16v2)); }
__device__ __forceinline__ float frcp(float x) { return __builtin_amdgcn_rcpf(x); }
__device__ __forceinline__ float fexp2(float x) { return __builtin_amdgcn_exp2f(x); }
__device__ __forceinline__ float bf2f(bf16_t h) { return __uint_as_float(((unsigned)h) << 16); }
__device__ __forceinline__ float bflo(unsigned w) { return __uint_as_float(w << 16); }
__device__ __forceinline__ float bfhi(unsigned w) { return __uint_as_float(w & 0xffff0000u); }
__device__ __forceinline__ float wave_sum(float v) {
#pragma unroll
    for (int d = 32; d > 0; d >>= 1) v += __shfl_xor(v, d, 64);
    return v;
}
__device__ __forceinline__ f32x4 mfma16(bf16x8 a, bf16x8 b, f32x4 c) { return __builtin_amdgcn_mfma_f32_16x16x32_bf16(a, b, c, 0, 0, 0); }

__device__ const float ROPE_INV_FREQ[32] = {
    1.000000000e+00f, 7.498942018e-01f, 5.623413324e-01f, 4.216965139e-01f, 3.162277639e-01f, 2.371373922e-01f, 1.778279394e-01f, 1.333521456e-01f,
    1.000000015e-01f, 7.498941571e-02f, 5.623412877e-02f, 4.216964915e-02f, 3.162277862e-02f, 2.371373586e-02f, 1.778279431e-02f, 1.333521493e-02f,
    9.999999776e-03f, 7.498942316e-03f, 5.623413250e-03f, 4.216964822e-03f, 3.162277862e-03f, 2.371373819e-03f, 1.778279431e-03f, 1.333521446e-03f,
    1.000000047e-03f, 7.498941850e-04f, 5.623413017e-04f, 4.216965463e-04f, 3.162277862e-04f, 2.371373848e-04f, 1.778279402e-04f, 1.333521504e-04f};

template <int WAVES_M, int WAVES_N, int WM, int WN, class Epi>
__device__ __forceinline__ void gemm_block(const bf16_t* __restrict__ A, int lda, const bf16_t* __restrict__ Bt, int ldb, int K,
                                           int m0, int n0, int nrows_bt, unsigned char* lds, Epi& epi) {
    constexpr int BM = WAVES_M * WM * 16, BN = WAVES_N * WN * 16;
    constexpr int AI = BM / 64, BI = BN / 64;
    static_assert(WAVES_M * WAVES_N == 8, "8 waves");
    const int tid = threadIdx.x, lane = tid & 63, wave = tid >> 6;
    const int wm = wave / WAVES_N, wn = wave % WAVES_N;
    const int r16 = lane & 15, g = lane >> 4;
    unsigned char* As = lds;
    unsigned char* Bs = lds + BM * 144;
    f32x4 acc[WM][WN];
#pragma unroll
    for (int i = 0; i < WM; ++i)
#pragma unroll
        for (int j = 0; j < WN; ++j) acc[i][j] = (f32x4){0.f, 0.f, 0.f, 0.f};
    uint4 ra0, ra1, ra2, ra3, rb0, rb1, rb2, rb3;
    static_assert(AI <= 4 && BI <= 4, "stage regs");
#define GA_LOAD(i, k0) if constexpr (AI > i) { const int c = tid + i * NT, row = c >> 3, kc = c & 7; ra##i = *(const uint4*)(A + (size_t)(m0 + row) * lda + (k0) + kc * 8); }
#define GB_LOAD(i, k0) if constexpr (BI > i) { const int c = tid + i * NT, row = c >> 3, kc = c & 7; int rg = n0 + row; rg = rg < nrows_bt ? rg : nrows_bt - 1; rb##i = *(const uint4*)(Bt + (size_t)rg * ldb + (k0) + kc * 8); }
#define GA_STORE(i) if constexpr (AI > i) { const int c = tid + i * NT, row = c >> 3, kc = c & 7; *(uint4*)(As + row * 144 + kc * 16) = ra##i; }
#define GB_STORE(i) if constexpr (BI > i) { const int c = tid + i * NT, row = c >> 3, kc = c & 7; *(uint4*)(Bs + row * 144 + kc * 16) = rb##i; }
    GA_LOAD(0, 0) GA_LOAD(1, 0) GA_LOAD(2, 0) GA_LOAD(3, 0) GB_LOAD(0, 0) GB_LOAD(1, 0) GB_LOAD(2, 0) GB_LOAD(3, 0)
    const int nk = K / 64;
    for (int kt = 0; kt < nk; ++kt) {
        __syncthreads();
        GA_STORE(0) GA_STORE(1) GA_STORE(2) GA_STORE(3) GB_STORE(0) GB_STORE(1) GB_STORE(2) GB_STORE(3)
        __syncthreads();
        if (kt + 1 < nk) {
            const int k0 = (kt + 1) * 64;
            GA_LOAD(0, k0) GA_LOAD(1, k0) GA_LOAD(2, k0) GA_LOAD(3, k0) GB_LOAD(0, k0) GB_LOAD(1, k0) GB_LOAD(2, k0) GB_LOAD(3, k0)
        }
#pragma unroll
        for (int kk = 0; kk < 2; ++kk) {
            bf16x8 af[WM];
#pragma unroll
            for (int i = 0; i < WM; ++i) af[i] = *(const bf16x8*)(As + ((wm * WM + i) * 16 + r16) * 144 + kk * 64 + g * 16);
#pragma unroll
            for (int j = 0; j < WN; ++j) {
                const bf16x8 bfr = *(const bf16x8*)(Bs + ((wn * WN + j) * 16 + r16) * 144 + kk * 64 + g * 16);
#pragma unroll
                for (int i = 0; i < WM; ++i) acc[i][j] = mfma16(bfr, af[i], acc[i][j]);
            }
        }
    }
#undef GA_LOAD
#undef GB_LOAD
#undef GA_STORE
#undef GB_STORE
    epi(acc, m0 + wm * WM * 16, n0 + wn * WN * 16, lane);
}

namespace g256 {
constexpr int BM = 256, BK = 64, HALF = 128, HT = HALF * BK;
__device__ __forceinline__ int lds_byte(int r, int c) { const int st = (r >> 4) * 2 + (c >> 5), rr = r & 15, cc = c & 31, ob = rr * 64 + cc * 2; return st * 1024 + (ob ^ (((ob >> 9) & 1) << 5)); }
__device__ __forceinline__ void stage_rc(int b, int& R, int& C) { const int st = b / 1024, sb = b % 1024, swz = sb ^ (((sb >> 9) & 1) << 5); R = (st >> 1) * 16 + swz / 64; C = (st & 1) * 32 + (swz % 64) / 2; }

template <class Epi>
__device__ __forceinline__ void tile(const bf16_t* __restrict__ A, const bf16_t* __restrict__ Bt, int K, int brow, int bcol, unsigned char* lds, Epi& epi) {
    bf16_t* shm = (bf16_t*)lds;
#define G_SA(b, h) (shm + ((b) * 2 + (h)) * HT)
#define G_SB(b, h) (shm + (4 + (b) * 2 + (h)) * HT)
#define G_STAGE(P, BASE, br, kt) do { const long _g = (long)(br) * K + (long)(kt) * BK; \
    _Pragma("unroll") for (int _i = 0; _i < 2; ++_i) { const int _b = tix * 16 + _i * 8192; int _r, _c; stage_rc(_b, _r, _c); \
      __builtin_amdgcn_global_load_lds((const unsigned*)(BASE + _g + (long)_r * K + _c), (unsigned*)((char*)(P) + _b), 16, 0, 0); } } while (0)
#define G_LDA(dst, b, h) _Pragma("unroll") for (int m = 0; m < 4; ++m) _Pragma("unroll") for (int k = 0; k < 2; ++k) \
    dst[m][k] = *reinterpret_cast<const bf16x8*>((char*)G_SA(b, h) + lds_byte(wr * 64 + m * 16 + fr, k * 32 + fq * 8))
#define G_LDB(dst, b, h) _Pragma("unroll") for (int n = 0; n < 2; ++n) _Pragma("unroll") for (int k = 0; k < 2; ++k) \
    dst[n][k] = *reinterpret_cast<const bf16x8*>((char*)G_SB(b, h) + lds_byte(wc * 32 + n * 16 + fr, k * 32 + fq * 8))
#define G_MMA(ai, bj, At, Bt_) do { __builtin_amdgcn_s_setprio(1); \
    _Pragma("unroll") for (int m = 0; m < 4; ++m) _Pragma("unroll") for (int n = 0; n < 2; ++n) _Pragma("unroll") for (int k = 0; k < 2; ++k) \
      acc[ai][bj][m][n] = __builtin_amdgcn_mfma_f32_16x16x32_bf16(Bt_[n][k], At[m][k], acc[ai][bj][m][n], 0, 0, 0); \
    __builtin_amdgcn_s_setprio(0); } while (0)
#define G_WAIT_V(n) asm volatile("s_waitcnt vmcnt(" #n ")" ::: "memory")
#define G_WAIT_L(n) asm volatile("s_waitcnt lgkmcnt(" #n ")" ::: "memory")
#define G_BAR __builtin_amdgcn_s_barrier()
#define G_SCHED __builtin_amdgcn_sched_barrier(0)
    int tix = threadIdx.x; asm volatile("" : "+v"(tix));
    const int wid = tix >> 6, lane = tix & 63, wr = wid >> 2, wc = wid & 3, fr = lane & 15, fq = lane >> 4;
    f32x4 acc[2][2][4][2];
#pragma unroll
    for (int i0 = 0; i0 < 2; ++i0)
#pragma unroll
        for (int i1 = 0; i1 < 2; ++i1)
#pragma unroll
            for (int i2 = 0; i2 < 4; ++i2)
#pragma unroll
                for (int i3 = 0; i3 < 2; ++i3) acc[i0][i1][i2][i3] = (f32x4){0.f, 0.f, 0.f, 0.f};
    bf16x8 At[4][2], B0[2][2], B1[2][2];
    const int nt = K / BK;
    G_STAGE(G_SB(0, 0), Bt, bcol, 0); G_STAGE(G_SA(0, 0), A, brow, 0);
    G_STAGE(G_SB(0, 1), Bt, bcol + HALF, 0); G_STAGE(G_SA(0, 1), A, brow + HALF, 0);
    if (wr == 1) G_BAR;
    G_WAIT_V(4); G_BAR;
    G_STAGE(G_SB(1, 0), Bt, bcol, 1); G_STAGE(G_SA(1, 0), A, brow, 1); G_STAGE(G_SB(1, 1), Bt, bcol + HALF, 1);
    G_WAIT_V(6); G_BAR;
    for (int t = 0; t < nt - 2; t += 2) {
        G_LDB(B0, 0, 0); G_SCHED; G_LDA(At, 0, 0); G_STAGE(G_SA(1, 1), A, brow + HALF, t + 1);
        G_WAIT_L(8); G_BAR; G_WAIT_L(0); G_MMA(0, 0, At, B0); G_BAR; G_SCHED;
        G_LDB(B1, 0, 1); G_STAGE(G_SB(0, 0), Bt, bcol, t + 2);
        G_BAR; G_WAIT_L(0); G_MMA(0, 1, At, B1); G_BAR;
        G_LDA(At, 0, 1); G_STAGE(G_SA(0, 0), A, brow, t + 2);
        G_BAR; G_WAIT_L(0); G_MMA(1, 0, At, B0); G_BAR; G_SCHED;
        G_STAGE(G_SB(0, 1), Bt, bcol + HALF, t + 2);
        G_WAIT_V(6); G_BAR; G_MMA(1, 1, At, B1); G_BAR;
        G_LDB(B0, 1, 0); G_SCHED; G_LDA(At, 1, 0); G_STAGE(G_SA(0, 1), A, brow + HALF, t + 2);
        G_WAIT_L(8); G_BAR; G_WAIT_L(0); G_MMA(0, 0, At, B0); G_BAR; G_SCHED;
        G_LDB(B1, 1, 1); G_STAGE(G_SB(1, 0), Bt, bcol, t + 3);
        G_BAR; G_WAIT_L(0); G_MMA(0, 1, At, B1); G_BAR;
        G_LDA(At, 1, 1); G_STAGE(G_SA(1, 0), A, brow, t + 3);
        G_BAR; G_WAIT_L(0); G_MMA(1, 0, At, B0); G_BAR; G_SCHED;
        G_STAGE(G_SB(1, 1), Bt, bcol + HALF, t + 3);
        G_WAIT_V(6); G_BAR; G_MMA(1, 1, At, B1); G_BAR;
    }
    { G_LDB(B0, 0, 0); G_LDA(At, 0, 0); G_STAGE(G_SA(1, 1), A, brow + HALF, nt - 1);
      G_BAR; G_WAIT_L(0); G_MMA(0, 0, At, B0); G_BAR;
      G_LDB(B1, 0, 1); G_BAR; G_WAIT_L(0); G_MMA(0, 1, At, B1); G_BAR;
      G_LDA(At, 0, 1); G_WAIT_V(4); G_BAR; G_WAIT_L(0); G_MMA(1, 0, At, B0); G_MMA(1, 1, At, B1); G_BAR; }
    { G_LDB(B0, 1, 0); G_LDA(At, 1, 0); G_WAIT_V(2); G_BAR; G_WAIT_L(0); G_MMA(0, 0, At, B0); G_BAR;
      G_LDB(B1, 1, 1); G_WAIT_V(0); G_BAR; G_WAIT_L(0); G_MMA(0, 1, At, B1); G_BAR;
      G_LDA(At, 1, 1); G_BAR; G_WAIT_L(0); G_MMA(1, 0, At, B0); G_MMA(1, 1, At, B1); G_BAR; }
    if (wr == 0) G_BAR;
    epi(acc, brow + wr * 64 + fr, bcol + wc * 32 + 4 * fq);
#undef G_SA
#undef G_SB
#undef G_STAGE
#undef G_LDA
#undef G_LDB
#undef G_MMA
#undef G_WAIT_V
#undef G_WAIT_L
#undef G_BAR
#undef G_SCHED
}
__device__ __forceinline__ bool next_tile(int L, int nM, int nN, int& pm, int& pn) {
    const int nwg = nM * nN; if (L >= nwg) return false;
    int wgid = L; { const int q = nwg / 8, r = nwg % 8, xcd = wgid % 8, off = wgid / 8; wgid = (xcd < r ? xcd * (q + 1) : r * (q + 1) + (xcd - r) * q) + off; }
    const int WGM = 8, nig = WGM * nN, gid = wgid / nig, fm = gid * WGM, gsz = (nM - fm) < WGM ? (nM - fm) : WGM;
    pm = fm + ((wgid % nig) % gsz); pn = (wgid % nig) / gsz; return true;
}
struct EpiBf16 { bf16_t* O; int ldc;
    __device__ __forceinline__ void operator()(const f32x4 (&acc)[2][2][4][2], int row0, int col0) const {
#pragma unroll
        for (int ai = 0; ai < 2; ++ai)
#pragma unroll
            for (int m = 0; m < 4; ++m) { bf16_t* rp = O + (size_t)(row0 + ai * 128 + m * 16) * ldc + col0;
#pragma unroll
                for (int bj = 0; bj < 2; ++bj)
#pragma unroll
                    for (int n = 0; n < 2; ++n) { const f32x4 v = acc[ai][bj][m][n]; uint2 w; w.x = pack2(v[0], v[1]); w.y = pack2(v[2], v[3]); *(uint2*)(rp + bj * 128 + n * 16) = w; } }
    }
};
struct EpiResid { const float* X; bf16_t* O; float* PART; unsigned char* lds;
    __device__ __forceinline__ void operator()(const f32x4 (&acc)[2][2][4][2], int row0, int col0) const {
        float* red = (float*)lds;
        const int wc = (col0 & 255) >> 5, fq = (col0 & 31) >> 2, rl0 = row0 & 255;
        __syncthreads();
#pragma unroll
        for (int ai = 0; ai < 2; ++ai)
#pragma unroll
            for (int m = 0; m < 4; ++m) { const size_t ro = (size_t)(row0 + ai * 128 + m * 16) * DM + col0; float ss = 0.f;
#pragma unroll
                for (int bj = 0; bj < 2; ++bj)
#pragma unroll
                    for (int n = 0; n < 2; ++n) { const size_t off = ro + bj * 128 + n * 16; const f32x4 v = *(const f32x4*)(X + off) + acc[ai][bj][m][n];
                        ss += v[0] * v[0] + v[1] * v[1] + v[2] * v[2] + v[3] * v[3];
                        uint2 w; w.x = pack2(v[0], v[1]); w.y = pack2(v[2], v[3]); *(uint2*)(O + off) = w; }
                ss += __shfl_xor(ss, 16, 64); ss += __shfl_xor(ss, 32, 64);
                if (fq == 0) red[wc * 256 + rl0 + ai * 128 + m * 16] = ss; }
        __syncthreads();
        if (threadIdx.x < 256) { const int r = threadIdx.x; PART[(size_t)(col0 >> 8) * T + (row0 & ~255) + r] = (red[r] + red[256 + r]) + (red[512 + r] + red[768 + r]); }
    }
};
struct EpiBf16Silu { bf16_t* O; int ldc; int nsilu;
    __device__ __forceinline__ void operator()(const f32x4 (&acc)[2][2][4][2], int row0, int col0) const {
        const bool sl = col0 < nsilu;
#pragma unroll
        for (int ai = 0; ai < 2; ++ai)
#pragma unroll
            for (int m = 0; m < 4; ++m) { bf16_t* rp = O + (size_t)(row0 + ai * 128 + m * 16) * ldc + col0;
#pragma unroll
                for (int bj = 0; bj < 2; ++bj)
#pragma unroll
                    for (int n = 0; n < 2; ++n) { f32x4 v = acc[ai][bj][m][n];
                        if (sl) {
#pragma unroll
                            for (int r = 0; r < 4; ++r) v[r] = v[r] * frcp(1.f + __expf(-v[r])); }
                        uint2 w; w.x = pack2(v[0], v[1]); w.y = pack2(v[2], v[3]); *(uint2*)(rp + bj * 128 + n * 16) = w; } }
    }
};
}

template <int WM_, int WN_> struct EpiBf16 {
    bf16_t* O; int ldc; int ncols;
    __device__ __forceinline__ void operator()(const f32x4 (&acc)[WM_][WN_], int mb, int nb, int lane) const {
        const int r16 = lane & 15, g = lane >> 4;
#pragma unroll
        for (int i = 0; i < WM_; ++i)
#pragma unroll
            for (int j = 0; j < WN_; ++j) {
                const int row = mb + i * 16 + r16, col = nb + j * 16 + 4 * g;
                if (col < ncols) { uint2 w; w.x = pack2(acc[i][j][0], acc[i][j][1]); w.y = pack2(acc[i][j][2], acc[i][j][3]); *(uint2*)(O + (size_t)row * ldc + col) = w; }
            }
    }
};
struct EpiQ {
    bf16_t* Q; const float* q_norm; const float* ropecs;
    __device__ __forceinline__ void operator()(const f32x4 (&accs)[2][12], int mb, int nb, int lane) const {
      const int r16 = lane & 15, g = lane >> 4;
#pragma unroll
      for (int mi = 0; mi < 2; ++mi) {
        const f32x4 (&accm)[12] = accs[mi];
        const int row = mb + mi * 16 + r16, h = nb / 192;
        float ssn = 0.f, ssr = 0.f;
#pragma unroll
        for (int j = 0; j < 8; ++j)
#pragma unroll
            for (int r = 0; r < 4; ++r) ssn += accm[j][r] * accm[j][r];
#pragma unroll
        for (int j = 8; j < 12; ++j)
#pragma unroll
            for (int r = 0; r < 4; ++r) ssr += accm[j][r] * accm[j][r];
        ssn += __shfl_xor(ssn, 16, 64); ssn += __shfl_xor(ssn, 32, 64);
        ssr += __shfl_xor(ssr, 16, 64); ssr += __shfl_xor(ssr, 32, 64);
        const float SC = 0.07216878364870322f * 1.4426950408889634f;
        const float rn = rsqrtf(ssn * (1.f / 128.f) + EPS) * SC, rr = rsqrtf(ssr * (1.f / 64.f) + EPS) * SC;
        bf16_t* qrow = Q + ((size_t)row * 4 + h) * 192;
#pragma unroll
        for (int j = 0; j < 8; ++j) {
            const int c = j * 16 + 4 * g;
            const f32x4 gn = *(const f32x4*)(q_norm + c);
            uint2 w; w.x = pack2(accm[j][0] * rn * gn[0], accm[j][1] * rn * gn[1]); w.y = pack2(accm[j][2] * rn * gn[2], accm[j][3] * rn * gn[3]);
            *(uint2*)(qrow + c) = w;
        }
#pragma unroll
        for (int j = 0; j < 2; ++j) {
            const int jj = j * 16 + 4 * g;
            const f32x4 g1 = *(const f32x4*)(q_norm + 128 + jj), g2 = *(const f32x4*)(q_norm + 160 + jj);
            float o1[4], o2[4];
#pragma unroll
            for (int r = 0; r < 4; ++r) {
                const float2 cs = *(const float2*)(ropecs + ((size_t)row * 32 + jj + r) * 2);
                const float a1 = accm[8 + j][r] * rr * g1[r], a2 = accm[10 + j][r] * rr * g2[r];
                o1[r] = a1 * cs.x - a2 * cs.y; o2[r] = a2 * cs.x + a1 * cs.y;
            }
            uint2 w; w.x = pack2(o1[0], o1[1]); w.y = pack2(o1[2], o1[3]); *(uint2*)(qrow + 128 + jj) = w;
            w.x = pack2(o2[0], o2[1]); w.y = pack2(o2[2], o2[3]); *(uint2*)(qrow + 160 + jj) = w;
        }
      }
    }
};
template <int WMK> struct EpiKV {
    bf16_t* KN; bf16_t* VT; const float* k_norm;
    __device__ __forceinline__ void operator()(const f32x4 (&accs)[WMK][16], int mb, int nb, int lane) const {
      const int r16 = lane & 15, g = lane >> 4;
#pragma unroll
      for (int mi = 0; mi < WMK; ++mi) {
        const f32x4 (&accm)[16] = accs[mi];
        const int row = mb + mi * 16 + r16, h = nb / 256;
        float ssn = 0.f;
#pragma unroll
        for (int j = 0; j < 8; ++j)
#pragma unroll
            for (int r = 0; r < 4; ++r) ssn += accm[j][r] * accm[j][r];
        ssn += __shfl_xor(ssn, 16, 64); ssn += __shfl_xor(ssn, 32, 64);
        const float rn = rsqrtf(ssn * (1.f / 128.f) + EPS);
        bf16_t* krow = KN + ((size_t)row * 4 + h) * 128;
#pragma unroll
        for (int j = 0; j < 8; ++j) {
            const int c = j * 16 + 4 * g;
            const f32x4 gn = *(const f32x4*)(k_norm + c);
            uint2 w; w.x = pack2(accm[j][0] * rn * gn[0], accm[j][1] * rn * gn[1]); w.y = pack2(accm[j][2] * rn * gn[2], accm[j][3] * rn * gn[3]);
            *(uint2*)(krow + c) = w;
        }
        const int b = row >> 11, s = row & 2047;
        bf16_t* vp = VT + ((size_t)(b * 4 + h) * 128 + 4 * g) * SEQ + s;
#pragma unroll
        for (int j = 0; j < 8; ++j) {
            asm volatile("" : "+v"(vp));
            vp[0] = f2bf(accm[8 + j][0]); vp[SEQ] = f2bf(accm[8 + j][1]); vp[2 * SEQ] = f2bf(accm[8 + j][2]); vp[3 * SEQ] = f2bf(accm[8 + j][3]);
            vp += 16 * SEQ;
        }
      }
    }
};

__device__ void transpose_convert(const float* __restrict__ W, bf16_t* __restrict__ Wt, int K, int N, unsigned char* lds, int bid, int nblk, const float* __restrict__ kscale = nullptr) {
    bf16_t* tile = (bf16_t*)lds;
    const int tid = threadIdx.x;
    const int tk = K / 64, tn = N / 64;
    for (int t = bid; t < tk * tn; t += nblk) {
        const int k0 = (t / tn) * 64, n0 = (t % tn) * 64;
        __syncthreads();
#pragma unroll
        for (int p = 0; p < 2; ++p) {
            const int kk = (tid >> 4) + p * 32, n4 = (tid & 15) * 4;
            f32x4 v = *(const f32x4*)(W + (size_t)(k0 + kk) * N + n0 + n4);
            if (kscale) v *= kscale[k0 + kk];
#pragma unroll
            for (int r = 0; r < 4; ++r) tile[(n4 + r) * 66 + kk] = f2bf(v[r]);
        }
        __syncthreads();
        {
            const int nn = tid >> 3, k8 = (tid & 7) * 8;
            unsigned w[4];
#pragma unroll
            for (int r = 0; r < 4; ++r) w[r] = (unsigned)tile[nn * 66 + k8 + 2 * r] | ((unsigned)tile[nn * 66 + k8 + 2 * r + 1] << 16);
            *(uint4*)(Wt + (size_t)(n0 + nn) * K + k0 + k8) = make_uint4(w[0], w[1], w[2], w[3]);
        }
    }
    __syncthreads();
}

__device__ void rmsnorm_rows(const float* __restrict__ X, const float* __restrict__ gain, bf16_t* __restrict__ O, int gw, int nw) {
    const int lane = threadIdx.x & 63;
    for (int row = gw; row < T; row += nw) {
        const float* xr = X + (size_t)row * DM;
        f32x4 v[4]; float ss = 0.f;
#pragma unroll
        for (int i = 0; i < 4; ++i) { v[i] = *(const f32x4*)(xr + i * 256 + lane * 4); ss += v[i][0] * v[i][0] + v[i][1] * v[i][1] + v[i][2] * v[i][2] + v[i][3] * v[i][3]; }
        ss = wave_sum(ss);
        const float rs = rsqrtf(ss * (1.f / 1024.f) + EPS);
#pragma unroll
        for (int i = 0; i < 4; ++i) {
            const f32x4 gn = *(const f32x4*)(gain + i * 256 + lane * 4);
            uint2 w; w.x = pack2(v[i][0] * rs * gn[0], v[i][1] * rs * gn[1]); w.y = pack2(v[i][2] * rs * gn[2], v[i][3] * rs * gn[3]);
            *(uint2*)(O + (size_t)row * DM + i * 256 + lane * 4) = w;
        }
    }
}

__device__ void phase0(const Args& a, unsigned char* lds) {
    unsigned char* ws = a.ws;
    const int bid = blockIdx.x, nblk = gridDim.x, tid = threadIdx.x;
    transpose_convert(a.w_in, (bf16_t*)(ws + WS_WIN_T), 1024, 3264, lds, bid, nblk);
    transpose_convert(a.w_q_up, (bf16_t*)(ws + WS_WQUP_T), 384, 768, lds, bid, nblk);
    transpose_convert(a.w_kv_up, (bf16_t*)(ws + WS_WKVUP_T), 256, 1024, lds, bid, nblk);
    transpose_convert(a.w_out, (bf16_t*)(ws + WS_WOUT_T), 1024, 1024, lds, bid, nblk);
    transpose_convert(a.peer_wq, (bf16_t*)(ws + WS_WPQ_T), 1024, 2048, lds, bid, nblk, a.ffn_norm);
    const int gt = bid * NT + tid, ngt = nblk * NT;
    bf16_t* sk = (bf16_t*)(ws + WS_SUBK);
    for (int i = gt; i < 16 * 128 * 128; i += ngt) sk[i] = f2bf(a.subk[i]);
    float* lb = (float*)(ws + WS_LB);
    for (int i = gt; i < 1024; i += ngt) { const float l0 = a.lb_logits[i], l1 = a.lb_logits[1024 + i]; lb[i] = 1.f / (1.f + expf(l1 - l0)); }
    rmsnorm_rows(a.x, a.attn_norm, (bf16_t*)(ws + WS_B), bid * 8 + (tid >> 6), nblk * 8);
}

__device__ void phase1(const Args& a, unsigned char* lds) {
    unsigned char* ws = a.ws;
    const bf16_t* H = (const bf16_t*)(ws + WS_B); const bf16_t* W = (const bf16_t*)(ws + WS_WIN_T);
    g256::EpiBf16Silu e{(bf16_t*)(ws + WS_C), INW, 512};
    for (int i = 0;; ++i) { int pm, pn; if (!g256::next_tile(i * gridDim.x + blockIdx.x, 64, 12, pm, pn)) break;
        __syncthreads();
        g256::tile(H, W, DM, pm * 256, pn * 256, lds, e); }
    __syncthreads();
    EpiBf16<1, 6> e2{(bf16_t*)(ws + WS_C), INW, INW};
    for (int t = blockIdx.x; t < 256; t += gridDim.x)
        gemm_block<4, 2, 1, 6>(H, DM, W, DM, DM, t * 64, 3072, INW, lds, e2);
}

__device__ void phase2(const Args& a) {
    unsigned char* ws = a.ws;
    const bf16_t* PROJ = (const bf16_t*)(ws + WS_C);
    bf16_t* CQN = (bf16_t*)(ws + WS_CQN); bf16_t* CKVN = (bf16_t*)(ws + WS_CKVN); bf16_t* KROPE = (bf16_t*)(ws + WS_KROPE);
    float* ROPECS = (float*)(ws + WS_ROPECS);
    const int lane = threadIdx.x & 63;
    const float2 gq0 = *(const float2*)(a.q_a_norm + lane * 2), gq1 = *(const float2*)(a.q_a_norm + 128 + lane * 2), gq2 = *(const float2*)(a.q_a_norm + 256 + lane * 2);
    const float2 gk0 = *(const float2*)(a.kv_a_norm + lane * 2), gk1 = *(const float2*)(a.kv_a_norm + 128 + lane * 2);
    const float gr = a.k_norm[128 + lane];
    const float invf = ROPE_INV_FREQ[lane & 31];
    const int nw = gridDim.x * 8;
    for (int t0 = blockIdx.x * 8 + (threadIdx.x >> 6); t0 < T; t0 += nw * 4) {
        unsigned wq[4][3], wk[4][2]; float vr[4], ps[4];
#pragma unroll
        for (int u = 0; u < 4; ++u) {
            const int t = min(t0 + u * nw, T - 1);
            const bf16_t* pr = PROJ + (size_t)t * INW;
#pragma unroll
            for (int i = 0; i < 3; ++i) wq[u][i] = *(const unsigned*)(pr + OFF_CQ + i * 128 + lane * 2);
#pragma unroll
            for (int i = 0; i < 2; ++i) wk[u][i] = *(const unsigned*)(pr + OFF_CKV + i * 128 + lane * 2);
            vr[u] = bf2f(pr[OFF_KR + lane]);
            ps[u] = (float)a.pos[t];
        }
        float sq[4], sk[4], sr[4];
#pragma unroll
        for (int u = 0; u < 4; ++u) {
            sq[u] = 0.f; sk[u] = 0.f;
#pragma unroll
            for (int i = 0; i < 3; ++i) { const float x0 = bflo(wq[u][i]), x1 = bfhi(wq[u][i]); sq[u] += x0 * x0 + x1 * x1; }
#pragma unroll
            for (int i = 0; i < 2; ++i) { const float x0 = bflo(wk[u][i]), x1 = bfhi(wk[u][i]); sk[u] += x0 * x0 + x1 * x1; }
            sr[u] = vr[u] * vr[u];
        }
#pragma unroll
        for (int d = 32; d > 0; d >>= 1)
#pragma unroll
            for (int u = 0; u < 4; ++u) { sq[u] += __shfl_xor(sq[u], d, 64); sk[u] += __shfl_xor(sk[u], d, 64); sr[u] += __shfl_xor(sr[u], d, 64); }
#pragma unroll
        for (int u = 0; u < 4; ++u) {
            const int t = t0 + u * nw;
            if (t < T) {
                const float rq = rsqrtf(sq[u] * (1.f / 384.f) + EPS), rk = rsqrtf(sk[u] * (1.f / 256.f) + EPS), rr = rsqrtf(sr[u] * (1.f / 64.f) + EPS);
                bf16_t* cq = CQN + (size_t)t * 384 + lane * 2; bf16_t* ck = CKVN + (size_t)t * 256 + lane * 2;
                *(unsigned*)(cq) = pack2(bflo(wq[u][0]) * rq * gq0.x, bfhi(wq[u][0]) * rq * gq0.y);
                *(unsigned*)(cq + 128) = pack2(bflo(wq[u][1]) * rq * gq1.x, bfhi(wq[u][1]) * rq * gq1.y);
                *(unsigned*)(cq + 256) = pack2(bflo(wq[u][2]) * rq * gq2.x, bfhi(wq[u][2]) * rq * gq2.y);
                *(unsigned*)(ck) = pack2(bflo(wk[u][0]) * rk * gk0.x, bfhi(wk[u][0]) * rk * gk0.y);
                *(unsigned*)(ck + 128) = pack2(bflo(wk[u][1]) * rk * gk1.x, bfhi(wk[u][1]) * rk * gk1.y);
                const float xn = vr[u] * rr * gr;
                const float other = __shfl_xor(xn, 32, 64);
                float sn, cs; sincosf(ps[u] * invf, &sn, &cs);
                const float o = (lane < 32) ? (xn * cs - other * sn) : (xn * cs + other * sn);
                KROPE[(size_t)t * 64 + lane] = f2bf(o);
                if (lane < 32) { *(float2*)(ROPECS + ((size_t)t * 32 + lane) * 2) = make_float2(cs, sn); }
            }
        }
    }
}

__device__ void phase3(const Args& a, unsigned char* lds) {
    unsigned char* ws = a.ws;
    EpiQ eq{(bf16_t*)(ws + WS_Q), a.q_norm, (const float*)(ws + WS_ROPECS)};
    EpiKV<1> ekv{(bf16_t*)(ws + WS_KN), (bf16_t*)(ws + WS_VT), a.k_norm};
    for (int t = blockIdx.x; t < 768; t += gridDim.x) {
        if (t < 256) { const int mt = t >> 2, h = t & 3;
            gemm_block<8, 1, 2, 12>((const bf16_t*)(ws + WS_CQN), 384, (const bf16_t*)(ws + WS_WQUP_T), 384, 384, mt * 256, h * 192, 768, lds, eq);
        } else { const int u = t - 256, mt = u >> 2, h = u & 3;
            gemm_block<8, 1, 1, 16>((const bf16_t*)(ws + WS_CKVN), 256, (const bf16_t*)(ws + WS_WKVUP_T), 256, 256, mt * 128, h * 256, 1024, lds, ekv);
        }
    }
}

constexpr int AT_KROW = 400, AT_VROW = 144, AT_KBYTES = 64 * AT_KROW, AT_VBYTES = 128 * AT_VROW, AT_BUF = AT_KBYTES + AT_VBYTES;
__device__ void attn_item(const Args& a, int item, unsigned char* lds) {
    unsigned char* ws = a.ws;
    const bf16_t* Q = (const bf16_t*)(ws + WS_Q); const bf16_t* KN = (const bf16_t*)(ws + WS_KN);
    const bf16_t* KR = (const bf16_t*)(ws + WS_KROPE); const bf16_t* VT = (const bf16_t*)(ws + WS_VT);
    bf16_t* YCAT = (bf16_t*)(ws + WS_B);
    const int qb = item & 7, h = (item >> 3) & 3, b = item >> 5;
    const int tid = threadIdx.x, lane = tid & 63, wave = tid >> 6, r16 = lane & 15, g = lane >> 4;
    const unsigned kn_off = (unsigned)((((size_t)b * SEQ + (tid >> 4)) * 4 + h) * 128 + (tid & 15) * 8);
    const unsigned kr_off = (unsigned)(((size_t)b * SEQ + (tid >> 3)) * 64 + (tid & 7) * 8);
    const unsigned vt_off = (unsigned)(((size_t)(b * 4 + h) * 128 + (tid >> 3)) * SEQ + (tid & 7) * 8);
    const int kn_dst = (tid >> 4) * AT_KROW + (tid & 15) * 16, kr_dst = (tid >> 3) * AT_KROW + 256 + (tid & 7) * 16;
    const int v_dst = AT_KBYTES + (tid >> 3) * AT_VROW + (tid & 7) * 16;
    bf16x8 qf[2][6];
#pragma unroll
    for (int qs = 0; qs < 2; ++qs) {
        const size_t tq = (size_t)b * SEQ + qb * 256 + wave * 32 + qs * 16 + r16;
#pragma unroll
        for (int kk = 0; kk < 6; ++kk) qf[qs][kk] = *(const bf16x8*)(Q + (tq * 4 + h) * 192 + kk * 32 + 8 * g);
    }
    f32x4 O[2][8];
#pragma unroll
    for (int qs = 0; qs < 2; ++qs)
#pragma unroll
        for (int d = 0; d < 8; ++d) O[qs][d] = (f32x4){0.f, 0.f, 0.f, 0.f};
    float m_run[2] = {0.f, 0.f}, l_part[2] = {0.f, 0.f};
    uint4 sk0, sk1, sk2, sv0, sv1;
#define AT_GLOADK(tile) do { \
        sk0 = *(const uint4*)(KN + kn_off + (size_t)(tile) * (64 * 512)); sk1 = *(const uint4*)(KN + kn_off + 32 * 512 + (size_t)(tile) * (64 * 512)); \
        sk2 = *(const uint4*)(KR + kr_off + (size_t)(tile) * (64 * 64)); } while (0)
#define AT_GLOADV(tile) do { \
        sv0 = *(const uint4*)(VT + vt_off + (size_t)(tile) * 64); sv1 = *(const uint4*)(VT + vt_off + (size_t)64 * SEQ + (size_t)(tile) * 64); } while (0)
#define AT_LSTOREK(buf) do { unsigned char* bb = lds + (buf) * AT_BUF; \
        *(uint4*)(bb + kn_dst) = sk0; *(uint4*)(bb + kn_dst + 32 * AT_KROW) = sk1; *(uint4*)(bb + kr_dst) = sk2; } while (0)
#define AT_LSTOREV(buf) do { unsigned char* bb = lds + (buf) * AT_BUF; \
        *(uint4*)(bb + v_dst) = sv0; *(uint4*)(bb + v_dst + 64 * AT_VROW) = sv1; } while (0)
    __syncthreads();
    AT_GLOADK(0); AT_GLOADV(0);
    AT_LSTOREK(0); AT_LSTOREV(0);
    __syncthreads();
    constexpr int NTILE = SEQ / 64;
    for (int t = 0; t < NTILE; ++t) {
        if (t + 1 < NTILE) AT_GLOADK(t + 1);
        const unsigned char* kb = lds + (t & 1) * AT_BUF;
        const unsigned char* vb = kb + AT_KBYTES;
        f32x4 S[2][4];
#pragma unroll
        for (int qs = 0; qs < 2; ++qs)
#pragma unroll
            for (int j = 0; j < 4; ++j) { const float nm = -m_run[qs]; S[qs][j] = (f32x4){nm, nm, nm, nm}; }
#pragma unroll
        for (int j = 0; j < 4; ++j) {
            const int krow = (j >> 1) * 32 + 8 * (r16 >> 2) + 4 * (j & 1) + (r16 & 3);
#pragma unroll
            for (int kk = 0; kk < 6; ++kk) {
                const bf16x8 kf = *(const bf16x8*)(kb + krow * AT_KROW + kk * 64 + g * 16);
                S[0][j] = mfma16(kf, qf[0][kk], S[0][j]);
                S[1][j] = mfma16(kf, qf[1][kk], S[1][j]);
            }
        }
        if (t + 1 < NTILE) { AT_LSTOREK((t + 1) & 1); AT_GLOADV(t + 1); }
        bf16x8 pf[2][2];
#pragma unroll
        for (int qs = 0; qs < 2; ++qs) {
            float mx = -1e30f;
#pragma unroll
            for (int j = 0; j < 4; ++j) mx = fmaxf(mx, fmaxf(fmaxf(S[qs][j][0], S[qs][j][1]), fmaxf(S[qs][j][2], S[qs][j][3])));
            mx = fmaxf(mx, __shfl_xor(mx, 16, 64)); mx = fmaxf(mx, __shfl_xor(mx, 32, 64));
            if (t == 0 || !__all(mx <= 8.f)) {
                const float delta = (t == 0) ? mx : fmaxf(mx, 0.f);
                m_run[qs] += delta;
#pragma unroll
                for (int j = 0; j < 4; ++j) { S[qs][j][0] -= delta; S[qs][j][1] -= delta; S[qs][j][2] -= delta; S[qs][j][3] -= delta; }
                if (t != 0) {
                    const float alpha = fexp2(-delta);
                    l_part[qs] *= alpha;
#pragma unroll
                    for (int d = 0; d < 8; ++d) O[qs][d] *= alpha;
                }
            }
            float ps = 0.f;
#pragma unroll
            for (int grp = 0; grp < 2; ++grp) {
                float pv[8];
#pragma unroll
                for (int jj = 0; jj < 8; ++jj) { pv[jj] = fexp2(S[qs][grp * 2 + (jj >> 2)][jj & 3]); ps += pv[jj]; }
                union { uint4 u; bf16x8 v; } cv; cv.u = make_uint4(pack2(pv[0], pv[1]), pack2(pv[2], pv[3]), pack2(pv[4], pv[5]), pack2(pv[6], pv[7]));
                pf[qs][grp] = cv.v;
            }
            l_part[qs] += ps;
        }
        __builtin_amdgcn_s_setprio(1);
#pragma unroll
        for (int grp = 0; grp < 2; ++grp)
#pragma unroll
            for (int d = 0; d < 8; ++d) {
                const bf16x8 vf = *(const bf16x8*)(vb + (d * 16 + r16) * AT_VROW + grp * 64 + g * 16);
                O[0][d] = mfma16(vf, pf[0][grp], O[0][d]);
                O[1][d] = mfma16(vf, pf[1][grp], O[1][d]);
            }
        __builtin_amdgcn_s_setprio(0);
        if (t + 1 < NTILE) AT_LSTOREV((t + 1) & 1);
        __syncthreads();
    }
#undef AT_GLOADK
#undef AT_GLOADV
#undef AT_LSTOREK
#undef AT_LSTOREV
#pragma unroll
    for (int qs = 0; qs < 2; ++qs) {
        float l = l_part[qs]; l += __shfl_xor(l, 16, 64); l += __shfl_xor(l, 32, 64);
        const float inv = frcp(l);
        float ss = 0.f;
#pragma unroll
        for (int d = 0; d < 8; ++d) { O[qs][d] *= inv; ss += O[qs][d][0] * O[qs][d][0] + O[qs][d][1] * O[qs][d][1] + O[qs][d][2] * O[qs][d][2] + O[qs][d][3] * O[qs][d][3]; }
        ss += __shfl_xor(ss, 16, 64); ss += __shfl_xor(ss, 32, 64);
        const float rs = rsqrtf(ss * (1.f / 128.f) + EPS);
        const size_t tq = (size_t)b * SEQ + qb * 256 + wave * 32 + qs * 16 + r16;
#pragma unroll
        for (int d = 0; d < 8; ++d) {
            const int dv = d * 16 + 4 * g;
            const f32x4 gn = *(const f32x4*)(a.mla_o_norm + h * 128 + dv);
            uint2 w; w.x = pack2(O[qs][d][0] * rs * gn[0], O[qs][d][1] * rs * gn[1]); w.y = pack2(O[qs][d][2] * rs * gn[2], O[qs][d][3] * rs * gn[3]);
            *(uint2*)(YCAT + tq * DM + 512 + h * 128 + dv) = w;
        }
    }
}

constexpr int HG_E = 0;
constexpr int HG_EL = HG_E + 64 * 132 * 4;
constexpr int HG_QT = HG_EL + 1024;
constexpr int HG_QH = HG_QT + 17408;
constexpr int HG_KD = HG_QH + 17408;
constexpr int HG_K10 = HG_KD + 17408;
constexpr int HG_VT = HG_K10 + 8704;
constexpr int HG_SM = HG_VT + 2 * 9216;
constexpr int HG_STB = HG_SM + 9216;
constexpr int HG_LDS = HG_STB + 2 * 17408;
__device__ void hgrn_item(const Args& a, int item, unsigned char* lds) {
    unsigned char* ws = a.ws;
    const bf16_t* PROJ = (const bf16_t*)(ws + WS_C);
    const float* LB = (const float*)(ws + WS_LB);
    bf16_t* OHG = (bf16_t*)(ws + WS_D);
    const int vs = item & 1, dir = (item >> 1) & 1, h = (item >> 2) & 3, b = item >> 4;
    const int tid = threadIdx.x, lane = tid & 63, wave = tid >> 6, r16 = lane & 15, g = lane >> 4;
    float* E = (float*)(lds + HG_E); float* EL = (float*)(lds + HG_EL);
    bf16_t* Qt = (bf16_t*)(lds + HG_QT); bf16_t* Qh = (bf16_t*)(lds + HG_QH); bf16_t* Kd = (bf16_t*)(lds + HG_KD); bf16_t* K10 = (bf16_t*)(lds + HG_K10);
    bf16_t* vT = (bf16_t*)(lds + HG_VT); bf16_t* Sm = (bf16_t*)(lds + HG_SM); bf16_t* STb = (bf16_t*)(lds + HG_STB);
    const int kB = wave * 16 + r16;
    const float lbk = LB[dir * 512 + h * 128 + kB];
    const int offf = dir ? OFF_FB : OFF_FF;
    const int rowA = tid >> 4, k8A = (tid & 15) * 8;
    const int vrow = tid >> 3, vc8 = (tid & 7) * 8;
    const size_t tokbase = (size_t)b * SEQ;
    __syncthreads();
    for (int i = tid; i < 2 * 64 * 136; i += NT) STb[i] = 0;
    f32x4 accS[4]; accS[0] = (f32x4){0.f, 0.f, 0.f, 0.f}; accS[1] = accS[0]; accS[2] = accS[0]; accS[3] = accS[0];
    unsigned short fB[16]; uint4 qA0, qA1, vA;
#define HG_PREFETCH(n) do { \
        _Pragma("unroll") for (int sc = 0; sc < 2; ++sc) _Pragma("unroll") for (int jj = 0; jj < 8; ++jj) { \
            const int tau = (n) * 64 + sc * 32 + g * 8 + jj, tt = dir ? (SEQ - 1 - tau) : tau; \
            fB[sc * 8 + jj] = PROJ[(tokbase + tt) * INW + offf + h * 128 + kB]; } \
        { const int tau = (n) * 64 + rowA, tt = dir ? (SEQ - 1 - tau) : tau; qA0 = *(const uint4*)(PROJ + (tokbase + tt) * INW + OFF_Q + h * 128 + k8A); } \
        { const int tau = (n) * 64 + rowA + 32, tt = dir ? (SEQ - 1 - tau) : tau; qA1 = *(const uint4*)(PROJ + (tokbase + tt) * INW + OFF_Q + h * 128 + k8A); } \
        { const int tau = (n) * 64 + vrow, tt = dir ? (SEQ - 1 - tau) : tau; vA = *(const uint4*)(PROJ + (tokbase + tt) * INW + OFF_I + h * 128 + vs * 64 + vc8); } \
    } while (0)
    HG_PREFETCH(0);
    for (int n = 0; n < 32; ++n) {
        bf16_t* vTn = vT + (n & 1) * (64 * 72);
        bf16x8 kbf[2];
        {
            float kd[16], ev[16], elast[2];
#pragma unroll
            for (int sc = 0; sc < 2; ++sc) {
                float run = 1.f, runi = 1.f, bb[8], bi[8];
#pragma unroll
                for (int jj = 0; jj < 8; ++jj) {
                    const float u = __expf(-bf2f(fB[sc * 8 + jj]));
                    const float a1 = 1.f + u, a2 = 1.f + lbk * u, r = frcp(a1 * a2);
                    const float f = a2 * a2 * r, fi = a1 * a1 * r;
                    kd[sc * 8 + jj] = 1.f - f;
                    run *= f; bb[jj] = run; runi *= fi; bi[jj] = runi;
                }
                float incl = run, inci = runi;
                { const float t1 = __shfl_up(incl, 16, 64), s1 = __shfl_up(inci, 16, 64); if (g >= 1) { incl *= t1; inci *= s1; } }
                { const float t2 = __shfl_up(incl, 32, 64), s2 = __shfl_up(inci, 32, 64); if (g >= 2) { incl *= t2; inci *= s2; } }
                float excl = __shfl_up(incl, 16, 64), exci = __shfl_up(inci, 16, 64); if (g == 0) { excl = 1.f; exci = 1.f; }
                elast[sc] = __shfl(incl, 48 + r16, 64);
#pragma unroll
                for (int jj = 0; jj < 8; ++jj) {
                    ev[sc * 8 + jj] = bb[jj] * excl;
                    kd[sc * 8 + jj] = kd[sc * 8 + jj] * (bi[jj] * exci);
                }
            }
#pragma unroll
            for (int sc = 0; sc < 2; ++sc)
#pragma unroll
                for (int jj = 0; jj < 8; ++jj) {
                    const int row = sc * 32 + g * 8 + jj;
                    E[row * 132 + kB] = ev[sc * 8 + jj];
                    Kd[row * 136 + kB] = f2bf(kd[sc * 8 + jj]);
                    if (sc == 0) K10[row * 136 + kB] = f2bf(kd[jj] * elast[0]);
                }
            if (g == 3) { EL[kB] = elast[0]; EL[128 + kB] = elast[1]; }
#pragma unroll
            for (int jj = 0; jj < 8; ++jj) { kbf[0][jj] = (short)f2bf(kd[jj] * elast[0] * elast[1]); kbf[1][jj] = (short)f2bf(kd[8 + jj] * elast[1]); }
        }
        {
            const unsigned w4[4] = {vA.x, vA.y, vA.z, vA.w};
#pragma unroll
            for (int q = 0; q < 4; ++q) { vTn[(vc8 + 2 * q) * 72 + vrow] = (bf16_t)(w4[q] & 0xffffu); vTn[(vc8 + 2 * q + 1) * 72 + vrow] = (bf16_t)(w4[q] >> 16); }
        }
        const uint4 qc0 = qA0, qc1 = qA1;
        if (n + 1 < 32) HG_PREFETCH(n + 1);
        __syncthreads();
        {
            const f32x4 d31 = *(const f32x4*)(EL + wave * 16 + 4 * g), d63 = *(const f32x4*)(EL + 128 + wave * 16 + 4 * g);
            const f32x4 dk = d31 * d63;
            bf16_t* stw = STb + (n & 1) * (64 * 136);
#pragma unroll
            for (int vt = 0; vt < 4; ++vt) {
                f32x4 c = accS[vt] * dk;
#pragma unroll
                for (int sc = 0; sc < 2; ++sc) {
                    const bf16x8 vf = *(const bf16x8*)(vTn + (vt * 16 + r16) * 72 + sc * 32 + 8 * g);
                    c = mfma16(kbf[sc], vf, c);
                }
                accS[vt] = c;
                uint2 w; w.x = pack2(c[0], c[1]); w.y = pack2(c[2], c[3]);
                *(uint2*)(stw + (vt * 16 + r16) * 136 + wave * 16 + 4 * g) = w;
            }
        }
        {
            const f32x4 e31a = *(const f32x4*)(EL + k8A), e31b = *(const f32x4*)(EL + k8A + 4);
#pragma unroll
            for (int u = 0; u < 2; ++u) {
                const int row = rowA + u * 32;
                const uint4 qq = u ? qc1 : qc0;
                const f32x4 ea = *(const f32x4*)(E + row * 132 + k8A), eb = *(const f32x4*)(E + row * 132 + k8A + 4);
                const float qr[8] = {bflo(qq.x), bfhi(qq.x), bflo(qq.y), bfhi(qq.y), bflo(qq.z), bfhi(qq.z), bflo(qq.w), bfhi(qq.w)};
                float qt[8], qh[8];
#pragma unroll
                for (int i = 0; i < 8; ++i) {
                    const float qs = qr[i];
                    qt[i] = qs * (i < 4 ? ea[i] : eb[i - 4]);
                    qh[i] = u ? qt[i] * (i < 4 ? e31a[i] : e31b[i - 4]) : qt[i];
                }
                *(uint4*)(Qt + row * 136 + k8A) = make_uint4(pack2(qt[0], qt[1]), pack2(qt[2], qt[3]), pack2(qt[4], qt[5]), pack2(qt[6], qt[7]));
                *(uint4*)(Qh + row * 136 + k8A) = make_uint4(pack2(qh[0], qh[1]), pack2(qh[2], qh[3]), pack2(qh[4], qh[5]), pack2(qh[6], qh[7]));
            }
        }
        __syncthreads();
#pragma unroll
        for (int q2 = 0; q2 < 2; ++q2) {
            const int tix = wave * 2 + q2, ti = tix >> 2, si = tix & 3;
            f32x4 sc = (f32x4){0.f, 0.f, 0.f, 0.f};
            if (si <= ti) {
                const bf16_t* kb = (ti >= 2 && si < 2) ? K10 : Kd;
#pragma unroll
                for (int kk = 0; kk < 4; ++kk) {
                    const bf16x8 af = *(const bf16x8*)(Qt + (ti * 16 + r16) * 136 + kk * 32 + 8 * g);
                    const bf16x8 bfr = *(const bf16x8*)(kb + (si * 16 + r16) * 136 + kk * 32 + 8 * g);
                    sc = mfma16(bfr, af, sc);
                }
                if (si == ti) {
#pragma unroll
                    for (int r = 0; r < 4; ++r) if (4 * g + r > r16) sc[r] = 0.f;
                }
            }
            uint2 w; w.x = pack2(sc[0], sc[1]); w.y = pack2(sc[2], sc[3]);
            *(uint2*)(Sm + (ti * 16 + r16) * 72 + si * 16 + 4 * g) = w;
        }
        __syncthreads();
#pragma unroll
        for (int q2 = 0; q2 < 2; ++q2) {
            const int ti = wave >> 1, vi = (wave & 1) * 2 + q2;
            const bf16_t* stp = STb + ((n + 1) & 1) * (64 * 136);
            f32x4 o = (f32x4){0.f, 0.f, 0.f, 0.f};
#pragma unroll
            for (int kk = 0; kk < 2; ++kk) {
                const bf16x8 af = *(const bf16x8*)(Sm + (ti * 16 + r16) * 72 + kk * 32 + 8 * g);
                const bf16x8 bfr = *(const bf16x8*)(vTn + (vi * 16 + r16) * 72 + kk * 32 + 8 * g);
                o = mfma16(bfr, af, o);
            }
#pragma unroll
            for (int kk = 0; kk < 4; ++kk) {
                const bf16x8 af = *(const bf16x8*)(Qh + (ti * 16 + r16) * 136 + kk * 32 + 8 * g);
                const bf16x8 bfr = *(const bf16x8*)(stp + (vi * 16 + r16) * 136 + kk * 32 + 8 * g);
                o = mfma16(bfr, af, o);
            }
            const int tau = n * 64 + ti * 16 + r16, tt = dir ? (SEQ - 1 - tau) : tau;
            uint2 w; w.x = pack2(o[0], o[1]); w.y = pack2(o[2], o[3]);
            *(uint2*)(OHG + ((size_t)dir * T + tokbase + tt) * 512 + h * 128 + vs * 64 + vi * 16 + 4 * g) = w;
        }
    }
#undef HG_PREFETCH
    __syncthreads();
}

__device__ void phase6(const Args& a, int gw, int nw) {
    unsigned char* ws = a.ws;
    const bf16_t* OHG = (const bf16_t*)(ws + WS_D); const bf16_t* PROJ = (const bf16_t*)(ws + WS_C);
    bf16_t* YCAT = (bf16_t*)(ws + WS_B);
    const int lane = threadIdx.x & 63;
    for (int t = gw; t < T; t += nw) {
        const int c0 = lane * 8;
        const uint4 f = *(const uint4*)(OHG + (size_t)t * 512 + c0), bw = *(const uint4*)(OHG + ((size_t)T + t) * 512 + c0);
        const uint4 gg = *(const uint4*)(PROJ + (size_t)t * INW + OFF_G + c0);
        float o[8];
        o[0] = bflo(f.x) + bflo(bw.x); o[1] = bfhi(f.x) + bfhi(bw.x); o[2] = bflo(f.y) + bflo(bw.y); o[3] = bfhi(f.y) + bfhi(bw.y);
        o[4] = bflo(f.z) + bflo(bw.z); o[5] = bfhi(f.z) + bfhi(bw.z); o[6] = bflo(f.w) + bflo(bw.w); o[7] = bfhi(f.w) + bfhi(bw.w);
        float gr[8] = {bflo(gg.x), bfhi(gg.x), bflo(gg.y), bfhi(gg.y), bflo(gg.z), bfhi(gg.z), bflo(gg.w), bfhi(gg.w)};
        float ss = 0.f;
#pragma unroll
        for (int i = 0; i < 8; ++i) ss += o[i] * o[i];
        ss += __shfl_xor(ss, 1, 64); ss += __shfl_xor(ss, 2, 64); ss += __shfl_xor(ss, 4, 64); ss += __shfl_xor(ss, 8, 64);
        const float rs = rsqrtf(ss * (1.f / 128.f) + EPS);
        float y[8];
#pragma unroll
        for (int i = 0; i < 8; ++i) { const float gt = gr[i] * frcp(1.f + __expf(-gr[i])); y[i] = o[i] * rs * a.hg_o_norm[c0 + i] * gt; }
        *(uint4*)(YCAT + (size_t)t * DM + c0) = make_uint4(pack2(y[0], y[1]), pack2(y[2], y[3]), pack2(y[4], y[5]), pack2(y[6], y[7]));
    }
}

template <int NB>
__device__ void convert_tables(const Args& a, int gw, int nw) {
    unsigned char* ws = a.ws;
    const int lane = threadIdx.x & 63;
    for (int rr0 = gw; rr0 < 32768; rr0 += nw * NB) {
        f32x4 x[NB][4];
#pragma unroll
        for (int b = 0; b < NB; ++b) {
            int rr = rr0 + b * nw; rr = rr < 32768 ? rr : 32767;
            const float* src = (rr >= 16384 ? a.peer_v : a.peer_u) + (size_t)(rr & 16383) * DM + lane * 4;
#pragma unroll
            for (int q = 0; q < 4; ++q) x[b][q] = *(const f32x4*)(src + q * 256);
        }
#pragma unroll
        for (int b = 0; b < NB; ++b) {
            const int rr = rr0 + b * nw;
            if (rr >= 32768) break;
            const bool isv = rr >= 16384; const int row = rr & 16383;
            float ss = 0.f;
#pragma unroll
            for (int q = 0; q < 4; ++q) ss += x[b][q][0] * x[b][q][0] + x[b][q][1] * x[b][q][1] + x[b][q][2] * x[b][q][2] + x[b][q][3] * x[b][q][3];
            ss = wave_sum(ss);
            const float rms = sqrtf(ss * (1.f / 1024.f));
            if (isv) {
                const float sc = 0.47f * rms, inv = sc > 0.f ? 1.f / sc : 0.f;
                unsigned char* dst = ws + WS_V4 + (size_t)row * 512 + lane * 2;
#pragma unroll
                for (int q = 0; q < 4; ++q) {
                    unsigned pk = 0;
                    pk = __builtin_amdgcn_cvt_scalef32_pk_fp4_f32(pk, fminf(fmaxf(x[b][q][0] * inv, -6.f), 6.f), fminf(fmaxf(x[b][q][1] * inv, -6.f), 6.f), 1.0f, 0);
                    pk = __builtin_amdgcn_cvt_scalef32_pk_fp4_f32(pk, fminf(fmaxf(x[b][q][2] * inv, -6.f), 6.f), fminf(fmaxf(x[b][q][3] * inv, -6.f), 6.f), 1.0f, 1);
                    *(unsigned short*)(dst + q * 128) = (unsigned short)pk;
                }
                if (lane == 0) ((float*)(ws + WS_VSCALE))[row] = sc;
            } else {
                const float st = 0.36f * rms, inv = st > 0.f ? 1.f / st : 0.f;
                unsigned char* dst = ws + WS_U4 + (size_t)row * 512 + lane * 2;
                int qs = 0;
#pragma unroll
                for (int q = 0; q < 4; ++q) {
                    unsigned hw = 0;
#pragma unroll
                    for (int e = 0; e < 4; ++e) { const int qi = (int)rintf(fminf(fmaxf(x[b][q][e] * inv, -8.f), 7.f)); qs += qi; hw |= (unsigned)(qi & 15) << (4 * e); }
                    *(unsigned short*)(dst + q * 128) = (unsigned short)hw;
                }
#pragma unroll
                for (int d = 32; d > 0; d >>= 1) qs += __shfl_xor(qs, d, 64);
                if (lane == 0) { ((float*)(ws + WS_USCALE))[row] = st; ((int*)(ws + WS_USUM))[row] = qs; }
            }
        }
    }
}

__device__ void phase7(const Args& a, unsigned char* lds) {
    unsigned char* ws = a.ws;
    g256::EpiResid e{a.x, (bf16_t*)(ws + WS_R), (float*)(ws + WS_PART), lds};
    for (int i = 0;; ++i) { int pm, pn; if (!g256::next_tile(i * gridDim.x + blockIdx.x, 64, 4, pm, pn)) break;
        __syncthreads();
        g256::tile((const bf16_t*)(ws + WS_B), (const bf16_t*)(ws + WS_WOUT_T), DM, pm * 256, pn * 256, lds, e); }
    __syncthreads();
    convert_tables<4>(a, blockIdx.x * 8 + (threadIdx.x >> 6), gridDim.x * 8);
}


__device__ __forceinline__ void ce_desc(float& x, float& y) { const float hi = fmaxf(x, y), lo = fminf(x, y); x = hi; y = lo; }
template <int N> __device__ __forceinline__ void bitonic_sort_desc(float (&v)[N]) {
#pragma unroll
    for (int k = 2; k <= N; k <<= 1)
#pragma unroll
        for (int j = k >> 1; j > 0; j >>= 1)
#pragma unroll
            for (int i = 0; i < N; ++i) { const int l = i ^ j; if (l > i) { if ((i & k) == 0) ce_desc(v[i], v[l]); else ce_desc(v[l], v[i]); } }
}
template <int N> __device__ __forceinline__ void bitonic_merge_desc(float (&v)[N]) {
#pragma unroll
    for (int j = N >> 1; j > 0; j >>= 1)
#pragma unroll
        for (int i = 0; i < N; ++i) { const int l = i ^ j; if (l > i) ce_desc(v[i], v[l]); }
}
__device__ __forceinline__ void xlane_merge16(float (&v)[16], int mask) {
    float o[16];
#pragma unroll
    for (int i = 0; i < 16; ++i) o[i] = __shfl_xor(v[15 - i], mask, 64);
#pragma unroll
    for (int i = 0; i < 16; ++i) v[i] = fmaxf(v[i], o[i]);
    bitonic_merge_desc<16>(v);
}
__device__ __forceinline__ unsigned bsel(unsigned m, unsigned x1, unsigned x0) { return x0 ^ ((x1 ^ x0) & m); }
__device__ __forceinline__ float sel16(const float (&v)[16], unsigned i) {
    const unsigned m0 = 0u - (i & 1u), m1 = 0u - ((i >> 1) & 1u), m2 = 0u - ((i >> 2) & 1u), m3 = 0u - ((i >> 3) & 1u);
    unsigned t8[8], t4[4], t2[2];
#pragma unroll
    for (int q = 0; q < 8; ++q) t8[q] = bsel(m0, __float_as_uint(v[2 * q + 1]), __float_as_uint(v[2 * q]));
#pragma unroll
    for (int q = 0; q < 4; ++q) t4[q] = bsel(m1, t8[2 * q + 1], t8[2 * q]);
#pragma unroll
    for (int q = 0; q < 2; ++q) t2[q] = bsel(m2, t4[2 * q + 1], t4[2 * q]);
    return __uint_as_float(bsel(m3, t2[1], t2[0]));
}
__device__ __forceinline__ float sel4(int g, float x0, float x1, float x2, float x3) {
    const unsigned m0 = 0u - ((unsigned)g & 1u), m1 = 0u - (((unsigned)g >> 1) & 1u);
    const unsigned lo = bsel(m0, __float_as_uint(x1), __float_as_uint(x0)), hi = bsel(m0, __float_as_uint(x3), __float_as_uint(x2));
    return __uint_as_float(bsel(m1, hi, lo));
}

static constexpr int PI[52] = {0,0,0,0,0,0,0,0,0,0,0,0,0,0,0,0,1,1,1,1,1,1,1,1,2,2,2,2,2,3,3,3,3,4,4,4,5,5,6,6,7,7,8,9,10,11,12,13,14,15,0,0};
static constexpr int PJ[52] = {0,1,2,3,4,5,6,7,8,9,10,11,12,13,14,15,0,1,2,3,4,5,6,7,0,1,2,3,4,0,1,2,3,0,1,2,0,1,0,1,0,1,0,0,0,0,0,0,0,0,0,0};
constexpr int RT_ROW = 272;
__device__ __forceinline__ void peer_half_top16(const bf16_t* __restrict__ PQ, const unsigned char* __restrict__ skl, int t0, int p, int c, int r16, int g, float (&out)[16]) {
    f32x4 sc[8];
#pragma unroll
    for (int ni = 0; ni < 8; ++ni) sc[ni] = (f32x4){0.f, 0.f, 0.f, 0.f};
    bf16x8 af[4];
#pragma unroll
    for (int kk = 0; kk < 4; ++kk) af[kk] = *(const bf16x8*)(PQ + (size_t)(t0 + r16) * 2048 + p * 256 + c * 128 + kk * 32 + 8 * g);
#pragma unroll
    for (int kk = 0; kk < 4; ++kk) {
        asm volatile("" ::: "memory");
#pragma unroll
        for (int ni = 0; ni < 8; ++ni) {
            const bf16x8 bfr = *(const bf16x8*)(skl + (c * 128 + ni * 16 + r16) * RT_ROW + kk * 64 + 16 * g);
            sc[ni] = mfma16(bfr, af[kk], sc[ni]);
        }
    }
    float hi[16];
#pragma unroll
    for (int ni = 0; ni < 4; ++ni)
#pragma unroll
        for (int r = 0; r < 4; ++r) {
            out[ni * 4 + r] = __uint_as_float((__float_as_uint(sc[ni][r]) & 0xffffff80u) | (unsigned)(ni * 16 + 4 * g + r));
            hi[ni * 4 + r] = __uint_as_float((__float_as_uint(sc[ni + 4][r]) & 0xffffff80u) | (unsigned)((ni + 4) * 16 + 4 * g + r));
        }
    bitonic_sort_desc<16>(out);
    bitonic_sort_desc<16>(hi);
#pragma unroll
    for (int i = 0; i < 16; ++i) out[i] = fmaxf(out[i], hi[15 - i]);
    bitonic_merge_desc<16>(out);
    xlane_merge16(out, 16);
    xlane_merge16(out, 32);
}
__device__ __forceinline__ void peer_route_finish(const Args& a, int p, int t0, const float (&ab0)[16], const float (&ab1)[16]) {
    unsigned char* ws = a.ws;
    int* IDX = (int*)(ws + WS_IDX); float* GATE = (float*)(ws + WS_GATE);
    int tix_ = threadIdx.x; asm volatile("" : "+v"(tix_));
    const int lane = tix_ & 63, r16 = lane & 15, g = lane >> 4;
    float va[16], vb[16];
#pragma unroll
    for (int i = 0; i < 16; ++i) { va[i] = __uint_as_float(__float_as_uint(ab0[i]) & 0xffffff80u); vb[i] = __uint_as_float(__float_as_uint(ab1[i]) & 0xffffff80u); }
    float v[16];
#pragma unroll
    for (int s = 0; s < 13; ++s) {
        const float x0 = __uint_as_float((__float_as_uint(va[PI[4 * s]] + vb[PJ[4 * s]]) & 0xffffff00u) | (unsigned)(PI[4 * s] * 16 + PJ[4 * s]));
        const float x1 = __uint_as_float((__float_as_uint(va[PI[4 * s + 1]] + vb[PJ[4 * s + 1]]) & 0xffffff00u) | (unsigned)(PI[4 * s + 1] * 16 + PJ[4 * s + 1]));
        const float x2 = (4 * s + 2 < 50) ? __uint_as_float((__float_as_uint(va[PI[4 * s + 2]] + vb[PJ[4 * s + 2]]) & 0xffffff00u) | (unsigned)(PI[4 * s + 2] * 16 + PJ[4 * s + 2])) : -3.0e38f;
        const float x3 = (4 * s + 3 < 50) ? __uint_as_float((__float_as_uint(va[PI[4 * s + 3]] + vb[PJ[4 * s + 3]]) & 0xffffff00u) | (unsigned)(PI[4 * s + 3] * 16 + PJ[4 * s + 3])) : -3.0e38f;
        v[s] = sel4(g, x0, x1, x2, x3);
    }
    v[13] = -3.0e38f; v[14] = -3.0e38f; v[15] = -3.0e38f;
    bitonic_sort_desc<16>(v);
    xlane_merge16(v, 16);
    xlane_merge16(v, 32);
    float e[16], sum = 0.f;
    const float mtop = __uint_as_float(__float_as_uint(v[0]) & 0xffffff00u);
#pragma unroll
    for (int q = 0; q < 16; ++q) { e[q] = __expf(__uint_as_float(__float_as_uint(v[q]) & 0xffffff00u) - mtop); sum += e[q]; }
    const float inv = 1.f / sum;
    int oi[4]; float og[4];
#pragma unroll
    for (int r = 0; r < 4; ++r) {
        const unsigned key = __float_as_uint(sel4(g, v[r], v[4 + r], v[8 + r], v[12 + r]));
        const unsigned pos = key & 255u;
        const unsigned ia = __float_as_uint(sel16(ab0, pos >> 4)) & 127u, ib = __float_as_uint(sel16(ab1, pos & 15u)) & 127u;
        oi[r] = (int)(ia * 128u + ib);
        og[r] = sel4(g, e[r], e[4 + r], e[8 + r], e[12 + r]) * inv;
    }
    const size_t o = (size_t)(t0 + r16) * 128 + p * 16 + 4 * g;
    *(int4*)(IDX + o) = make_int4(oi[0], oi[1], oi[2], oi[3]);
    *(f32x4*)(GATE + o) = (f32x4){og[0], og[1], og[2], og[3]};
}

__device__ __forceinline__ float dpp_xor1(float v) { return __builtin_bit_cast(float, __builtin_amdgcn_mov_dpp(__builtin_bit_cast(int, v), 0xB1, 0xF, 0xF, true)); }
__device__ __forceinline__ float dpp_xor2(float v) { return __builtin_bit_cast(float, __builtin_amdgcn_mov_dpp(__builtin_bit_cast(int, v), 0x4E, 0xF, 0xF, true)); }
__device__ __forceinline__ float dpp_hmirror(float v) { return __builtin_bit_cast(float, __builtin_amdgcn_mov_dpp(__builtin_bit_cast(int, v), 0x141, 0xF, 0xF, true)); }


constexpr int PU_ROW = 272;
__device__ __forceinline__ float dot2bf(unsigned x, unsigned y, float acc) { return __builtin_amdgcn_fdot2_f32_bf16(__builtin_bit_cast(bf16v2, x), __builtin_bit_cast(bf16v2, y), acc, false); }


__device__ __forceinline__ void peer_half_top16_lds(const unsigned char* __restrict__ qs, const unsigned char* __restrict__ skl, int r16, int g, float (&out)[16]) {
    f32x4 sc[8];
#pragma unroll
    for (int ni = 0; ni < 8; ++ni) sc[ni] = (f32x4){0.f, 0.f, 0.f, 0.f};
#pragma unroll
    for (int kk = 0; kk < 4; ++kk) {
        asm volatile("" ::: "memory");
        const bf16x8 af = *(const bf16x8*)(qs + r16 * RT_ROW + kk * 64 + 16 * g);
#pragma unroll
        for (int ni = 0; ni < 8; ++ni) {
            const bf16x8 bfr = *(const bf16x8*)(skl + (ni * 16 + r16) * RT_ROW + kk * 64 + 16 * g);
            sc[ni] = mfma16(bfr, af, sc[ni]);
        }
    }
    float hi[16];
#pragma unroll
    for (int ni = 0; ni < 4; ++ni)
#pragma unroll
        for (int r = 0; r < 4; ++r) {
            out[ni * 4 + r] = __uint_as_float((__float_as_uint(sc[ni][r]) & 0xffffff80u) | (unsigned)(ni * 16 + 4 * g + r));
            hi[ni * 4 + r] = __uint_as_float((__float_as_uint(sc[ni + 4][r]) & 0xffffff80u) | (unsigned)((ni + 4) * 16 + 4 * g + r));
        }
    bitonic_sort_desc<16>(out);
    bitonic_sort_desc<16>(hi);
#pragma unroll
    for (int i = 0; i < 16; ++i) out[i] = fmaxf(out[i], hi[15 - i]);
    bitonic_merge_desc<16>(out);
    xlane_merge16(out, 16);
    xlane_merge16(out, 32);
}
struct EpiRoute { const Args* ap; unsigned char* lds; int p; int brow;
    __device__ __forceinline__ void operator()(const f32x4 (&acc)[2][2][4][2], int row0, int col0) const {
        int tix = threadIdx.x; asm volatile("" : "+v"(tix));
        const int lane = tix & 63, wave = tix >> 6, r16 = lane & 15, g = lane >> 4;
        unsigned char* qs = lds;
        unsigned char* skl = lds + 256 * RT_ROW;
        const int rl0 = row0 - brow, cl0 = (col0 - p * 256);
        float* tl = (float*)(lds + 384 * RT_ROW);
        float rs[2][4];
        { const float* PART = (const float*)(ap->ws + WS_PART);
#pragma unroll
          for (int ai = 0; ai < 2; ++ai)
#pragma unroll
            for (int m = 0; m < 4; ++m) { const int row = row0 + ai * 128 + m * 16;
                rs[ai][m] = rsqrtf(((PART[row] + PART[T + row]) + (PART[2 * T + row] + PART[3 * T + row])) * (1.f / 1024.f) + EPS); } }
#pragma unroll 1
        for (int c = 0; c < 2; ++c) {
            __syncthreads();
#pragma unroll
            for (int ai = 0; ai < 2; ++ai)
#pragma unroll
                for (int m = 0; m < 4; ++m)
#pragma unroll
                    for (int n = 0; n < 2; ++n) { const f32x4 v = (c ? acc[ai][1][m][n] : acc[ai][0][m][n]) * rs[ai][m]; uint2 w; w.x = pack2(v[0], v[1]); w.y = pack2(v[2], v[3]);
                        *(uint2*)(qs + (rl0 + ai * 128 + m * 16) * RT_ROW + (cl0 + n * 16) * 2) = w; }
            { const bf16_t* SK = (const bf16_t*)(ap->ws + WS_SUBK) + ((size_t)p * 2 + c) * 128 * 128;
              for (int ch = tix; ch < 128 * 16; ch += NT) { const int row = ch >> 4, q = ch & 15; *(uint4*)(skl + row * RT_ROW + q * 16) = *(const uint4*)(SK + row * 128 + q * 8); } }
            __syncthreads();
#pragma unroll 1
            for (int k = 0; k < 2; ++k) {
                float lst[16];
                peer_half_top16_lds(qs + ((wave * 2 + k) * 16) * RT_ROW, skl, r16, g, lst);
                if (g == 0) { float* d = tl + (((wave * 2 + k) * 16 + r16) * 2 + c) * 16;
#pragma unroll
                    for (int q = 0; q < 4; ++q) *(f32x4*)(d + q * 4) = (f32x4){lst[q * 4], lst[q * 4 + 1], lst[q * 4 + 2], lst[q * 4 + 3]}; }
            }
        }
        __syncthreads();
#pragma unroll 1
        for (int k = 0; k < 2; ++k) {
            float ab0[16], ab1[16];
            const float* d = tl + (((wave * 2 + k) * 16 + r16) * 2) * 16;
#pragma unroll
            for (int q = 0; q < 4; ++q) { const f32x4 x0 = *(const f32x4*)(d + q * 4), x1 = *(const f32x4*)(d + 16 + q * 4);
                ab0[q * 4] = x0[0]; ab0[q * 4 + 1] = x0[1]; ab0[q * 4 + 2] = x0[2]; ab0[q * 4 + 3] = x0[3]; ab1[q * 4] = x1[0]; ab1[q * 4 + 1] = x1[1]; ab1[q * 4 + 2] = x1[2]; ab1[q * 4 + 3] = x1[3]; }
            peer_route_finish(*ap, p, brow + (wave * 2 + k) * 16, ab0, ab1);
        }
    }
};

__device__ void phase9_fused(const Args& a, unsigned char* lds) {
    unsigned char* ws = a.ws;
    for (int i = 0;; ++i) { int pm, pn; if (!g256::next_tile(i * gridDim.x + blockIdx.x, 64, 8, pm, pn)) break;
        EpiRoute e{&a, lds, pn, pm * 256};
        __syncthreads();
        g256::tile((const bf16_t*)(ws + WS_R), (const bf16_t*)(ws + WS_WPQ_T), DM, pm * 256, pn * 256, lds, e); }
    __syncthreads();
}

__device__ __forceinline__ int idpp_xor1(int v) { return __builtin_amdgcn_mov_dpp(v, 0xB1, 0xF, 0xF, true); }
__device__ __forceinline__ int idpp_xor2(int v) { return __builtin_amdgcn_mov_dpp(v, 0x4E, 0xF, 0xF, true); }
__device__ __forceinline__ int idpp_hmirror(int v) { return __builtin_amdgcn_mov_dpp(v, 0x141, 0xF, 0xF, true); }

__device__ void peer_uv_phase(const Args& a, unsigned char* lds) {
    unsigned char* ws = a.ws;
    const unsigned char* U4 = ws + WS_U4; const unsigned char* V4 = ws + WS_V4;
    const unsigned* IDX = (const unsigned*)(ws + WS_IDX); const float* GATE = (const float*)(ws + WS_GATE);
    const float* VS = (const float*)(ws + WS_VSCALE); const float* US = (const float*)(ws + WS_USCALE);
    const int* USUM = (const int*)(ws + WS_USUM);
    const int wv = __builtin_amdgcn_readfirstlane((int)(threadIdx.x >> 6));
    unsigned char* wl = lds + wv * 6528;
    unsigned char* il = wl + 8 * 272;
    unsigned char* hl = lds + 8 * 6528 + wv * 8192;
    float* hsl = (float*)(lds + 8 * 6528 + 8 * 8192) + wv * 8;
    for (int item = blockIdx.x * 8 + wv; item < 2048; item += gridDim.x * 8) {
    const int tpbase = ((item >> 3) & 7) * 1024 + (item >> 6) * 8 + (item & 7);
    {
        int tix0 = threadIdx.x; asm volatile("" : "+v"(tix0));
        const int lane = tix0 & 63;
        const bf16_t* R = (const bf16_t*)(ws + WS_R);
        uint2 rw[8][4];
#pragma unroll
        for (int tau = 0; tau < 8; ++tau) { const size_t t = (size_t)(tpbase + 256 * (tau >> 1)) * 2 + (tau & 1);
#pragma unroll
            for (int i = 0; i < 4; ++i) rw[tau][i] = *(const uint2*)(R + t * DM + i * 256 + lane * 4); }
        f32x4 gn[4];
#pragma unroll
        for (int i = 0; i < 4; ++i) gn[i] = *(const f32x4*)(a.ffn_norm + i * 256 + lane * 4);
        unsigned char* hr = hl + (lane >> 3) * 32 + ((lane >> 1) & 3) * 4 + (lane & 1) * 2;
#pragma unroll
        for (int tau = 0; tau < 8; ++tau) {
            f32x4 v[4]; float ss = 0.f;
#pragma unroll
            for (int i = 0; i < 4; ++i) { v[i] = (f32x4){bflo(rw[tau][i].x), bfhi(rw[tau][i].x), bflo(rw[tau][i].y), bfhi(rw[tau][i].y)};
                ss += v[i][0] * v[i][0] + v[i][1] * v[i][1] + v[i][2] * v[i][2] + v[i][3] * v[i][3]; }
            ss = wave_sum(ss);
            const float rs = rsqrtf(ss * (1.f / 1024.f) + EPS);
            float amax = 0.f;
#pragma unroll
            for (int i = 0; i < 4; ++i)
#pragma unroll
                for (int e = 0; e < 4; ++e) { v[i][e] = v[i][e] * rs * gn[i][e]; amax = fmaxf(amax, fabsf(v[i][e])); }
#pragma unroll
            for (int d = 32; d > 0; d >>= 1) amax = fmaxf(amax, __shfl_xor(amax, d, 64));
            const float inv = amax > 0.f ? 127.f / amax : 0.f;
#pragma unroll
            for (int i = 0; i < 4; ++i) {
                unsigned ha = 0, hb = 0;
#pragma unroll
                for (int e = 0; e < 4; ++e) { const unsigned tb = (unsigned)((int)rintf(v[i][e] * inv) + 128); ha |= ((tb >> 4) ^ 8u) << (4 * e); hb |= ((tb & 15u) ^ 8u) << (4 * e); }
                *(unsigned short*)(hr + tau * 1024 + i * 256) = (unsigned short)ha; *(unsigned short*)(hr + tau * 1024 + i * 256 + 16) = (unsigned short)hb;
            }
            if (lane == 0) hsl[tau] = amax * (1.f / 127.f);
        }
    }
    {
    int tix = threadIdx.x; asm volatile("" : "+v"(tix));
    const int lane = tix & 63, m = lane & 7, j = lane >> 3;
    const size_t tp0 = (size_t)tpbase;
    int acc[4][2][2];
#pragma unroll
    for (int k = 0; k < 4; ++k) { acc[k][0][0] = 0; acc[k][0][1] = 0; acc[k][1][0] = 0; acc[k][1][1] = 0; }
#pragma unroll 1
    for (int sl = 0; sl < 4; ++sl) {
        const unsigned uoff = (unsigned)(sl * 128 + 16 * m);
#pragma unroll
        for (int k = 0; k < 4; ++k) {
            const size_t tp = tp0 + 256 * k;
            uint4 ha[2], hb[2]; uint4 iq[2][4];
#pragma unroll
            for (int tt = 0; tt < 2; ++tt) {
                const size_t t = tp * 2 + tt;
                ha[tt] = *(const uint4*)(hl + (2 * k + tt) * 1024 + sl * 256 + m * 32); hb[tt] = *(const uint4*)(hl + (2 * k + tt) * 1024 + sl * 256 + m * 32 + 16);
#pragma unroll
                for (int q = 0; q < 4; ++q) iq[tt][q] = *(const uint4*)(IDX + t * 128 + j * 16 + q * 4);
            }
            uint4 uq[2][16];
#pragma unroll
            for (int tt = 0; tt < 2; ++tt)
#pragma unroll
                for (int q = 0; q < 4; ++q) {
                    uq[tt][q * 4] = *(const uint4*)(U4 + (iq[tt][q].x * 512u + uoff)); uq[tt][q * 4 + 1] = *(const uint4*)(U4 + (iq[tt][q].y * 512u + uoff));
                    uq[tt][q * 4 + 2] = *(const uint4*)(U4 + (iq[tt][q].z * 512u + uoff)); uq[tt][q * 4 + 3] = *(const uint4*)(U4 + (iq[tt][q].w * 512u + uoff));
                }
#pragma unroll
            for (int tt = 0; tt < 2; ++tt) {
                const int haw[4] = {(int)ha[tt].x, (int)ha[tt].y, (int)ha[tt].z, (int)ha[tt].w};
                const int hbw[4] = {(int)hb[tt].x, (int)hb[tt].y, (int)hb[tt].z, (int)hb[tt].w};
                int val0 = 0, val1 = 0;
#pragma unroll
                for (int it = 0; it < 16; ++it) {
                    int wd[4] = {(int)uq[tt][it].x, (int)uq[tt][it].y, (int)uq[tt][it].z, (int)uq[tt][it].w};
                    asm volatile("" : "+v"(wd[0]), "+v"(wd[1]), "+v"(wd[2]), "+v"(wd[3]), "+v"(val0), "+v"(val1));
                    int dh = 0, dl = 0;
#pragma unroll
                    for (int q = 0; q < 4; ++q) { dh = __builtin_amdgcn_sdot8(haw[q], wd[q], dh, false); dl = __builtin_amdgcn_sdot8(hbw[q], wd[q], dl, false); }
                    int d = (dh << 4) + dl;
                    d += idpp_xor1(d); d += idpp_xor2(d); d += idpp_hmirror(d);
                    if ((it >> 1) == m) { if (it & 1) val1 = d; else val0 = d; }
                }
                acc[k][tt][0] += val0; acc[k][tt][1] += val1;
            }
        }
    }
#pragma unroll
    for (int k = 0; k < 4; ++k)
#pragma unroll
        for (int tt = 0; tt < 2; ++tt) {
            const size_t t = (tp0 + 256 * k) * 2 + tt; const size_t o = t * 128 + j * 16 + 2 * m;
            const float2 gt = *(const float2*)(GATE + o); const uint2 id = *(const uint2*)(IDX + o);
            const float hs = hsl[2 * k + tt];
            const float x0 = (float)(acc[k][tt][0] + 8 * USUM[id.x]) * (hs * US[id.x]), x1 = (float)(acc[k][tt][1] + 8 * USUM[id.y]) * (hs * US[id.y]);
            const float w0 = gt.x * 0.5f * x0 * (1.f + erff(x0 * 0.70710678118654752f)) * VS[id.x];
            const float w1 = gt.y * 0.5f * x1 * (1.f + erff(x1 * 0.70710678118654752f)) * VS[id.y];
            *(unsigned*)(wl + (2 * k + tt) * 272 + (j * 16 + 2 * m) * 2) = pack2h(w0, w1);
            *(uint2*)(il + (2 * k + tt) * 528 + (j * 16 + 2 * m) * 4) = id;
        }
    }
    int tix2 = threadIdx.x; asm volatile("" : "+v"(tix2));
    const int m2 = tix2 & 7, j2 = (tix2 >> 3) & 7;
    const unsigned tv = (unsigned)((tpbase + 256 * (j2 >> 1)) * 2 + (j2 & 1));
    const unsigned char* wrow = wl + j2 * 272; const unsigned char* irow = il + j2 * 528;
#pragma unroll 1
    for (int sl = 0; sl < 4; ++sl) {
        const unsigned voff = (unsigned)(sl * 128 + 16 * m2);
        float y[32];
#pragma unroll
        for (int i = 0; i < 32; ++i) y[i] = 0.f;
#pragma unroll 1
        for (int grp = 0; grp < 4; ++grp) {
            uint4 wq[4];
            uint4 vq[32];
#pragma unroll
            for (int q = 0; q < 8; ++q) {
                const uint4 i4 = *(const uint4*)(irow + grp * 128 + q * 16);
                vq[q * 4] = *(const uint4*)(V4 + (i4.x * 512u + voff)); vq[q * 4 + 1] = *(const uint4*)(V4 + (i4.y * 512u + voff));
                vq[q * 4 + 2] = *(const uint4*)(V4 + (i4.z * 512u + voff)); vq[q * 4 + 3] = *(const uint4*)(V4 + (i4.w * 512u + voff));
            }
#pragma unroll
            for (int q = 0; q < 4; ++q) wq[q] = *(const uint4*)(wrow + grp * 64 + q * 16);
#pragma unroll
            for (int it = 0; it < 32; ++it) {
                const uint4 wv4 = wq[it >> 3]; const int wc_ = (it >> 1) & 3;
                const unsigned wword = wc_ == 0 ? wv4.x : (wc_ == 1 ? wv4.y : (wc_ == 2 ? wv4.z : wv4.w));
                const f16v2 wp = __builtin_bit_cast(f16v2, wword);
                const float wt = (float)((it & 1) ? wp[1] : wp[0]);
                unsigned wd0 = vq[it].x, wd1 = vq[it].y, wd2 = vq[it].z, wd3 = vq[it].w;
                asm volatile("" : "+v"(wd0), "+v"(wd1), "+v"(wd2), "+v"(wd3), "+v"(y[0]));
                const unsigned wd[4] = {wd0, wd1, wd2, wd3};
#pragma unroll
                for (int q = 0; q < 4; ++q) {
                    const f32v2 p0 = __builtin_amdgcn_cvt_scalef32_pk_f32_fp4(wd[q], 1.0f, 0), p1 = __builtin_amdgcn_cvt_scalef32_pk_f32_fp4(wd[q], 1.0f, 1);
                    const f32v2 p2 = __builtin_amdgcn_cvt_scalef32_pk_f32_fp4(wd[q], 1.0f, 2), p3 = __builtin_amdgcn_cvt_scalef32_pk_f32_fp4(wd[q], 1.0f, 3);
                    y[q * 8] += wt * p0[0]; y[q * 8 + 1] += wt * p0[1]; y[q * 8 + 2] += wt * p1[0]; y[q * 8 + 3] += wt * p1[1];
                    y[q * 8 + 4] += wt * p2[0]; y[q * 8 + 5] += wt * p2[1]; y[q * 8 + 6] += wt * p3[0]; y[q * 8 + 7] += wt * p3[1];
                }
            }
        }
        const unsigned ooff = tv * (unsigned)DM + (unsigned)(sl * 256 + 32 * m2);
        const bf16_t* rrow = (const bf16_t*)(ws + WS_R) + ooff; float* orow = a.out + ooff;
#pragma unroll
        for (int q = 0; q < 4; ++q) {
            const uint4 r = *(const uint4*)(rrow + q * 8);
            *(f32x4*)(orow + q * 8) = (f32x4){bflo(r.x) + y[q * 8], bfhi(r.x) + y[q * 8 + 1], bflo(r.y) + y[q * 8 + 2], bfhi(r.y) + y[q * 8 + 3]};
            *(f32x4*)(orow + q * 8 + 4) = (f32x4){bflo(r.z) + y[q * 8 + 4], bfhi(r.z) + y[q * 8 + 5], bflo(r.w) + y[q * 8 + 6], bfhi(r.w) + y[q * 8 + 7]};
        }
    }
    }
}

#define XB_TMO      128
#define XB_XCNT(j)  (256  + 64 * (j))
#define XB_XSUB(j)  (1280 + 64 * (j))
#define XB_XGEN(j)  (2304 + 64 * (j))
#define XB_TOP      3328
#define XB_TOPGEN   3392
#define XCD_BAR_WORDS 3456
#define XB_SPIN_CAP (1u << 22)
#define LAS __attribute__((address_space(3)))
__device__ __forceinline__ unsigned xb_ld(unsigned* p)              { return __hip_atomic_load(p, __ATOMIC_RELAXED, __HIP_MEMORY_SCOPE_AGENT); }
__device__ __forceinline__ unsigned xb_add(unsigned* p, unsigned v) { return __hip_atomic_fetch_add(p, v, __ATOMIC_RELAXED, __HIP_MEMORY_SCOPE_AGENT); }
__device__ __forceinline__ unsigned xb_xcc_id() { return (unsigned)__builtin_amdgcn_s_getreg((3 << 11) | 20) & 0xFu; }
#define XB_SPIN(cond, bar) do { unsigned _sp = 0; while (cond) { __builtin_amdgcn_s_sleep(1); \
    if ((++_sp & 255u) == 0u) { if (xb_ld(&(bar)[XB_TMO])) break; if (_sp > XB_SPIN_CAP) { atomicAdd(&(bar)[XB_TMO], 1u); break; } } } } while (0)
struct XcdBarrier { unsigned* bar; unsigned x; volatile LAS unsigned* st; };
__device__ __forceinline__ XcdBarrier xcd_barrier_post(unsigned* bar, volatile LAS unsigned* st) {
    XcdBarrier b; b.bar = bar; b.x = xb_xcc_id(); b.st = st;
    if (threadIdx.x == 0) (void)xb_add(&bar[XB_XCNT(b.x)], 1u);
    return b;
}
__device__ __forceinline__ void xcd_barrier_complete(unsigned* bar, unsigned x, unsigned& nloc, unsigned& nx) {
    const unsigned G = gridDim.x * gridDim.y * gridDim.z;
    unsigned sum, cnt, mine, sp = 0u;
    for (;;) {
        sum = 0u; cnt = 0u; mine = 0u;
#pragma unroll
        for (unsigned j = 0; j < 16; ++j) { const unsigned c = xb_ld(&bar[XB_XCNT(j)]); sum += c; cnt += (c > 0u) ? 1u : 0u; mine = (j == x) ? c : mine; }
        if (sum == G) break;
        __builtin_amdgcn_s_sleep(1);
        if ((++sp & 255u) == 0u) { if (xb_ld(&bar[XB_TMO])) break; if (sp > XB_SPIN_CAP) { atomicAdd(&bar[XB_TMO], 1u); break; } }
    }
    nloc = mine > 0u ? mine : 1u; nx = cnt > 0u ? cnt : 1u;
}
__device__ __forceinline__ void xcd_barrier(const XcdBarrier& b) {
    asm volatile("s_waitcnt vmcnt(0)" ::: "memory");
    __syncthreads();
    if (threadIdx.x == 0) {
        unsigned* bar = b.bar;
        __builtin_amdgcn_s_waitcnt(0);
        unsigned nloc = b.st[0], nx = b.st[1];
        if (nloc == 0u) { xcd_barrier_complete(bar, b.x, nloc, nx); b.st[0] = nloc; b.st[1] = nx; }
        const unsigned old = xb_add(&bar[XB_XSUB(b.x)], 1u);
        const unsigned gen = old / nloc;
        if (old + 1u == (gen + 1u) * nloc) {
            __builtin_amdgcn_fence(__ATOMIC_RELEASE, "agent");
            asm volatile("s_waitcnt vmcnt(0)" ::: "memory");
            const unsigned og = xb_add(&bar[XB_TOP], 1u);
            const unsigned tg = og / nx;
            if (og + 1u == (tg + 1u) * nx) xb_add(&bar[XB_TOPGEN], 1u);
            else XB_SPIN(xb_ld(&bar[XB_TOPGEN]) == tg, bar);
            __builtin_amdgcn_fence(__ATOMIC_ACQUIRE, "agent");
            xb_add(&bar[XB_XGEN(b.x)], 1u);
            asm volatile("s_waitcnt vmcnt(0)" ::: "memory");
        } else {
            XB_SPIN(xb_ld(&bar[XB_XGEN(b.x)]) == gen, bar);
            __builtin_amdgcn_fence(__ATOMIC_ACQUIRE, "agent");
            asm volatile("s_waitcnt vmcnt(0)" ::: "memory");
        }
    }
    __syncthreads();
}

#define XB_FLAT0 3520
__device__ __forceinline__ void flat_barrier(unsigned* bar, unsigned word, unsigned n) {
    asm volatile("s_waitcnt vmcnt(0)" ::: "memory");
    __syncthreads();
    if (threadIdx.x == 0) {
        __builtin_amdgcn_fence(__ATOMIC_RELEASE, "agent");
        asm volatile("s_waitcnt vmcnt(0)" ::: "memory");
        (void)xb_add(&bar[word], 1u);
        XB_SPIN(xb_ld(&bar[word]) < n, bar);
        __builtin_amdgcn_fence(__ATOMIC_ACQUIRE, "agent");
        asm volatile("s_waitcnt vmcnt(0)" ::: "memory");
    }
    __syncthreads();
}

constexpr int LDS_MAIN = HG_LDS;
static_assert(LDS_MAIN >= 512 * PU_ROW && LDS_MAIN >= 2 * AT_BUF && LDS_MAIN >= 131072, "LDS_MAIN");
constexpr int LDS_BYTES = LDS_MAIN + 16;
constexpr int N_PHASES = 14;

__global__ void __launch_bounds__(NT, 2) fwd_kernel(Args a) {
    extern __shared__ __attribute__((aligned(16))) unsigned char lds[];
#if N_LAUNCH_MODE == 1
#ifdef USE_CG_SYNC
    cg::grid_group grid = cg::this_grid();
#endif
    volatile LAS unsigned* xst = (volatile LAS unsigned*)(lds + LDS_MAIN);
    if (threadIdx.x < 4) xst[threadIdx.x] = 0u;
    __syncthreads();
    XcdBarrier xbar = xcd_barrier_post((unsigned*)(a.ws + WS_CTL), xst);
#ifdef USE_CG_SYNC
#define SEAM(k) do { if (a.ph_lo <= (k) && (k) + 1 < a.ph_hi) { if ((k) == 0) grid.sync(); else xcd_barrier(xbar); } } while (0)
#else
#define SEAM(k) do { if (a.ph_lo <= (k) && (k) + 1 < a.ph_hi) { xcd_barrier(xbar); } } while (0)
#endif
#else
#define SEAM(k) do { } while (0)
#endif
#define IN(k) (a.ph_lo <= (k) && (k) < a.ph_hi)
#define REPS(k) for (int rep_ = 0; rep_ < ((k) == REPEAT_PHASE ? 2 : 1); ++rep_)
    if (IN(0)) REPS(0) { phase0(a, lds); } SEAM(0);
    if (IN(1)) REPS(1) { phase1(a, lds); } SEAM(1);
    if (IN(2)) REPS(2) { phase2(a); } SEAM(2);
    if (IN(3)) REPS(3) { phase3(a, lds); } SEAM(3);
    if (IN(4)) REPS(4) {
        const int nhalf = gridDim.x >> 1;
        if ((int)blockIdx.x < nhalf) { for (int r_ = 0; r_ < ATT_REP; ++r_) for (int it = blockIdx.x; it < 256; it += nhalf) attn_item(a, it, lds); }
        else { for (int r_ = 0; r_ < HG_REP; ++r_) for (int it = blockIdx.x - nhalf; it < 128; it += gridDim.x - nhalf) hgrn_item(a, it, lds);
               flat_barrier((unsigned*)(a.ws + WS_CTL), XB_FLAT0, gridDim.x - nhalf);
               phase6(a, (blockIdx.x - nhalf) * 8 + (threadIdx.x >> 6), (gridDim.x - nhalf) * 8); }
    } SEAM(5);
    if (IN(7)) REPS(7) { phase7(a, lds); } SEAM(7);
    if (IN(9)) REPS(9) { phase9_fused(a, lds); } SEAM(10);
    if (IN(11)) { __syncthreads(); peer_uv_phase(a, lds); }
}

extern "C" void kernel_launch(void* const* d_in, const int* in_sizes, int n_in, void* d_out, int out_size, void* d_ws, size_t ws_size, hipStream_t stream) {
    static int grid = 0;
    if (grid == 0) {
        if (n_in != 19 || out_size != T * DM || ws_size < WS_END) { fprintf(stderr, "kernel_launch: unexpected shapes (n_in %d out %d ws %zu)\n", n_in, out_size, ws_size); grid = -1; return; }
        int dev = 0, cus = 0, per_cu = 0;
        (void)hipGetDevice(&dev); (void)hipDeviceGetAttribute(&cus, hipDeviceAttributeMultiprocessorCount, dev);
        (void)hipFuncSetAttribute((const void*)fwd_kernel, hipFuncAttributeMaxDynamicSharedMemorySize, LDS_BYTES);
        (void)hipOccupancyMaxActiveBlocksPerMultiprocessor(&per_cu, (const void*)fwd_kernel, NT, LDS_BYTES);
        if (per_cu < 1) { fprintf(stderr, "kernel_launch: occupancy query says %d blocks/CU\n", per_cu); per_cu = 1; }
        grid = cus;
        (void)hipGetLastError();
    }
    if (grid < 0) return;
    Args a{};
    a.x = (const float*)d_in[0]; a.pos = (const int*)d_in[1]; a.attn_norm = (const float*)d_in[2]; a.w_in = (const float*)d_in[3];
    a.lb_logits = (const float*)d_in[4]; a.hg_o_norm = (const float*)d_in[5]; a.q_a_norm = (const float*)d_in[6]; a.w_q_up = (const float*)d_in[7];
    a.kv_a_norm = (const float*)d_in[8]; a.w_kv_up = (const float*)d_in[9]; a.q_norm = (const float*)d_in[10]; a.k_norm = (const float*)d_in[11];
    a.mla_o_norm = (const float*)d_in[12]; a.w_out = (const float*)d_in[13]; a.ffn_norm = (const float*)d_in[14]; a.peer_wq = (const float*)d_in[15];
    a.subk = (const float*)d_in[16]; a.peer_u = (const float*)d_in[17]; a.peer_v = (const float*)d_in[18];
    a.out = (float*)d_out; a.ws = (unsigned char*)d_ws;
    const int last = (STOP_AFTER < N_PHASES - 1) ? STOP_AFTER : N_PHASES - 1;
#if N_LAUNCH_MODE == 1
    (void)hipMemsetAsync((unsigned char*)d_ws + WS_CTL, 0, 16384, stream);
    a.ph_lo = 0; a.ph_hi = last + 1;
#ifdef USE_CG_SYNC
    void* args[] = {&a};
    hipError_t e = hipLaunchCooperativeKernel((const void*)fwd_kernel, dim3(grid), dim3(NT), args, LDS_BYTES, stream);
    if (e != hipSuccess) fprintf(stderr, "cooperative launch failed: %s (grid %d)\n", hipGetErrorString(e), grid);
#else
    hipLaunchKernelGGL(fwd_kernel, dim3(grid), dim3(NT), LDS_BYTES, stream, a);
#endif
#else
    for (int ph = 0; ph <= last; ++ph) {
        a.ph_lo = ph; a.ph_hi = ph + 1;
        hipLaunchKernelGGL(fwd_kernel, dim3(grid), dim3(NT), LDS_BYTES, stream, a);
    }
#endif
}
```

```cpp
#include <hip/hip_runtime.h>
#include <hip/hip_cooperative_groups.h>
#include <cstdio>
#include <cstdint>
namespace cg = cooperative_groups;

#ifndef N_LAUNCH_MODE
#define N_LAUNCH_MODE 1
#endif
#ifndef REPEAT_PHASE
#define REPEAT_PHASE -1
#endif
#ifndef ATT_REP
#define ATT_REP 1
#endif
#ifndef HG_REP
#define HG_REP 1
#endif
#ifndef STOP_AFTER
#define STOP_AFTER 99
#endif

typedef unsigned short bf16_t;
typedef short bf16x8 __attribute__((ext_vector_type(8)));
typedef float f32x4 __attribute__((ext_vector_type(4)));

constexpr int NT = 512;
constexpr int T = 16384, SEQ = 2048, NB = 8, DM = 1024, INW = 3264;
constexpr int OFF_Q = 0, OFF_FF = 512, OFF_FB = 1024, OFF_I = 1536, OFF_G = 2048, OFF_CQ = 2560, OFF_CKV = 2944, OFF_KR = 3200;
constexpr float EPS = 1e-6f;

constexpr size_t WS_CTL = 0;
constexpr size_t WS_WIN_T = 65536;
constexpr size_t WS_WQUP_T = WS_WIN_T + (size_t)3264 * 1024 * 2;
constexpr size_t WS_WKVUP_T = WS_WQUP_T + (size_t)768 * 384 * 2;
constexpr size_t WS_WOUT_T = WS_WKVUP_T + (size_t)1024 * 256 * 2;
constexpr size_t WS_WPQ_T = WS_WOUT_T + (size_t)1024 * 1024 * 2;
constexpr size_t WS_SUBK = WS_WPQ_T + (size_t)2048 * 1024 * 2;
constexpr size_t WS_LB = WS_SUBK + (size_t)16 * 128 * 128 * 2;
constexpr size_t WS_B = 15728640;
constexpr size_t WS_CQN = WS_B;
constexpr size_t WS_CKVN = WS_B + (size_t)T * 384 * 2;
constexpr size_t WS_C = WS_B + 33554432;
constexpr size_t WS_R = WS_C + 33554432;
constexpr size_t WS_PART = WS_C;
constexpr size_t WS_D = WS_C + (size_t)T * INW * 2;
constexpr size_t WS_Q = WS_D + 33554432;
constexpr size_t WS_KN = WS_Q + (size_t)T * 768 * 2;
constexpr size_t WS_VT = WS_KN + (size_t)T * 512 * 2;
constexpr size_t WS_KROPE = WS_VT + (size_t)T * 512 * 2;
constexpr size_t WS_TAIL = WS_KROPE + (size_t)T * 64 * 2;
constexpr size_t WS_ROPECS = WS_D;
constexpr size_t WS_U4 = WS_TAIL;
constexpr size_t WS_V4 = WS_U4 + (size_t)16384 * 512;
constexpr size_t WS_VSCALE = WS_V4 + (size_t)16384 * 512;
constexpr size_t WS_USCALE = WS_VSCALE + 65536;
constexpr size_t WS_USUM = WS_USCALE + 65536;
constexpr size_t WS_END = WS_USUM + 65536;
constexpr size_t WS_W16 = WS_KROPE;
constexpr size_t WS_IDX = WS_VT;
constexpr size_t WS_GATE = WS_VT + (size_t)T * 128 * 4;
constexpr size_t WS_ELIST = WS_D + 67108864;
constexpr size_t WS_COUNTS = WS_CTL + 16384;
constexpr size_t WS_BSTART = WS_CTL + 16384 + 32768;
static_assert(WS_ELIST + (size_t)T * 128 * 4 <= WS_VT, "edge list overflow");
static_assert(WS_LB + 4096 <= WS_B, "weights overflow");
static_assert(WS_D + (size_t)T * 2048 * 2 <= WS_IDX, "PQ overlaps IDX");
static_assert(WS_GATE + (size_t)T * 128 * 4 <= WS_VT + (size_t)T * 512 * 2, "gate overflow");
static_assert(WS_END <= 268435456, "workspace too big");

struct Args {
    const float* x; const int* pos; const float* attn_norm; const float* w_in; const float* lb_logits; const float* hg_o_norm;
    const float* q_a_norm; const float* w_q_up; const float* kv_a_norm; const float* w_kv_up; const float* q_norm; const float* k_norm;
    const float* mla_o_norm; const float* w_out; const float* ffn_norm; const float* peer_wq; const float* subk; const float* peer_u; const float* peer_v;
    float* out; unsigned char* ws; int ph_lo, ph_hi;
};

typedef __bf16 bf16v2 __attribute__((ext_vector_type(2)));
typedef float f32v2 __attribute__((ext_vector_type(2)));
__device__ __forceinline__ unsigned pack2(float lo, float hi) { const f32v2 v = {lo, hi}; return __builtin_bit_cast(unsigned, __builtin_convertvector(v, bf16v2)); }
__device__ __forceinline__ bf16_t f2bf(float f) { return (bf16_t)(pack2(f, 0.f) & 0xffffu); }
typedef _Float16 f16v2 __attribute__((ext_vector_type(2)));
__device__ __forceinline__ unsigned pack2h(float lo, float hi) { const f32v2 v = {lo, hi}; return __builtin_bit_cast(unsigned, __builtin_convertvector(v, f16v2)); }
__device__ __forceinline__ float frcp(float x) { return __builtin_amdgcn_rcpf(x); }
__device__ __forceinline__ float fexp2(float x) { return __builtin_amdgcn_exp2f(x); }
__device__ __forceinline__ float bf2f(bf16_t h) { return __uint_as_float(((unsigned)h) << 16); }
__device__ __forceinline__ float bflo(unsigned w) { return __uint_as_float(w << 16); }
__device__ __forceinline__ float bfhi(unsigned w) { return __uint_as_float(w & 0xffff0000u); }
__device__ __forceinline__ float wave_sum(float v) {
#pragma unroll
    for (int d = 32; d > 0; d >>= 1) v += __shfl_xor(v, d, 64);
    return v;
}
__device__ __forceinline__ f32x4 mfma16(bf16x8 a, bf16x8 b, f32x4 c) { return __builtin_amdgcn_mfma_f32_16x16x32_bf16(a, b, c, 0, 0, 0); }

__device__ const float ROPE_INV_FREQ[32] = {
    1.000000000e+00f, 7.498942018e-01f, 5.623413324e-01f, 4.216965139e-01f, 3.162277639e-01f, 2.371373922e-01f, 1.778279394e-01f, 1.333521456e-01f,
    1.000000015e-01f, 7.498941571e-02f, 5.623412877e-02f, 4.216964915e-02f, 3.162277862e-02f, 2.371373586e-02f, 1.778279431e-02f, 1.333521493e-02f,
    9.999999776e-03f, 7.498942316e-03f, 5.623413250e-03f, 4.216964822e-03f, 3.162277862e-03f, 2.371373819e-03f, 1.778279431e-03f, 1.333521446e-03f,
    1.000000047e-03f, 7.498941850e-04f, 5.623413017e-04f, 4.216965463e-04f, 3.162277862e-04f, 2.371373848e-04f, 1.778279402e-04f, 1.333521504e-04f};

template <int WAVES_M, int WAVES_N, int WM, int WN, bool ROWSS = false, class Epi>
__device__ __forceinline__ void gemm_block(const bf16_t* __restrict__ A, int lda, const bf16_t* __restrict__ Bt, int ldb, int K,
                                           int m0, int n0, int nrows_bt, unsigned char* lds, Epi& epi) {
    constexpr int BM = WAVES_M * WM * 16, BN = WAVES_N * WN * 16;
    constexpr int AI = BM / 64, BI = BN / 64;
    static_assert(WAVES_M * WAVES_N == 8, "8 waves");
    int tid = threadIdx.x; asm volatile("" : "+v"(tid));
    const int lane = tid & 63, wave = tid >> 6;
    const int wm = wave / WAVES_N, wn = wave % WAVES_N;
    const int r16 = lane & 15, g = lane >> 4;
    unsigned char* As = lds;
    unsigned char* Bs = lds + BM * 144;
    f32x4 acc[WM][WN];
#pragma unroll
    for (int i = 0; i < WM; ++i)
#pragma unroll
        for (int j = 0; j < WN; ++j) acc[i][j] = (f32x4){0.f, 0.f, 0.f, 0.f};
    uint4 ra0, ra1, ra2, ra3, rb0, rb1, rb2, rb3;
    float ssa0 = 0.f, ssa1 = 0.f, ssa2 = 0.f, ssa3 = 0.f;
    static_assert(AI <= 4 && BI <= 4, "stage regs");
#define GA_LOAD(i, k0) if constexpr (AI > i) { const int c = tid + i * NT, row = c >> 3, kc = c & 7; ra##i = *(const uint4*)(A + (size_t)(m0 + row) * lda + (k0) + kc * 8); }
#define GB_LOAD(i, k0) if constexpr (BI > i) { const int c = tid + i * NT, row = c >> 3, kc = c & 7; int rg = n0 + row; rg = rg < nrows_bt ? rg : nrows_bt - 1; rb##i = *(const uint4*)(Bt + (size_t)rg * ldb + (k0) + kc * 8); }
#define GA_STORE(i) if constexpr (AI > i) { const int c = tid + i * NT, row = c >> 3, kc = c & 7; *(uint4*)(As + row * 144 + kc * 16) = ra##i; \
        if constexpr (ROWSS) { const float x0 = bflo(ra##i.x), x1 = bfhi(ra##i.x), x2 = bflo(ra##i.y), x3 = bfhi(ra##i.y), x4 = bflo(ra##i.z), x5 = bfhi(ra##i.z), x6 = bflo(ra##i.w), x7 = bfhi(ra##i.w); \
            ssa##i += (x0 * x0 + x1 * x1) + (x2 * x2 + x3 * x3) + (x4 * x4 + x5 * x5) + (x6 * x6 + x7 * x7); } }
#define GB_STORE(i) if constexpr (BI > i) { const int c = tid + i * NT, row = c >> 3, kc = c & 7; *(uint4*)(Bs + row * 144 + kc * 16) = rb##i; }
    GA_LOAD(0, 0) GA_LOAD(1, 0) GA_LOAD(2, 0) GA_LOAD(3, 0) GB_LOAD(0, 0) GB_LOAD(1, 0) GB_LOAD(2, 0) GB_LOAD(3, 0)
    const int nk = K / 64;
    for (int kt = 0; kt < nk; ++kt) {
        __syncthreads();
        GA_STORE(0) GA_STORE(1) GA_STORE(2) GA_STORE(3) GB_STORE(0) GB_STORE(1) GB_STORE(2) GB_STORE(3)
        __syncthreads();
        if (kt + 1 < nk) {
            const int k0 = (kt + 1) * 64;
            GA_LOAD(0, k0) GA_LOAD(1, k0) GA_LOAD(2, k0) GA_LOAD(3, k0) GB_LOAD(0, k0) GB_LOAD(1, k0) GB_LOAD(2, k0) GB_LOAD(3, k0)
        }
#pragma unroll
        for (int kk = 0; kk < 2; ++kk) {
            bf16x8 af[WM];
#pragma unroll
            for (int i = 0; i < WM; ++i) af[i] = *(const bf16x8*)(As + ((wm * WM + i) * 16 + r16) * 144 + kk * 64 + g * 16);
#pragma unroll
            for (int j = 0; j < WN; ++j) {
                const bf16x8 bfr = *(const bf16x8*)(Bs + ((wn * WN + j) * 16 + r16) * 144 + kk * 64 + g * 16);
#pragma unroll
                for (int i = 0; i < WM; ++i) acc[i][j] = mfma16(bfr, af[i], acc[i][j]);
            }
        }
    }
#undef GA_LOAD
#undef GB_LOAD
#undef GA_STORE
#undef GB_STORE
    if constexpr (ROWSS) {
        float* rowss = (float*)(lds + 131072);
#define G_RSS(i) if constexpr (AI > i) { float v = ssa##i; v += __shfl_xor(v, 1, 64); v += __shfl_xor(v, 2, 64); v += __shfl_xor(v, 4, 64); if ((tid & 7) == 0) rowss[(tid >> 3) + 64 * i] = v; }
        G_RSS(0) G_RSS(1) G_RSS(2) G_RSS(3)
#undef G_RSS
        __syncthreads();
    }
    epi(acc, m0 + wm * WM * 16, n0 + wn * WN * 16, lane);
}

namespace g256 {
constexpr int BM = 256, BK = 64, HALF = 128, HT = HALF * BK;
__device__ __forceinline__ int lds_byte(int r, int c) { const int st = (r >> 4) * 2 + (c >> 5), rr = r & 15, cc = c & 31, ob = rr * 64 + cc * 2; return st * 1024 + (ob ^ (((ob >> 9) & 1) << 5)); }
__device__ __forceinline__ void stage_rc(int b, int& R, int& C) { const int st = b / 1024, sb = b % 1024, swz = sb ^ (((sb >> 9) & 1) << 5); R = (st >> 1) * 16 + swz / 64; C = (st & 1) * 32 + (swz % 64) / 2; }

template <class Epi>
__device__ __forceinline__ void tile(const bf16_t* __restrict__ A, const bf16_t* __restrict__ Bt, int K, int brow, int bcol, unsigned char* lds, Epi& epi) {
    bf16_t* shm = (bf16_t*)lds;
#define G_SA(b, h) (shm + ((b) * 2 + (h)) * HT)
#define G_SB(b, h) (shm + (4 + (b) * 2 + (h)) * HT)
#define G_STAGE(P, BASE, br, kt) do { const long _g = (long)(br) * K + (long)(kt) * BK; \
    _Pragma("unroll") for (int _i = 0; _i < 2; ++_i) { const int _b = tix * 16 + _i * 8192; int _r, _c; stage_rc(_b, _r, _c); \
      __builtin_amdgcn_global_load_lds((const unsigned*)(BASE + _g + (long)_r * K + _c), (unsigned*)((char*)(P) + _b), 16, 0, 0); } } while (0)
#define G_LDA(dst, b, h) _Pragma("unroll") for (int m = 0; m < 4; ++m) _Pragma("unroll") for (int k = 0; k < 2; ++k) \
    dst[m][k] = *reinterpret_cast<const bf16x8*>((char*)G_SA(b, h) + lds_byte(wr * 64 + m * 16 + fr, k * 32 + fq * 8))
#define G_LDB(dst, b, h) _Pragma("unroll") for (int n = 0; n < 2; ++n) _Pragma("unroll") for (int k = 0; k < 2; ++k) \
    dst[n][k] = *reinterpret_cast<const bf16x8*>((char*)G_SB(b, h) + lds_byte(wc * 32 + n * 16 + fr, k * 32 + fq * 8))
#define G_MMA(ai, bj, At, Bt_) do { __builtin_amdgcn_s_setprio(1); \
    _Pragma("unroll") for (int m = 0; m < 4; ++m) _Pragma("unroll") for (int n = 0; n < 2; ++n) _Pragma("unroll") for (int k = 0; k < 2; ++k) \
      acc[ai][bj][m][n] = __builtin_amdgcn_mfma_f32_16x16x32_bf16(Bt_[n][k], At[m][k], acc[ai][bj][m][n], 0, 0, 0); \
    __builtin_amdgcn_s_setprio(0); } while (0)
#define G_WAIT_V(n) asm volatile("s_waitcnt vmcnt(" #n ")" ::: "memory")
#define G_WAIT_L(n) asm volatile("s_waitcnt lgkmcnt(" #n ")" ::: "memory")
#define G_BAR __builtin_amdgcn_s_barrier()
#define G_SCHED __builtin_amdgcn_sched_barrier(0)
    int tix = threadIdx.x; asm volatile("" : "+v"(tix));
    const int wid = tix >> 6, lane = tix & 63, wr = wid >> 2, wc = wid & 3, fr = lane & 15, fq = lane >> 4;
    f32x4 acc[2][2][4][2];
#pragma unroll
    for (int i0 = 0; i0 < 2; ++i0)
#pragma unroll
        for (int i1 = 0; i1 < 2; ++i1)
#pragma unroll
            for (int i2 = 0; i2 < 4; ++i2)
#pragma unroll
                for (int i3 = 0; i3 < 2; ++i3) acc[i0][i1][i2][i3] = (f32x4){0.f, 0.f, 0.f, 0.f};
    bf16x8 At[4][2], B0[2][2], B1[2][2];
    const int nt = K / BK;
    G_STAGE(G_SB(0, 0), Bt, bcol, 0); G_STAGE(G_SA(0, 0), A, brow, 0);
    G_STAGE(G_SB(0, 1), Bt, bcol + HALF, 0); G_STAGE(G_SA(0, 1), A, brow + HALF, 0);
    if (wr == 1) G_BAR;
    G_WAIT_V(4); G_BAR;
    G_STAGE(G_SB(1, 0), Bt, bcol, 1); G_STAGE(G_SA(1, 0), A, brow, 1); G_STAGE(G_SB(1, 1), Bt, bcol + HALF, 1);
    G_WAIT_V(6); G_BAR;
    for (int t = 0; t < nt - 2; t += 2) {
        G_LDB(B0, 0, 0); G_SCHED; G_LDA(At, 0, 0); G_STAGE(G_SA(1, 1), A, brow + HALF, t + 1);
        G_WAIT_L(8); G_BAR; G_WAIT_L(0); G_MMA(0, 0, At, B0); G_BAR; G_SCHED;
        G_LDB(B1, 0, 1); G_STAGE(G_SB(0, 0), Bt, bcol, t + 2);
        G_BAR; G_WAIT_L(0); G_MMA(0, 1, At, B1); G_BAR;
        G_LDA(At, 0, 1); G_STAGE(G_SA(0, 0), A, brow, t + 2);
        G_BAR; G_WAIT_L(0); G_MMA(1, 0, At, B0); G_BAR; G_SCHED;
        G_STAGE(G_SB(0, 1), Bt, bcol + HALF, t + 2);
        G_WAIT_V(6); G_BAR; G_MMA(1, 1, At, B1); G_BAR;
        G_LDB(B0, 1, 0); G_SCHED; G_LDA(At, 1, 0); G_STAGE(G_SA(0, 1), A, brow + HALF, t + 2);
        G_WAIT_L(8); G_BAR; G_WAIT_L(0); G_MMA(0, 0, At, B0); G_BAR; G_SCHED;
        G_LDB(B1, 1, 1); G_STAGE(G_SB(1, 0), Bt, bcol, t + 3);
        G_BAR; G_WAIT_L(0); G_MMA(0, 1, At, B1); G_BAR;
        G_LDA(At, 1, 1); G_STAGE(G_SA(1, 0), A, brow, t + 3);
        G_BAR; G_WAIT_L(0); G_MMA(1, 0, At, B0); G_BAR; G_SCHED;
        G_STAGE(G_SB(1, 1), Bt, bcol + HALF, t + 3);
        G_WAIT_V(6); G_BAR; G_MMA(1, 1, At, B1); G_BAR;
    }
    { G_LDB(B0, 0, 0); G_LDA(At, 0, 0); G_STAGE(G_SA(1, 1), A, brow + HALF, nt - 1);
      G_BAR; G_WAIT_L(0); G_MMA(0, 0, At, B0); G_BAR;
      G_LDB(B1, 0, 1); G_BAR; G_WAIT_L(0); G_MMA(0, 1, At, B1); G_BAR;
      G_LDA(At, 0, 1); G_WAIT_V(4); G_BAR; G_WAIT_L(0); G_MMA(1, 0, At, B0); G_MMA(1, 1, At, B1); G_BAR; }
    { G_LDB(B0, 1, 0); G_LDA(At, 1, 0); G_WAIT_V(2); G_BAR; G_WAIT_L(0); G_MMA(0, 0, At, B0); G_BAR;
      G_LDB(B1, 1, 1); G_WAIT_V(0); G_BAR; G_WAIT_L(0); G_MMA(0, 1, At, B1); G_BAR;
      G_LDA(At, 1, 1); G_BAR; G_WAIT_L(0); G_MMA(1, 0, At, B0); G_MMA(1, 1, At, B1); G_BAR; }
    if (wr == 0) G_BAR;
    epi(acc, brow + wr * 64 + fr, bcol + wc * 32 + 4 * fq);
#undef G_SA
#undef G_SB
#undef G_STAGE
#undef G_LDA
#undef G_LDB
#undef G_MMA
#undef G_WAIT_V
#undef G_WAIT_L
#undef G_BAR
#undef G_SCHED
}
__device__ __forceinline__ bool next_tile(int L, int nM, int nN, int& pm, int& pn) {
    const int nwg = nM * nN; if (L >= nwg) return false;
    int wgid = L; { const int q = nwg / 8, r = nwg % 8, xcd = wgid % 8, off = wgid / 8; wgid = (xcd < r ? xcd * (q + 1) : r * (q + 1) + (xcd - r) * q) + off; }
    const int WGM = 8, nig = WGM * nN, gid = wgid / nig, fm = gid * WGM, gsz = (nM - fm) < WGM ? (nM - fm) : WGM;
    pm = fm + ((wgid % nig) % gsz); pn = (wgid % nig) / gsz; return true;
}
struct EpiBf16 { bf16_t* O; int ldc;
    __device__ __forceinline__ void operator()(const f32x4 (&acc)[2][2][4][2], int row0, int col0) const {
#pragma unroll
        for (int ai = 0; ai < 2; ++ai)
#pragma unroll
            for (int m = 0; m < 4; ++m) { bf16_t* rp = O + (size_t)(row0 + ai * 128 + m * 16) * ldc + col0;
#pragma unroll
                for (int bj = 0; bj < 2; ++bj)
#pragma unroll
                    for (int n = 0; n < 2; ++n) { const f32x4 v = acc[ai][bj][m][n]; uint2 w; w.x = pack2(v[0], v[1]); w.y = pack2(v[2], v[3]); *(uint2*)(rp + bj * 128 + n * 16) = w; } }
    }
};
struct EpiResid { const float* X; bf16_t* O; float* PART; unsigned char* lds;
    __device__ __forceinline__ void operator()(const f32x4 (&acc)[2][2][4][2], int row0, int col0) const {
        float* red = (float*)lds;
        const int wc = (col0 & 255) >> 5, fq = (col0 & 31) >> 2, rl0 = row0 & 255;
        __syncthreads();
#pragma unroll
        for (int ai = 0; ai < 2; ++ai)
#pragma unroll
            for (int m = 0; m < 4; ++m) { const size_t ro = (size_t)(row0 + ai * 128 + m * 16) * DM + col0; float ss = 0.f;
#pragma unroll
                for (int bj = 0; bj < 2; ++bj)
#pragma unroll
                    for (int n = 0; n < 2; ++n) { const size_t off = ro + bj * 128 + n * 16; const f32x4 v = *(const f32x4*)(X + off) + acc[ai][bj][m][n];
                        ss += v[0] * v[0] + v[1] * v[1] + v[2] * v[2] + v[3] * v[3];
                        uint2 w; w.x = pack2(v[0], v[1]); w.y = pack2(v[2], v[3]); *(uint2*)(O + off) = w; }
                ss += __shfl_xor(ss, 16, 64); ss += __shfl_xor(ss, 32, 64);
                if (fq == 0) red[wc * 256 + rl0 + ai * 128 + m * 16] = ss; }
        __syncthreads();
        if (threadIdx.x < 256) { const int r = threadIdx.x; PART[(size_t)(col0 >> 8) * T + (row0 & ~255) + r] = (red[r] + red[256 + r]) + (red[512 + r] + red[768 + r]); }
    }
};
struct EpiBf16Silu { bf16_t* O; int ldc; int nsilu;
    __device__ __forceinline__ void operator()(const f32x4 (&acc)[2][2][4][2], int row0, int col0) const {
        const bool sl = col0 < nsilu;
#pragma unroll
        for (int ai = 0; ai < 2; ++ai)
#pragma unroll
            for (int m = 0; m < 4; ++m) { bf16_t* rp = O + (size_t)(row0 + ai * 128 + m * 16) * ldc + col0;
#pragma unroll
                for (int bj = 0; bj < 2; ++bj)
#pragma unroll
                    for (int n = 0; n < 2; ++n) { f32x4 v = acc[ai][bj][m][n];
                        if (sl) {
#pragma unroll
                            for (int r = 0; r < 4; ++r) v[r] = v[r] * frcp(1.f + __expf(-v[r])); }
                        uint2 w; w.x = pack2(v[0], v[1]); w.y = pack2(v[2], v[3]); *(uint2*)(rp + bj * 128 + n * 16) = w; } }
    }
};
}

template <int WM_, int WN_> struct EpiBf16 {
    bf16_t* O; int ldc; int ncols;
    __device__ __forceinline__ void operator()(const f32x4 (&acc)[WM_][WN_], int mb, int nb, int lane) const {
        const int r16 = lane & 15, g = lane >> 4;
#pragma unroll
        for (int i = 0; i < WM_; ++i)
#pragma unroll
            for (int j = 0; j < WN_; ++j) {
                const int row = mb + i * 16 + r16, col = nb + j * 16 + 4 * g;
                if (col < ncols) { uint2 w; w.x = pack2(acc[i][j][0], acc[i][j][1]); w.y = pack2(acc[i][j][2], acc[i][j][3]); *(uint2*)(O + (size_t)row * ldc + col) = w; }
            }
    }
};
struct EpiQ {
    bf16_t* Q; const float* q_norm; const float* ropecs; const float* rowss;
    __device__ __forceinline__ void operator()(const f32x4 (&accs)[2][12], int mb, int nb, int lane) const {
      const int r16 = lane & 15, g = lane >> 4;
#pragma unroll
      for (int mi = 0; mi < 2; ++mi) {
        const f32x4 (&accm)[12] = accs[mi];
        const int row = mb + mi * 16 + r16, h = nb / 192;
        float ssn = 0.f, ssr = 0.f;
#pragma unroll
        for (int j = 0; j < 8; ++j)
#pragma unroll
            for (int r = 0; r < 4; ++r) ssn += accm[j][r] * accm[j][r];
#pragma unroll
        for (int j = 8; j < 12; ++j)
#pragma unroll
            for (int r = 0; r < 4; ++r) ssr += accm[j][r] * accm[j][r];
        ssn += __shfl_xor(ssn, 16, 64); ssn += __shfl_xor(ssn, 32, 64);
        ssr += __shfl_xor(ssr, 16, 64); ssr += __shfl_xor(ssr, 32, 64);
        const float SC = 0.07216878364870322f * 1.4426950408889634f;
        const float rq = rsqrtf(rowss[row & 255] * (1.f / 384.f) + EPS), rq2 = rq * rq;
        const float rn = rq * rsqrtf(rq2 * ssn * (1.f / 128.f) + EPS) * SC, rr = rq * rsqrtf(rq2 * ssr * (1.f / 64.f) + EPS) * SC;
        bf16_t* qrow = Q + ((size_t)row * 4 + h) * 192;
#pragma unroll
        for (int j = 0; j < 8; ++j) {
            const int c = j * 16 + 4 * g;
            const f32x4 gn = *(const f32x4*)(q_norm + c);
            uint2 w; w.x = pack2(accm[j][0] * rn * gn[0], accm[j][1] * rn * gn[1]); w.y = pack2(accm[j][2] * rn * gn[2], accm[j][3] * rn * gn[3]);
            *(uint2*)(qrow + c) = w;
        }
#pragma unroll
        for (int j = 0; j < 2; ++j) {
            const int jj = j * 16 + 4 * g;
            const f32x4 g1 = *(const f32x4*)(q_norm + 128 + jj), g2 = *(const f32x4*)(q_norm + 160 + jj);
            float o1[4], o2[4];
#pragma unroll
            for (int r = 0; r < 4; ++r) {
                const float2 cs = *(const float2*)(ropecs + ((size_t)row * 32 + jj + r) * 2);
                const float a1 = accm[8 + j][r] * rr * g1[r], a2 = accm[10 + j][r] * rr * g2[r];
                o1[r] = a1 * cs.x - a2 * cs.y; o2[r] = a2 * cs.x + a1 * cs.y;
            }
            uint2 w; w.x = pack2(o1[0], o1[1]); w.y = pack2(o1[2], o1[3]); *(uint2*)(qrow + 128 + jj) = w;
            w.x = pack2(o2[0], o2[1]); w.y = pack2(o2[2], o2[3]); *(uint2*)(qrow + 160 + jj) = w;
        }
      }
    }
};
template <int WMK> struct EpiKV {
    bf16_t* KN; bf16_t* VT; const float* k_norm; const float* rowss;
    __device__ __forceinline__ void operator()(const f32x4 (&accs)[WMK][16], int mb, int nb, int lane) const {
      const int r16 = lane & 15, g = lane >> 4;
#pragma unroll
      for (int mi = 0; mi < WMK; ++mi) {
        const f32x4 (&accm)[16] = accs[mi];
        const int row = mb + mi * 16 + r16, h = nb / 256;
        float ssn = 0.f;
#pragma unroll
        for (int j = 0; j < 8; ++j)
#pragma unroll
            for (int r = 0; r < 4; ++r) ssn += accm[j][r] * accm[j][r];
        ssn += __shfl_xor(ssn, 16, 64); ssn += __shfl_xor(ssn, 32, 64);
        const float rk = rsqrtf(rowss[row & 127] * (1.f / 256.f) + EPS);
        const float rn = rk * rsqrtf(rk * rk * ssn * (1.f / 128.f) + EPS);
        bf16_t* krow = KN + ((size_t)row * 4 + h) * 128;
#pragma unroll
        for (int j = 0; j < 8; ++j) {
            const int c = j * 16 + 4 * g;
            const f32x4 gn = *(const f32x4*)(k_norm + c);
            uint2 w; w.x = pack2(accm[j][0] * rn * gn[0], accm[j][1] * rn * gn[1]); w.y = pack2(accm[j][2] * rn * gn[2], accm[j][3] * rn * gn[3]);
            *(uint2*)(krow + c) = w;
        }
        const int b = row >> 11, s = row & 2047;
        bf16_t* vp = VT + ((size_t)(b * 4 + h) * 128 + 4 * g) * SEQ + s;
#pragma unroll
        for (int j = 0; j < 8; ++j) {
            asm volatile("" : "+v"(vp));
            vp[0] = f2bf(accm[8 + j][0] * rk); vp[SEQ] = f2bf(accm[8 + j][1] * rk); vp[2 * SEQ] = f2bf(accm[8 + j][2] * rk); vp[3 * SEQ] = f2bf(accm[8 + j][3] * rk);
            vp += 16 * SEQ;
        }
      }
    }
};

__device__ void transpose_convert(const float* __restrict__ W, bf16_t* __restrict__ Wt, int K, int N, unsigned char* lds, int bid, int nblk, const float* __restrict__ kscale = nullptr) {
    bf16_t* tile = (bf16_t*)lds;
    const int tid = threadIdx.x;
    const int tk = K / 64, tn = N / 64;
    for (int t = bid; t < tk * tn; t += nblk) {
        const int k0 = (t / tn) * 64, n0 = (t % tn) * 64;
        __syncthreads();
#pragma unroll
        for (int p = 0; p < 2; ++p) {
            const int kk = (tid >> 4) + p * 32, n4 = (tid & 15) * 4;
            f32x4 v = *(const f32x4*)(W + (size_t)(k0 + kk) * N + n0 + n4);
            if (kscale) v *= kscale[k0 + kk];
#pragma unroll
            for (int r = 0; r < 4; ++r) tile[(n4 + r) * 66 + kk] = f2bf(v[r]);
        }
        __syncthreads();
        {
            const int nn = tid >> 3, k8 = (tid & 7) * 8;
            unsigned w[4];
#pragma unroll
            for (int r = 0; r < 4; ++r) w[r] = (unsigned)tile[nn * 66 + k8 + 2 * r] | ((unsigned)tile[nn * 66 + k8 + 2 * r + 1] << 16);
            *(uint4*)(Wt + (size_t)(n0 + nn) * K + k0 + k8) = make_uint4(w[0], w[1], w[2], w[3]);
        }
    }
    __syncthreads();
}

__device__ void rmsnorm_rows(const float* __restrict__ X, const float* __restrict__ gain, bf16_t* __restrict__ O, int gw, int nw) {
    const int lane = threadIdx.x & 63;
    for (int row = gw; row < T; row += nw) {
        const float* xr = X + (size_t)row * DM;
        f32x4 v[4]; float ss = 0.f;
#pragma unroll
        for (int i = 0; i < 4; ++i) { v[i] = *(const f32x4*)(xr + i * 256 + lane * 4); ss += v[i][0] * v[i][0] + v[i][1] * v[i][1] + v[i][2] * v[i][2] + v[i][3] * v[i][3]; }
        ss = wave_sum(ss);
        const float rs = rsqrtf(ss * (1.f / 1024.f) + EPS);
#pragma unroll
        for (int i = 0; i < 4; ++i) {
            const f32x4 gn = *(const f32x4*)(gain + i * 256 + lane * 4);
            uint2 w; w.x = pack2(v[i][0] * rs * gn[0], v[i][1] * rs * gn[1]); w.y = pack2(v[i][2] * rs * gn[2], v[i][3] * rs * gn[3]);
            *(uint2*)(O + (size_t)row * DM + i * 256 + lane * 4) = w;
        }
    }
}

__device__ void phase0(const Args& a, unsigned char* lds) {
    unsigned char* ws = a.ws;
    const int bid = blockIdx.x, nblk = gridDim.x, tid = threadIdx.x;
    transpose_convert(a.w_in, (bf16_t*)(ws + WS_WIN_T), 1024, 3264, lds, bid, nblk);
    transpose_convert(a.w_q_up, (bf16_t*)(ws + WS_WQUP_T), 384, 768, lds, bid, nblk, a.q_a_norm);
    transpose_convert(a.w_kv_up, (bf16_t*)(ws + WS_WKVUP_T), 256, 1024, lds, bid, nblk, a.kv_a_norm);
    transpose_convert(a.w_out, (bf16_t*)(ws + WS_WOUT_T), 1024, 1024, lds, bid, nblk);
    transpose_convert(a.peer_wq, (bf16_t*)(ws + WS_WPQ_T), 1024, 2048, lds, bid, nblk, a.ffn_norm);
    const int gt = bid * NT + tid, ngt = nblk * NT;
    bf16_t* sk = (bf16_t*)(ws + WS_SUBK);
    for (int i = gt; i < 16 * 128 * 128; i += ngt) sk[i] = f2bf(a.subk[i]);
    float* lb = (float*)(ws + WS_LB);
    for (int i = gt; i < 1024; i += ngt) { const float l0 = a.lb_logits[i], l1 = a.lb_logits[1024 + i]; lb[i] = 1.f / (1.f + expf(l1 - l0)); }
    { float* ROPECS = (float*)(ws + WS_ROPECS);
      for (int i = gt; i < T * 32; i += ngt) { float sn, cs; sincosf((float)a.pos[i >> 5] * ROPE_INV_FREQ[i & 31], &sn, &cs); *(float2*)(ROPECS + (size_t)i * 2) = make_float2(cs, sn); } }
    rmsnorm_rows(a.x, a.attn_norm, (bf16_t*)(ws + WS_B), bid * 8 + (tid >> 6), nblk * 8);
}

__device__ void phase1(const Args& a, unsigned char* lds) {
    unsigned char* ws = a.ws;
    const bf16_t* H = (const bf16_t*)(ws + WS_B); const bf16_t* W = (const bf16_t*)(ws + WS_WIN_T);
    g256::EpiBf16Silu e{(bf16_t*)(ws + WS_C), INW, 512};
    for (int i = 0;; ++i) { int pm, pn; if (!g256::next_tile(i * gridDim.x + blockIdx.x, 64, 12, pm, pn)) break;
        __syncthreads();
        g256::tile(H, W, DM, pm * 256, pn * 256, lds, e); }
    __syncthreads();
    EpiBf16<1, 6> e2{(bf16_t*)(ws + WS_C), INW, INW};
    for (int t = blockIdx.x; t < 256; t += gridDim.x)
        gemm_block<4, 2, 1, 6>(H, DM, W, DM, DM, t * 64, 3072, INW, lds, e2);
}

__device__ void phase3(const Args& a, unsigned char* lds) {
    unsigned char* ws = a.ws;
    const bf16_t* PROJ = (const bf16_t*)(ws + WS_C);
    {
        bf16_t* KROPE = (bf16_t*)(ws + WS_KROPE); const float* ROPECS = (const float*)(ws + WS_ROPECS);
        const int lane = threadIdx.x & 63, wave = threadIdx.x >> 6;
        const float gr = a.k_norm[128 + lane];
        for (int tb = blockIdx.x * 64 + wave * 8; tb < T; tb += gridDim.x * 64)
#pragma unroll 1
            for (int half = 0; half < 2; ++half) {
                float vr[4], sr[4]; float2 cs[4];
#pragma unroll
                for (int u = 0; u < 4; ++u) { const int t = tb + half * 4 + u; vr[u] = bf2f(PROJ[(size_t)t * INW + OFF_KR + lane]); cs[u] = *(const float2*)(ROPECS + ((size_t)t * 32 + (lane & 31)) * 2); sr[u] = vr[u] * vr[u]; }
#pragma unroll
                for (int d = 32; d > 0; d >>= 1)
#pragma unroll
                    for (int u = 0; u < 4; ++u) sr[u] += __shfl_xor(sr[u], d, 64);
#pragma unroll
                for (int u = 0; u < 4; ++u) { const int t = tb + half * 4 + u;
                    const float xn = vr[u] * rsqrtf(sr[u] * (1.f / 64.f) + EPS) * gr, other = __shfl_xor(xn, 32, 64);
                    KROPE[(size_t)t * 64 + lane] = f2bf((lane < 32) ? (xn * cs[u].x - other * cs[u].y) : (xn * cs[u].x + other * cs[u].y)); }
            }
    }
    const float* rowss = (const float*)(lds + 131072);
    EpiQ eq{(bf16_t*)(ws + WS_Q), a.q_norm, (const float*)(ws + WS_ROPECS), rowss};
    EpiKV<1> ekv{(bf16_t*)(ws + WS_KN), (bf16_t*)(ws + WS_VT), a.k_norm, rowss};
    for (int t = blockIdx.x; t < 768; t += gridDim.x) {
        __syncthreads();
        if (t < 256) { const int mt = t >> 2, h = t & 3;
            gemm_block<8, 1, 2, 12, true>(PROJ + OFF_CQ, INW, (const bf16_t*)(ws + WS_WQUP_T), 384, 384, mt * 256, h * 192, 768, lds, eq);
        } else { const int u = t - 256, mt = u >> 2, h = u & 3;
            gemm_block<8, 1, 1, 16, true>(PROJ + OFF_CKV, INW, (const bf16_t*)(ws + WS_WKVUP_T), 256, 256, mt * 128, h * 256, 1024, lds, ekv);
        }
    }
}

constexpr int AT_KROW = 400, AT_VROW = 144, AT_KBYTES = 64 * AT_KROW, AT_VBYTES = 128 * AT_VROW, AT_BUF = AT_KBYTES + AT_VBYTES;
__device__ void attn_item(const Args& a, int item, unsigned char* lds) {
    unsigned char* ws = a.ws;
    const bf16_t* Q = (const bf16_t*)(ws + WS_Q); const bf16_t* KN = (const bf16_t*)(ws + WS_KN);
    const bf16_t* KR = (const bf16_t*)(ws + WS_KROPE); const bf16_t* VT = (const bf16_t*)(ws + WS_VT);
    bf16_t* YCAT = (bf16_t*)(ws + WS_B);
    const int qb = item & 7, h = (item >> 3) & 3, b = item >> 5;
    const int tid = threadIdx.x, lane = tid & 63, wave = tid >> 6, r16 = lane & 15, g = lane >> 4;
    const unsigned kn_off = (unsigned)((((size_t)b * SEQ + (tid >> 4)) * 4 + h) * 128 + (tid & 15) * 8);
    const unsigned kr_off = (unsigned)(((size_t)b * SEQ + (tid >> 3)) * 64 + (tid & 7) * 8);
    const unsigned vt_off = (unsigned)(((size_t)(b * 4 + h) * 128 + (tid >> 3)) * SEQ + (tid & 7) * 8);
    const int kn_dst = (tid >> 4) * AT_KROW + (tid & 15) * 16, kr_dst = (tid >> 3) * AT_KROW + 256 + (tid & 7) * 16;
    const int v_dst = AT_KBYTES + (tid >> 3) * AT_VROW + (tid & 7) * 16;
    bf16x8 qf[2][6];
#pragma unroll
    for (int qs = 0; qs < 2; ++qs) {
        const size_t tq = (size_t)b * SEQ + qb * 256 + wave * 32 + qs * 16 + r16;
#pragma unroll
        for (int kk = 0; kk < 6; ++kk) qf[qs][kk] = *(const bf16x8*)(Q + (tq * 4 + h) * 192 + kk * 32 + 8 * g);
    }
    f32x4 O[2][8];
#pragma unroll
    for (int qs = 0; qs < 2; ++qs)
#pragma unroll
        for (int d = 0; d < 8; ++d) O[qs][d] = (f32x4){0.f, 0.f, 0.f, 0.f};
    float m_run[2] = {0.f, 0.f}, l_part[2] = {0.f, 0.f};
    uint4 sk0, sk1, sk2, sv0, sv1;
#define AT_GLOADK(tile) do { \
        sk0 = *(const uint4*)(KN + kn_off + (size_t)(tile) * (64 * 512)); sk1 = *(const uint4*)(KN + kn_off + 32 * 512 + (size_t)(tile) * (64 * 512)); \
        sk2 = *(const uint4*)(KR + kr_off + (size_t)(tile) * (64 * 64)); } while (0)
#define AT_GLOADV(tile) do { \
        sv0 = *(const uint4*)(VT + vt_off + (size_t)(tile) * 64); sv1 = *(const uint4*)(VT + vt_off + (size_t)64 * SEQ + (size_t)(tile) * 64); } while (0)
#define AT_LSTOREK(buf) do { unsigned char* bb = lds + (buf) * AT_BUF; \
        *(uint4*)(bb + kn_dst) = sk0; *(uint4*)(bb + kn_dst + 32 * AT_KROW) = sk1; *(uint4*)(bb + kr_dst) = sk2; } while (0)
#define AT_LSTOREV(buf) do { unsigned char* bb = lds + (buf) * AT_BUF; \
        *(uint4*)(bb + v_dst) = sv0; *(uint4*)(bb + v_dst + 64 * AT_VROW) = sv1; } while (0)
    __syncthreads();
    AT_GLOADK(0); AT_GLOADV(0);
    AT_LSTOREK(0); AT_LSTOREV(0);
    __syncthreads();
    constexpr int NTILE = SEQ / 64;
    for (int t = 0; t < NTILE; ++t) {
        if (t + 1 < NTILE) AT_GLOADK(t + 1);
        const unsigned char* kb = lds + (t & 1) * AT_BUF;
        const unsigned char* vb = kb + AT_KBYTES;
        f32x4 S[2][4];
#pragma unroll
        for (int qs = 0; qs < 2; ++qs)
#pragma unroll
            for (int j = 0; j < 4; ++j) { const float nm = -m_run[qs]; S[qs][j] = (f32x4){nm, nm, nm, nm}; }
#pragma unroll
        for (int j = 0; j < 4; ++j) {
            const int krow = (j >> 1) * 32 + 8 * (r16 >> 2) + 4 * (j & 1) + (r16 & 3);
#pragma unroll
            for (int kk = 0; kk < 6; ++kk) {
                const bf16x8 kf = *(const bf16x8*)(kb + krow * AT_KROW + kk * 64 + g * 16);
                S[0][j] = mfma16(kf, qf[0][kk], S[0][j]);
                S[1][j] = mfma16(kf, qf[1][kk], S[1][j]);
            }
        }
        if (t + 1 < NTILE) { AT_LSTOREK((t + 1) & 1); AT_GLOADV(t + 1); }
        bf16x8 pf[2][2];
#pragma unroll
        for (int qs = 0; qs < 2; ++qs) {
            float mx = -1e30f;
#pragma unroll
            for (int j = 0; j < 4; ++j) mx = fmaxf(mx, fmaxf(fmaxf(S[qs][j][0], S[qs][j][1]), fmaxf(S[qs][j][2], S[qs][j][3])));
            mx = fmaxf(mx, __shfl_xor(mx, 16, 64)); mx = fmaxf(mx, __shfl_xor(mx, 32, 64));
            if (t == 0 || !__all(mx <= 8.f)) {
                const float delta = (t == 0) ? mx : fmaxf(mx, 0.f);
                m_run[qs] += delta;
#pragma unroll
                for (int j = 0; j < 4; ++j) { S[qs][j][0] -= delta; S[qs][j][1] -= delta; S[qs][j][2] -= delta; S[qs][j][3] -= delta; }
                if (t != 0) {
                    const float alpha = fexp2(-delta);
                    l_part[qs] *= alpha;
#pragma unroll
                    for (int d = 0; d < 8; ++d) O[qs][d] *= alpha;
                }
            }
            float ps = 0.f;
#pragma unroll
            for (int grp = 0; grp < 2; ++grp) {
                float pv[8];
#pragma unroll
                for (int jj = 0; jj < 8; ++jj) { pv[jj] = fexp2(S[qs][grp * 2 + (jj >> 2)][jj & 3]); ps += pv[jj]; }
                union { uint4 u; bf16x8 v; } cv; cv.u = make_uint4(pack2(pv[0], pv[1]), pack2(pv[2], pv[3]), pack2(pv[4], pv[5]), pack2(pv[6], pv[7]));
                pf[qs][grp] = cv.v;
            }
            l_part[qs] += ps;
        }
        __builtin_amdgcn_s_setprio(1);
#pragma unroll
        for (int grp = 0; grp < 2; ++grp)
#pragma unroll
            for (int d = 0; d < 8; ++d) {
                const bf16x8 vf = *(const bf16x8*)(vb + (d * 16 + r16) * AT_VROW + grp * 64 + g * 16);
                O[0][d] = mfma16(vf, pf[0][grp], O[0][d]);
                O[1][d] = mfma16(vf, pf[1][grp], O[1][d]);
            }
        __builtin_amdgcn_s_setprio(0);
        if (t + 1 < NTILE) AT_LSTOREV((t + 1) & 1);
        __syncthreads();
    }
#undef AT_GLOADK
#undef AT_GLOADV
#undef AT_LSTOREK
#undef AT_LSTOREV
#pragma unroll
    for (int qs = 0; qs < 2; ++qs) {
        float l = l_part[qs]; l += __shfl_xor(l, 16, 64); l += __shfl_xor(l, 32, 64);
        const float inv = frcp(l);
        float ss = 0.f;
#pragma unroll
        for (int d = 0; d < 8; ++d) { O[qs][d] *= inv; ss += O[qs][d][0] * O[qs][d][0] + O[qs][d][1] * O[qs][d][1] + O[qs][d][2] * O[qs][d][2] + O[qs][d][3] * O[qs][d][3]; }
        ss += __shfl_xor(ss, 16, 64); ss += __shfl_xor(ss, 32, 64);
        const float rs = rsqrtf(ss * (1.f / 128.f) + EPS);
        const size_t tq = (size_t)b * SEQ + qb * 256 + wave * 32 + qs * 16 + r16;
#pragma unroll
        for (int d = 0; d < 8; ++d) {
            const int dv = d * 16 + 4 * g;
            const f32x4 gn = *(const f32x4*)(a.mla_o_norm + h * 128 + dv);
            uint2 w; w.x = pack2(O[qs][d][0] * rs * gn[0], O[qs][d][1] * rs * gn[1]); w.y = pack2(O[qs][d][2] * rs * gn[2], O[qs][d][3] * rs * gn[3]);
            *(uint2*)(YCAT + tq * DM + 512 + h * 128 + dv) = w;
        }
    }
}

constexpr int HG_E = 0;
constexpr int HG_EL = HG_E + 64 * 132 * 4;
constexpr int HG_QT = HG_EL + 1024;
constexpr int HG_QH = HG_QT + 17408;
constexpr int HG_KD = HG_QH + 17408;
constexpr int HG_K10 = HG_KD + 17408;
constexpr int HG_VT = HG_K10 + 8704;
constexpr int HG_SM = HG_VT + 2 * 9216;
constexpr int HG_STB = HG_SM + 9216;
constexpr int HG_LDS = HG_STB + 2 * 17408;
__device__ void hgrn_item(const Args& a, int item, unsigned char* lds) {
    unsigned char* ws = a.ws;
    const bf16_t* PROJ = (const bf16_t*)(ws + WS_C);
    const float* LB = (const float*)(ws + WS_LB);
    bf16_t* OHG = (bf16_t*)(ws + WS_D);
    const int vs = item & 1, dir = (item >> 1) & 1, h = (item >> 2) & 3, b = item >> 4;
    const int tid = threadIdx.x, lane = tid & 63, wave = tid >> 6, r16 = lane & 15, g = lane >> 4;
    float* E = (float*)(lds + HG_E); float* EL = (float*)(lds + HG_EL);
    bf16_t* Qt = (bf16_t*)(lds + HG_QT); bf16_t* Qh = (bf16_t*)(lds + HG_QH); bf16_t* Kd = (bf16_t*)(lds + HG_KD); bf16_t* K10 = (bf16_t*)(lds + HG_K10);
    bf16_t* vT = (bf16_t*)(lds + HG_VT); bf16_t* Sm = (bf16_t*)(lds + HG_SM); bf16_t* STb = (bf16_t*)(lds + HG_STB);
    const int kB = wave * 16 + r16;
    const float lbk = LB[dir * 512 + h * 128 + kB];
    const int offf = dir ? OFF_FB : OFF_FF;
    const int rowA = tid >> 4, k8A = (tid & 15) * 8;
    const int vrow = tid >> 3, vc8 = (tid & 7) * 8;
    const size_t tokbase = (size_t)b * SEQ;
    __syncthreads();
    for (int i = tid; i < 2 * 64 * 136; i += NT) STb[i] = 0;
    f32x4 accS[4]; accS[0] = (f32x4){0.f, 0.f, 0.f, 0.f}; accS[1] = accS[0]; accS[2] = accS[0]; accS[3] = accS[0];
    unsigned short fB[16]; uint4 qA0, qA1, vA;
#define HG_PREFETCH(n) do { \
        _Pragma("unroll") for (int sc = 0; sc < 2; ++sc) _Pragma("unroll") for (int jj = 0; jj < 8; ++jj) { \
            const int tau = (n) * 64 + sc * 32 + g * 8 + jj, tt = dir ? (SEQ - 1 - tau) : tau; \
            fB[sc * 8 + jj] = PROJ[(tokbase + tt) * INW + offf + h * 128 + kB]; } \
        { const int tau = (n) * 64 + rowA, tt = dir ? (SEQ - 1 - tau) : tau; qA0 = *(const uint4*)(PROJ + (tokbase + tt) * INW + OFF_Q + h * 128 + k8A); } \
        { const int tau = (n) * 64 + rowA + 32, tt = dir ? (SEQ - 1 - tau) : tau; qA1 = *(const uint4*)(PROJ + (tokbase + tt) * INW + OFF_Q + h * 128 + k8A); } \
        { const int tau = (n) * 64 + vrow, tt = dir ? (SEQ - 1 - tau) : tau; vA = *(const uint4*)(PROJ + (tokbase + tt) * INW + OFF_I + h * 128 + vs * 64 + vc8); } \
    } while (0)
    HG_PREFETCH(0);
    for (int n = 0; n < 32; ++n) {
        bf16_t* vTn = vT + (n & 1) * (64 * 72);
        bf16x8 kbf[2];
        {
            float kd[16], ev[16], elast[2];
#pragma unroll
            for (int sc = 0; sc < 2; ++sc) {
                float run = 1.f, runi = 1.f, bb[8], bi[8];
#pragma unroll
                for (int jj = 0; jj < 8; ++jj) {
                    const float u = __expf(-bf2f(fB[sc * 8 + jj]));
                    const float a1 = 1.f + u, a2 = 1.f + lbk * u, r = frcp(a1 * a2);
                    const float f = a2 * a2 * r, fi = a1 * a1 * r;
                    kd[sc * 8 + jj] = 1.f - f;
                    run *= f; bb[jj] = run; runi *= fi; bi[jj] = runi;
                }
                float incl = run, inci = runi;
                { const float t1 = __shfl_up(incl, 16, 64), s1 = __shfl_up(inci, 16, 64); if (g >= 1) { incl *= t1; inci *= s1; } }
                { const float t2 = __shfl_up(incl, 32, 64), s2 = __shfl_up(inci, 32, 64); if (g >= 2) { incl *= t2; inci *= s2; } }
                float excl = __shfl_up(incl, 16, 64), exci = __shfl_up(inci, 16, 64); if (g == 0) { excl = 1.f; exci = 1.f; }
                elast[sc] = __shfl(incl, 48 + r16, 64);
#pragma unroll
                for (int jj = 0; jj < 8; ++jj) {
                    ev[sc * 8 + jj] = bb[jj] * excl;
                    kd[sc * 8 + jj] = kd[sc * 8 + jj] * (bi[jj] * exci);
                }
            }
#pragma unroll
            for (int sc = 0; sc < 2; ++sc)
#pragma unroll
                for (int jj = 0; jj < 8; ++jj) {
                    const int row = sc * 32 + g * 8 + jj;
                    E[row * 132 + kB] = ev[sc * 8 + jj];
                    Kd[row * 136 + kB] = f2bf(kd[sc * 8 + jj]);
                    if (sc == 0) K10[row * 136 + kB] = f2bf(kd[jj] * elast[0]);
                }
            if (g == 3) { EL[kB] = elast[0]; EL[128 + kB] = elast[1]; }
#pragma unroll
            for (int jj = 0; jj < 8; ++jj) { kbf[0][jj] = (short)f2bf(kd[jj] * elast[0] * elast[1]); kbf[1][jj] = (short)f2bf(kd[8 + jj] * elast[1]); }
        }
        {
            const unsigned w4[4] = {vA.x, vA.y, vA.z, vA.w};
#pragma unroll
            for (int q = 0; q < 4; ++q) { vTn[(vc8 + 2 * q) * 72 + vrow] = (bf16_t)(w4[q] & 0xffffu); vTn[(vc8 + 2 * q + 1) * 72 + vrow] = (bf16_t)(w4[q] >> 16); }
        }
        const uint4 qc0 = qA0, qc1 = qA1;
        if (n + 1 < 32) HG_PREFETCH(n + 1);
        __syncthreads();
        {
            const f32x4 d31 = *(const f32x4*)(EL + wave * 16 + 4 * g), d63 = *(const f32x4*)(EL + 128 + wave * 16 + 4 * g);
            const f32x4 dk = d31 * d63;
            bf16_t* stw = STb + (n & 1) * (64 * 136);
#pragma unroll
            for (int vt = 0; vt < 4; ++vt) {
                f32x4 c = accS[vt] * dk;
#pragma unroll
                for (int sc = 0; sc < 2; ++sc) {
                    const bf16x8 vf = *(const bf16x8*)(vTn + (vt * 16 + r16) * 72 + sc * 32 + 8 * g);
                    c = mfma16(kbf[sc], vf, c);
                }
                accS[vt] = c;
                uint2 w; w.x = pack2(c[0], c[1]); w.y = pack2(c[2], c[3]);
                *(uint2*)(stw + (vt * 16 + r16) * 136 + wave * 16 + 4 * g) = w;
            }
        }
        {
            const f32x4 e31a = *(const f32x4*)(EL + k8A), e31b = *(const f32x4*)(EL + k8A + 4);
#pragma unroll
            for (int u = 0; u < 2; ++u) {
                const int row = rowA + u * 32;
                const uint4 qq = u ? qc1 : qc0;
                const f32x4 ea = *(const f32x4*)(E + row * 132 + k8A), eb = *(const f32x4*)(E + row * 132 + k8A + 4);
                const float qr[8] = {bflo(qq.x), bfhi(qq.x), bflo(qq.y), bfhi(qq.y), bflo(qq.z), bfhi(qq.z), bflo(qq.w), bfhi(qq.w)};
                float qt[8], qh[8];
#pragma unroll
                for (int i = 0; i < 8; ++i) {
                    const float qs = qr[i];
                    qt[i] = qs * (i < 4 ? ea[i] : eb[i - 4]);
                    qh[i] = u ? qt[i] * (i < 4 ? e31a[i] : e31b[i - 4]) : qt[i];
                }
                *(uint4*)(Qt + row * 136 + k8A) = make_uint4(pack2(qt[0], qt[1]), pack2(qt[2], qt[3]), pack2(qt[4], qt[5]), pack2(qt[6], qt[7]));
                *(uint4*)(Qh + row * 136 + k8A) = make_uint4(pack2(qh[0], qh[1]), pack2(qh[2], qh[3]), pack2(qh[4], qh[5]), pack2(qh[6], qh[7]));
            }
        }
        __syncthreads();
#pragma unroll
        for (int q2 = 0; q2 < 2; ++q2) {
            const int tix = wave * 2 + q2, ti = tix >> 2, si = tix & 3;
            f32x4 sc = (f32x4){0.f, 0.f, 0.f, 0.f};
            if (si <= ti) {
                const bf16_t* kb = (ti >= 2 && si < 2) ? K10 : Kd;
#pragma unroll
                for (int kk = 0; kk < 4; ++kk) {
                    const bf16x8 af = *(const bf16x8*)(Qt + (ti * 16 + r16) * 136 + kk * 32 + 8 * g);
                    const bf16x8 bfr = *(const bf16x8*)(kb + (si * 16 + r16) * 136 + kk * 32 + 8 * g);
                    sc = mfma16(bfr, af, sc);
                }
                if (si == ti) {
#pragma unroll
                    for (int r = 0; r < 4; ++r) if (4 * g + r > r16) sc[r] = 0.f;
                }
            }
            uint2 w; w.x = pack2(sc[0], sc[1]); w.y = pack2(sc[2], sc[3]);
            *(uint2*)(Sm + (ti * 16 + r16) * 72 + si * 16 + 4 * g) = w;
        }
        __syncthreads();
#pragma unroll
        for (int q2 = 0; q2 < 2; ++q2) {
            const int ti = wave >> 1, vi = (wave & 1) * 2 + q2;
            const bf16_t* stp = STb + ((n + 1) & 1) * (64 * 136);
            f32x4 o = (f32x4){0.f, 0.f, 0.f, 0.f};
#pragma unroll
            for (int kk = 0; kk < 2; ++kk) {
                const bf16x8 af = *(const bf16x8*)(Sm + (ti * 16 + r16) * 72 + kk * 32 + 8 * g);
                const bf16x8 bfr = *(const bf16x8*)(vTn + (vi * 16 + r16) * 72 + kk * 32 + 8 * g);
                o = mfma16(bfr, af, o);
            }
#pragma unroll
            for (int kk = 0; kk < 4; ++kk) {
                const bf16x8 af = *(const bf16x8*)(Qh + (ti * 16 + r16) * 136 + kk * 32 + 8 * g);
                const bf16x8 bfr = *(const bf16x8*)(stp + (vi * 16 + r16) * 136 + kk * 32 + 8 * g);
                o = mfma16(bfr, af, o);
            }
            const int tau = n * 64 + ti * 16 + r16, tt = dir ? (SEQ - 1 - tau) : tau;
            uint2 w; w.x = pack2(o[0], o[1]); w.y = pack2(o[2], o[3]);
            *(uint2*)(OHG + ((size_t)dir * T + tokbase + tt) * 512 + h * 128 + vs * 64 + vi * 16 + 4 * g) = w;
        }
    }
#undef HG_PREFETCH
    __syncthreads();
}

__device__ void phase6(const Args& a, int gw, int nw) {
    unsigned char* ws = a.ws;
    const bf16_t* OHG = (const bf16_t*)(ws + WS_D); const bf16_t* PROJ = (const bf16_t*)(ws + WS_C);
    bf16_t* YCAT = (bf16_t*)(ws + WS_B);
    const int lane = threadIdx.x & 63;
    for (int t = gw; t < T; t += nw) {
        const int c0 = lane * 8;
        const uint4 f = *(const uint4*)(OHG + (size_t)t * 512 + c0), bw = *(const uint4*)(OHG + ((size_t)T + t) * 512 + c0);
        const uint4 gg = *(const uint4*)(PROJ + (size_t)t * INW + OFF_G + c0);
        float o[8];
        o[0] = bflo(f.x) + bflo(bw.x); o[1] = bfhi(f.x) + bfhi(bw.x); o[2] = bflo(f.y) + bflo(bw.y); o[3] = bfhi(f.y) + bfhi(bw.y);
        o[4] = bflo(f.z) + bflo(bw.z); o[5] = bfhi(f.z) + bfhi(bw.z); o[6] = bflo(f.w) + bflo(bw.w); o[7] = bfhi(f.w) + bfhi(bw.w);
        float gr[8] = {bflo(gg.x), bfhi(gg.x), bflo(gg.y), bfhi(gg.y), bflo(gg.z), bfhi(gg.z), bflo(gg.w), bfhi(gg.w)};
        float ss = 0.f;
#pragma unroll
        for (int i = 0; i < 8; ++i) ss += o[i] * o[i];
        ss += __shfl_xor(ss, 1, 64); ss += __shfl_xor(ss, 2, 64); ss += __shfl_xor(ss, 4, 64); ss += __shfl_xor(ss, 8, 64);
        const float rs = rsqrtf(ss * (1.f / 128.f) + EPS);
        float y[8];
#pragma unroll
        for (int i = 0; i < 8; ++i) { const float gt = gr[i] * frcp(1.f + __expf(-gr[i])); y[i] = o[i] * rs * a.hg_o_norm[c0 + i] * gt; }
        *(uint4*)(YCAT + (size_t)t * DM + c0) = make_uint4(pack2(y[0], y[1]), pack2(y[2], y[3]), pack2(y[4], y[5]), pack2(y[6], y[7]));
    }
}

template <int NB>
__device__ void convert_tables(const Args& a, int gw, int nw) {
    unsigned char* ws = a.ws;
    const int lane = threadIdx.x & 63;
    for (int rr0 = gw; rr0 < 32768; rr0 += nw * NB) {
        f32x4 x[NB][4];
#pragma unroll
        for (int b = 0; b < NB; ++b) {
            int rr = rr0 + b * nw; rr = rr < 32768 ? rr : 32767;
            const float* src = (rr >= 16384 ? a.peer_v : a.peer_u) + (size_t)(rr & 16383) * DM + lane * 4;
#pragma unroll
            for (int q = 0; q < 4; ++q) x[b][q] = *(const f32x4*)(src + q * 256);
        }
#pragma unroll
        for (int b = 0; b < NB; ++b) {
            const int rr = rr0 + b * nw;
            if (rr >= 32768) break;
            const bool isv = rr >= 16384; const int row = rr & 16383;
            float ss = 0.f;
#pragma unroll
            for (int q = 0; q < 4; ++q) ss += x[b][q][0] * x[b][q][0] + x[b][q][1] * x[b][q][1] + x[b][q][2] * x[b][q][2] + x[b][q][3] * x[b][q][3];
            ss = wave_sum(ss);
            const float rms = sqrtf(ss * (1.f / 1024.f));
            if (isv) {
                const float sc = 0.47f * rms, inv = sc > 0.f ? 1.f / sc : 0.f;
                unsigned char* dst = ws + WS_V4 + (size_t)row * 512 + lane * 2;
#pragma unroll
                for (int q = 0; q < 4; ++q) {
                    unsigned pk = 0;
                    pk = __builtin_amdgcn_cvt_scalef32_pk_fp4_f32(pk, fminf(fmaxf(x[b][q][0] * inv, -6.f), 6.f), fminf(fmaxf(x[b][q][1] * inv, -6.f), 6.f), 1.0f, 0);
                    pk = __builtin_amdgcn_cvt_scalef32_pk_fp4_f32(pk, fminf(fmaxf(x[b][q][2] * inv, -6.f), 6.f), fminf(fmaxf(x[b][q][3] * inv, -6.f), 6.f), 1.0f, 1);
                    *(unsigned short*)(dst + q * 128) = (unsigned short)pk;
                }
                if (lane == 0) ((float*)(ws + WS_VSCALE))[row] = sc;
            } else {
                const float st = 0.36f * rms, inv = st > 0.f ? 1.f / st : 0.f;
                unsigned char* dst = ws + WS_U4 + (size_t)row * 512 + lane * 2;
                int qs = 0;
#pragma unroll
                for (int q = 0; q < 4; ++q) {
                    unsigned hw = 0;
#pragma unroll
                    for (int e = 0; e < 4; ++e) { const int qi = (int)rintf(fminf(fmaxf(x[b][q][e] * inv, -8.f), 7.f)); qs += qi; hw |= (unsigned)(qi & 15) << (4 * e); }
                    *(unsigned short*)(dst + q * 128) = (unsigned short)hw;
                }
#pragma unroll
                for (int d = 32; d > 0; d >>= 1) qs += __shfl_xor(qs, d, 64);
                if (lane == 0) { ((float*)(ws + WS_USCALE))[row] = st; ((int*)(ws + WS_USUM))[row] = qs; }
            }
        }
    }
}

__device__ void phase7(const Args& a, unsigned char* lds) {
    unsigned char* ws = a.ws;
    g256::EpiResid e{a.x, (bf16_t*)(ws + WS_R), (float*)(ws + WS_PART), lds};
    for (int i = 0;; ++i) { int pm, pn; if (!g256::next_tile(i * gridDim.x + blockIdx.x, 64, 4, pm, pn)) break;
        __syncthreads();
        g256::tile((const bf16_t*)(ws + WS_B), (const bf16_t*)(ws + WS_WOUT_T), DM, pm * 256, pn * 256, lds, e); }
    __syncthreads();
    convert_tables<4>(a, blockIdx.x * 8 + (threadIdx.x >> 6), gridDim.x * 8);
}


__device__ __forceinline__ void ce_desc(float& x, float& y) { const float hi = fmaxf(x, y), lo = fminf(x, y); x = hi; y = lo; }
template <int N> __device__ __forceinline__ void bitonic_sort_desc(float (&v)[N]) {
#pragma unroll
    for (int k = 2; k <= N; k <<= 1)
#pragma unroll
        for (int j = k >> 1; j > 0; j >>= 1)
#pragma unroll
            for (int i = 0; i < N; ++i) { const int l = i ^ j; if (l > i) { if ((i & k) == 0) ce_desc(v[i], v[l]); else ce_desc(v[l], v[i]); } }
}
template <int N> __device__ __forceinline__ void bitonic_merge_desc(float (&v)[N]) {
#pragma unroll
    for (int j = N >> 1; j > 0; j >>= 1)
#pragma unroll
        for (int i = 0; i < N; ++i) { const int l = i ^ j; if (l > i) ce_desc(v[i], v[l]); }
}
__device__ __forceinline__ void xlane_merge16(float (&v)[16], int mask) {
    float o[16];
#pragma unroll
    for (int i = 0; i < 16; ++i) o[i] = __shfl_xor(v[15 - i], mask, 64);
#pragma unroll
    for (int i = 0; i < 16; ++i) v[i] = fmaxf(v[i], o[i]);
    bitonic_merge_desc<16>(v);
}
__device__ __forceinline__ unsigned bsel(unsigned m, unsigned x1, unsigned x0) { return x0 ^ ((x1 ^ x0) & m); }
__device__ __forceinline__ float sel16(const float (&v)[16], unsigned i) {
    const unsigned m0 = 0u - (i & 1u), m1 = 0u - ((i >> 1) & 1u), m2 = 0u - ((i >> 2) & 1u), m3 = 0u - ((i >> 3) & 1u);
    unsigned t8[8], t4[4], t2[2];
#pragma unroll
    for (int q = 0; q < 8; ++q) t8[q] = bsel(m0, __float_as_uint(v[2 * q + 1]), __float_as_uint(v[2 * q]));
#pragma unroll
    for (int q = 0; q < 4; ++q) t4[q] = bsel(m1, t8[2 * q + 1], t8[2 * q]);
#pragma unroll
    for (int q = 0; q < 2; ++q) t2[q] = bsel(m2, t4[2 * q + 1], t4[2 * q]);
    return __uint_as_float(bsel(m3, t2[1], t2[0]));
}
__device__ __forceinline__ float sel4(int g, float x0, float x1, float x2, float x3) {
    const unsigned m0 = 0u - ((unsigned)g & 1u), m1 = 0u - (((unsigned)g >> 1) & 1u);
    const unsigned lo = bsel(m0, __float_as_uint(x1), __float_as_uint(x0)), hi = bsel(m0, __float_as_uint(x3), __float_as_uint(x2));
    return __uint_as_float(bsel(m1, hi, lo));
}

static constexpr int PI[52] = {0,0,0,0,0,0,0,0,0,0,0,0,0,0,0,0,1,1,1,1,1,1,1,1,2,2,2,2,2,3,3,3,3,4,4,4,5,5,6,6,7,7,8,9,10,11,12,13,14,15,0,0};
static constexpr int PJ[52] = {0,1,2,3,4,5,6,7,8,9,10,11,12,13,14,15,0,1,2,3,4,5,6,7,0,1,2,3,4,0,1,2,3,0,1,2,0,1,0,1,0,1,0,0,0,0,0,0,0,0,0,0};
constexpr int RT_ROW = 272;
__device__ __forceinline__ void peer_half_top16(const bf16_t* __restrict__ PQ, const unsigned char* __restrict__ skl, int t0, int p, int c, int r16, int g, float (&out)[16]) {
    f32x4 sc[8];
#pragma unroll
    for (int ni = 0; ni < 8; ++ni) sc[ni] = (f32x4){0.f, 0.f, 0.f, 0.f};
    bf16x8 af[4];
#pragma unroll
    for (int kk = 0; kk < 4; ++kk) af[kk] = *(const bf16x8*)(PQ + (size_t)(t0 + r16) * 2048 + p * 256 + c * 128 + kk * 32 + 8 * g);
#pragma unroll
    for (int kk = 0; kk < 4; ++kk) {
        asm volatile("" ::: "memory");
#pragma unroll
        for (int ni = 0; ni < 8; ++ni) {
            const bf16x8 bfr = *(const bf16x8*)(skl + (c * 128 + ni * 16 + r16) * RT_ROW + kk * 64 + 16 * g);
            sc[ni] = mfma16(bfr, af[kk], sc[ni]);
        }
    }
    float hi[16];
#pragma unroll
    for (int ni = 0; ni < 4; ++ni)
#pragma unroll
        for (int r = 0; r < 4; ++r) {
            out[ni * 4 + r] = __uint_as_float((__float_as_uint(sc[ni][r]) & 0xffffff80u) | (unsigned)(ni * 16 + 4 * g + r));
            hi[ni * 4 + r] = __uint_as_float((__float_as_uint(sc[ni + 4][r]) & 0xffffff80u) | (unsigned)((ni + 4) * 16 + 4 * g + r));
        }
    bitonic_sort_desc<16>(out);
    bitonic_sort_desc<16>(hi);
#pragma unroll
    for (int i = 0; i < 16; ++i) out[i] = fmaxf(out[i], hi[15 - i]);
    bitonic_merge_desc<16>(out);
    xlane_merge16(out, 16);
    xlane_merge16(out, 32);
}
__device__ __forceinline__ void peer_route_finish(const Args& a, int p, int t0, const float (&ab0)[16], const float (&ab1)[16]) {
    unsigned char* ws = a.ws;
    int* IDX = (int*)(ws + WS_IDX); float* GATE = (float*)(ws + WS_GATE);
    int tix_ = threadIdx.x; asm volatile("" : "+v"(tix_));
    const int lane = tix_ & 63, r16 = lane & 15, g = lane >> 4;
    float va[16], vb[16];
#pragma unroll
    for (int i = 0; i < 16; ++i) { va[i] = __uint_as_float(__float_as_uint(ab0[i]) & 0xffffff80u); vb[i] = __uint_as_float(__float_as_uint(ab1[i]) & 0xffffff80u); }
    float v[16];
#pragma unroll
    for (int s = 0; s < 13; ++s) {
        const float x0 = __uint_as_float((__float_as_uint(va[PI[4 * s]] + vb[PJ[4 * s]]) & 0xffffff00u) | (unsigned)(PI[4 * s] * 16 + PJ[4 * s]));
        const float x1 = __uint_as_float((__float_as_uint(va[PI[4 * s + 1]] + vb[PJ[4 * s + 1]]) & 0xffffff00u) | (unsigned)(PI[4 * s + 1] * 16 + PJ[4 * s + 1]));
        const float x2 = (4 * s + 2 < 50) ? __uint_as_float((__float_as_uint(va[PI[4 * s + 2]] + vb[PJ[4 * s + 2]]) & 0xffffff00u) | (unsigned)(PI[4 * s + 2] * 16 + PJ[4 * s + 2])) : -3.0e38f;
        const float x3 = (4 * s + 3 < 50) ? __uint_as_float((__float_as_uint(va[PI[4 * s + 3]] + vb[PJ[4 * s + 3]]) & 0xffffff00u) | (unsigned)(PI[4 * s + 3] * 16 + PJ[4 * s + 3])) : -3.0e38f;
        v[s] = sel4(g, x0, x1, x2, x3);
    }
    v[13] = -3.0e38f; v[14] = -3.0e38f; v[15] = -3.0e38f;
    bitonic_sort_desc<16>(v);
    xlane_merge16(v, 16);
    xlane_merge16(v, 32);
    float e[16], sum = 0.f;
    const float mtop = __uint_as_float(__float_as_uint(v[0]) & 0xffffff00u);
#pragma unroll
    for (int q = 0; q < 16; ++q) { e[q] = __expf(__uint_as_float(__float_as_uint(v[q]) & 0xffffff00u) - mtop); sum += e[q]; }
    const float inv = 1.f / sum;
    int oi[4]; float og[4];
#pragma unroll
    for (int r = 0; r < 4; ++r) {
        const unsigned key = __float_as_uint(sel4(g, v[r], v[4 + r], v[8 + r], v[12 + r]));
        const unsigned pos = key & 255u;
        const unsigned ia = __float_as_uint(sel16(ab0, pos >> 4)) & 127u, ib = __float_as_uint(sel16(ab1, pos & 15u)) & 127u;
        oi[r] = (int)(ia * 128u + ib);
        og[r] = sel4(g, e[r], e[4 + r], e[8 + r], e[12 + r]) * inv;
    }
    const size_t o = (size_t)(t0 + r16) * 128 + p * 16 + 4 * g;
    *(int4*)(IDX + o) = make_int4(oi[0], oi[1], oi[2], oi[3]);
    *(f32x4*)(GATE + o) = (f32x4){og[0], og[1], og[2], og[3]};
}

__device__ __forceinline__ float dpp_xor1(float v) { return __builtin_bit_cast(float, __builtin_amdgcn_mov_dpp(__builtin_bit_cast(int, v), 0xB1, 0xF, 0xF, true)); }
__device__ __forceinline__ float dpp_xor2(float v) { return __builtin_bit_cast(float, __builtin_amdgcn_mov_dpp(__builtin_bit_cast(int, v), 0x4E, 0xF, 0xF, true)); }
__device__ __forceinline__ float dpp_hmirror(float v) { return __builtin_bit_cast(float, __builtin_amdgcn_mov_dpp(__builtin_bit_cast(int, v), 0x141, 0xF, 0xF, true)); }


constexpr int PU_ROW = 272;
__device__ __forceinline__ float dot2bf(unsigned x, unsigned y, float acc) { return __builtin_amdgcn_fdot2_f32_bf16(__builtin_bit_cast(bf16v2, x), __builtin_bit_cast(bf16v2, y), acc, false); }


__device__ __forceinline__ void peer_half_top16_lds(const unsigned char* __restrict__ qs, const unsigned char* __restrict__ skl, int r16, int g, float (&out)[16]) {
    f32x4 sc[8];
#pragma unroll
    for (int ni = 0; ni < 8; ++ni) sc[ni] = (f32x4){0.f, 0.f, 0.f, 0.f};
#pragma unroll
    for (int kk = 0; kk < 4; ++kk) {
        asm volatile("" ::: "memory");
        const bf16x8 af = *(const bf16x8*)(qs + r16 * RT_ROW + kk * 64 + 16 * g);
#pragma unroll
        for (int ni = 0; ni < 8; ++ni) {
            const bf16x8 bfr = *(const bf16x8*)(skl + (ni * 16 + r16) * RT_ROW + kk * 64 + 16 * g);
            sc[ni] = mfma16(bfr, af, sc[ni]);
        }
    }
    float hi[16];
#pragma unroll
    for (int ni = 0; ni < 4; ++ni)
#pragma unroll
        for (int r = 0; r < 4; ++r) {
            out[ni * 4 + r] = __uint_as_float((__float_as_uint(sc[ni][r]) & 0xffffff80u) | (unsigned)(ni * 16 + 4 * g + r));
            hi[ni * 4 + r] = __uint_as_float((__float_as_uint(sc[ni + 4][r]) & 0xffffff80u) | (unsigned)((ni + 4) * 16 + 4 * g + r));
        }
    bitonic_sort_desc<16>(out);
    bitonic_sort_desc<16>(hi);
#pragma unroll
    for (int i = 0; i < 16; ++i) out[i] = fmaxf(out[i], hi[15 - i]);
    bitonic_merge_desc<16>(out);
    xlane_merge16(out, 16);
    xlane_merge16(out, 32);
}
struct EpiRoute { const Args* ap; unsigned char* lds; int p; int brow;
    __device__ __forceinline__ void operator()(const f32x4 (&acc)[2][2][4][2], int row0, int col0) const {
        int tix = threadIdx.x; asm volatile("" : "+v"(tix));
        const int lane = tix & 63, wave = tix >> 6, r16 = lane & 15, g = lane >> 4;
        unsigned char* qs = lds;
        unsigned char* skl = lds + 256 * RT_ROW;
        const int rl0 = row0 - brow, cl0 = (col0 - p * 256);
        float* tl = (float*)(lds + 384 * RT_ROW);
        float rs[2][4];
        { const float* PART = (const float*)(ap->ws + WS_PART);
#pragma unroll
          for (int ai = 0; ai < 2; ++ai)
#pragma unroll
            for (int m = 0; m < 4; ++m) { const int row = row0 + ai * 128 + m * 16;
                rs[ai][m] = rsqrtf(((PART[row] + PART[T + row]) + (PART[2 * T + row] + PART[3 * T + row])) * (1.f / 1024.f) + EPS); } }
        uint4 skr0, skr1, skr2, skr3;
        { const bf16_t* SK = (const bf16_t*)(ap->ws + WS_SUBK) + ((size_t)p * 2) * 128 * 128;
          skr0 = *(const uint4*)(SK + (size_t)tix * 8); skr1 = *(const uint4*)(SK + (size_t)(tix + NT) * 8);
          skr2 = *(const uint4*)(SK + (size_t)(tix + 2 * NT) * 8); skr3 = *(const uint4*)(SK + (size_t)(tix + 3 * NT) * 8); }
#pragma unroll 1
        for (int c = 0; c < 2; ++c) {
            __syncthreads();
#pragma unroll
            for (int ai = 0; ai < 2; ++ai)
#pragma unroll
                for (int m = 0; m < 4; ++m)
#pragma unroll
                    for (int n = 0; n < 2; ++n) { const f32x4 v = (c ? acc[ai][1][m][n] : acc[ai][0][m][n]) * rs[ai][m]; uint2 w; w.x = pack2(v[0], v[1]); w.y = pack2(v[2], v[3]);
                        *(uint2*)(qs + (rl0 + ai * 128 + m * 16) * RT_ROW + (cl0 + n * 16) * 2) = w; }
            { *(uint4*)(skl + (tix >> 4) * RT_ROW + (tix & 15) * 16) = skr0; *(uint4*)(skl + ((tix + NT) >> 4) * RT_ROW + (tix & 15) * 16) = skr1;
              *(uint4*)(skl + ((tix + 2 * NT) >> 4) * RT_ROW + (tix & 15) * 16) = skr2; *(uint4*)(skl + ((tix + 3 * NT) >> 4) * RT_ROW + (tix & 15) * 16) = skr3; }
            __syncthreads();
            if (c == 0) { const bf16_t* SK = (const bf16_t*)(ap->ws + WS_SUBK) + ((size_t)p * 2 + 1) * 128 * 128;
              skr0 = *(const uint4*)(SK + (size_t)tix * 8); skr1 = *(const uint4*)(SK + (size_t)(tix + NT) * 8);
              skr2 = *(const uint4*)(SK + (size_t)(tix + 2 * NT) * 8); skr3 = *(const uint4*)(SK + (size_t)(tix + 3 * NT) * 8); }
#pragma unroll 1
            for (int k = 0; k < 2; ++k) {
                float lst[16];
                peer_half_top16_lds(qs + ((wave * 2 + k) * 16) * RT_ROW, skl, r16, g, lst);
                if (g == 0) { float* d = tl + (((wave * 2 + k) * 16 + r16) * 2 + c) * 16;
#pragma unroll
                    for (int q = 0; q < 4; ++q) *(f32x4*)(d + q * 4) = (f32x4){lst[q * 4], lst[q * 4 + 1], lst[q * 4 + 2], lst[q * 4 + 3]}; }
            }
        }
        __syncthreads();
#pragma unroll 1
        for (int k = 0; k < 2; ++k) {
            float ab0[16], ab1[16];
            const float* d = tl + (((wave * 2 + k) * 16 + r16) * 2) * 16;
#pragma unroll
            for (int q = 0; q < 4; ++q) { const f32x4 x0 = *(const f32x4*)(d + q * 4), x1 = *(const f32x4*)(d + 16 + q * 4);
                ab0[q * 4] = x0[0]; ab0[q * 4 + 1] = x0[1]; ab0[q * 4 + 2] = x0[2]; ab0[q * 4 + 3] = x0[3]; ab1[q * 4] = x1[0]; ab1[q * 4 + 1] = x1[1]; ab1[q * 4 + 2] = x1[2]; ab1[q * 4 + 3] = x1[3]; }
            peer_route_finish(*ap, p, brow + (wave * 2 + k) * 16, ab0, ab1);
        }
    }
};

__device__ void phase9_fused(const Args& a, unsigned char* lds) {
    unsigned char* ws = a.ws;
    for (int i = 0;; ++i) { int pm, pn; if (!g256::next_tile(i * gridDim.x + blockIdx.x, 64, 8, pm, pn)) break;
        EpiRoute e{&a, lds, pn, pm * 256};
        __syncthreads();
        g256::tile((const bf16_t*)(ws + WS_R), (const bf16_t*)(ws + WS_WPQ_T), DM, pm * 256, pn * 256, lds, e); }
    __syncthreads();
}

__device__ __forceinline__ int idpp_xor1(int v) { return __builtin_amdgcn_mov_dpp(v, 0xB1, 0xF, 0xF, true); }
__device__ __forceinline__ int idpp_xor2(int v) { return __builtin_amdgcn_mov_dpp(v, 0x4E, 0xF, 0xF, true); }
__device__ __forceinline__ int idpp_hmirror(int v) { return __builtin_amdgcn_mov_dpp(v, 0x141, 0xF, 0xF, true); }

__device__ void peer_uv_phase(const Args& a, unsigned char* lds) {
    unsigned char* ws = a.ws;
    const unsigned char* U4 = ws + WS_U4; const unsigned char* V4 = ws + WS_V4;
    const unsigned* IDX = (const unsigned*)(ws + WS_IDX); const float* GATE = (const float*)(ws + WS_GATE);
    const float* VS = (const float*)(ws + WS_VSCALE); const float* US = (const float*)(ws + WS_USCALE);
    const int* USUM = (const int*)(ws + WS_USUM);
    const int wv = __builtin_amdgcn_readfirstlane((int)(threadIdx.x >> 6));
    unsigned char* wl = lds + wv * 6528;
    unsigned char* il = wl + 8 * 272;
    unsigned char* hl = lds + 8 * 6528 + wv * 8192;
    float* hsl = (float*)(lds + 8 * 6528 + 8 * 8192) + wv * 8;
    for (int item = blockIdx.x * 8 + wv; item < 2048; item += gridDim.x * 8) {
    const int tpbase = ((item >> 3) & 7) * 1024 + (item >> 6) * 8 + (item & 7);
    {
        int tix0 = threadIdx.x; asm volatile("" : "+v"(tix0));
        const int lane = tix0 & 63;
        const bf16_t* R = (const bf16_t*)(ws + WS_R);
        uint2 rw[8][4];
#pragma unroll
        for (int tau = 0; tau < 8; ++tau) { const size_t t = (size_t)(tpbase + 256 * (tau >> 1)) * 2 + (tau & 1);
#pragma unroll
            for (int i = 0; i < 4; ++i) rw[tau][i] = *(const uint2*)(R + t * DM + i * 256 + lane * 4); }
        f32x4 gn[4];
#pragma unroll
        for (int i = 0; i < 4; ++i) gn[i] = *(const f32x4*)(a.ffn_norm + i * 256 + lane * 4);
        unsigned char* hr = hl + (lane >> 3) * 32 + ((lane >> 1) & 3) * 4 + (lane & 1) * 2;
#pragma unroll
        for (int tau = 0; tau < 8; ++tau) {
            f32x4 v[4]; float ss = 0.f;
#pragma unroll
            for (int i = 0; i < 4; ++i) { v[i] = (f32x4){bflo(rw[tau][i].x), bfhi(rw[tau][i].x), bflo(rw[tau][i].y), bfhi(rw[tau][i].y)};
                ss += v[i][0] * v[i][0] + v[i][1] * v[i][1] + v[i][2] * v[i][2] + v[i][3] * v[i][3]; }
            ss = wave_sum(ss);
            const float rs = rsqrtf(ss * (1.f / 1024.f) + EPS);
            float amax = 0.f;
#pragma unroll
            for (int i = 0; i < 4; ++i)
#pragma unroll
                for (int e = 0; e < 4; ++e) { v[i][e] = v[i][e] * rs * gn[i][e]; amax = fmaxf(amax, fabsf(v[i][e])); }
#pragma unroll
            for (int d = 32; d > 0; d >>= 1) amax = fmaxf(amax, __shfl_xor(amax, d, 64));
            const float inv = amax > 0.f ? 127.f / amax : 0.f;
#pragma unroll
            for (int i = 0; i < 4; ++i) {
                unsigned ha = 0, hb = 0;
#pragma unroll
                for (int e = 0; e < 4; ++e) { const unsigned tb = (unsigned)((int)rintf(v[i][e] * inv) + 128); ha |= ((tb >> 4) ^ 8u) << (4 * e); hb |= ((tb & 15u) ^ 8u) << (4 * e); }
                *(unsigned short*)(hr + tau * 1024 + i * 256) = (unsigned short)ha; *(unsigned short*)(hr + tau * 1024 + i * 256 + 16) = (unsigned short)hb;
            }
            if (lane == 0) hsl[tau] = amax * (1.f / 127.f);
        }
    }
    {
    int tix = threadIdx.x; asm volatile("" : "+v"(tix));
    const int lane = tix & 63, m = lane & 7, j = lane >> 3;
    const size_t tp0 = (size_t)tpbase;
    int acc[4][2][2];
#pragma unroll
    for (int k = 0; k < 4; ++k) { acc[k][0][0] = 0; acc[k][0][1] = 0; acc[k][1][0] = 0; acc[k][1][1] = 0; }
#pragma unroll 1
    for (int sl = 0; sl < 4; ++sl) {
        const unsigned uoff = (unsigned)(sl * 128 + 16 * m);
#pragma unroll
        for (int k = 0; k < 4; ++k) {
            const size_t tp = tp0 + 256 * k;
            uint4 ha[2], hb[2]; uint4 iq[2][4];
#pragma unroll
            for (int tt = 0; tt < 2; ++tt) {
                const size_t t = tp * 2 + tt;
                ha[tt] = *(const uint4*)(hl + (2 * k + tt) * 1024 + sl * 256 + m * 32); hb[tt] = *(const uint4*)(hl + (2 * k + tt) * 1024 + sl * 256 + m * 32 + 16);
#pragma unroll
                for (int q = 0; q < 4; ++q) iq[tt][q] = *(const uint4*)(IDX + t * 128 + j * 16 + q * 4);
            }
            uint4 uq[2][16];
#pragma unroll
            for (int tt = 0; tt < 2; ++tt)
#pragma unroll
                for (int q = 0; q < 4; ++q) {
                    uq[tt][q * 4] = *(const uint4*)(U4 + (iq[tt][q].x * 512u + uoff)); uq[tt][q * 4 + 1] = *(const uint4*)(U4 + (iq[tt][q].y * 512u + uoff));
                    uq[tt][q * 4 + 2] = *(const uint4*)(U4 + (iq[tt][q].z * 512u + uoff)); uq[tt][q * 4 + 3] = *(const uint4*)(U4 + (iq[tt][q].w * 512u + uoff));
                }
#pragma unroll
            for (int tt = 0; tt < 2; ++tt) {
                const int haw[4] = {(int)ha[tt].x, (int)ha[tt].y, (int)ha[tt].z, (int)ha[tt].w};
                const int hbw[4] = {(int)hb[tt].x, (int)hb[tt].y, (int)hb[tt].z, (int)hb[tt].w};
                int val0 = 0, val1 = 0;
#pragma unroll
                for (int it = 0; it < 16; ++it) {
                    int wd[4] = {(int)uq[tt][it].x, (int)uq[tt][it].y, (int)uq[tt][it].z, (int)uq[tt][it].w};
                    asm volatile("" : "+v"(wd[0]), "+v"(wd[1]), "+v"(wd[2]), "+v"(wd[3]), "+v"(val0), "+v"(val1));
                    int dh = 0, dl = 0;
#pragma unroll
                    for (int q = 0; q < 4; ++q) { dh = __builtin_amdgcn_sdot8(haw[q], wd[q], dh, false); dl = __builtin_amdgcn_sdot8(hbw[q], wd[q], dl, false); }
                    int d = (dh << 4) + dl;
                    d += idpp_xor1(d); d += idpp_xor2(d); d += idpp_hmirror(d);
                    if ((it >> 1) == m) { if (it & 1) val1 = d; else val0 = d; }
                }
                acc[k][tt][0] += val0; acc[k][tt][1] += val1;
            }
        }
    }
#pragma unroll
    for (int k = 0; k < 4; ++k)
#pragma unroll
        for (int tt = 0; tt < 2; ++tt) {
            const size_t t = (tp0 + 256 * k) * 2 + tt; const size_t o = t * 128 + j * 16 + 2 * m;
            const float2 gt = *(const float2*)(GATE + o); const uint2 id = *(const uint2*)(IDX + o);
            const float hs = hsl[2 * k + tt];
            const float x0 = (float)(acc[k][tt][0] + 8 * USUM[id.x]) * (hs * US[id.x]), x1 = (float)(acc[k][tt][1] + 8 * USUM[id.y]) * (hs * US[id.y]);
            const float w0 = gt.x * 0.5f * x0 * (1.f + erff(x0 * 0.70710678118654752f)) * VS[id.x];
            const float w1 = gt.y * 0.5f * x1 * (1.f + erff(x1 * 0.70710678118654752f)) * VS[id.y];
            *(unsigned*)(wl + (2 * k + tt) * 272 + (j * 16 + 2 * m) * 2) = pack2h(w0, w1);
            *(uint2*)(il + (2 * k + tt) * 528 + (j * 16 + 2 * m) * 4) = id;
        }
    }
    int tix2 = threadIdx.x; asm volatile("" : "+v"(tix2));
    const int m2 = tix2 & 7, j2 = (tix2 >> 3) & 7;
    const unsigned tv = (unsigned)((tpbase + 256 * (j2 >> 1)) * 2 + (j2 & 1));
    const unsigned char* wrow = wl + j2 * 272; const unsigned char* irow = il + j2 * 528;
#pragma unroll 1
    for (int sl = 0; sl < 4; ++sl) {
        const unsigned voff = (unsigned)(sl * 128 + 16 * m2);
        float y[32];
#pragma unroll
        for (int i = 0; i < 32; ++i) y[i] = 0.f;
#pragma unroll 1
        for (int grp = 0; grp < 4; ++grp) {
            uint4 wq[4];
            uint4 vq[32];
#pragma unroll
            for (int q = 0; q < 8; ++q) {
                const uint4 i4 = *(const uint4*)(irow + grp * 128 + q * 16);
                vq[q * 4] = *(const uint4*)(V4 + (i4.x * 512u + voff)); vq[q * 4 + 1] = *(const uint4*)(V4 + (i4.y * 512u + voff));
                vq[q * 4 + 2] = *(const uint4*)(V4 + (i4.z * 512u + voff)); vq[q * 4 + 3] = *(const uint4*)(V4 + (i4.w * 512u + voff));
            }
#pragma unroll
            for (int q = 0; q < 4; ++q) wq[q] = *(const uint4*)(wrow + grp * 64 + q * 16);
#pragma unroll
            for (int it = 0; it < 32; ++it) {
                const uint4 wv4 = wq[it >> 3]; const int wc_ = (it >> 1) & 3;
                const unsigned wword = wc_ == 0 ? wv4.x : (wc_ == 1 ? wv4.y : (wc_ == 2 ? wv4.z : wv4.w));
                const f16v2 wp = __builtin_bit_cast(f16v2, wword);
                const float wt = (float)((it & 1) ? wp[1] : wp[0]);
                unsigned wd0 = vq[it].x, wd1 = vq[it].y, wd2 = vq[it].z, wd3 = vq[it].w;
                asm volatile("" : "+v"(wd0), "+v"(wd1), "+v"(wd2), "+v"(wd3), "+v"(y[0]));
                const unsigned wd[4] = {wd0, wd1, wd2, wd3};
#pragma unroll
                for (int q = 0; q < 4; ++q) {
                    const f32v2 p0 = __builtin_amdgcn_cvt_scalef32_pk_f32_fp4(wd[q], 1.0f, 0), p1 = __builtin_amdgcn_cvt_scalef32_pk_f32_fp4(wd[q], 1.0f, 1);
                    const f32v2 p2 = __builtin_amdgcn_cvt_scalef32_pk_f32_fp4(wd[q], 1.0f, 2), p3 = __builtin_amdgcn_cvt_scalef32_pk_f32_fp4(wd[q], 1.0f, 3);
                    y[q * 8] += wt * p0[0]; y[q * 8 + 1] += wt * p0[1]; y[q * 8 + 2] += wt * p1[0]; y[q * 8 + 3] += wt * p1[1];
                    y[q * 8 + 4] += wt * p2[0]; y[q * 8 + 5] += wt * p2[1]; y[q * 8 + 6] += wt * p3[0]; y[q * 8 + 7] += wt * p3[1];
                }
            }
        }
        const unsigned ooff = tv * (unsigned)DM + (unsigned)(sl * 256 + 32 * m2);
        const bf16_t* rrow = (const bf16_t*)(ws + WS_R) + ooff; float* orow = a.out + ooff;
#pragma unroll
        for (int q = 0; q < 4; ++q) {
            const uint4 r = *(const uint4*)(rrow + q * 8);
            *(f32x4*)(orow + q * 8) = (f32x4){bflo(r.x) + y[q * 8], bfhi(r.x) + y[q * 8 + 1], bflo(r.y) + y[q * 8 + 2], bfhi(r.y) + y[q * 8 + 3]};
            *(f32x4*)(orow + q * 8 + 4) = (f32x4){bflo(r.z) + y[q * 8 + 4], bfhi(r.z) + y[q * 8 + 5], bflo(r.w) + y[q * 8 + 6], bfhi(r.w) + y[q * 8 + 7]};
        }
    }
    }
}

#define XB_TMO      128
#define XB_XCNT(j)  (256  + 64 * (j))
#define XB_XSUB(j)  (1280 + 64 * (j))
#define XB_XGEN(j)  (2304 + 64 * (j))
#define XB_TOP      3328
#define XB_TOPGEN   3392
#define XCD_BAR_WORDS 3456
#define XB_SPIN_CAP (1u << 22)
#define LAS __attribute__((address_space(3)))
__device__ __forceinline__ unsigned xb_ld(unsigned* p)              { return __hip_atomic_load(p, __ATOMIC_RELAXED, __HIP_MEMORY_SCOPE_AGENT); }
__device__ __forceinline__ unsigned xb_add(unsigned* p, unsigned v) { return __hip_atomic_fetch_add(p, v, __ATOMIC_RELAXED, __HIP_MEMORY_SCOPE_AGENT); }
__device__ __forceinline__ unsigned xb_xcc_id() { return (unsigned)__builtin_amdgcn_s_getreg((3 << 11) | 20) & 0xFu; }
#define XB_SPIN(cond, bar) do { unsigned _sp = 0; while (cond) { __builtin_amdgcn_s_sleep(1); \
    if ((++_sp & 255u) == 0u) { if (xb_ld(&(bar)[XB_TMO])) break; if (_sp > XB_SPIN_CAP) { atomicAdd(&(bar)[XB_TMO], 1u); break; } } } } while (0)
struct XcdBarrier { unsigned* bar; unsigned x; volatile LAS unsigned* st; };
__device__ __forceinline__ XcdBarrier xcd_barrier_post(unsigned* bar, volatile LAS unsigned* st) {
    XcdBarrier b; b.bar = bar; b.x = xb_xcc_id(); b.st = st;
    if (threadIdx.x == 0) (void)xb_add(&bar[XB_XCNT(b.x)], 1u);
    return b;
}
__device__ __forceinline__ void xcd_barrier_complete(unsigned* bar, unsigned x, unsigned& nloc, unsigned& nx) {
    const unsigned G = gridDim.x * gridDim.y * gridDim.z;
    unsigned sum, cnt, mine, sp = 0u;
    for (;;) {
        sum = 0u; cnt = 0u; mine = 0u;
#pragma unroll
        for (unsigned j = 0; j < 16; ++j) { const unsigned c = xb_ld(&bar[XB_XCNT(j)]); sum += c; cnt += (c > 0u) ? 1u : 0u; mine = (j == x) ? c : mine; }
        if (sum == G) break;
        __builtin_amdgcn_s_sleep(1);
        if ((++sp & 255u) == 0u) { if (xb_ld(&bar[XB_TMO])) break; if (sp > XB_SPIN_CAP) { atomicAdd(&bar[XB_TMO], 1u); break; } }
    }
    nloc = mine > 0u ? mine : 1u; nx = cnt > 0u ? cnt : 1u;
}
__device__ __forceinline__ void xcd_barrier(const XcdBarrier& b) {
    asm volatile("s_waitcnt vmcnt(0)" ::: "memory");
    __syncthreads();
    if (threadIdx.x == 0) {
        unsigned* bar = b.bar;
        __builtin_amdgcn_s_waitcnt(0);
        unsigned nloc = b.st[0], nx = b.st[1];
        if (nloc == 0u) { xcd_barrier_complete(bar, b.x, nloc, nx); b.st[0] = nloc; b.st[1] = nx; }
        const unsigned old = xb_add(&bar[XB_XSUB(b.x)], 1u);
        const unsigned gen = old / nloc;
        if (old + 1u == (gen + 1u) * nloc) {
            __builtin_amdgcn_fence(__ATOMIC_RELEASE, "agent");
            asm volatile("s_waitcnt vmcnt(0)" ::: "memory");
            const unsigned og = xb_add(&bar[XB_TOP], 1u);
            const unsigned tg = og / nx;
            if (og + 1u == (tg + 1u) * nx) xb_add(&bar[XB_TOPGEN], 1u);
            else XB_SPIN(xb_ld(&bar[XB_TOPGEN]) == tg, bar);
            __builtin_amdgcn_fence(__ATOMIC_ACQUIRE, "agent");
            xb_add(&bar[XB_XGEN(b.x)], 1u);
            asm volatile("s_waitcnt vmcnt(0)" ::: "memory");
        } else {
            XB_SPIN(xb_ld(&bar[XB_XGEN(b.x)]) == gen, bar);
            __builtin_amdgcn_fence(__ATOMIC_ACQUIRE, "agent");
            asm volatile("s_waitcnt vmcnt(0)" ::: "memory");
        }
    }
    __syncthreads();
}

#define XB_FLAT0 3520
__device__ __forceinline__ void flat_barrier(unsigned* bar, unsigned word, unsigned n) {
    asm volatile("s_waitcnt vmcnt(0)" ::: "memory");
    __syncthreads();
    if (threadIdx.x == 0) {
        __builtin_amdgcn_fence(__ATOMIC_RELEASE, "agent");
        asm volatile("s_waitcnt vmcnt(0)" ::: "memory");
        (void)xb_add(&bar[word], 1u);
        XB_SPIN(xb_ld(&bar[word]) < n, bar);
        __builtin_amdgcn_fence(__ATOMIC_ACQUIRE, "agent");
        asm volatile("s_waitcnt vmcnt(0)" ::: "memory");
    }
    __syncthreads();
}

constexpr int LDS_MAIN = HG_LDS;
static_assert(LDS_MAIN >= 512 * PU_ROW && LDS_MAIN >= 2 * AT_BUF && LDS_MAIN >= 131072, "LDS_MAIN");
constexpr int LDS_BYTES = LDS_MAIN + 16;
constexpr int N_PHASES = 14;

__global__ void __launch_bounds__(NT, 2) fwd_kernel(Args a) {
    extern __shared__ __attribute__((aligned(16))) unsigned char lds[];
#if N_LAUNCH_MODE == 1
#ifdef USE_CG_SYNC
    cg::grid_group grid = cg::this_grid();
#endif
    volatile LAS unsigned* xst = (volatile LAS unsigned*)(lds + LDS_MAIN);
    if (threadIdx.x < 4) xst[threadIdx.x] = 0u;
    __syncthreads();
    XcdBarrier xbar = xcd_barrier_post((unsigned*)(a.ws + WS_CTL), xst);
#ifdef USE_CG_SYNC
#define SEAM(k) do { if (a.ph_lo <= (k) && (k) + 1 < a.ph_hi) { if ((k) == 0) grid.sync(); else xcd_barrier(xbar); } } while (0)
#else
#define SEAM(k) do { if (a.ph_lo <= (k) && (k) + 1 < a.ph_hi) { xcd_barrier(xbar); } } while (0)
#endif
#else
#define SEAM(k) do { } while (0)
#endif
#define IN(k) (a.ph_lo <= (k) && (k) < a.ph_hi)
#define REPS(k) for (int rep_ = 0; rep_ < ((k) == REPEAT_PHASE ? 2 : 1); ++rep_)
    if (IN(0)) REPS(0) { phase0(a, lds); } SEAM(0);
    if (IN(1)) REPS(1) { phase1(a, lds); } SEAM(1);
    if (IN(3)) REPS(3) { phase3(a, lds); } SEAM(3);
    if (IN(4)) REPS(4) {
        const int nhalf = gridDim.x >> 1;
        if ((int)blockIdx.x < nhalf) { for (int r_ = 0; r_ < ATT_REP; ++r_) for (int it = blockIdx.x; it < 256; it += nhalf) attn_item(a, it, lds); }
        else { for (int r_ = 0; r_ < HG_REP; ++r_) for (int it = blockIdx.x - nhalf; it < 128; it += gridDim.x - nhalf) hgrn_item(a, it, lds);
               flat_barrier((unsigned*)(a.ws + WS_CTL), XB_FLAT0, gridDim.x - nhalf);
               phase6(a, (blockIdx.x - nhalf) * 8 + (threadIdx.x >> 6), (gridDim.x - nhalf) * 8); }
    } SEAM(5);
    if (IN(7)) REPS(7) { phase7(a, lds); } SEAM(7);
    if (IN(9)) REPS(9) { phase9_fused(a, lds); } SEAM(10);
    if (IN(11)) { __syncthreads(); peer_uv_phase(a, lds); }
}

extern "C" void kernel_launch(void* const* d_in, const int* in_sizes, int n_in, void* d_out, int out_size, void* d_ws, size_t ws_size, hipStream_t stream) {
    static int grid = 0;
    if (grid == 0) {
        if (n_in != 19 || out_size != T * DM || ws_size < WS_END) { fprintf(stderr, "kernel_launch: unexpected shapes (n_in %d out %d ws %zu)\n", n_in, out_size, ws_size); grid = -1; return; }
        int dev = 0, cus = 0, per_cu = 0;
        (void)hipGetDevice(&dev); (void)hipDeviceGetAttribute(&cus, hipDeviceAttributeMultiprocessorCount, dev);
        (void)hipFuncSetAttribute((const void*)fwd_kernel, hipFuncAttributeMaxDynamicSharedMemorySize, LDS_BYTES);
        (void)hipOccupancyMaxActiveBlocksPerMultiprocessor(&per_cu, (const void*)fwd_kernel, NT, LDS_BYTES);
        if (per_cu < 1) { fprintf(stderr, "kernel_launch: occupancy query says %d blocks/CU\n", per_cu); per_cu = 1; }
        grid = cus;
        (void)hipGetLastError();
    }
    if (grid < 0) return;
    Args a{};
    a.x = (const float*)d_in[0]; a.pos = (const int*)d_in[1]; a.attn_norm = (const float*)d_in[2]; a.w_in = (const float*)d_in[3];
    a.lb_logits = (const float*)d_in[4]; a.hg_o_norm = (const float*)d_in[5]; a.q_a_norm = (const float*)d_in[6]; a.w_q_up = (const float*)d_in[7];
    a.kv_a_norm = (const float*)d_in[8]; a.w_kv_up = (const float*)d_in[9]; a.q_norm = (const float*)d_in[10]; a.k_norm = (const float*)d_in[11];
    a.mla_o_norm = (const float*)d_in[12]; a.w_out = (const float*)d_in[13]; a.ffn_norm = (const float*)d_in[14]; a.peer_wq = (const float*)d_in[15];
    a.subk = (const float*)d_in[16]; a.peer_u = (const float*)d_in[17]; a.peer_v = (const float*)d_in[18];
    a.out = (float*)d_out; a.ws = (unsigned char*)d_ws;
    const int last = (STOP_AFTER < N_PHASES - 1) ? STOP_AFTER : N_PHASES - 1;
#if N_LAUNCH_MODE == 1
    (void)hipMemsetAsync((unsigned char*)d_ws + WS_CTL, 0, 16384, stream);
    a.ph_lo = 0; a.ph_hi = last + 1;
#ifdef USE_CG_SYNC
    void* args[] = {&a};
    hipError_t e = hipLaunchCooperativeKernel((const void*)fwd_kernel, dim3(grid), dim3(NT), args, LDS_BYTES, stream);
    if (e != hipSuccess) fprintf(stderr, "cooperative launch failed: %s (grid %d)\n", hipGetErrorString(e), grid);
#else
    hipLaunchKernelGGL(fwd_kernel, dim3(grid), dim3(NT), LDS_BYTES, stream, a);
#endif
#else
    for (int ph = 0; ph <= last; ++ph) {
        a.ph_lo = ph; a.ph_hi = ph + 1;
        hipLaunchKernelGGL(fwd_kernel, dim3(grid), dim3(NT), LDS_BYTES, stream, a);
    }
#endif
}
```
